# Optimizing an MI355X kernel written in HIP

```python
import math
import jax, jax.numpy as jnp
from jax import lax
import numpy as np

D_MODEL = 1024
BATCH = 8
SEQ = 4096
DEPTH = 4

CHUNK = 64
QBLOCK = 64
MIX_W = D_MODEL
N_HEADS = 8
HEAD_DIM = 64
ATTN_W = N_HEADS * HEAD_DIM
CONV_CH = MIX_W - ATTN_W
CONV_K = 31
IDX_HEADS = 8
IDX_DIM = 64
TOPK_MAX = 256
NUM_BUCKETS = 32
MAX_DISTANCE = 128
D_FF = 2816
N_EXPERTS = 8
TOP_K = 2
D_FF_EXPERT = 3584
N_DENSE = (DEPTH + 1) // 2
N_MOE = DEPTH // 2
OFF_Q = 0
OFF_K = OFF_Q + ATTN_W
OFF_V = OFF_K + ATTN_W
OFF_QI = OFF_V + ATTN_W
OFF_KI = OFF_QI + IDX_HEADS * IDX_DIM
OFF_WI = OFF_KI + IDX_DIM
OFF_GLU = OFF_WI + IDX_HEADS
IN_COLS = OFF_GLU + 2 * CONV_CH
DN_ALPHA = (2.0 * DEPTH) ** 0.25
DN_BETA = (8.0 * DEPTH) ** -0.25
LN_EPS = 1e-5
NEG = -1e30

kernel_name = "hymba_dsa_conformer_moe_deepnorm"


def layer_norm(x, g, b):
    xf = x.astype(jnp.float32)
    mu = jnp.mean(xf, axis=-1, keepdims=True)
    var = jnp.mean(jnp.square(xf - mu), axis=-1, keepdims=True)
    y = (xf - mu) * lax.rsqrt(var + LN_EPS)
    return (y * g.astype(jnp.float32) + b.astype(jnp.float32)).astype(x.dtype)


def t5_bucket(rel):
    nb = NUM_BUCKETS // 2
    max_exact = nb // 2
    ret = jnp.where(rel > 0, nb, 0).astype(jnp.int32)
    n = jnp.abs(rel)
    nf = jnp.maximum(n, 1).astype(jnp.float32)
    large = max_exact + (jnp.log(nf / max_exact) / math.log(MAX_DISTANCE / max_exact)
                         * (nb - max_exact)).astype(jnp.int32)
    large = jnp.minimum(large, nb - 1)
    return ret + jnp.where(n < max_exact, n, large)


def sparse_attention(q, k, v, q_idx, k_idx, w_idx, rel_bias):
    B, S = q.shape[0], q.shape[1]
    nb = S // QBLOCK
    top_k = min(TOPK_MAX, S // 4)
    key_chunk = jnp.arange(S, dtype=jnp.int32) // CHUNK
    k_flat = k.reshape(B, S, ATTN_W)
    v_flat = v.reshape(B, S, ATTN_W)
    gather = jax.vmap(lambda a, i: a[i])

    def to_blocks(a):
        return jnp.moveaxis(a.reshape((B, nb, QBLOCK) + a.shape[2:]), 1, 0)

    def block_fn(args):
        blk_id, qb, qib, wb = args
        t = blk_id * QBLOCK + jnp.arange(QBLOCK, dtype=jnp.int32)
        t_chunk = t // CHUNK
        dots = jnp.einsum('bthd,bsd->bths', qib, k_idx).astype(jnp.float32) * (IDX_DIM ** -0.5)
        wf = wb.astype(jnp.float32) * (IDX_HEADS ** -0.5)
        score = jnp.einsum('bths,bth->bts', jax.nn.relu(dots), wf)
        admissible = key_chunk[None, :] <= t_chunk[:, None]
        score = jnp.where(admissible[None], score, NEG)
        _, idx = lax.top_k(score, top_k)
        valid = (idx // CHUNK) <= t_chunk[None, :, None]
        flat = idx.reshape(B, QBLOCK * top_k)
        kg = gather(k_flat, flat).reshape(B, QBLOCK, top_k, N_HEADS, HEAD_DIM)
        vg = gather(v_flat, flat).reshape(B, QBLOCK, top_k, N_HEADS, HEAD_DIM)
        logits = jnp.einsum('bthd,btkhd->bthk', qb, kg).astype(jnp.float32) * (HEAD_DIM ** -0.5)
        bucket = t5_bucket(idx - t[None, :, None])
        bias = jnp.moveaxis(rel_bias[bucket], -1, 2)
        logits = logits + bias.astype(jnp.float32)
        logits = jnp.where(valid[:, :, None, :], logits, NEG)
        p = jax.nn.softmax(logits, axis=-1).astype(v.dtype)
        return jnp.einsum('bthk,btkhd->bthd', p, vg)

    out = lax.map(block_fn, (jnp.arange(nb, dtype=jnp.int32), to_blocks(q),
                             to_blocks(q_idx), to_blocks(w_idx)))
    return jnp.moveaxis(out, 0, 1).reshape(B, S, ATTN_W)


def conformer_conv(glu_in, conv_w, conv_b, ln_g, ln_b):
    a, g = glu_in[..., :CONV_CH], glu_in[..., CONV_CH:]
    u = a * jax.nn.sigmoid(g)
    y = lax.conv_general_dilated(u, conv_w[:, None, :], window_strides=(1,),
                                 padding=[(CONV_K - 1, 0)],
                                 dimension_numbers=('NWC', 'WIO', 'NWC'),
                                 feature_group_count=CONV_CH) + conv_b
    y = layer_norm(y, ln_g, ln_b)
    return jax.nn.silu(y)


def swiglu(x, w_gate, w_up, w_down):
    return (jax.nn.silu(x @ w_gate) * (x @ w_up)) @ w_down


def moe_swiglu(x, router, w_gate, w_up, w_down):
    logits = (x @ router).astype(jnp.float32)
    top_vals, top_idx = lax.top_k(logits, TOP_K)
    sel = jax.nn.softmax(top_vals, axis=-1)
    gates = jnp.sum(jax.nn.one_hot(top_idx, N_EXPERTS, dtype=jnp.float32) * sel[..., None], axis=-2)
    gates = gates.astype(x.dtype)
    out = jnp.zeros_like(x)
    for e in range(N_EXPERTS):
        out = out + gates[..., e:e + 1] * swiglu(x, w_gate[e], w_up[e], w_down[e])
    return out


def setup_inputs(seed: int = 0) -> dict:
    key = jax.random.key(seed)
    ks = jax.random.split(key, 24)
    f32 = jnp.float32

    def nrm(k, shape, scale):
        return jax.random.normal(k, shape, f32) * scale

    def gain(k, shape):
        return 1.0 + 0.05 * jax.random.normal(k, shape, f32)

    return {
        "x": nrm(ks[0], (BATCH, SEQ, D_MODEL), 1.0),
        "w_in": nrm(ks[1], (DEPTH, D_MODEL, IN_COLS), D_MODEL ** -0.5),
        "conv_w": nrm(ks[2], (DEPTH, CONV_K, CONV_CH), CONV_K ** -0.5),
        "conv_b": nrm(ks[3], (DEPTH, CONV_CH), 0.02),
        "conv_ln_g": gain(ks[4], (DEPTH, CONV_CH)),
        "conv_ln_b": nrm(ks[5], (DEPTH, CONV_CH), 0.02),
        "mix_scale": gain(ks[6], (DEPTH, MIX_W)),
        "rel_bias": nrm(ks[7], (NUM_BUCKETS, N_HEADS), 0.5),
        "w_out": nrm(ks[8], (DEPTH, MIX_W, D_MODEL), DN_BETA * MIX_W ** -0.5),
        "ln1_g": gain(ks[9], (DEPTH, D_MODEL)),
        "ln1_b": nrm(ks[10], (DEPTH, D_MODEL), 0.02),
        "ln2_g": gain(ks[11], (DEPTH, D_MODEL)),
        "ln2_b": nrm(ks[12], (DEPTH, D_MODEL), 0.02),
        "ffn_w_gate": nrm(ks[13], (N_DENSE, D_MODEL, D_FF), D_MODEL ** -0.5),
        "ffn_w_up": nrm(ks[14], (N_DENSE, D_MODEL, D_FF), D_MODEL ** -0.5),
        "ffn_w_down": nrm(ks[15], (N_DENSE, D_FF, D_MODEL), DN_BETA * D_FF ** -0.5),
        "moe_router": nrm(ks[16], (N_MOE, D_MODEL, N_EXPERTS), D_MODEL ** -0.5),
        "moe_w_gate": nrm(ks[17], (N_MOE, N_EXPERTS, D_MODEL, D_FF_EXPERT), D_MODEL ** -0.5),
        "moe_w_up": nrm(ks[18], (N_MOE, N_EXPERTS, D_MODEL, D_FF_EXPERT), D_MODEL ** -0.5),
        "moe_w_down": nrm(ks[19], (N_MOE, N_EXPERTS, D_FF_EXPERT, D_MODEL), DN_BETA * D_FF_EXPERT ** -0.5),
    }


def reference(x, w_in, conv_w, conv_b, conv_ln_g, conv_ln_b, mix_scale, rel_bias, w_out,
              ln1_g, ln1_b, ln2_g, ln2_b, ffn_w_gate, ffn_w_up, ffn_w_down,
              moe_router, moe_w_gate, moe_w_up, moe_w_down):
    B, S = x.shape[0], x.shape[1]
    for l in range(DEPTH):
        h = x @ w_in[l]
        q = h[..., OFF_Q:OFF_K].reshape(B, S, N_HEADS, HEAD_DIM)
        k = h[..., OFF_K:OFF_V].reshape(B, S, N_HEADS, HEAD_DIM)
        v = h[..., OFF_V:OFF_QI].reshape(B, S, N_HEADS, HEAD_DIM)
        q_idx = h[..., OFF_QI:OFF_KI].reshape(B, S, IDX_HEADS, IDX_DIM)
        k_idx = h[..., OFF_KI:OFF_WI]
        w_idx = h[..., OFF_WI:OFF_GLU]
        glu_in = h[..., OFF_GLU:]
        attn = sparse_attention(q, k, v, q_idx, k_idx, w_idx, rel_bias)
        conv = conformer_conv(glu_in, conv_w[l], conv_b[l], conv_ln_g[l], conv_ln_b[l])
        mixed = jnp.concatenate([attn, conv], axis=-1) * mix_scale[l]
        x = layer_norm(DN_ALPHA * x + mixed @ w_out[l], ln1_g[l], ln1_b[l])
        if l % 2 == 0:
            f = swiglu(x, ffn_w_gate[l // 2], ffn_w_up[l // 2], ffn_w_down[l // 2])
        else:
            m = l // 2
            f = moe_swiglu(x, moe_router[m], moe_w_gate[m], moe_w_up[m], moe_w_down[m])
        x = layer_norm(DN_ALPHA * x + f, ln2_g[l], ln2_b[l])
    return x
```

```cpp
#include <hip/hip_runtime.h>
#include <cstdio>
#include <cstdint>

#define GAS __attribute__((address_space(1)))
#define LAS __attribute__((address_space(3)))
#define CAS __attribute__((address_space(4)))
typedef unsigned short bf16;
typedef short bf16x8 __attribute__((ext_vector_type(8)));
typedef short s16x4 __attribute__((ext_vector_type(4)));
typedef float f32x2 __attribute__((ext_vector_type(2)));
typedef float f32x4 __attribute__((ext_vector_type(4)));
typedef float f32x16 __attribute__((ext_vector_type(16)));
typedef unsigned u32x2 __attribute__((ext_vector_type(2)));
typedef unsigned u32x4 __attribute__((ext_vector_type(4)));
typedef int i32x8 __attribute__((ext_vector_type(8)));

#ifndef PROBE_MASK
#define PROBE_MASK 0
#endif
constexpr int BATCH = 8, SEQ = 4096, DM = 1024, M = BATCH * SEQ, DEPTH = 4;
constexpr int AW = 512, NH = 8, HD = 64, CCH = 512, CK = 31;
constexpr int IN_COLS = 3144, NIN = 3328;
constexpr int OFF_KI = 2048, OFF_WI = 2112, OFF_GLU = 2120;
constexpr int DFF = 2816, DFE = 3584, NE = 8;
constexpr int TOPK = 256;
constexpr float DN_ALPHA = 1.6817928305074290f;
constexpr float LN_EPS = 1e-5f;
constexpr float LOG2E = 1.4426950408889634f;
constexpr float QSCALE = 0.125f * LOG2E;
constexpr int NWAVES = 8, NTHR = 512;
constexpr int MAXT = 272, RT = 272;

constexpr size_t MiB = 1u << 20;
constexpr size_t WS_CTL = 0, CTL_ZERO_BYTES = 1 * MiB;
constexpr size_t WS_WIN = 1 * MiB, WS_WOUT = 8 * MiB, WS_WFF = 10 * MiB;
constexpr size_t WS_R1 = 178 * MiB, WS_XB = 306 * MiB, WS_A = 370 * MiB;
constexpr size_t WS_Q = WS_A, WS_K = WS_A + 32 * MiB, WS_V = WS_A + 64 * MiB, WS_QI = WS_A + 96 * MiB, WS_KI = WS_A + 128 * MiB, WS_WI = WS_A + 132 * MiB,
                 WS_U = WS_A + 133 * MiB, WS_MIX = WS_A + 165 * MiB, WS_H = WS_A;
constexpr size_t WS_YD = 616 * MiB, WS_ROUTE = 752 * MiB, WS_ROWLIST = WS_ROUTE + 512 * 1024, WS_ROWGATE = WS_ROWLIST + 320 * 1024, WS_SLOTROW = WS_ROWGATE + 320 * 1024,
                 WS_CNTWG = WS_SLOTROW + 256 * 1024, WS_MASK = 754 * MiB, WS_XQ = 820 * MiB, WS_END = 852 * MiB;
static_assert((size_t)RT * 256 * DFE <= 246 * MiB && (size_t)M * DFF <= 246 * MiB, "H overlay (fp8)");
static_assert((size_t)MAXT * 256 * DM * 2 <= 136 * MiB, "Yd");
static_assert(WS_CNTWG + 8192 <= WS_MASK && WS_MASK + (size_t)DEPTH * BATCH * 128 * 4096 * 4 <= WS_XQ, "route / masks");
constexpr int CW_BAR = 4096;

constexpr int RING_OFF = 0, RING_BYTES = 131072;
constexpr int AUX_OFF = 131072, AUX_BYTES = 26624;
constexpr int LDSCTL_OFF = AUX_OFF + AUX_BYTES, MISC_OFF = LDSCTL_OFF + 2048;
constexpr int LDS_BYTES = 157 * 1024;
static_assert(MISC_OFF + 128 <= LDS_BYTES, "LDS map");

__device__ __forceinline__ unsigned cvt_pk_bf16(float lo, float hi) { unsigned r; asm volatile("v_cvt_pk_bf16_f32 %0, %1, %2" : "=v"(r) : "v"(lo), "v"(hi)); return r; }
__device__ __forceinline__ float bf2f(unsigned short b) { return __uint_as_float((unsigned)b << 16); }
__device__ __forceinline__ float fsigmoid(float x) { return __builtin_amdgcn_rcpf(1.0f + __builtin_amdgcn_exp2f(-x * LOG2E)); }
#define LDS_WAIT() asm volatile("s_waitcnt lgkmcnt(0)" ::: "memory")
#define VM_WAIT() asm volatile("s_waitcnt vmcnt(0)" ::: "memory")

namespace pg8 {
constexpr int BM = 256, BK = 64, HALF = 128, HTB = HALF * BK * 2, STAGE_BYTES = 8 * HTB, NXCD = 8, WGM = 8;
__host__ __device__ __forceinline__ int lds_byte(int r, int c) { const int st = (r >> 4) * 2 + (c >> 5), rr = r & 15, cc = c & 31, ob = rr * 64 + cc * 2; return st * 1024 + (ob ^ (((ob >> 9) & 1) << 5)); }
__host__ __device__ __forceinline__ void stage_rc(int b, int& R, int& C) { const int st = b / 1024, sb = b % 1024, swz = sb ^ (((sb >> 9) & 1) << 5); R = (st >> 1) * 16 + swz / 64; C = (st & 1) * 32 + (swz % 64) / 2; }
__host__ __device__ __forceinline__ int perm32(int rho) { const int n = rho >> 4, i = rho & 15; return 8 * (i >> 2) + 4 * n + (i & 3); }
struct Unit { int pm, pn; };

struct OrderBase {
    int nM, nN, nwg, G, c;
    __device__ __forceinline__ void init_tiles(int nM_, int nN_, int G_, int c_) { nM = nM_; nN = nN_; nwg = nM * nN; G = G_; c = c_; }
    __device__ __forceinline__ bool next(int i, Unit& u) const { const long L = (long)i * G + c; if (L >= nwg) return false; unit_of((int)L, u); return true; }
    __device__ __forceinline__ void unit_of(int L, Unit& u) const {
        int wgid = L; { const int q = nwg / NXCD, r = nwg % NXCD, xcd = wgid % NXCD, off = wgid / NXCD; wgid = (xcd < r ? xcd * (q + 1) : r * (q + 1) + (xcd - r) * q) + off; }
        const int nig = WGM * nN, gid = wgid / nig, fm = gid * WGM, gsz = (nM - fm) < WGM ? (nM - fm) : WGM;
        u.pm = fm + ((wgid % nig) % gsz); u.pn = (wgid % nig) / gsz;
    }
    __device__ __forceinline__ void a_ready(const Unit&) const {}
    __device__ __forceinline__ void done(const Unit&) const {}
};
struct DenseOrder : OrderBase {
    static constexpr bool GATHER = false;
    const char* Bt; int K;
    __device__ __forceinline__ size_t a_base(const Unit& u) const { return (size_t)u.pm * ((size_t)BM * K * 2); }
    __device__ __forceinline__ unsigned a_off(const Unit&, int) const { return 0u; }
    __device__ __forceinline__ const char* b_base(const Unit& u) const { return Bt + (size_t)u.pn * ((size_t)BM * K * 2); }
};

struct DenseOrderG : OrderBase {
    static constexpr bool GATHER = true;
    const char* Bt; int K;
    __device__ __forceinline__ size_t a_base(const Unit&) const { return 0; }
    __device__ __forceinline__ unsigned a_off(const Unit& u, int r) const { return (unsigned)(u.pm * BM + r) * (unsigned)(K * 2); }
    __device__ __forceinline__ const char* b_base(const Unit& u) const { return Bt + (size_t)u.pn * ((size_t)BM * K * 2); }
};

template <class Epi, class Sched, bool ALIGN_EPI, bool SP2, bool F8 = false>
__device__ __forceinline__ void gemm_phase(const int tid, LAS unsigned char* lds, const char* Abase, const int K, const Sched& S, const Epi& E) {
    const int wid = __builtin_amdgcn_readfirstlane(tid >> 6), lane = tid & 63, wr = wid >> 2, wc = wid & 3, fr = lane & 15, fq = lane >> 4;
    const int nt = K / BK;
    constexpr bool GATHER = Sched::GATHER;
    unsigned voffA[2], voffB[2];
#pragma unroll
    for (int i = 0; i < 2; ++i) { int R, C; stage_rc(tid * 16 + i * 8192, R, C); const int Rb = Epi::PERM ? ((R & ~31) + perm32(R & 31)) : R;
        voffA[i] = GATHER ? (unsigned)C * 2u : (unsigned)(R * K + C) * 2u; voffB[i] = (unsigned)(Rb * K + C) * 2u; }
    const size_t kstep = (size_t)(BK * 2);
    const size_t hstep = (size_t)HALF * K * 2;
    const unsigned ldsw = (unsigned)wid * 1024u;
    const int aoff = lds_byte(wr * 64 + fr, fq * 8), boff = lds_byte(wc * 32 + fr, fq * 8);
#define PG8_SA(b, h) (((b) * 2 + (h)) * HTB)
#define PG8_SB(b, h) ((4 + (b) * 2 + (h)) * HTB)
#define PG8_STAGE(bufoff, gbase, voff) do { _Pragma("unroll") for (int _i = 0; _i < 2; ++_i) \
        __builtin_amdgcn_global_load_lds((const unsigned*)((const char*)(gbase) + (voff)[_i]), (LAS unsigned*)(lds + (bufoff) + ldsw + _i * 8192), 16, 0, 0); } while (0)
typedef int i32x4_t __attribute__((ext_vector_type(4)));
#define PG8_LDA(dst, b, h) do { _Pragma("unroll") for (int m = 0; m < 4; ++m) { if constexpr (F8) { dst[m].lo = *(const LAS i32x4_t*)(lds + PG8_SA(b, h) + aoff + m * 2048); dst[m].hi = *(const LAS i32x4_t*)(lds + PG8_SA(b, h) + aoff + m * 2048 + 1024); } \
        else { _Pragma("unroll") for (int k = 0; k < 2; ++k) dst##b16[m][k] = *(const LAS bf16x8*)(lds + PG8_SA(b, h) + aoff + m * 2048 + k * 1024); } } } while (0)
#define PG8_LDB(dst, b, h) do { _Pragma("unroll") for (int n = 0; n < 2; ++n) { if constexpr (F8) { dst[n].lo = *(const LAS i32x4_t*)(lds + PG8_SB(b, h) + boff + n * 2048); dst[n].hi = *(const LAS i32x4_t*)(lds + PG8_SB(b, h) + boff + n * 2048 + 1024); } \
        else { _Pragma("unroll") for (int k = 0; k < 2; ++k) dst##b16[n][k] = *(const LAS bf16x8*)(lds + PG8_SB(b, h) + boff + n * 2048 + k * 1024); } } } while (0)
#define PG8_MMA(ai, bj, At, Bt) do { __builtin_amdgcn_s_setprio(1); _Pragma("unroll") for (int m = 0; m < 4; ++m) _Pragma("unroll") for (int n = 0; n < 2; ++n) { \
        if constexpr (F8) { acc[ai][bj][m][n] = __builtin_amdgcn_mfma_scale_f32_16x16x128_f8f6f4(Bt[n], At[m], acc[ai][bj][m][n], 0, 0, 0, 0x7f7f7f7f, 0, 0x7f7f7f7f); } \
        else { _Pragma("unroll") for (int k = 0; k < 2; ++k) acc[ai][bj][m][n] = __builtin_amdgcn_mfma_f32_16x16x32_bf16(Bt##b16[n][k], At##b16[m][k], acc[ai][bj][m][n], 0, 0, 0); } } __builtin_amdgcn_s_setprio(0); } while (0)
#define PG8_WAIT_V(n) asm volatile("s_waitcnt vmcnt(" #n ")" ::: "memory")
#define PG8_WAIT_L(n) asm volatile("s_waitcnt lgkmcnt(" #n ")" ::: "memory")
#define PG8_BAR __builtin_amdgcn_s_barrier()
#define PG8_SCHED __builtin_amdgcn_sched_barrier(0)
    Unit cur, nxt; int ui = 0;
    if (!S.next(0, cur)) return;
    f32x4 acc[2][2][4][2];
    { float z0 = 0.f; asm volatile("" : "+v"(z0));
#pragma unroll
    for (int a = 0; a < 2; ++a)
#pragma unroll
        for (int b = 0; b < 2; ++b)
#pragma unroll
            for (int m = 0; m < 4; ++m)
#pragma unroll
                for (int n = 0; n < 2; ++n) acc[a][b][m][n] = (f32x4){z0, z0, z0, z0}; }
    bf16x8 Atb16[F8 ? 1 : 4][2], B0b16[F8 ? 1 : 2][2], B1b16[F8 ? 1 : 2][2]; i32x8 At[F8 ? 4 : 1], B0[F8 ? 2 : 1], B1[F8 ? 2 : 1]; (void)Atb16; (void)B0b16; (void)B1b16; (void)At; (void)B0; (void)B1;
    unsigned cOff0[2], cOff1[2];
#define PG8_ROWS(u) do { if constexpr (GATHER) { _Pragma("unroll") for (int _i = 0; _i < 2; ++_i) { int R_, C_; stage_rc(tid * 16 + _i * 8192, R_, C_); cOff0[_i] = S.a_off(u, R_) + voffA[_i]; cOff1[_i] = S.a_off(u, HALF + R_) + voffA[_i]; } } } while (0)
#define PG8_STAGE_A(bufoff, h, ptr) do { if constexpr (GATHER) { if ((h) == 0) PG8_STAGE(bufoff, ptr, cOff0); else PG8_STAGE(bufoff, ptr, cOff1); } else { PG8_STAGE(bufoff, (ptr) + (h) * hstep, voffA); } } while (0)
    const char* cA = Abase; if constexpr (!GATHER) cA = Abase + S.a_base(cur);
    PG8_ROWS(cur);
    const char* cB = S.b_base(cur);
    S.a_ready(cur);
    {
        PG8_STAGE(PG8_SB(0, 0), cB, voffB); PG8_STAGE(PG8_SB(0, 1), cB + hstep, voffB); PG8_STAGE_A(PG8_SA(0, 0), 0, cA); PG8_STAGE_A(PG8_SA(0, 1), 1, cA);
        if (wr == 1) PG8_BAR;
        PG8_WAIT_V(2); PG8_BAR;
        PG8_STAGE(PG8_SB(1, 0), cB + kstep, voffB); PG8_STAGE_A(PG8_SA(1, 0), 0, cA + kstep); PG8_STAGE(PG8_SB(1, 1), cB + hstep + kstep, voffB);
        PG8_WAIT_V(6); PG8_BAR;
    }
    for (;;) {
        const bool has_next = S.next(ui + 1, nxt);
        unsigned nOff0[2] = {0u, 0u}, nOff1[2] = {0u, 0u};
        if constexpr (GATHER) { if (has_next) { _Pragma("unroll") for (int _i = 0; _i < 2; ++_i) { int R_, C_; stage_rc(tid * 16 + _i * 8192, R_, C_); nOff0[_i] = S.a_off(nxt, R_); nOff1[_i] = S.a_off(nxt, HALF + R_); } } }
        const char* nA = cA; if constexpr (!GATHER) { if (has_next) nA = Abase + S.a_base(nxt); }
        const char* nB = has_next ? S.b_base(nxt) : cB;
#pragma nounroll
        for (int t = 0; t < nt; t += 2) {
            const bool last = (t == nt - 2);
            const char* a1 = cA + (size_t)(t + 1) * kstep;
            const char* a2 = last ? nA : cA + (size_t)(t + 2) * kstep; const char* b2 = last ? nB : cB + (size_t)(t + 2) * kstep;
            const char* a3 = a2 + kstep; const char* b3 = b2 + kstep;
            if (last && has_next) S.a_ready(nxt);
            if constexpr (SP2) {
            PG8_LDB(B0, 0, 0); PG8_LDB(B1, 0, 1); PG8_SCHED; PG8_LDA(At, 0, 0); PG8_STAGE_A(PG8_SA(1, 1), 1, a1);
            if constexpr (GATHER) { if (last && has_next) { _Pragma("unroll") for (int _i = 0; _i < 2; ++_i) { cOff0[_i] = nOff0[_i] + voffA[_i]; cOff1[_i] = nOff1[_i] + voffA[_i]; } } }
            PG8_WAIT_V(8); PG8_WAIT_L(0); PG8_BAR; PG8_MMA(0, 0, At, B0); PG8_MMA(0, 1, At, B1); PG8_BAR; PG8_SCHED;
            PG8_LDA(At, 0, 1); PG8_STAGE(PG8_SB(0, 0), b2, voffB); PG8_STAGE(PG8_SB(0, 1), b2 + hstep, voffB); PG8_STAGE_A(PG8_SA(0, 0), 0, a2);
            PG8_WAIT_V(8); PG8_WAIT_L(0); PG8_BAR; PG8_MMA(1, 0, At, B0); PG8_MMA(1, 1, At, B1); PG8_BAR; PG8_SCHED;
            PG8_LDB(B0, 1, 0); PG8_LDB(B1, 1, 1); PG8_SCHED; PG8_LDA(At, 1, 0); PG8_STAGE_A(PG8_SA(0, 1), 1, a2);
            PG8_WAIT_V(8); PG8_WAIT_L(0); PG8_BAR; PG8_MMA(0, 0, At, B0); PG8_MMA(0, 1, At, B1); PG8_BAR; PG8_SCHED;
            PG8_LDA(At, 1, 1); PG8_STAGE(PG8_SB(1, 0), b3, voffB); PG8_STAGE(PG8_SB(1, 1), b3 + hstep, voffB); PG8_STAGE_A(PG8_SA(1, 0), 0, a3);
            PG8_WAIT_V(8); PG8_WAIT_L(0); PG8_BAR; PG8_MMA(1, 0, At, B0); PG8_MMA(1, 1, At, B1); PG8_BAR; PG8_SCHED;
            } else { static_assert(SP2, "only the two-super-phase loop is kept"); }
        }
        if constexpr (ALIGN_EPI) { if (wr == 0) PG8_BAR; }
        E(acc, cur, wr, wc, fr, fq); S.done(cur);
        if (!has_next) break;
        { float z0 = 0.f; asm volatile("" : "+v"(z0));
#pragma unroll
        for (int a = 0; a < 2; ++a)
#pragma unroll
            for (int b = 0; b < 2; ++b)
#pragma unroll
                for (int m = 0; m < 4; ++m)
#pragma unroll
                    for (int n = 0; n < 2; ++n) acc[a][b][m][n] = (f32x4){z0, z0, z0, z0}; }
        cur = nxt; cA = nA; cB = nB; ++ui;
        if constexpr (ALIGN_EPI) { if (wr == 1) PG8_BAR; }
    }
    PG8_WAIT_V(0);
    if constexpr (!ALIGN_EPI) { if (wr == 0) PG8_BAR; }
    PG8_BAR;
#undef PG8_SA
#undef PG8_SB
#undef PG8_STAGE
#undef PG8_STAGE_A
#undef PG8_ROWS
#undef PG8_LDA
#undef PG8_LDB
#undef PG8_MMA
#undef PG8_WAIT_V
#undef PG8_WAIT_L
#undef PG8_BAR
#undef PG8_SCHED
}
}

namespace pg8 {
__device__ __forceinline__ u32x4 pack8(const f32x4 v0, const f32x4 v1) { u32x4 w; w.x = cvt_pk_bf16(v0[0], v0[1]); w.y = cvt_pk_bf16(v0[2], v0[3]); w.z = cvt_pk_bf16(v1[0], v1[1]); w.w = cvt_pk_bf16(v1[2], v1[3]); return w; }

__device__ __forceinline__ unsigned pk4_fp8(float a, float b, float c, float d) {
    a = __builtin_amdgcn_fmed3f(a, -448.f, 448.f); b = __builtin_amdgcn_fmed3f(b, -448.f, 448.f); c = __builtin_amdgcn_fmed3f(c, -448.f, 448.f); d = __builtin_amdgcn_fmed3f(d, -448.f, 448.f);
    unsigned r = 0u; r = (unsigned)__builtin_amdgcn_cvt_pk_fp8_f32(a, b, (int)r, false); r = (unsigned)__builtin_amdgcn_cvt_pk_fp8_f32(c, d, (int)r, true); return r; }
__device__ __forceinline__ u32x2 pack8_fp8(const f32x4 v0, const f32x4 v1) { u32x2 w; w.x = pk4_fp8(v0[0], v0[1], v0[2], v0[3]); w.y = pk4_fp8(v1[0], v1[1], v1[2], v1[3]); return w; }
constexpr float F8_ASC = 16.f, F8_WGU = 64.f, F8_HSC = 8.f, F8_WDN = 256.f;
struct EpiIn {
    static constexpr bool PERM = true;
    bf16 *Q, *Kb, *V, *QI, *KI, *U; float* WI; int pn_off; float dsc; int glu_from;
    __device__ __forceinline__ void operator()(const f32x4 (&acc)[2][2][4][2], const Unit& u, int wr, int wc, int fr, int fq) const {
        const int row0 = u.pm * BM + wr * 64 + fr; const int pn = (u.pn >= glu_from) ? u.pn - glu_from + 9 : u.pn + pn_off;
        if (pn < 2 || (pn >= 6 && pn < 8)) {
            bf16* base = (pn < 2) ? Q : QI;
            const float sc = ((pn < 2) ? QSCALE : 1.0f) * dsc;
            const int col0 = (pn & 1) * 256 + wc * 32 + 8 * fq;
#pragma unroll
            for (int ai = 0; ai < 2; ++ai)
#pragma unroll
                for (int m = 0; m < 4; ++m) { bf16* rowp = base + (size_t)(row0 + ai * HALF + m * 16) * AW + col0;
#pragma unroll
                    for (int bj = 0; bj < 2; ++bj) *(u32x4*)(rowp + bj * HALF) = pack8(acc[ai][bj][m][0] * sc, acc[ai][bj][m][1] * sc); }
        } else if (pn < 6) {
            const bool isK = pn < 4; bf16* base = isK ? Kb : V;
#pragma unroll
            for (int ai = 0; ai < 2; ++ai)
#pragma unroll
                for (int m = 0; m < 4; ++m) { const int row = row0 + ai * HALF + m * 16, bb = row >> 12, t = row & 4095, tile = t >> 6, r = t & 63;
#pragma unroll
                    for (int bj = 0; bj < 2; ++bj) { const int col = (pn & 1) * 256 + bj * HALF + wc * 32 + 8 * fq, h = col >> 6, d = col & 63;
                        const size_t tb = ((size_t)((bb * NH + h) * 64 + tile)) * 4096;
                        const size_t off = isK ? tb + (d >> 3) * 512 + r * 8 : tb + (d >> 5) * 2048 + r * 32 + (d & 31);
                        *(u32x4*)(base + off) = pack8(acc[ai][bj][m][0] * dsc, acc[ai][bj][m][1] * dsc); } }
        } else if (pn == 8) {
#pragma unroll
            for (int ai = 0; ai < 2; ++ai)
#pragma unroll
                for (int m = 0; m < 4; ++m) { const size_t row = (size_t)(row0 + ai * HALF + m * 16);
                    if (wc < 2) { const int c8 = wc * 4 + fq;
                        *(u32x4*)(KI + (row >> 5) * 2048 + (c8 >> 1) * 512 + (c8 & 1) * 256 + (row & 31) * 8) = pack8(acc[ai][0][m][0] * dsc, acc[ai][0][m][1] * dsc); }
                    else if (wc == 2 && fq == 0) { *(f32x4*)(WI + row * 8) = acc[ai][0][m][0] * dsc; *(f32x4*)(WI + row * 8 + 4) = acc[ai][0][m][1] * dsc; } }
        } else {
            const int col0 = (pn - 9) * 128 + wc * 32 + 8 * fq;
#pragma unroll
            for (int ai = 0; ai < 2; ++ai)
#pragma unroll
                for (int m = 0; m < 4; ++m) { f32x4 o[2];
#pragma unroll
                    for (int n = 0; n < 2; ++n) { const f32x4 a = acc[ai][0][m][n], g = acc[ai][1][m][n];
#pragma unroll
                        for (int e = 0; e < 4; ++e) o[n][e] = a[e] * dsc * fsigmoid(g[e] * dsc); }
                    *(u32x4*)(U + (size_t)(row0 + ai * HALF + m * 16) * CCH + col0) = pack8(o[0], o[1]); }
        }
    }
};
struct EpiRes {
    static constexpr bool PERM = true;
    const bf16* base; bf16* out; float asc;
    __device__ __forceinline__ void operator()(const f32x4 (&acc)[2][2][4][2], const Unit& u, int wr, int wc, int fr, int fq) const {
        const int row0 = u.pm * BM + wr * 64 + fr, col0 = u.pn * BM + wc * 32 + 8 * fq;
#pragma unroll
        for (int ai = 0; ai < 2; ++ai) {
            u32x4 bsv[4][2];
#pragma unroll
            for (int m = 0; m < 4; ++m)
#pragma unroll
                for (int bj = 0; bj < 2; ++bj) bsv[m][bj] = __builtin_nontemporal_load((const u32x4*)(base + (size_t)(row0 + ai * HALF + m * 16) * DM + col0 + bj * HALF));
#pragma unroll
            for (int m = 0; m < 4; ++m) { const size_t off = (size_t)(row0 + ai * HALF + m * 16) * DM + col0;
#pragma unroll
                for (int bj = 0; bj < 2; ++bj) { const u32x4 bs = bsv[m][bj];
                    f32x4 b0, b1; b0[0] = __uint_as_float(bs.x << 16); b0[1] = __uint_as_float(bs.x & 0xffff0000u); b0[2] = __uint_as_float(bs.y << 16); b0[3] = __uint_as_float(bs.y & 0xffff0000u);
                    b1[0] = __uint_as_float(bs.z << 16); b1[1] = __uint_as_float(bs.z & 0xffff0000u); b1[2] = __uint_as_float(bs.w << 16); b1[3] = __uint_as_float(bs.w & 0xffff0000u);
                    *(u32x4*)(out + off + bj * HALF) = pack8(b0 * DN_ALPHA + acc[ai][bj][m][0] * asc, b1 * DN_ALPHA + acc[ai][bj][m][1] * asc); } }
        }
    }
};
struct EpiSwi {
    static constexpr bool PERM = true;
    unsigned char* H; int ldh;
    __device__ __forceinline__ void operator()(const f32x4 (&acc)[2][2][4][2], const Unit& u, int wr, int wc, int fr, int fq) const {
        const int row0 = u.pm * BM + wr * 64 + fr, col0 = u.pn * 128 + wc * 32 + 8 * fq;
        constexpr float ds = 1.0f / (F8_ASC * F8_WGU);
#pragma unroll
        for (int ai = 0; ai < 2; ++ai)
#pragma unroll
            for (int m = 0; m < 4; ++m) { f32x4 o[2];
#pragma unroll
                for (int n = 0; n < 2; ++n) { const f32x4 g = acc[ai][0][m][n] * ds, up = acc[ai][1][m][n] * (ds * F8_HSC);
#pragma unroll
                    for (int e = 0; e < 4; ++e) o[n][e] = g[e] * fsigmoid(g[e]) * up[e]; }
                *(u32x2*)(H + (size_t)(row0 + ai * HALF + m * 16) * ldh + col0) = pack8_fp8(o[0], o[1]); }
    }
};
struct EpiMoeDown {
    static constexpr bool PERM = true;
    bf16* Yd; const float* rowgate; int tlo;
    __device__ __forceinline__ void operator()(const f32x4 (&acc)[2][2][4][2], const Unit& u, int wr, int wc, int fr, int fq) const {
        const int row0 = (tlo + u.pm) * BM + wr * 64 + fr, col0 = u.pn * BM + wc * 32 + 8 * fq;
#pragma unroll
        for (int ai = 0; ai < 2; ++ai)
#pragma unroll
            for (int m = 0; m < 4; ++m) { const int row = row0 + ai * HALF + m * 16; const float gt = rowgate[row] * (1.0f / (F8_HSC * F8_WDN)); bf16* rowp = Yd + (size_t)row * DM + col0;
#pragma unroll
                for (int bj = 0; bj < 2; ++bj) *(u32x4*)(rowp + bj * HALF) = pack8(acc[ai][bj][m][0] * gt, acc[ai][bj][m][1] * gt); }
    }
};
struct MoeGuOrder : OrderBase {
    static constexpr bool GATHER = true;
    const int* rowlist; const LAS int* texp; int tlo; const char* W; size_t estride;
    __device__ __forceinline__ size_t a_base(const Unit&) const { return 0; }
    __device__ __forceinline__ unsigned a_off(const Unit& u, int r) const { return (unsigned)rowlist[(tlo + u.pm) * BM + r] * (unsigned)DM; }
    __device__ __forceinline__ const char* b_base(const Unit& u) const { return W + (size_t)texp[tlo + u.pm] * estride + (size_t)u.pn * ((size_t)BM * DM); }
};
struct MoeDnOrder : OrderBase {
    static constexpr bool GATHER = true;
    const LAS int* texp; int tlo; const char* W; size_t estride;
    __device__ __forceinline__ size_t a_base(const Unit&) const { return 0; }
    __device__ __forceinline__ unsigned a_off(const Unit& u, int r) const { return (unsigned)(u.pm * BM + r) * (unsigned)DFE; }
    __device__ __forceinline__ const char* b_base(const Unit& u) const { return W + (size_t)texp[tlo + u.pm] * estride + (size_t)u.pn * ((size_t)BM * DFE); }
};
}

typedef GAS unsigned gu32;
#define RLX_AGENT __ATOMIC_RELAXED, __HIP_MEMORY_SCOPE_AGENT
#define XB_TMO      128
#define XB_XCNT(j)  (256  + 64 * (j))
#define XB_XSUB(j)  (1280 + 64 * (j))
#define XB_XGEN(j)  (2304 + 64 * (j))
#define XB_TOP      3328
#define XB_TOPGEN   3392
#define XCD_BAR_WORDS 3456
#define XB_SPIN_CAP (1u << 18)

__device__ __forceinline__ unsigned xb_ld(unsigned* p)              { return __hip_atomic_load(p, __ATOMIC_RELAXED, __HIP_MEMORY_SCOPE_AGENT); }
__device__ __forceinline__ unsigned xb_add(unsigned* p, unsigned v) { return __hip_atomic_fetch_add(p, v, __ATOMIC_RELAXED, __HIP_MEMORY_SCOPE_AGENT); }
__device__ __forceinline__ unsigned xb_xcc_id() { return (unsigned)__builtin_amdgcn_s_getreg((3 << 11) | 20) & 0xFu; }
#define XB_SPIN(cond, bar) do { unsigned _sp = 0; while (cond) { __builtin_amdgcn_s_sleep(1); \
    if ((++_sp & 255u) == 0u) { if (xb_ld(&(bar)[XB_TMO])) break; if (_sp > XB_SPIN_CAP) { atomicAdd(&(bar)[XB_TMO], 1u); break; } } } } while (0)

struct XcdBarrier {
    unsigned* bar; unsigned x;
    volatile LAS unsigned* st;
};
__device__ __forceinline__ XcdBarrier xcd_barrier_post(unsigned* bar, volatile LAS unsigned* st) {
    XcdBarrier b; b.bar = bar; b.x = xb_xcc_id(); b.st = st;
    if (threadIdx.x == 0) (void)xb_add(&bar[XB_XCNT(b.x)], 1u);
    return b;
}
__device__ __forceinline__ void xcd_barrier_complete(unsigned* bar, unsigned x, unsigned& nloc, unsigned& nx) {
    const unsigned G = gridDim.x * gridDim.y * gridDim.z;
    unsigned sum, cnt, mine, sp = 0u;
    for (;;) {
        sum = 0u; cnt = 0u; mine = 0u;
#pragma unroll
        for (unsigned j = 0; j < 16; ++j) { const unsigned c = xb_ld(&bar[XB_XCNT(j)]); sum += c; cnt += (c > 0u) ? 1u : 0u; mine = (j == x) ? c : mine; }
        if (sum == G) break;
        __builtin_amdgcn_s_sleep(1);
        if ((++sp & 255u) == 0u) { if (xb_ld(&bar[XB_TMO])) break; if (sp > XB_SPIN_CAP) { atomicAdd(&bar[XB_TMO], 1u); break; } }
    }
    nloc = mine > 0u ? mine : 1u; nx = cnt > 0u ? cnt : 1u;
}
__device__ __forceinline__ void xcd_barrier(const XcdBarrier& b) {
    asm volatile("s_waitcnt vmcnt(0)" ::: "memory");
    __syncthreads();
    if (threadIdx.x == 0) {
        unsigned* bar = b.bar;
        __builtin_amdgcn_s_waitcnt(0);
        unsigned nloc = b.st[0], nx = b.st[1];
        if (nloc == 0u) { xcd_barrier_complete(bar, b.x, nloc, nx); b.st[0] = nloc; b.st[1] = nx; }
        const unsigned old = xb_add(&bar[XB_XSUB(b.x)], 1u);
        const unsigned gen = old / nloc;
        if (old + 1u == (gen + 1u) * nloc) {
            __builtin_amdgcn_fence(__ATOMIC_RELEASE, "agent");
            asm volatile("s_waitcnt vmcnt(0)" ::: "memory");
            const unsigned og = xb_add(&bar[XB_TOP], 1u);
            const unsigned tg = og / nx;
            if (og + 1u == (tg + 1u) * nx) xb_add(&bar[XB_TOPGEN], 1u);
            else XB_SPIN(xb_ld(&bar[XB_TOPGEN]) == tg, bar);
            __builtin_amdgcn_fence(__ATOMIC_ACQUIRE, "agent");
            xb_add(&bar[XB_XGEN(b.x)], 1u);
            asm volatile("s_waitcnt vmcnt(0)" ::: "memory");
        } else {
            XB_SPIN(xb_ld(&bar[XB_XGEN(b.x)]) == gen, bar);
            __builtin_amdgcn_fence(__ATOMIC_ACQUIRE, "agent");
            asm volatile("s_waitcnt vmcnt(0)" ::: "memory");
        }
    }
    __syncthreads();
}

struct Frame {
    LAS unsigned char* lds;
    int tid, lane, wave, vcu, G;
    unsigned char* ws;
};
__device__ __forceinline__ const float* arg_in(int k) { return (const float*)*(const GAS float* const volatile CAS*)((const CAS char*)__builtin_amdgcn_kernarg_segment_ptr() + 8 * k); }
__device__ __forceinline__ float* arg_out() { return (float*)*(GAS float* const volatile CAS*)((const CAS char*)__builtin_amdgcn_kernarg_segment_ptr() + 160); }
#define WSP(T, off) ((T*)(F.ws + (off)))
__device__ __forceinline__ Frame fresh(const Frame& F0) {
    Frame F = F0; int wv = F0.wave, v = F0.vcu, g = F0.G; asm volatile("" : "+s"(wv), "+s"(v), "+s"(g)); F.wave = wv; F.vcu = v; F.G = g;
    int ln; asm volatile("v_mbcnt_lo_u32_b32 %0, -1, 0\n\tv_mbcnt_hi_u32_b32 %0, -1, %0" : "=v"(ln)); F.lane = ln; F.tid = wv * 64 + ln;
    GAS unsigned char* w = (GAS unsigned char*)F0.ws; asm volatile("" : "+s"(w)); F.ws = (unsigned char*)w;
    return F;
}

__device__ __forceinline__ float wave_sum(float v) {
#define WS_DPP(x, ctrl) __int_as_float(__builtin_amdgcn_update_dpp(0, __float_as_int(x), (ctrl), 0xf, 0xf, false))
    v += WS_DPP(v, 0xB1); v += WS_DPP(v, 0x4E); v += WS_DPP(v, 0x141); v += WS_DPP(v, 0x140);
#undef WS_DPP
    const float r0 = __int_as_float(__builtin_amdgcn_readlane(__float_as_int(v), 0)), r1 = __int_as_float(__builtin_amdgcn_readlane(__float_as_int(v), 16)),
                r2 = __int_as_float(__builtin_amdgcn_readlane(__float_as_int(v), 32)), r3 = __int_as_float(__builtin_amdgcn_readlane(__float_as_int(v), 48));
    return (r0 + r1) + (r2 + r3);
}

template <bool FP8> __device__ __forceinline__ void tr_item64(const float* W, int ldw, int c0, int nvalid, int k0, void* WT, int Kd, int r0, float scale, LAS float* scr, int lane) {
    const int n4 = 4 * (lane & 15); const bool ok = n4 < nvalid;
    const float* src = W + (size_t)(k0 + (lane >> 4)) * ldw + c0 + n4;
#pragma unroll 8
    for (int i = 0; i < 16; ++i) { f32x4 v = {0.f, 0.f, 0.f, 0.f}; if (ok) v = *(const f32x4*)(src + (size_t)(4 * i) * ldw);
        LAS float* d = scr + (4 * i + (lane >> 4)) * 65 + n4; d[0] = v[0]; d[1] = v[1]; d[2] = v[2]; d[3] = v[3]; }
    LDS_WAIT(); asm volatile("" ::: "memory");
    const int c = lane & 7;
#pragma unroll
    for (int j = 0; j < 8; ++j) { const int nn = (lane >> 3) + 8 * j; const LAS float* s = scr + (8 * c) * 65 + nn;
        if constexpr (FP8) { u32x2 o; o.x = pg8::pk4_fp8(s[0 * 65] * scale, s[1 * 65] * scale, s[2 * 65] * scale, s[3 * 65] * scale); o.y = pg8::pk4_fp8(s[4 * 65] * scale, s[5 * 65] * scale, s[6 * 65] * scale, s[7 * 65] * scale);
            *(u32x2*)((unsigned char*)WT + (size_t)(r0 + nn) * Kd + k0 + 8 * c) = o; }
        else { u32x4 o; o.x = cvt_pk_bf16(s[0 * 65], s[1 * 65]); o.y = cvt_pk_bf16(s[2 * 65], s[3 * 65]); o.z = cvt_pk_bf16(s[4 * 65], s[5 * 65]); o.w = cvt_pk_bf16(s[6 * 65], s[7 * 65]);
            *(u32x4*)((bf16*)WT + (size_t)(r0 + nn) * Kd + k0 + 8 * c) = o; } }
    LDS_WAIT(); asm volatile("" ::: "memory");
}

__device__ __forceinline__ void convert_weights(Frame& F, int l) {
    LAS float* scr = (LAS float*)(F.lds + RING_OFF + F.wave * 16640);
    const int gw = F.vcu * NWAVES + F.wave, NGW = F.G * NWAVES, lane = F.lane;
    bf16* WinT = WSP(bf16, WS_WIN); bf16* WoutT = WSP(bf16, WS_WOUT); unsigned char* Wff = WSP(unsigned char, WS_WFF);
    const float* w_in = arg_in(1) + (size_t)l * DM * IN_COLS;
    const float* w_out = arg_in(8) + (size_t)l * DM * DM;
    constexpr int I_IN = (NIN / 64) * 16, I_OUT = 16 * 16;
    for (int it = gw; it < I_IN + I_OUT; it += NGW) {
        if (it < I_IN) {
            const int nb = it >> 4, kb = it & 15; int c0 = 0, nv = 64;
            if (nb < 33) c0 = 64 * nb;
            else if (nb == 33) { c0 = OFF_WI; nv = 8; }
            else if (nb < 36) { nv = 0; }
            else { const int rr = 64 * (nb - 36), p = rr >> 8, w = rr & 255; c0 = (w < 128) ? (OFF_GLU + 128 * p + w) : (OFF_GLU + CCH + 128 * p + (w - 128)); }
            if (nb < 24) tr_item64<true>(w_in, IN_COLS, c0, nv, 64 * kb, WinT, DM, 64 * nb, pg8::F8_WGU, scr, lane);
            else if (nb >= 36) tr_item64<true>(w_in, IN_COLS, c0, nv, 64 * kb, WinT, DM, 64 * (nb - 12), pg8::F8_WGU, scr, lane);
            else tr_item64<false>(w_in, IN_COLS, c0, nv, 64 * kb, WinT, DM, 64 * nb, 1.f, scr, lane);
        } else { const int r = it - I_IN, nb = r >> 4, kb = r & 15; tr_item64<false>(w_out, DM, 64 * nb, 64, 64 * kb, WoutT, DM, 64 * nb, 1.f, scr, lane); }
    }
    if ((l & 1) == 0) {
        const int d = l >> 1;
        const float* wg = arg_in(13) + (size_t)d * DM * DFF; const float* wu = arg_in(14) + (size_t)d * DM * DFF; const float* wd = arg_in(15) + (size_t)d * DFF * DM;
        unsigned char* Wgu = Wff; unsigned char* Wdn = Wgu + (size_t)2 * DFF * DM;
        constexpr int I_GU = (2 * DFF / 64) * 16, I_DN = 16 * (DFF / 64);
        for (int it = gw; it < I_GU + I_DN; it += NGW) {
            if (it < I_GU) { const int nb = it >> 4, kb = it & 15, rr = 64 * nb, p = rr >> 8, w = rr & 255;
                tr_item64<true>((w < 128) ? wg : wu, DFF, 128 * p + (w & 127), 64, 64 * kb, Wgu, DM, rr, pg8::F8_WGU, scr, lane); }
            else { const int r = it - I_GU, nb = r / (DFF / 64), kb = r % (DFF / 64); tr_item64<true>(wd, DM, 64 * nb, 64, 64 * kb, Wdn, DFF, 64 * nb, pg8::F8_WDN, scr, lane); }
        }
    } else {
        const int d = l >> 1;
        constexpr int I_GU = (2 * DFE / 64) * 16, I_DN = 16 * (DFE / 64), I_E = I_GU + I_DN;
        for (int it = gw; it < NE * I_E; it += NGW) {
            const int e = it / I_E, r0 = it % I_E;
            const float* wg = arg_in(17) + ((size_t)d * NE + e) * DM * DFE; const float* wu = arg_in(18) + ((size_t)d * NE + e) * DM * DFE; const float* wd = arg_in(19) + ((size_t)d * NE + e) * DFE * DM;
            unsigned char* Wgu = Wff + (size_t)e * (3 * (size_t)DFE * DM); unsigned char* Wdn = Wgu + (size_t)2 * DFE * DM;
            if (r0 < I_GU) { const int nb = r0 >> 4, kb = r0 & 15, rr = 64 * nb, p = rr >> 8, w = rr & 255;
                tr_item64<true>((w < 128) ? wg : wu, DFE, 128 * p + (w & 127), 64, 64 * kb, Wgu, DM, rr, pg8::F8_WGU, scr, lane); }
            else { const int r = r0 - I_GU, nb = r / (DFE / 64), kb = r % (DFE / 64); tr_item64<true>(wd, DM, 64 * nb, 64, 64 * kb, Wdn, DFE, 64 * nb, pg8::F8_WDN, scr, lane); }
        }
    }
}

__device__ __forceinline__ void cvt_x(Frame& F) {
    const float* x = arg_in(0); bf16* XB = WSP(bf16, WS_XB); unsigned char* XQ = WSP(unsigned char, WS_XQ);
    const int gw = F.vcu * NWAVES + F.wave, NGW = F.G * NWAVES;
    for (int m = gw; m < M; m += NGW) {
        const f32x4* xr = (const f32x4*)(x + (size_t)m * DM) + F.lane; u32x2* o = (u32x2*)(XB + (size_t)m * DM) + F.lane; unsigned* o8 = (unsigned*)(XQ + (size_t)m * DM) + F.lane;
#pragma unroll
        for (int j = 0; j < 4; ++j) { const f32x4 v = xr[64 * j]; u32x2 w; w.x = cvt_pk_bf16(v[0], v[1]); w.y = cvt_pk_bf16(v[2], v[3]); o[64 * j] = w;
            o8[64 * j] = pg8::pk4_fp8(v[0] * pg8::F8_ASC, v[1] * pg8::F8_ASC, v[2] * pg8::F8_ASC, v[3] * pg8::F8_ASC); }
    }
}

__device__ __forceinline__ void ln_load(const bf16* row, f32x4 (&v)[4], int lane) {
#pragma unroll
    for (int j = 0; j < 4; ++j) { const u32x2 a = ((const u32x2*)row)[lane + 64 * j]; v[j][0] = __uint_as_float(a.x << 16); v[j][1] = __uint_as_float(a.x & 0xffff0000u); v[j][2] = __uint_as_float(a.y << 16); v[j][3] = __uint_as_float(a.y & 0xffff0000u); }
}
template <bool FP8OUT> __device__ __forceinline__ void ln_finish(f32x4 (&v)[4], const f32x4 (&g)[4], const f32x4 (&bb)[4], bf16* brow, unsigned char* qrow, float* frow, int lane) {
    float s = 0.f;
#pragma unroll
    for (int j = 0; j < 4; ++j) s += (v[j][0] + v[j][1]) + (v[j][2] + v[j][3]);
    const float mean = wave_sum(s) * (1.f / DM); float s2 = 0.f;
#pragma unroll
    for (int j = 0; j < 4; ++j) { v[j] = v[j] - mean; s2 += (v[j][0] * v[j][0] + v[j][1] * v[j][1]) + (v[j][2] * v[j][2] + v[j][3] * v[j][3]); }
    const float rstd = 1.f / sqrtf(wave_sum(s2) * (1.f / DM) + LN_EPS);
#pragma unroll
    for (int j = 0; j < 4; ++j) { v[j] = v[j] * rstd * g[j] + bb[j];
        { u32x2 w; w.x = cvt_pk_bf16(v[j][0], v[j][1]); w.y = cvt_pk_bf16(v[j][2], v[j][3]); ((u32x2*)brow)[lane + 64 * j] = w; }
        if constexpr (FP8OUT) { ((unsigned*)qrow)[lane + 64 * j] = pg8::pk4_fp8(v[j][0] * pg8::F8_ASC, v[j][1] * pg8::F8_ASC, v[j][2] * pg8::F8_ASC, v[j][3] * pg8::F8_ASC); }
        else { if (frow) ((f32x4*)frow)[lane + 64 * j] = v[j];
               if (qrow) ((unsigned*)qrow)[lane + 64 * j] = pg8::pk4_fp8(v[j][0] * pg8::F8_ASC, v[j][1] * pg8::F8_ASC, v[j][2] * pg8::F8_ASC, v[j][3] * pg8::F8_ASC); } }
}

__device__ __forceinline__ void p_ln1(Frame& F, int l) {
    bf16* R1 = WSP(bf16, WS_R1); bf16* XB = WSP(bf16, WS_XB);
    const bool moe = (l & 1) != 0;
    LAS int* cntL = (LAS int*)(F.lds + LDSCTL_OFF + 1152);
    if (F.tid < 8) cntL[F.tid] = 0;
    __syncthreads();
    f32x4 g[4], bb[4];
#pragma unroll
    for (int j = 0; j < 4; ++j) { g[j] = ((const f32x4*)(arg_in(9) + (size_t)l * DM))[F.lane + 64 * j]; bb[j] = ((const f32x4*)(arg_in(10) + (size_t)l * DM))[F.lane + 64 * j]; }
    const float* router = arg_in(16) + (size_t)(l >> 1) * DM * NE;
    u32x4* route = WSP(u32x4, WS_ROUTE);
    f32x4 vn[4]; ln_load(R1 + (size_t)(F.vcu * 128 + F.wave * 16) * DM, vn, F.lane);
    for (int i = 0; i < 16; ++i) {
        const int m = F.vcu * 128 + F.wave * 16 + i;
        f32x4 v[4];
#pragma unroll
        for (int j = 0; j < 4; ++j) v[j] = vn[j];
        if (i + 1 < 16) ln_load(R1 + (size_t)(m + 1) * DM, vn, F.lane);
        ln_finish<true>(v, g, bb, R1 + (size_t)m * DM, (unsigned char*)XB + (size_t)m * DM, nullptr, F.lane);
        if (moe) {
            float lg[8];
#pragma unroll
            for (int e = 0; e < 8; ++e) lg[e] = 0.f;
#pragma unroll
            for (int j = 0; j < 4; ++j)
#pragma unroll
                for (int c = 0; c < 4; ++c) { const float* rp = router + (size_t)(4 * F.lane + 256 * j + c) * NE; const f32x4 r0 = *(const f32x4*)rp, r1 = *(const f32x4*)(rp + 4); const float xv = v[j][c];
                    lg[0] += xv * r0[0]; lg[1] += xv * r0[1]; lg[2] += xv * r0[2]; lg[3] += xv * r0[3]; lg[4] += xv * r1[0]; lg[5] += xv * r1[1]; lg[6] += xv * r1[2]; lg[7] += xv * r1[3]; }
#pragma unroll
            for (int e = 0; e < 8; ++e) lg[e] = wave_sum(lg[e]);
            int e1 = 0; float v1 = lg[0];
#pragma unroll
            for (int e = 1; e < 8; ++e) if (lg[e] > v1) { v1 = lg[e]; e1 = e; }
            int e2 = -1; float v2 = -3.0e38f;
#pragma unroll
            for (int e = 0; e < 8; ++e) if (e != e1 && (e2 < 0 || lg[e] > v2)) { v2 = lg[e]; e2 = e; }
            const float g1 = 1.0f / (1.0f + __expf(v2 - v1)), g2 = 1.0f - g1;
            if (F.lane == 0) { u32x4 r; r.x = (unsigned)e1; r.y = (unsigned)e2; r.z = __float_as_uint(g1); r.w = __float_as_uint(g2); route[m] = r;
                __hip_atomic_fetch_add(cntL + e1, 1, __ATOMIC_RELAXED, __HIP_MEMORY_SCOPE_WORKGROUP); __hip_atomic_fetch_add(cntL + e2, 1, __ATOMIC_RELAXED, __HIP_MEMORY_SCOPE_WORKGROUP); }
        }
    }
    __syncthreads();
    if (moe && F.tid < 8) WSP(int, WS_CNTWG)[F.vcu * 8 + F.tid] = cntL[F.tid];
}

__device__ __forceinline__ void p_ln2(Frame& F, int l) {
    const bf16* R1 = WSP(bf16, WS_R1); bf16* XB = WSP(bf16, WS_XB); float* outp = (l == DEPTH - 1) ? arg_out() : nullptr;
    f32x4 g[4], bb[4];
#pragma unroll
    for (int j = 0; j < 4; ++j) { g[j] = ((const f32x4*)(arg_in(11) + (size_t)l * DM))[F.lane + 64 * j]; bb[j] = ((const f32x4*)(arg_in(12) + (size_t)l * DM))[F.lane + 64 * j]; }
    f32x4 vn[4]; ln_load(R1 + (size_t)(F.vcu * 128 + F.wave * 16) * DM, vn, F.lane);
    for (int i = 0; i < 16; ++i) {
        const int m = F.vcu * 128 + F.wave * 16 + i;
        f32x4 v[4];
#pragma unroll
        for (int j = 0; j < 4; ++j) v[j] = vn[j];
        if (i + 1 < 16) ln_load(R1 + (size_t)(m + 1) * DM, vn, F.lane);
        ln_finish<false>(v, g, bb, XB + (size_t)m * DM, WSP(unsigned char, WS_XQ) + (size_t)m * DM, outp ? outp + (size_t)m * DM : nullptr, F.lane);
    }
}

__device__ __forceinline__ void moe_tables(Frame& F) {
    LAS int* texp = (LAS int*)(F.lds + LDSCTL_OFF);
    LAS int* tot = (LAS int*)(F.lds + LDSCTL_OFF + 1088);
    LAS int* tbase = (LAS int*)(F.lds + LDSCTL_OFF + 1200);
    const int* cnt = WSP(int, WS_CNTWG);
    LAS int* tmp = (LAS int*)(F.lds + AUX_OFF);
    __syncthreads();
    if (F.tid < 256) { typedef int i32x4_ __attribute__((ext_vector_type(4))); const i32x4_ a = ((const i32x4_*)cnt)[2 * F.tid], b = ((const i32x4_*)cnt)[2 * F.tid + 1];
        *(LAS i32x4_*)(tmp + 8 * F.tid) = a; *(LAS i32x4_*)(tmp + 8 * F.tid + 4) = b; }
    __syncthreads();
    if (F.tid < 8) { int t = 0, off = 0; for (int w = 0; w < 256; ++w) { const int c = tmp[w * 8 + F.tid]; if (w < F.vcu) off += c; t += c; } tot[F.tid] = t; tot[8 + F.tid] = off; }
    __syncthreads();
    if (F.tid == 0) { int b = 0; for (int e = 0; e < 8; ++e) { tbase[e] = b; b += (tot[e] + 255) >> 8; } tbase[8] = b; }
    __syncthreads();
    if (F.tid < MAXT) { int e = 0;
#pragma unroll
        for (int j = 1; j < 8; ++j) e += (F.tid >= tbase[j]) ? 1 : 0;
        texp[F.tid] = e; }
    __syncthreads();
}

__device__ __forceinline__ void p_list(Frame& F) {
    moe_tables(F);
    LAS int* tot = (LAS int*)(F.lds + LDSCTL_OFF + 1088); LAS int* tbase = (LAS int*)(F.lds + LDSCTL_OFF + 1200);
    const u32x4* route = WSP(u32x4, WS_ROUTE);
    int* rowlist = WSP(int, WS_ROWLIST); float* rowgate = WSP(float, WS_ROWGATE); int* slotrow = WSP(int, WS_SLOTROW);
    if (F.wave == 0) {
        int run[8];
#pragma unroll
        for (int e = 0; e < 8; ++e) run[e] = tot[8 + e];
        for (int blk = 0; blk < 2; ++blk) {
            const int t = F.vcu * 128 + blk * 64 + F.lane; const u32x4 r = route[t]; const int e1 = (int)r.x, e2 = (int)r.y;
            int p1 = 0, p2 = 0;
            const unsigned long long lt = (1ull << F.lane) - 1ull;
#pragma unroll
            for (int e = 0; e < 8; ++e) { const unsigned long long mk = __ballot(e1 == e || e2 == e); const int rk = run[e] + __popcll(mk & lt); if (e1 == e) p1 = rk; if (e2 == e) p2 = rk; run[e] += __popcll(mk); }
            const int row1 = tbase[e1] * 256 + p1, row2 = tbase[e2] * 256 + p2;
            rowlist[row1] = t; rowgate[row1] = __uint_as_float(r.z); rowlist[row2] = t; rowgate[row2] = __uint_as_float(r.w);
            slotrow[2 * t] = row1; slotrow[2 * t + 1] = row2;
        }
    }
    if (F.vcu < 8) { const int e = F.vcu, mt = (tot[e] + 255) >> 8; for (int p = tot[e] + F.tid; p < mt * 256; p += NTHR) { rowlist[tbase[e] * 256 + p] = 0; rowgate[tbase[e] * 256 + p] = 0.f; } }
}

__device__ __forceinline__ void p_comb(Frame& F, int l) {
    const bf16* R1 = WSP(bf16, WS_R1); bf16* XB = WSP(bf16, WS_XB); const bf16* Yd = WSP(bf16, WS_YD); const int* slotrow = WSP(int, WS_SLOTROW); float* outp = (l == DEPTH - 1) ? arg_out() : nullptr;
    f32x4 g[4], bb[4];
#pragma unroll
    for (int j = 0; j < 4; ++j) { g[j] = ((const f32x4*)(arg_in(11) + (size_t)l * DM))[F.lane + 64 * j]; bb[j] = ((const f32x4*)(arg_in(12) + (size_t)l * DM))[F.lane + 64 * j]; }
    const int m0 = F.vcu * 128 + F.wave * 16;
    const int myslot = (F.lane < 32) ? slotrow[2 * m0 + F.lane] : 0;
    f32x4 xn[4], an[4], bn[4];
#define COMB_LOAD(i_) do { const int ra_ = __builtin_amdgcn_readlane(myslot, 2 * (i_)), rb_ = __builtin_amdgcn_readlane(myslot, 2 * (i_) + 1); \
        ln_load(R1 + (size_t)(m0 + (i_)) * DM, xn, F.lane); ln_load(Yd + (size_t)ra_ * DM, an, F.lane); ln_load(Yd + (size_t)rb_ * DM, bn, F.lane); } while (0)
    COMB_LOAD(0);
    for (int i = 0; i < 16; ++i) {
        const int m = m0 + i;
        f32x4 v[4];
#pragma unroll
        for (int j = 0; j < 4; ++j) v[j] = xn[j] * DN_ALPHA + (an[j] + bn[j]);
        if (i + 1 < 16) COMB_LOAD(i + 1);
        ln_finish<false>(v, g, bb, XB + (size_t)m * DM, WSP(unsigned char, WS_XQ) + (size_t)m * DM, outp ? outp + (size_t)m * DM : nullptr, F.lane);
    }
#undef COMB_LOAD
}

#define DPP_I(v, ctrl) __builtin_amdgcn_update_dpp(0, (v), (ctrl), 0xf, 0xf, false)
__device__ __forceinline__ int wave_isum(int v) {
    v += DPP_I(v, 0xB1); v += DPP_I(v, 0x4E); v += DPP_I(v, 0x141); v += DPP_I(v, 0x140);
    return __builtin_amdgcn_readlane(v, 0) + __builtin_amdgcn_readlane(v, 16) + __builtin_amdgcn_readlane(v, 32) + __builtin_amdgcn_readlane(v, 48);
}
#define DPP_F(v, ctrl) __int_as_float(__builtin_amdgcn_update_dpp(0, __float_as_int(v), (ctrl), 0xf, 0xf, false))
typedef unsigned short u16x2 __attribute__((__vector_size__(4)));
#define IDX_BAR() asm volatile("s_waitcnt lgkmcnt(0)\n\ts_barrier" ::: "memory")
__device__ __forceinline__ void p_idx(Frame& F, int l) {
    constexpr int QP = 16;
    LAS unsigned short* bins = (LAS unsigned short*)(F.lds + RING_OFF);
    LAS unsigned* hq = (LAS unsigned*)(F.lds + AUX_OFF);
    LAS unsigned* hist = (LAS unsigned*)(F.lds + AUX_OFF + 16384) + F.wave * 256;
    LAS int* ci = (LAS int*)(F.lds + AUX_OFF + 24576) + F.wave * 64;
    LAS float* wtab = (LAS float*)(F.lds + LDSCTL_OFF + 1280);
    LAS float* sqp = (LAS float*)(F.lds + LDSCTL_OFF + 1792);
    const bf16* QI = WSP(bf16, WS_QI); const bf16* KI = WSP(bf16, WS_KI); const float* WI = WSP(float, WS_WI);
    unsigned long long* maskQ = WSP(unsigned long long, WS_MASK);
    const int lane = F.lane, wave = F.wave, tid = F.tid, w = F.vcu;
    const int am = lane & 31, ahm = (am >> 2) & 1, arr = (am & 3) + 4 * (am >> 3), atl = 2 * ahm + (arr >> 3), ah = arr & 7, kg = lane >> 5, hi = lane >> 5, n = lane & 31;
    bf16x8 af[4][4]; float wreg = 0.f;
#define IDX_UNIT(s8_, qb32_, b_) do { const int ui_ = (s8_) >> 1; const int up_ = (ui_ == 0) ? w : (ui_ == 1) ? 511 - w : (ui_ == 2) ? 512 + w : 1023 - w; qb32_ = up_ >> 3; b_ = up_ & 7; } while (0)
#define IDX_LOADQ(s8_) do { int qb_, bb_; IDX_UNIT(s8_, qb_, bb_); const size_t r0_ = (size_t)bb_ * SEQ + qb_ * 32 + ((s8_) & 1) * QP; \
        _Pragma("unroll") for (int rt = 0; rt < 4; ++rt) _Pragma("unroll") for (int ks = 0; ks < 4; ++ks) af[rt][ks] = *(const bf16x8*)(QI + (r0_ + 4 * rt + atl) * AW + ah * 64 + ks * 16 + 8 * kg); \
        if (tid < 128) wreg = WI[(r0_ + (tid >> 3)) * 8 + (tid & 7)]; } while (0)
#define IDX_WTAB(par_) do { if (tid < 128) { wtab[tid] = wreg; float sm = wreg, sq2 = wreg * wreg; \
        sm += DPP_F(sm, 0xB1); sq2 += DPP_F(sq2, 0xB1); sm += DPP_F(sm, 0x4E); sq2 += DPP_F(sq2, 0x4E); sm += DPP_F(sm, 0x141); sq2 += DPP_F(sq2, 0x141); \
        if ((tid & 7) == 0) { const float a_ = 1.0f / (28.02f * sqrtf(sq2) + 1.0e-20f); sqp[32 * (par_) + 2 * (tid >> 3)] = a_; sqp[32 * (par_) + 2 * (tid >> 3) + 1] = 0.33333f - 3.19f * sm * a_; } } } while (0)
    IDX_LOADQ(0);
    IDX_WTAB(0);
    for (int i = tid; i < QP * 256; i += NTHR) hq[i] = 0u;
    IDX_BAR();
    for (int s8 = 0; s8 < 8; ++s8) {
        int qb32, b; IDX_UNIT(s8, qb32, b);
        const int sub = s8 & 1, c = qb32 >> 1, N = 64 * (c + 1), NT32 = 2 * (c + 1);
        const size_t rowb = (size_t)b * SEQ;
        const bool dosel = N > TOPK;
        for (int repA_ = 0; repA_ < (((PROBE_MASK) >> 12) & 1) + 1; ++repA_) {
            const int ntw = (NT32 - wave + 7) >> 3;
            constexpr int BT = 2; const int nbat = (ntw + BT - 1) / BT;
            bf16x8 b0[BT][4], b1[BT][4];
            const LAS float* sqc = sqp + 32 * (s8 & 1);
#define IDX_LOADB(dst, bb_) do { _Pragma("unroll") for (int u = 0; u < BT; ++u) { int j_ = wave + 8 * (BT * (bb_) + u); j_ = j_ < NT32 ? j_ : NT32 - 1; \
            _Pragma("unroll") for (int ks = 0; ks < 4; ++ks) dst[u][ks] = *(const bf16x8*)(KI + (rowb + 32 * j_) * 64 + ks * 512 + kg * 256 + n * 8); } } while (0)
#define IDX_RELU(x) __int_as_float(max(__float_as_int(x), 0))
#define IDX_COMP(src, bb_) do { _Pragma("unroll") for (int rp = 0; rp < 2; ++rp) { \
            f32x4 wq_[4][2];   \
            _Pragma("unroll") for (int rq = 0; rq < 4; ++rq) { const int qi_ = 4 * (2 * rp + (rq >> 1)) + 2 * hi + (rq & 1); const LAS f32x4* wp_ = (const LAS f32x4*)(wtab + qi_ * 8); wq_[rq][0] = wp_[0]; wq_[rq][1] = wp_[1]; } \
            _Pragma("unroll") for (int u = 0; u < BT; ++u) { const int j_ = wave + 8 * (BT * (bb_) + u); if (j_ < NT32) { f32x16 acc0 = {}, acc1 = {}; \
                _Pragma("unroll") for (int ks = 0; ks < 4; ++ks) { acc0 = __builtin_amdgcn_mfma_f32_32x32x16_bf16(af[2 * rp][ks], src[u][ks], acc0, 0, 0, 0); acc1 = __builtin_amdgcn_mfma_f32_32x32x16_bf16(af[2 * rp + 1][ks], src[u][ks], acc1, 0, 0, 0); } \
                _Pragma("unroll") for (int r2 = 0; r2 < 2; ++r2) { const int rt = 2 * rp + r2; const f32x16& ac_ = r2 ? acc1 : acc0; float t_[2]; \
                    _Pragma("unroll") for (int q = 0; q < 2; ++q) { const f32x4 w0_ = wq_[2 * r2 + q][0], w1_ = wq_[2 * r2 + q][1]; \
                        f32x2 s2_ = (f32x2){w0_[0], w0_[1]} * (f32x2){IDX_RELU(ac_[8 * q + 0]), IDX_RELU(ac_[8 * q + 1])}; \
                        s2_ = __builtin_elementwise_fma((f32x2){w0_[2], w0_[3]}, (f32x2){IDX_RELU(ac_[8 * q + 2]), IDX_RELU(ac_[8 * q + 3])}, s2_); \
                        s2_ = __builtin_elementwise_fma((f32x2){w1_[0], w1_[1]}, (f32x2){IDX_RELU(ac_[8 * q + 4]), IDX_RELU(ac_[8 * q + 5])}, s2_); \
                        s2_ = __builtin_elementwise_fma((f32x2){w1_[2], w1_[3]}, (f32x2){IDX_RELU(ac_[8 * q + 6]), IDX_RELU(ac_[8 * q + 7])}, s2_); \
                        const f32x2 mc_ = *(const LAS f32x2*)(sqc + 2 * (4 * rt + 2 * hi + q)); t_[q] = __builtin_fmaf(s2_[0] + s2_[1], mc_[0], mc_[1]); } \
                    const u16x2 pk_ = __builtin_amdgcn_cvt_pknorm_u16(t_[0], t_[1]); \
                    _Pragma("unroll") for (int q = 0; q < 2; ++q) { const int qi_ = 4 * rt + 2 * hi + q; const unsigned short ky_ = q ? pk_[1] : pk_[0]; bins[qi_ * 4096 + 32 * j_ + n] = ky_; \
                        if (dosel) __hip_atomic_fetch_add(hq + qi_ * 256 + ((unsigned)ky_ >> 8), 1u, __ATOMIC_RELAXED, __HIP_MEMORY_SCOPE_WORKGROUP); } } } } } } while (0)
            IDX_LOADB(b0, 0);
            for (int bb = 0; bb < nbat; bb += 2) {
                IDX_LOADB(b1, bb + 1);
                IDX_COMP(b0, bb);
                IDX_LOADB(b0, bb + 2);
                IDX_COMP(b1, bb + 1);
            }
#undef IDX_LOADB
#undef IDX_COMP
#undef IDX_RELU
        }
        if (s8 + 1 < 8) IDX_LOADQ(s8 + 1);
        IDX_BAR();
        for (int repB_ = 0; repB_ < (((PROBE_MASK) >> 13) & 1) + 1; ++repB_)
        for (int qq = 0; qq < 2; ++qq) {
            const int q = wave + 8 * qq;
            const int nch = (N + 511) >> 9;
            const LAS unsigned short* brow = bins + q * 4096;
            LAS unsigned char* st8 = (LAS unsigned char*)hist + 512 * qq;
            { unsigned z0 = 0u; asm volatile("" : "+v"(z0)); *(LAS u32x2*)(st8 + 8 * lane) = (u32x2){z0, z0}; }
#define IDX_SCAN(K, HD, TARGET) \
            int tl_ = 0; _Pragma("unroll") for (int i = 0; i < K; ++i) tl_ += HD[i]; \
            int P_ = tl_; P_ += DPP_I(P_, 0x111); P_ += DPP_I(P_, 0x112); P_ += DPP_I(P_, 0x114); P_ += DPP_I(P_, 0x118); \
            { const int R0 = __builtin_amdgcn_readlane(P_, 15), R1 = __builtin_amdgcn_readlane(P_, 31), R2 = __builtin_amdgcn_readlane(P_, 47); P_ += (lane >= 16 ? R0 : 0) + (lane >= 32 ? R1 : 0) + (lane >= 48 ? R2 : 0); } \
            const unsigned long long over_ = __ballot(P_ >= (TARGET)); const int Lc_ = over_ ? (int)__builtin_ctzll(over_) : 63; \
            int cumL_ = P_ - tl_, bsel_ = 0, cbv_ = 0; bool fnd_ = false; \
            _Pragma("unroll") for (int i = K - 1; i >= 0; --i) { if (!fnd_) { if (cumL_ + HD[i] >= (TARGET) || i == 0) { fnd_ = true; bsel_ = i; cbv_ = HD[i]; } else cumL_ += HD[i]; } } \
            Bs = K * (63 - Lc_) + __builtin_amdgcn_readlane(bsel_, Lc_); cb = __builtin_amdgcn_readlane(cbv_, Lc_); cumv = __builtin_amdgcn_readlane(cumL_, Lc_);
#define IDX_CODE(v, j) ((int)(((j) & 1) ? ((v)[(j) >> 1] >> 16) : ((v)[(j) >> 1] & 0xffffu)))
            int Bs = -1, cb = 0, need = 0, sh = 8; bool fast_ok = true;
            LAS unsigned* crow = hq + q * 256;
            if (dosel) {
                { const u32x4 h4 = *(const LAS u32x4*)(crow + 4 * (63 - lane)); const int hd4[4] = {(int)h4[0], (int)h4[1], (int)h4[2], (int)h4[3]};
                  int cumv; IDX_SCAN(4, hd4, TOPK)
                  need = TOPK - cumv; fast_ok = over_ != 0ull && need >= 1 && need <= cb; }
                if (fast_ok && cb > 64) {
                    { unsigned z0 = 0u; asm volatile("" : "+v"(z0)); *(LAS u32x4*)(crow + 4 * lane) = (u32x4){z0, z0, z0, z0}; }
                    for (int ch = 0; ch < nch; ++ch) { const u32x4 v = *(const LAS u32x4*)(brow + 512 * ch + 8 * lane); const bool okl = 512 * ch + 8 * lane < N;
#pragma unroll
                        for (int j = 0; j < 8; ++j) { const int kj = IDX_CODE(v, j); const bool m = okl && (kj >> 8) == Bs;
                            __hip_atomic_fetch_add(m ? crow + (kj & 255) : (LAS unsigned*)ci + lane, 1u, __ATOMIC_RELAXED, __HIP_MEMORY_SCOPE_WORKGROUP); } }
                    asm volatile("s_waitcnt lgkmcnt(0)" ::: "memory");
                    const u32x4 h4 = *(const LAS u32x4*)(crow + 4 * (63 - lane)); const int hd4[4] = {(int)h4[0], (int)h4[1], (int)h4[2], (int)h4[3]};
                    int nB, nC, nV; bool ok2;
                    { int Bs, cb, cumv; IDX_SCAN(4, hd4, need)
                      nB = Bs; nC = cb; nV = cumv; ok2 = over_ != 0ull; }
                    Bs = (Bs << 8) | nB; sh = 0; need -= nV; cb = nC;
                    fast_ok = ok2 && need >= 1 && need <= cb;
                }
                fast_ok = fast_ok && cb <= 64;
            }
#undef IDX_SCAN
            if (fast_ok) {
                int nc = 0;
                u32x4 vn = *(const LAS u32x4*)(brow + 8 * lane);
                for (int ch = 0; ch < nch; ++ch) { const u32x4 v = vn; const int e0 = 512 * ch + 8 * lane; const bool okl = e0 < N; unsigned byte = 0u;
                    if (ch + 1 < nch) vn = *(const LAS u32x4*)(brow + 512 * (ch + 1) + 8 * lane);
                    int bj[8], cl = 0;
#pragma unroll
                    for (int j = 0; j < 8; ++j) { bj[j] = okl ? (IDX_CODE(v, j) >> sh) : -2; cl += (bj[j] == Bs) ? 1 : 0; byte |= (unsigned)(Bs - bj[j]) >> 31 << j; }
                    int ps = cl;
                    ps += DPP_I(ps, 0x111); ps += DPP_I(ps, 0x112); ps += DPP_I(ps, 0x114); ps += DPP_I(ps, 0x118);
                    ps += __builtin_amdgcn_update_dpp(0, ps, 0x142, 0xa, 0xf, false); ps += __builtin_amdgcn_update_dpp(0, ps, 0x143, 0xc, 0xf, false);
                    int off = nc + ps - cl;
#pragma unroll
                    for (int j = 0; j < 8; ++j) { const bool eq = bj[j] == Bs; crow[eq ? off : 64 + lane] = (unsigned)((IDX_CODE(v, j) << 12) | (e0 + j)); off += eq ? 1 : 0; }
                    nc += __builtin_amdgcn_readlane(ps, 63);
                    st8[64 * ch + lane] = (unsigned char)byte; }
                if (dosel) {
                    asm volatile("s_waitcnt lgkmcnt(0)" ::: "memory");
                    const int mc = (lane < cb) ? (int)crow[lane] : 0; const int mord = (mc & ~4095) | (4095 - (mc & 4095)); int rank = 0;
                    for (int j = 0; j < cb; ++j) { const int oj = __builtin_amdgcn_readlane(mord, j); rank += (oj > mord) ? 1 : 0; }
                    if (lane < cb && rank < need) __hip_atomic_fetch_or((LAS unsigned*)st8 + ((mc & 4095) >> 5), 1u << (mc & 31), __ATOMIC_RELAXED, __HIP_MEMORY_SCOPE_WORKGROUP);
                }
            } else {
                int Tk = -1; unsigned Jx = 0xffffffffu;
                for (int bit = 15; bit >= 0; --bit) {
                    const int cand = Tk < 0 ? (1 << bit) : (Tk | (1 << bit)); int cl = 0;
                    for (int ch = 0; ch < nch; ++ch) { const u32x4 v = *(const LAS u32x4*)(brow + 512 * ch + 8 * lane); const int e0 = 512 * ch + 8 * lane;
#pragma unroll
                        for (int j = 0; j < 8; ++j) cl += (e0 < N && IDX_CODE(v, j) >= cand) ? 1 : 0; }
                    if (wave_isum(cl) >= TOPK) Tk = cand;
                }
                if (Tk < 0) Tk = 0;
                int cg = 0, ce = 0;
                for (int ch = 0; ch < nch; ++ch) { const u32x4 v = *(const LAS u32x4*)(brow + 512 * ch + 8 * lane); const int e0 = 512 * ch + 8 * lane;
#pragma unroll
                    for (int j = 0; j < 8; ++j) if (e0 < N) { cg += (IDX_CODE(v, j) > Tk) ? 1 : 0; ce += (IDX_CODE(v, j) == Tk) ? 1 : 0; } }
                const int nd = TOPK - wave_isum(cg), ceq = wave_isum(ce);
                if (ceq > nd) {
                    unsigned Jc = 0u;
                    for (int bit = 11; bit >= 0; --bit) {
                        const unsigned cj = Jc | (1u << bit); int cl = 0;
                        for (int ch = 0; ch < nch; ++ch) { const u32x4 v = *(const LAS u32x4*)(brow + 512 * ch + 8 * lane); const int e0 = 512 * ch + 8 * lane;
#pragma unroll
                            for (int j = 0; j < 8; ++j) cl += (e0 < N && IDX_CODE(v, j) == Tk && (unsigned)(e0 + j) < cj) ? 1 : 0; }
                        if (wave_isum(cl) < nd) Jc = cj;
                    }
                    Jx = Jc;
                }
                for (int ch = 0; ch < nch; ++ch) { const u32x4 v = *(const LAS u32x4*)(brow + 512 * ch + 8 * lane); const int e0 = 512 * ch + 8 * lane; unsigned byte = 0u;
#pragma unroll
                    for (int j = 0; j < 8; ++j) { const int kj = IDX_CODE(v, j); byte |= (unsigned)((kj > Tk || (kj == Tk && (unsigned)(e0 + j) <= Jx)) ? 1 : 0) << j; }
                    st8[64 * ch + lane] = (unsigned char)(e0 < N ? byte : 0u); }
            }
#undef IDX_CODE
            { unsigned z0 = 0u; asm volatile("" : "+v"(z0)); *(LAS u32x4*)(crow + 4 * lane) = (u32x4){z0, z0, z0, z0}; }
        }
        IDX_WTAB((s8 + 1) & 1);
        IDX_BAR();
        {
            const int tile = tid >> 3, w8 = tid & 7, NJw = 4 * ((qb32 >> 3) + 1);
            if (tile < NJw) {
#pragma unroll
                for (int qq = 0; qq < 2; ++qq) { const u32x2 mk = *(const LAS u32x2*)((const LAS unsigned*)(F.lds + AUX_OFF + 16384) + w8 * 256 + 128 * qq + 2 * tile);
                    maskQ[((size_t)(b * 128 + qb32) * 64 + tile) * 32 + QP * sub + 8 * qq + w8] = ((unsigned long long)mk.y << 32) | mk.x; } }
        }
    }
#undef IDX_UNIT
#undef IDX_LOADQ
#undef IDX_WTAB
#undef IDX_BAR
}

__device__ __forceinline__ void p_conv(Frame& F, int l) {
    LAS bf16* Ut = (LAS bf16*)(F.lds + RING_OFF);
    LAS float* Yt = (LAS float*)(F.lds + RING_OFF + 65536);
    const bf16* U = WSP(bf16, WS_U); bf16* MIX = WSP(bf16, WS_MIX);
    const float* cw = arg_in(2) + (size_t)l * CK * CCH; const int c = F.tid, lane = F.lane;
    float wj[CK];
#pragma unroll
    for (int j = 0; j < CK; ++j) wj[j] = cw[j * CCH + c];
    const float cb = arg_in(3)[l * CCH + c];
    f32x4 lg0 = *(const f32x4*)(arg_in(4) + l * CCH + 8 * lane), lg1 = *(const f32x4*)(arg_in(4) + l * CCH + 8 * lane + 4);
    f32x4 lb0 = *(const f32x4*)(arg_in(5) + l * CCH + 8 * lane), lb1 = *(const f32x4*)(arg_in(5) + l * CCH + 8 * lane + 4);
    f32x4 ms0 = *(const f32x4*)(arg_in(6) + l * DM + CCH + 8 * lane), ms1 = *(const f32x4*)(arg_in(6) + l * DM + CCH + 8 * lane + 4);
    u32x4 tp[8];
#define CONV_LOAD(it_) do { const int un_ = F.vcu + 256 * (it_), b_ = un_ >> 7, t0_ = (un_ & 127) * 32; \
        _Pragma("unroll") for (int k = 0; k < 8; ++k) { const int ch = F.tid + NTHR * k, r = ch >> 6, cc = ch & 63, t = t0_ - 30 + r; unsigned z0 = 0u; asm volatile("" : "+v"(z0)); tp[k] = (u32x4){z0, z0, z0, z0}; \
            if (ch < 62 * 64 && t >= 0) tp[k] = *(const u32x4*)(U + ((size_t)b_ * SEQ + t) * CCH + cc * 8); } } while (0)
    CONV_LOAD(0);
    for (int it = 0; it < 4; ++it) {
        const int unit = F.vcu + 256 * it, b = unit >> 7, tt0 = (unit & 127) * 32;
#pragma unroll
        for (int k = 0; k < 8; ++k) { const int ch = F.tid + NTHR * k, r = ch >> 6, cc = ch & 63; if (ch < 62 * 64) *(LAS u32x4*)(Ut + r * CCH + cc * 8) = tp[k]; }
        if (it + 1 < 4) CONV_LOAD(it + 1);
        __syncthreads();
        float acc[32], uu[62];
#pragma unroll
        for (int s = 0; s < 62; ++s) uu[s] = bf2f(Ut[s * CCH + c]);
#pragma unroll
        for (int tt = 0; tt < 32; ++tt) acc[tt] = cb;
#pragma unroll
        for (int j = 0; j < CK; ++j)
#pragma unroll
            for (int tt = 0; tt < 32; ++tt) acc[tt] = __builtin_fmaf(wj[j], uu[tt + j], acc[tt]);
#pragma unroll
        for (int tt = 0; tt < 32; ++tt) Yt[tt * CCH + c] = acc[tt];
        __syncthreads();
#pragma unroll
        for (int k = 0; k < 4; ++k) { const int tt = F.wave * 4 + k;
            f32x4 y0 = *(const LAS f32x4*)(Yt + tt * CCH + 8 * lane), y1 = *(const LAS f32x4*)(Yt + tt * CCH + 8 * lane + 4);
            const float mean = wave_sum((y0[0] + y0[1]) + (y0[2] + y0[3]) + (y1[0] + y1[1]) + (y1[2] + y1[3])) * (1.f / CCH);
            y0 = y0 - mean; y1 = y1 - mean;
            const float var = wave_sum((y0[0] * y0[0] + y0[1] * y0[1]) + (y0[2] * y0[2] + y0[3] * y0[3]) + (y1[0] * y1[0] + y1[1] * y1[1]) + (y1[2] * y1[2] + y1[3] * y1[3])) * (1.f / CCH);
            const float rstd = 1.f / sqrtf(var + LN_EPS);
            y0 = y0 * rstd * lg0 + lb0; y1 = y1 * rstd * lg1 + lb1;
#pragma unroll
            for (int e = 0; e < 4; ++e) { y0[e] = y0[e] * fsigmoid(y0[e]) * ms0[e]; y1[e] = y1[e] * fsigmoid(y1[e]) * ms1[e]; }
            *(u32x4*)(MIX + ((size_t)b * SEQ + tt0 + tt) * DM + CCH + 8 * lane) = pg8::pack8(y0, y1); }
        __syncthreads();
    }
#undef CONV_LOAD
}

namespace at {
constexpr int QBLK = 32, QB = 256, KVBLK = 64, NSLOT = 3, SLOTB = 8192;
constexpr int LDS_K = 0, LDS_V = NSLOT * SLOTB, LDS_WS = 2 * NSLOT * SLOTB, LDS_OST = LDS_WS + 8 * 64 * 4, LDS_BIAS = LDS_OST + 8 * 4096, LDS_END = LDS_BIAS + 1024;
static_assert(LDS_END <= RING_BYTES, "attention LDS");
constexpr float NEGV = -200.0f;
__device__ __forceinline__ int crow(int r, int hi) { return (r & 3) + 8 * (r >> 2) + 4 * hi; }
#define SBAR() __builtin_amdgcn_sched_barrier(0)
__device__ __forceinline__ void glds16(const void* gsrc, unsigned lds_dst) { unsigned keep;
    asm volatile("s_mov_b32 %0, m0\n\ts_mov_b32 m0, %2\n\ts_nop 0\n\tglobal_load_lds_dwordx4 %1, off\n\ts_mov_b32 m0, %0" : "=&s"(keep) : "v"(gsrc), "s"(lds_dst) : "memory"); }
__device__ __forceinline__ float max3f(float a, float b, float c) { float r; asm("v_max3_f32 %0, %1, %2, %3" : "=v"(r) : "v"(a), "v"(b), "v"(c)); return r; }
__device__ __forceinline__ float max2f(float a, float b) { float r; asm("v_max_f32_e32 %0, %1, %2" : "=v"(r) : "v"(a), "v"(b)); return r; }
__device__ __forceinline__ float fadd_s(float a, float b) { float r; asm("v_add_f32_e32 %0, %1, %2" : "=v"(r) : "v"(a), "v"(b)); return r; }
__device__ __forceinline__ float fsub_s(float a, float b) { float r; asm("v_sub_f32_e32 %0, %1, %2" : "=v"(r) : "v"(a), "v"(b)); return r; }
typedef float f32x2_t __attribute__((ext_vector_type(2))); typedef __bf16 bf16x2_t __attribute__((ext_vector_type(2)));
__device__ __forceinline__ unsigned cvtpk_s(float lo, float hi) { f32x2_t v = {lo, hi}; bf16x2_t b = __builtin_convertvector(v, bf16x2_t); return __builtin_bit_cast(unsigned, b); }
typedef LAS const char* lds_cptr;
typedef short v4i16_t __attribute__((ext_vector_type(4)));
__device__ __forceinline__ void kload8(bf16x8* kf, lds_cptr kp) {
    kf[0] = *(const LAS bf16x8*)(kp);        kf[1] = *(const LAS bf16x8*)(kp + 512);  kf[2] = *(const LAS bf16x8*)(kp + 2048); kf[3] = *(const LAS bf16x8*)(kp + 2560);
    kf[4] = *(const LAS bf16x8*)(kp + 4096); kf[5] = *(const LAS bf16x8*)(kp + 4608); kf[6] = *(const LAS bf16x8*)(kp + 6144); kf[7] = *(const LAS bf16x8*)(kp + 6656); }
__device__ __forceinline__ void kload2(bf16x8* kf, lds_cptr kp, int j) { kf[2 * j] = *(const LAS bf16x8*)(kp + j * 2048); kf[2 * j + 1] = *(const LAS bf16x8*)(kp + j * 2048 + 512); }
__device__ __forceinline__ s16x4 vtr(lds_cptr p) { return __builtin_bit_cast(s16x4, __builtin_amdgcn_ds_read_tr16_b64_v4i16((LAS v4i16_t*)p)); }
__device__ __forceinline__ float rowmax(const f32x16& p0, const f32x16& p1) {
    float a = max3f(p0[0], p0[1], p1[0]), b = max3f(p0[2], p0[3], p1[1]); a = max3f(a, p1[2], p1[3]);
#pragma unroll
    for (int r = 4; r < 16; r += 4) { a = max3f(a, p0[r], p0[r + 1]); b = max3f(b, p0[r + 2], p0[r + 3]); a = max3f(a, p1[r], p1[r + 1]); b = max3f(b, p1[r + 2], p1[r + 3]); }
    const float m = max2f(a, b);
    auto rr = __builtin_amdgcn_permlane32_swap(__float_as_uint(m), __float_as_uint(m), false, false);
    return max2f(__uint_as_float(rr[0]), __uint_as_float(rr[1]));
}
__device__ __forceinline__ void pv(f32x16* o, int vb, bf16x8 pa0, bf16x8 pa1, bf16x8 pa2, bf16x8 pa3) {
#pragma unroll
    for (int d0 = 0; d0 < 2; ++d0) { s16x4 lo[4], hi[4];
#pragma unroll
        for (int ks = 0; ks < 4; ++ks) {
            asm volatile("ds_read_b64_tr_b16 %0,%1 offset:%c2" : "=&v"(lo[ks]) : "v"(vb), "i"(d0 * 4096 + ks * 1024) : "memory");
            asm volatile("ds_read_b64_tr_b16 %0,%1 offset:%c2" : "=&v"(hi[ks]) : "v"(vb), "i"(d0 * 4096 + ks * 1024 + 512) : "memory"); }
        asm volatile("s_waitcnt lgkmcnt(0)" ::: "memory"); SBAR();
#define AT_PK(k) (bf16x8){lo[k][0], lo[k][1], lo[k][2], lo[k][3], hi[k][0], hi[k][1], hi[k][2], hi[k][3]}
        o[d0] = __builtin_amdgcn_mfma_f32_32x32x16_bf16(pa0, AT_PK(0), o[d0], 0, 0, 0);
        o[d0] = __builtin_amdgcn_mfma_f32_32x32x16_bf16(pa1, AT_PK(1), o[d0], 0, 0, 0);
        o[d0] = __builtin_amdgcn_mfma_f32_32x32x16_bf16(pa2, AT_PK(2), o[d0], 0, 0, 0);
        o[d0] = __builtin_amdgcn_mfma_f32_32x32x16_bf16(pa3, AT_PK(3), o[d0], 0, 0, 0);
#undef AT_PK
    }
}
template <int THRL> __device__ __forceinline__ void attn_unit(int b, int h, int qb, const bf16* Q, const bf16* __restrict__ Kt, const bf16* __restrict__ Vt, const unsigned long long* maskQ,
                                                              bf16* MIX, float ms0, float ms1, LAS unsigned char* shm, int tid) {
    const int lane = tid & 63, r32 = lane & 31, hi = lane >> 5; const int wid = __builtin_amdgcn_readfirstlane(tid >> 6);
    const size_t rowbase = (size_t)b * SEQ; const int q0 = qb * QB, qw = q0 + wid * QBLK, cwv = qw >> 6;
    const bf16* Qw = Q + (rowbase + qw) * AW + h * HD;
    const unsigned lds0 = (unsigned)(uintptr_t)shm; const lds_cptr shm3 = (lds_cptr)shm;
    LAS float* wsf = (LAS float*)(shm + LDS_WS) + wid * 64;
    const LAS float* biasT = (const LAS float*)(shm + LDS_BIAS);
    const bf16* ksrc = Kt + ((size_t)(b * NH + h) * 64) * 4096 + wid * 512 + lane * 8;
    const bf16* vsrc = Vt + ((size_t)(b * NH + h) * 64) * 4096 + wid * 512 + lane * 8;
    const unsigned kdst = lds0 + LDS_K + wid * 1024, vdst = lds0 + LDS_V + wid * 1024;
#define DMA_K(t, slot) glds16(ksrc + (size_t)(t) * 4096, (unsigned)__builtin_amdgcn_readfirstlane(kdst + (slot)))
#define DMA_V(t, slot) glds16(vsrc + (size_t)(t) * 4096, (unsigned)__builtin_amdgcn_readfirstlane(vdst + (slot)))
    int r32m = r32; asm volatile("" : "+v"(r32m));
    const unsigned long long* mrow = maskQ + ((size_t)(b * 128 + (qw >> 5)) * 64) * 32 + r32m;
#define MLOAD(dst, t) dst = *(const GAS u32x2*)((const GAS unsigned long long*)mrow + (size_t)(t) * 32)
#define MLOAD_UNUSED(dst, t) dst = *(const u32x2*)(mrow + (size_t)(t) * 32)
#define WAIT_BAR(N, M) asm volatile("s_waitcnt vmcnt(" #N ") lgkmcnt(0)\n\ts_barrier" ::: "memory")
    const int vb0 = (int)(lds0 + LDS_V) + ((lane >> 4) & 1) * 32 + (lane & 3) * 8 + (4 * hi + ((lane & 15) >> 2)) * 64;
    bf16x8 kf[8];
    const lds_cptr kp0 = shm3 + LDS_K + hi * 1024 + r32 * 16; const lds_cptr vp0 = shm3 + LDS_V + ((lane >> 4) & 1) * 32 + (lane & 3) * 8 + (4 * hi + ((lane & 15) >> 2)) * 64;
    const int NT = (q0 + QB) / KVBLK;
    u32x2 mA, mB;
    MLOAD(mA, 0);
    DMA_K(0, 0); DMA_V(0, 0); DMA_K(1, SLOTB);
    const lds_cptr qp = shm3 + LDS_OST + wid * 4096 + hi * 512 + r32 * 16;
#pragma unroll
    for (int d0 = 0; d0 < 4; ++d0) { const bf16x8 qv = *(const bf16x8*)(Qw + (size_t)r32 * AW + d0 * 16 + hi * 8); *(LAS bf16x8*)(shm + LDS_OST + wid * 4096 + hi * 512 + r32 * 16 + d0 * 1024) = qv; }
#define QRD(d0) (*(const LAS bf16x8*)(qp + (d0) * 1024))
    float mhat = 0.f, l_reg = 0.f; f32x16 o[2]; o[0] = f32x16{}; o[1] = f32x16{}; f32x16 negm = f32x16{}; asm volatile("" : "+v"(negm));
#define MASKB(P0, P1, t, MW) do { \
        if (64 * (t) + 63 - qw >= -90 && (t) <= cwv) { const int bi_ = 64 * (t) - (qw + r32) + 128 + 4 * hi; \
            _Pragma("unroll") for (int r = 0; r < 16; ++r) { const int k0_ = (r & 3) + 8 * (r >> 2); int i0_ = bi_ + k0_; i0_ = i0_ < 0 ? 0 : i0_; int i1_ = bi_ + k0_ + 32; i1_ = i1_ < 0 ? 0 : i1_; P0[r] += biasT[i0_]; P1[r] += biasT[i1_]; } } \
        { const unsigned ml_ = MW.x >> (4 * hi), mh_ = MW.y >> (4 * hi); const unsigned nv_ = __float_as_uint(NEGV); \
            _Pragma("unroll") for (int r = 0; r < 16; ++r) { const unsigned s0_ = (unsigned)__builtin_amdgcn_sbfe((int)ml_, (r & 3) + 8 * (r >> 2), 1), s1_ = (unsigned)__builtin_amdgcn_sbfe((int)mh_, (r & 3) + 8 * (r >> 2), 1); \
                P0[r] = __uint_as_float((s0_ & __float_as_uint(P0[r])) | (~s0_ & nv_)); P1[r] = __uint_as_float((s1_ & __float_as_uint(P1[r])) | (~s1_ & nv_)); } } } while (0)
    bool resc = false;
#define START(P0, P1) do { const float rm = rowmax(P0, P1); resc = false; \
    { const float dl = rm; mhat = fadd_s(mhat, dl); \
      _Pragma("unroll") for (int r = 0; r < 16; ++r) { P0[r] = fsub_s(P0[r], dl); P1[r] = fsub_s(P1[r], dl); } \
      _Pragma("unroll") for (int r = 0; r < 16; ++r) negm[r] = -mhat; asm volatile("" : "+v"(negm)); } \
    _Pragma("unroll") for (int r = 0; r < 16; ++r) P0[r] = __builtin_amdgcn_exp2f(P0[r]); } while (0)
#define RESC() do { if (resc) { asm volatile("s_waitcnt lgkmcnt(0)" ::: "memory"); \
      _Pragma("unroll") for (int d_ = 0; d_ < 2; ++d_) _Pragma("unroll") for (int r = 0; r < 16; ++r) o[d_][r] *= wsf[crow(r, hi)]; } } while (0)
    f32x16 pA0, pA1, pB0, pB1;
    int sl_prev = 0, sl_cur = 0, sl_next = SLOTB;
#define ROT() do { sl_prev = sl_cur; sl_cur = sl_next; sl_next = (sl_next == (NSLOT - 1) * SLOTB) ? 0 : sl_next + SLOTB; } while (0)
    DMA_K(2, 2 * SLOTB);
    WAIT_BAR(3, mA);
    {
        const lds_cptr kb = kp0;
        pA0 = f32x16{}; pA1 = f32x16{};
#pragma unroll
        for (int d0 = 0; d0 < 4; ++d0) { const bf16x8 b0 = *(const LAS bf16x8*)(kb + d0 * 2048), b1 = *(const LAS bf16x8*)(kb + d0 * 2048 + 512);
            const bf16x8 qv = QRD(d0); pA0 = __builtin_amdgcn_mfma_f32_32x32x16_bf16(b0, qv, pA0, 0, 0, 0); pA1 = __builtin_amdgcn_mfma_f32_32x32x16_bf16(b1, qv, pA1, 0, 0, 0); }
        MASKB(pA0, pA1, 0, mA);
        asm volatile("s_nop 15\n\ts_nop 7" : "+v"(pA0), "+v"(pA1));
        START(pA0, pA1);
#pragma unroll
        for (int r = 0; r < 16; ++r) pA1[r] = __builtin_amdgcn_exp2f(pA1[r]);
    }
    WAIT_BAR(0, mA);
    MLOAD(mB, 1);
    DMA_K(3, 0); DMA_V(1, SLOTB);
    ROT();
    kload8(kf, kp0 + sl_cur);
    WAIT_BAR(2, mB);
    s16x4 vlo[8], vhi[8]; u32x4 pw0, pw1, pw2, pw3;
#define PKW(P, B) cvtpk_s(P[B], P[B + 1])
#define PAF(k) __builtin_bit_cast(bf16x8, pw##k)
#define VFR(i) (bf16x8){vlo[i][0], vlo[i][1], vlo[i][2], vlo[i][3], vhi[i][0], vhi[i][1], vhi[i][2], vhi[i][3]}
#define PIN(x) asm volatile("" : "+v"(x))
#define MX3(a, b, c) __builtin_fmaxf(__builtin_fmaxf((a), (b)), (c))
#define GAPA(MF, A0, A1, A2, A3, W0, W1, PW) do { MF; sacc += A0; sacc += A1; sacc += A2; sacc += A3; PIN(sacc); W0; W1; PIN(PW); SBAR(); } while (0)
#define EX(v) __builtin_amdgcn_exp2f(v)
#define GAPB(MF, X, B) do { MF; X[B] = EX(X[B]); X[B + 1] = EX(X[B + 1]); X[B + 2] = EX(X[B + 2]); X[B + 3] = EX(X[B + 3]); PIN(X); SBAR(); } while (0)
#define VRD(i) do { vlo[i] = vtr(vp_ + (((i) >> 2) * 4096 + ((i) & 3) * 1024)); vhi[i] = vtr(vp_ + (((i) >> 2) * 4096 + ((i) & 3) * 1024 + 512)); } while (0)
#define KRD(G, j) do { if (G) { kload2(kf, kp0 + sl_next, j); SBAR(); } } while (0)
#define STEP(C0, C1, P0, P1, t, MC, MN, GM, GK, GV, GL) do { SBAR(); \
    const lds_cptr vp_ = vp0 + sl_prev; \
    bf16x8 qa_ = QRD(0), qb_; VRD(0); SBAR(); float sacc = (P0[0] + P0[1]); \
    GAPA(C0 = __builtin_amdgcn_mfma_f32_32x32x16_bf16(kf[0], qa_, negm, 0, 0, 0), P0[2], P0[3], P0[4], P0[5],     pw0[0] = PKW(P0, 0), pw0[1] = PKW(P0, 2), pw0); \
    VRD(4); SBAR(); GAPA(C1 = __builtin_amdgcn_mfma_f32_32x32x16_bf16(kf[1], qa_, negm, 0, 0, 0), P0[6], P0[7], P0[8], P0[9],     pw0[2] = PKW(P0, 4), pw0[3] = PKW(P0, 6), pw0); \
    qb_ = QRD(1); VRD(1); SBAR(); GAPA(C0 = __builtin_amdgcn_mfma_f32_32x32x16_bf16(kf[2], qb_, C0, 0, 0, 0),   P0[10], P0[11], P0[12], P0[13], pw1[0] = PKW(P0, 8), pw1[1] = PKW(P0, 10), pw1); \
    VRD(5); SBAR(); GAPA(C1 = __builtin_amdgcn_mfma_f32_32x32x16_bf16(kf[3], qb_, C1, 0, 0, 0),   P0[14], P0[15], P1[0], P1[1],   pw1[2] = PKW(P0, 12), pw1[3] = PKW(P0, 14), pw1); \
    qa_ = QRD(2); VRD(2); SBAR(); GAPA(C0 = __builtin_amdgcn_mfma_f32_32x32x16_bf16(kf[4], qa_, C0, 0, 0, 0),   P1[2], P1[3], P1[4], P1[5],     pw2[0] = PKW(P1, 0), pw2[1] = PKW(P1, 2), pw2); \
    VRD(6); SBAR(); GAPA(C1 = __builtin_amdgcn_mfma_f32_32x32x16_bf16(kf[5], qa_, C1, 0, 0, 0),   P1[6], P1[7], P1[8], P1[9],     pw2[2] = PKW(P1, 4), pw2[3] = PKW(P1, 6), pw2); \
    qb_ = QRD(3); VRD(3); SBAR(); GAPA(C0 = __builtin_amdgcn_mfma_f32_32x32x16_bf16(kf[6], qb_, C0, 0, 0, 0),   P1[10], P1[11], P1[12], P1[13], pw3[0] = PKW(P1, 8), pw3[1] = PKW(P1, 10), pw3); \
    VRD(7); SBAR(); GAPA(C1 = __builtin_amdgcn_mfma_f32_32x32x16_bf16(kf[7], qb_, C1, 0, 0, 0),   P1[14], P1[15], 0.f, 0.f,       pw3[2] = PKW(P1, 12), pw3[3] = PKW(P1, 14), pw3); \
    l_reg += sacc; \
    MASKB(C0, C1, t, MC); \
    if (GM) { MLOAD(MN, (t) + 1); } if (GK) { DMA_K((t) + 3, sl_cur); } if (GV) { DMA_V((t) + 1, sl_next); } \
    { float a = MX3(C0[0], C0[1], C1[0]), b_ = MX3(C0[2], C0[3], C1[1]); a = MX3(a, C1[2], C1[3]); \
      _Pragma("unroll") for (int r = 4; r < 16; r += 4) { a = MX3(a, C0[r], C0[r + 1]); b_ = MX3(b_, C0[r + 2], C0[r + 3]); a = MX3(a, C1[r], C1[r + 1]); b_ = MX3(b_, C1[r + 2], C1[r + 3]); } \
      float rm = __builtin_fmaxf(a, b_); { auto rr = __builtin_amdgcn_permlane32_swap(__float_as_uint(rm), __float_as_uint(rm), false, false); rm = __builtin_fmaxf(__uint_as_float(rr[0]), __uint_as_float(rr[1])); } \
      resc = false; \
      if (__builtin_expect(__any(rm > (float)THRL), 0)) { const float dl = __builtin_fmaxf(rm, 0.f); mhat += dl; \
        _Pragma("unroll") for (int r = 0; r < 16; ++r) { C0[r] -= dl; C1[r] -= dl; } \
        _Pragma("unroll") for (int r = 0; r < 16; ++r) negm[r] = -mhat; asm volatile("" : "+v"(negm)); \
        const float f = __builtin_amdgcn_exp2f(-dl); l_reg *= f; if (hi == 0) wsf[r32] = f; resc = true; } } \
    SBAR(); \
    GAPB(o[0] = __builtin_amdgcn_mfma_f32_32x32x16_bf16(PAF(0), VFR(0), o[0], 0, 0, 0), C0, 0); \
    GAPB(o[1] = __builtin_amdgcn_mfma_f32_32x32x16_bf16(PAF(0), VFR(4), o[1], 0, 0, 0), C0, 4); \
    KRD(GL, 0); GAPB(o[0] = __builtin_amdgcn_mfma_f32_32x32x16_bf16(PAF(1), VFR(1), o[0], 0, 0, 0), C0, 8); \
    KRD(GL, 1); GAPB(o[1] = __builtin_amdgcn_mfma_f32_32x32x16_bf16(PAF(1), VFR(5), o[1], 0, 0, 0), C0, 12); \
    KRD(GL, 2); GAPB(o[0] = __builtin_amdgcn_mfma_f32_32x32x16_bf16(PAF(2), VFR(2), o[0], 0, 0, 0), C1, 0); \
    KRD(GL, 3); GAPB(o[1] = __builtin_amdgcn_mfma_f32_32x32x16_bf16(PAF(2), VFR(6), o[1], 0, 0, 0), C1, 4); \
    GAPB(o[0] = __builtin_amdgcn_mfma_f32_32x32x16_bf16(PAF(3), VFR(3), o[0], 0, 0, 0), C1, 8); \
    GAPB(o[1] = __builtin_amdgcn_mfma_f32_32x32x16_bf16(PAF(3), VFR(7), o[1], 0, 0, 0), C1, 12); \
    } while (0)
    int t = 1;
    for (; t + 5 < NT; t += 2) {
        STEP(pB0, pB1, pA0, pA1, t, mB, mA, true, true, true, true);       WAIT_BAR(2, mA); RESC(); ROT();
        STEP(pA0, pA1, pB0, pB1, t + 1, mA, mB, true, true, true, true);   WAIT_BAR(2, mB); RESC(); ROT();
    }
#define ENDW(tt, M) do { if ((tt) + 3 < NT) { WAIT_BAR(2, M); } else if ((tt) + 2 < NT) { WAIT_BAR(1, M); } else { WAIT_BAR(0, M); } } while (0)
    for (; t + 1 < NT; t += 2) {
        STEP(pB0, pB1, pA0, pA1, t, mB, mA, (t + 1 < NT), (t + 3 < NT), (t + 1 < NT), (t + 1 < NT));         ENDW(t, mA);     RESC(); ROT();
        STEP(pA0, pA1, pB0, pB1, t + 1, mA, mB, (t + 2 < NT), (t + 4 < NT), (t + 2 < NT), (t + 2 < NT));     ENDW(t + 1, mB); RESC(); ROT();
    }
    STEP(pB0, pB1, pA0, pA1, NT - 1, mB, mA, false, false, false, false); RESC();
    { float sacc = pB0[0] + pB0[1];
#pragma unroll
      for (int r = 2; r < 16; ++r) sacc += pB0[r];
#pragma unroll
      for (int r = 0; r < 16; ++r) sacc += pB1[r];
      l_reg += sacc;
      pw0 = (u32x4){PKW(pB0, 0), PKW(pB0, 2), PKW(pB0, 4), PKW(pB0, 6)}; pw1 = (u32x4){PKW(pB0, 8), PKW(pB0, 10), PKW(pB0, 12), PKW(pB0, 14)};
      pw2 = (u32x4){PKW(pB1, 0), PKW(pB1, 2), PKW(pB1, 4), PKW(pB1, 6)}; pw3 = (u32x4){PKW(pB1, 8), PKW(pB1, 10), PKW(pB1, 12), PKW(pB1, 14)};
      SBAR(); pv(o, vb0 + sl_cur, PAF(0), PAF(1), PAF(2), PAF(3)); }
    { auto rr = __builtin_amdgcn_permlane32_swap(__float_as_uint(l_reg), __float_as_uint(l_reg), false, false); l_reg = __uint_as_float(rr[0]) + __uint_as_float(rr[1]); }
    if (hi == 0) wsf[32 + r32] = l_reg; asm volatile("s_waitcnt lgkmcnt(0)" ::: "memory");
    float rli[16];
#pragma unroll
    for (int r = 0; r < 16; ++r) rli[r] = __builtin_amdgcn_rcpf(wsf[32 + crow(r, hi)]);
    { LAS bf16* stg = (LAS bf16*)(shm + LDS_OST) + wid * 2048;
#pragma unroll
      for (int r = 0; r < 16; ++r) { const int orow = crow(r, hi);
          stg[orow * 64 + r32] = (bf16)(cvtpk_s(o[0][r] * rli[r] * ms0, 0.f) & 0xffffu); stg[orow * 64 + 32 + r32] = (bf16)(cvtpk_s(o[1][r] * rli[r] * ms1, 0.f) & 0xffffu); }
      asm volatile("s_waitcnt lgkmcnt(0)" ::: "memory");
      int ln2 = lane; asm volatile("" : "+v"(ln2));
#pragma unroll
      for (int i = 0; i < 4; ++i) { const int row = i * 8 + (ln2 >> 3), ch = ln2 & 7; const u32x4 v = *(const LAS u32x4*)(stg + row * 64 + ch * 8);
          *(u32x4*)(MIX + (rowbase + qw + row) * DM + h * HD + ch * 8) = v; } }
    asm volatile("s_waitcnt lgkmcnt(0)\n\ts_barrier" ::: "memory");
#undef QRD
#undef DMA_K
#undef DMA_V
#undef MLOAD
#undef WAIT_BAR
#undef MASKB
#undef START
#undef RESC
#undef ROT
#undef PKW
#undef PAF
#undef VFR
#undef PIN
#undef MX3
#undef GAPA
#undef GAPB
#undef EX
#undef VRD
#undef KRD
#undef STEP
#undef ENDW
}
#undef SBAR
}

__device__ __forceinline__ void p_attn(Frame& F, int l) {
    const bf16* Q = WSP(bf16, WS_Q); const bf16* Kg = WSP(bf16, WS_K); const bf16* Vg = WSP(bf16, WS_V); bf16* MIX = WSP(bf16, WS_MIX);
    const unsigned long long* maskQ = WSP(unsigned long long, WS_MASK);
    LAS unsigned char* shm = F.lds + RING_OFF;
    const int tid = F.tid, lane = F.lane, r32 = lane & 31;
    const int bh = F.vcu >> 2, sq = F.vcu & 3, b = bh >> 3, h = bh & 7;
    LAS float* biasT = (LAS float*)(shm + at::LDS_BIAS);
    if (tid < 192) { const int rel = tid - 128, nn = rel < 0 ? -rel : rel; int bk = nn;
        if (nn >= 8) bk = 8 + (nn >= 12) + (nn >= 16) + (nn >= 23) + (nn >= 32) + (nn >= 46) + (nn >= 64) + (nn >= 91);
        bk += (rel > 0) ? 16 : 0;
        biasT[tid] = (arg_in(7)[bk * NH + h] - arg_in(7)[15 * NH + h]) * LOG2E; }
    __syncthreads();
    const float ms0 = arg_in(6)[l * DM + h * 64 + r32], ms1 = arg_in(6)[l * DM + h * 64 + 32 + r32];
    for (int ui = 0; ui < 4; ++ui) {
        const int qb = (ui == 0) ? sq : (ui == 1) ? 7 - sq : (ui == 2) ? 8 + sq : 15 - sq;
        at::attn_unit<8>(b, h, qb, Q, Kg, Vg, maskQ, MIX, ms0, ms1, shm, tid);
    }
}


#define REP(bit) for (int rep_ = 0; rep_ < (((PROBE_MASK) >> (bit)) & 1) + 1; ++rep_)
struct Args { const float* in[20]; float* out; unsigned char* ws; int seg_lo, seg_hi; };
constexpr int N_SEG = 1 + 2 * 8 + 2 * 9;

__global__ void __launch_bounds__(NTHR, 2) fwd_kernel(Args a) {
    extern __shared__ __attribute__((aligned(16))) unsigned char lds_raw[];
    Frame F0;
    F0.lds = (LAS unsigned char*)lds_raw;
    F0.tid = threadIdx.x; F0.lane = F0.tid & 63; F0.wave = __builtin_amdgcn_readfirstlane(F0.tid >> 6);
    F0.G = gridDim.x; { const int bx = blockIdx.x; F0.vcu = (F0.G % 8 == 0) ? (bx % 8) * (F0.G / 8) + bx / 8 : bx; }
    F0.ws = a.ws;
    for (int u = F0.tid; u < (LDS_BYTES - LDSCTL_OFF) / 4; u += NTHR) ((LAS unsigned*)(F0.lds + LDSCTL_OFF))[u] = 0u;
    __syncthreads();
    unsigned* ctl = (unsigned*)(F0.ws + WS_CTL);
    XcdBarrier bar = xcd_barrier_post(ctl + CW_BAR, (volatile LAS unsigned*)(F0.lds + MISC_OFF + 32));
    int sg = 0;
    const int lo = a.seg_lo, hi = a.seg_hi;
#define ACTIVE (lo <= sg && sg < hi)
#define SEAM() do { if (lo <= sg && sg + 1 < hi) xcd_barrier(bar); ++sg; } while (0)

    if (ACTIVE) { Frame F = fresh(F0); cvt_x(F); convert_weights(F, 0); }
    SEAM();
    for (int l = 0; l < DEPTH; ++l) {
        if (ACTIVE) REP(3) {
            {
                Frame F = fresh(F0);
                pg8::DenseOrderG S; S.init_tiles(M / 256, 10, F.G, (int)(F.G % 8 == 0 ? (F.vcu % (F.G / 8)) * 8 + F.vcu / (F.G / 8) : F.vcu)); S.Bt = (const char*)WSP(unsigned char, WS_WIN); S.K = DM / 2;
                pg8::EpiIn E{WSP(bf16, WS_Q), WSP(bf16, WS_K), WSP(bf16, WS_V), WSP(bf16, WS_QI), WSP(bf16, WS_KI), WSP(bf16, WS_U), WSP(float, WS_WI), 0, 1.0f / (pg8::F8_ASC * pg8::F8_WGU), 6};
                pg8::gemm_phase<pg8::EpiIn, pg8::DenseOrderG, true, true, true>(F.tid, F.lds + RING_OFF, (const char*)WSP(unsigned char, WS_XQ), DM / 2, S, E);
            }
            {
                Frame F = fresh(F0);
                pg8::DenseOrder S; S.init_tiles(M / 256, 3, F.G, (int)(F.G % 8 == 0 ? (F.vcu % (F.G / 8)) * 8 + F.vcu / (F.G / 8) : F.vcu)); S.Bt = (const char*)(WSP(bf16, WS_WIN) + (size_t)1536 * DM); S.K = DM;
                pg8::EpiIn E{WSP(bf16, WS_Q), WSP(bf16, WS_K), WSP(bf16, WS_V), WSP(bf16, WS_QI), WSP(bf16, WS_KI), WSP(bf16, WS_U), WSP(float, WS_WI), 6, 1.0f, 99};
                pg8::gemm_phase<pg8::EpiIn, pg8::DenseOrder, true, true>(F.tid, F.lds + RING_OFF, (const char*)WSP(bf16, WS_XB), DM, S, E);
            }
        }
        SEAM();
        if (ACTIVE) {
#ifndef NO_IDX
            REP(0) { Frame F = fresh(F0); p_idx(F, l); }
#endif
#ifndef NO_CONV
            REP(1) { Frame F = fresh(F0); p_conv(F, l); }
#endif
        }
        SEAM();
        if (ACTIVE) {
#ifndef NO_ATTN
            REP(2) { Frame F = fresh(F0); p_attn(F, l); }
#endif
        }
        SEAM();
        if (ACTIVE) REP(4) { Frame F = fresh(F0); bf16* R1 = WSP(bf16, WS_R1);
            pg8::DenseOrder S; S.init_tiles(M / 256, DM / 256, F.G, (int)(F.G % 8 == 0 ? (F.vcu % (F.G / 8)) * 8 + F.vcu / (F.G / 8) : F.vcu)); S.Bt = (const char*)WSP(bf16, WS_WOUT); S.K = DM;
            pg8::EpiRes E{WSP(bf16, WS_XB), R1, 1.0f};
            pg8::gemm_phase<pg8::EpiRes, pg8::DenseOrder, true, true>(F.tid, F.lds + RING_OFF, (const char*)WSP(bf16, WS_MIX), DM, S, E);
        }
        SEAM();
        if (ACTIVE) { Frame F = fresh(F0); p_ln1(F, l); }
        SEAM();
        if ((l & 1) == 0) {
            if (ACTIVE) REP(5) { Frame F = fresh(F0); bf16* XB = WSP(bf16, WS_XB);
                pg8::DenseOrderG S; S.init_tiles(M / 256, 2 * DFF / 256, F.G, (int)(F.G % 8 == 0 ? (F.vcu % (F.G / 8)) * 8 + F.vcu / (F.G / 8) : F.vcu)); S.Bt = (const char*)WSP(bf16, WS_WFF); S.K = DM / 2;
                pg8::EpiSwi E{WSP(unsigned char, WS_H), DFF};
                pg8::gemm_phase<pg8::EpiSwi, pg8::DenseOrderG, true, true, true>(F.tid, F.lds + RING_OFF, (const char*)XB, DM / 2, S, E);
            }
            SEAM();
            if (ACTIVE) { Frame F = fresh(F0); bf16* R1 = WSP(bf16, WS_R1);
                pg8::DenseOrderG S; S.init_tiles(M / 256, DM / 256, F.G, (int)(F.G % 8 == 0 ? (F.vcu % (F.G / 8)) * 8 + F.vcu / (F.G / 8) : F.vcu)); S.Bt = (const char*)(WSP(unsigned char, WS_WFF) + (size_t)2 * DFF * DM); S.K = DFF / 2;
                pg8::EpiRes E{R1, R1, 1.0f / (pg8::F8_HSC * pg8::F8_WDN)};
                pg8::gemm_phase<pg8::EpiRes, pg8::DenseOrderG, true, true, true>(F.tid, F.lds + RING_OFF, (const char*)WSP(unsigned char, WS_H), DFF / 2, S, E);
            }
            SEAM();
            if (ACTIVE) { REP(11) { Frame F = fresh(F0); p_ln2(F, l); } if (l + 1 < DEPTH) REP(8) { Frame F = fresh(F0); convert_weights(F, l + 1); } }
            SEAM();
        } else {
            if (ACTIVE) { Frame F = fresh(F0); p_list(F); }
            SEAM();
            for (int r = 0; r < 1; ++r) {
                if (ACTIVE) REP(6) { Frame F = fresh(F0); bf16* XB = WSP(bf16, WS_XB);
                    moe_tables(F);
                    const int Tm = ((LAS int*)(F.lds + LDSCTL_OFF + 1200))[8]; const int tlo = r * RT; int nMr = Tm - tlo; nMr = nMr < 0 ? 0 : (nMr > RT ? RT : nMr);
                    pg8::MoeGuOrder S; S.init_tiles(nMr, 2 * DFE / 256, F.G, (int)(F.G % 8 == 0 ? (F.vcu % (F.G / 8)) * 8 + F.vcu / (F.G / 8) : F.vcu)); S.rowlist = WSP(int, WS_ROWLIST); S.texp = (const LAS int*)(F.lds + LDSCTL_OFF); S.tlo = tlo;
                    S.W = (const char*)WSP(unsigned char, WS_WFF); S.estride = (size_t)3 * DFE * DM;
                    pg8::EpiSwi E{WSP(unsigned char, WS_H), DFE};
                    pg8::gemm_phase<pg8::EpiSwi, pg8::MoeGuOrder, true, true, true>(F.tid, F.lds + RING_OFF, (const char*)XB, DM / 2, S, E);
                }
                SEAM();
                if (ACTIVE) REP(7) { Frame F = fresh(F0);
                    moe_tables(F);
                    const int Tm = ((LAS int*)(F.lds + LDSCTL_OFF + 1200))[8]; const int tlo = r * RT; int nMr = Tm - tlo; nMr = nMr < 0 ? 0 : (nMr > RT ? RT : nMr);
                    pg8::MoeDnOrder S; S.init_tiles(nMr, DM / 256, F.G, (int)(F.G % 8 == 0 ? (F.vcu % (F.G / 8)) * 8 + F.vcu / (F.G / 8) : F.vcu)); S.texp = (const LAS int*)(F.lds + LDSCTL_OFF); S.tlo = tlo;
                    S.W = (const char*)(WSP(unsigned char, WS_WFF) + (size_t)2 * DFE * DM); S.estride = (size_t)3 * DFE * DM;
                    pg8::EpiMoeDown E{WSP(bf16, WS_YD), WSP(float, WS_ROWGATE), tlo};
                    pg8::gemm_phase<pg8::EpiMoeDown, pg8::MoeDnOrder, true, true, true>(F.tid, F.lds + RING_OFF, (const char*)WSP(unsigned char, WS_H), DFE / 2, S, E);
                }
                SEAM();
            }
            if (ACTIVE) { REP(10) { Frame F = fresh(F0); p_comb(F, l); } if (l + 1 < DEPTH) REP(8) { Frame F = fresh(F0); convert_weights(F, l + 1); } }
            SEAM();
        }
    }
#undef ACTIVE
#undef SEAM
}

#ifndef MK_MULTI
#define MK_MULTI 0
#endif
extern "C" void kernel_launch(void* const* d_in, const int* in_sizes, int n_in, void* d_out, int out_size, void* d_ws, size_t ws_size, hipStream_t stream) {
    static int grid = 0;
    if (grid == 0) {
        if (n_in != 20 || in_sizes[0] != M * DM || out_size != M * DM || ws_size < WS_END) { fprintf(stderr, "kernel_launch: unexpected shapes (n_in %d, in0 %d, out %d, ws %zu, need %zu); nothing launched\n", n_in, n_in > 0 ? in_sizes[0] : -1, out_size, ws_size, (size_t)WS_END); grid = -1; return; }
        int dev = 0, cus = 0, per_cu = 0;
        if (hipGetDevice(&dev) != hipSuccess || hipDeviceGetAttribute(&cus, hipDeviceAttributeMultiprocessorCount, dev) != hipSuccess) { grid = -1; return; }
        if (hipFuncSetAttribute((const void*)fwd_kernel, hipFuncAttributeMaxDynamicSharedMemorySize, LDS_BYTES) != hipSuccess) { fprintf(stderr, "kernel_launch: hipFuncSetAttribute failed\n"); grid = -1; return; }
        if (hipOccupancyMaxActiveBlocksPerMultiprocessor(&per_cu, (const void*)fwd_kernel, NTHR, LDS_BYTES) != hipSuccess || per_cu < 1) fprintf(stderr, "kernel_launch: occupancy query reports %d\n", per_cu);
        (void)hipGetLastError();
        grid = cus;
        if (grid != 256) { fprintf(stderr, "kernel_launch: built for 256 CUs, device has %d; nothing launched\n", cus); grid = -1; return; }
    }
    if (grid < 0) return;
    if (hipMemsetAsync((char*)d_ws + WS_CTL, 0, CTL_ZERO_BYTES, stream) != hipSuccess) return;
    Args a{};
    for (int i = 0; i < 20; ++i) a.in[i] = (const float*)d_in[i];
    a.out = (float*)d_out; a.ws = (unsigned char*)d_ws;
#if MK_MULTI
    for (int s = 0; s < N_SEG; ++s) { a.seg_lo = s; a.seg_hi = s + 1; hipLaunchKernelGGL(fwd_kernel, dim3(grid), dim3(NTHR), LDS_BYTES, stream, a); }
#else
    a.seg_lo = 0; a.seg_hi = N_SEG;
    hipLaunchKernelGGL(fwd_kernel, dim3(grid), dim3(NTHR), LDS_BYTES, stream, a);
#endif
    const hipError_t le = hipPeekAtLastError();
    if (le != hipSuccess) fprintf(stderr, "kernel_launch: launch failed: %s\n", hipGetErrorName(le));
}
```

```cpp
#include <hip/hip_runtime.h>
#include <cstdio>
#include <cstdint>

#define GAS __attribute__((address_space(1)))
#define LAS __attribute__((address_space(3)))
#define CAS __attribute__((address_space(4)))
typedef unsigned short bf16;
typedef short bf16x8 __attribute__((ext_vector_type(8)));
typedef short s16x4 __attribute__((ext_vector_type(4)));
typedef float f32x2 __attribute__((ext_vector_type(2)));
typedef float f32x4 __attribute__((ext_vector_type(4)));
typedef float f32x16 __attribute__((ext_vector_type(16)));
typedef unsigned u32x2 __attribute__((ext_vector_type(2)));
typedef unsigned u32x4 __attribute__((ext_vector_type(4)));
typedef int i32x8 __attribute__((ext_vector_type(8)));

#ifndef PROBE_MASK
#define PROBE_MASK 0
#endif
constexpr int BATCH = 8, SEQ = 4096, DM = 1024, M = BATCH * SEQ, DEPTH = 4;
constexpr int AW = 512, NH = 8, HD = 64, CCH = 512, CK = 31;
constexpr int IN_COLS = 3144, NIN = 3328;
constexpr int OFF_KI = 2048, OFF_WI = 2112, OFF_GLU = 2120;
constexpr int DFF = 2816, DFE = 3584, NE = 8;
constexpr int TOPK = 256;
constexpr float DN_ALPHA = 1.6817928305074290f;
constexpr float LN_EPS = 1e-5f;
constexpr float LOG2E = 1.4426950408889634f;
constexpr float QSCALE = 0.125f * LOG2E;
constexpr int NWAVES = 8, NTHR = 512;
constexpr int MAXT = 272, RT = 272;

constexpr size_t MiB = 1u << 20;
constexpr size_t WS_CTL = 0, CTL_ZERO_BYTES = 1 * MiB;
constexpr size_t WS_WIN = 1 * MiB, WS_WOUT = 8 * MiB, WS_WFF = 10 * MiB;
constexpr size_t WS_R1 = 178 * MiB, WS_XB = 306 * MiB, WS_A = 370 * MiB;
constexpr size_t WS_Q = WS_A, WS_K = WS_A + 32 * MiB, WS_V = WS_A + 64 * MiB, WS_QI = WS_A + 96 * MiB, WS_KI = WS_A + 128 * MiB, WS_WI = WS_A + 132 * MiB,
                 WS_U = WS_A + 133 * MiB, WS_MIX = WS_A + 165 * MiB, WS_H = WS_A;
constexpr size_t WS_YD = 616 * MiB, WS_ROUTE = 752 * MiB, WS_ROWLIST = WS_ROUTE + 512 * 1024, WS_ROWGATE = WS_ROWLIST + 320 * 1024, WS_SLOTROW = WS_ROWGATE + 320 * 1024,
                 WS_CNTWG = WS_SLOTROW + 256 * 1024, WS_MASK = 754 * MiB, WS_XQ = 820 * MiB, WS_END = 852 * MiB;
static_assert((size_t)RT * 256 * DFE <= 246 * MiB && (size_t)M * DFF <= 246 * MiB, "H overlay (fp8)");
static_assert((size_t)MAXT * 256 * DM * 2 <= 136 * MiB, "Yd");
static_assert(WS_CNTWG + 8192 <= WS_MASK && WS_MASK + (size_t)DEPTH * BATCH * 128 * 4096 * 4 <= WS_XQ, "route / masks");
constexpr int CW_BAR = 4096;

constexpr int RING_OFF = 0, RING_BYTES = 131072;
constexpr int AUX_OFF = 131072, AUX_BYTES = 26624;
constexpr int LDSCTL_OFF = AUX_OFF + AUX_BYTES, MISC_OFF = LDSCTL_OFF + 2048;
constexpr int LDS_BYTES = 157 * 1024;
static_assert(MISC_OFF + 128 <= LDS_BYTES, "LDS map");

__device__ __forceinline__ unsigned cvt_pk_bf16(float lo, float hi) { unsigned r; asm volatile("v_cvt_pk_bf16_f32 %0, %1, %2" : "=v"(r) : "v"(lo), "v"(hi)); return r; }
__device__ __forceinline__ float bf2f(unsigned short b) { return __uint_as_float((unsigned)b << 16); }
__device__ __forceinline__ float fsigmoid(float x) { return __builtin_amdgcn_rcpf(1.0f + __builtin_amdgcn_exp2f(-x * LOG2E)); }
#define LDS_WAIT() asm volatile("s_waitcnt lgkmcnt(0)" ::: "memory")
#define VM_WAIT() asm volatile("s_waitcnt vmcnt(0)" ::: "memory")

namespace pg8 {
constexpr int BM = 256, BK = 64, HALF = 128, HTB = HALF * BK * 2, STAGE_BYTES = 8 * HTB, NXCD = 8, WGM = 8;
__host__ __device__ __forceinline__ int lds_byte(int r, int c) { const int st = (r >> 4) * 2 + (c >> 5), rr = r & 15, cc = c & 31, ob = rr * 64 + cc * 2; return st * 1024 + (ob ^ (((ob >> 9) & 1) << 5)); }
__host__ __device__ __forceinline__ void stage_rc(int b, int& R, int& C) { const int st = b / 1024, sb = b % 1024, swz = sb ^ (((sb >> 9) & 1) << 5); R = (st >> 1) * 16 + swz / 64; C = (st & 1) * 32 + (swz % 64) / 2; }
__host__ __device__ __forceinline__ int perm32(int rho) { const int n = rho >> 4, i = rho & 15; return 8 * (i >> 2) + 4 * n + (i & 3); }
struct Unit { int pm, pn; };

struct OrderBase {
    int nM, nN, nwg, G, c;
    __device__ __forceinline__ void init_tiles(int nM_, int nN_, int G_, int c_) { nM = nM_; nN = nN_; nwg = nM * nN; G = G_; c = c_; }
    __device__ __forceinline__ bool next(int i, Unit& u) const { const long L = (long)i * G + c; if (L >= nwg) return false; unit_of((int)L, u); return true; }
    __device__ __forceinline__ void unit_of(int L, Unit& u) const {
        int wgid = L; { const int q = nwg / NXCD, r = nwg % NXCD, xcd = wgid % NXCD, off = wgid / NXCD; wgid = (xcd < r ? xcd * (q + 1) : r * (q + 1) + (xcd - r) * q) + off; }
        const int nig = WGM * nN, gid = wgid / nig, fm = gid * WGM, gsz = (nM - fm) < WGM ? (nM - fm) : WGM;
        u.pm = fm + ((wgid % nig) % gsz); u.pn = (wgid % nig) / gsz;
    }
    __device__ __forceinline__ void a_ready(const Unit&) const {}
    __device__ __forceinline__ void done(const Unit&) const {}
};
struct DenseOrder : OrderBase {
    static constexpr bool GATHER = false;
    const char* Bt; int K;
    __device__ __forceinline__ size_t a_base(const Unit& u) const { return (size_t)u.pm * ((size_t)BM * K * 2); }
    __device__ __forceinline__ unsigned a_off(const Unit&, int) const { return 0u; }
    __device__ __forceinline__ const char* b_base(const Unit& u) const { return Bt + (size_t)u.pn * ((size_t)BM * K * 2); }
};

struct DenseOrderG : OrderBase {
    static constexpr bool GATHER = true;
    const char* Bt; int K;
    __device__ __forceinline__ size_t a_base(const Unit&) const { return 0; }
    __device__ __forceinline__ unsigned a_off(const Unit& u, int r) const { return (unsigned)(u.pm * BM + r) * (unsigned)(K * 2); }
    __device__ __forceinline__ const char* b_base(const Unit& u) const { return Bt + (size_t)u.pn * ((size_t)BM * K * 2); }
};

template <class Epi, class Sched, bool ALIGN_EPI, bool SP2, bool F8 = false>
__device__ __forceinline__ void gemm_phase(const int tid, LAS unsigned char* lds, const char* Abase, const int K, const Sched& S, const Epi& E) {
    const int wid = __builtin_amdgcn_readfirstlane(tid >> 6), lane = tid & 63, wr = wid >> 2, wc = wid & 3, fr = lane & 15, fq = lane >> 4;
    const int nt = K / BK;
    constexpr bool GATHER = Sched::GATHER;
    unsigned voffA[2], voffB[2];
#pragma unroll
    for (int i = 0; i < 2; ++i) { int R, C; stage_rc(tid * 16 + i * 8192, R, C); const int Rb = Epi::PERM ? ((R & ~31) + perm32(R & 31)) : R;
        voffA[i] = GATHER ? (unsigned)C * 2u : (unsigned)(R * K + C) * 2u; voffB[i] = (unsigned)(Rb * K + C) * 2u; }
    const size_t kstep = (size_t)(BK * 2);
    const size_t hstep = (size_t)HALF * K * 2;
    const unsigned ldsw = (unsigned)wid * 1024u;
    const int aoff = lds_byte(wr * 64 + fr, fq * 8), boff = lds_byte(wc * 32 + fr, fq * 8);
#define PG8_SA(b, h) (((b) * 2 + (h)) * HTB)
#define PG8_SB(b, h) ((4 + (b) * 2 + (h)) * HTB)
#define PG8_STAGE(bufoff, gbase, voff) do { _Pragma("unroll") for (int _i = 0; _i < 2; ++_i) \
        __builtin_amdgcn_global_load_lds((const unsigned*)((const char*)(gbase) + (voff)[_i]), (LAS unsigned*)(lds + (bufoff) + ldsw + _i * 8192), 16, 0, 0); } while (0)
typedef int i32x4_t __attribute__((ext_vector_type(4)));
#define PG8_LDA(dst, b, h) do { _Pragma("unroll") for (int m = 0; m < 4; ++m) { if constexpr (F8) { dst[m].lo = *(const LAS i32x4_t*)(lds + PG8_SA(b, h) + aoff + m * 2048); dst[m].hi = *(const LAS i32x4_t*)(lds + PG8_SA(b, h) + aoff + m * 2048 + 1024); } \
        else { _Pragma("unroll") for (int k = 0; k < 2; ++k) dst##b16[m][k] = *(const LAS bf16x8*)(lds + PG8_SA(b, h) + aoff + m * 2048 + k * 1024); } } } while (0)
#define PG8_LDB(dst, b, h) do { _Pragma("unroll") for (int n = 0; n < 2; ++n) { if constexpr (F8) { dst[n].lo = *(const LAS i32x4_t*)(lds + PG8_SB(b, h) + boff + n * 2048); dst[n].hi = *(const LAS i32x4_t*)(lds + PG8_SB(b, h) + boff + n * 2048 + 1024); } \
        else { _Pragma("unroll") for (int k = 0; k < 2; ++k) dst##b16[n][k] = *(const LAS bf16x8*)(lds + PG8_SB(b, h) + boff + n * 2048 + k * 1024); } } } while (0)
#define PG8_MMA(ai, bj, At, Bt) do { __builtin_amdgcn_s_setprio(1); _Pragma("unroll") for (int m = 0; m < 4; ++m) _Pragma("unroll") for (int n = 0; n < 2; ++n) { \
        if constexpr (F8) { acc[ai][bj][m][n] = __builtin_amdgcn_mfma_scale_f32_16x16x128_f8f6f4(Bt[n], At[m], acc[ai][bj][m][n], 0, 0, 0, 0x7f7f7f7f, 0, 0x7f7f7f7f); } \
        else { _Pragma("unroll") for (int k = 0; k < 2; ++k) acc[ai][bj][m][n] = __builtin_amdgcn_mfma_f32_16x16x32_bf16(Bt##b16[n][k], At##b16[m][k], acc[ai][bj][m][n], 0, 0, 0); } } __builtin_amdgcn_s_setprio(0); } while (0)
#define PG8_WAIT_V(n) asm volatile("s_waitcnt vmcnt(" #n ")" ::: "memory")
#define PG8_WAIT_L(n) asm volatile("s_waitcnt lgkmcnt(" #n ")" ::: "memory")
#define PG8_BAR __builtin_amdgcn_s_barrier()
#define PG8_SCHED __builtin_amdgcn_sched_barrier(0)
    Unit cur, nxt; int ui = 0;
    if (!S.next(0, cur)) return;
    f32x4 acc[2][2][4][2];
    { float z0 = 0.f; asm volatile("" : "+v"(z0));
#pragma unroll
    for (int a = 0; a < 2; ++a)
#pragma unroll
        for (int b = 0; b < 2; ++b)
#pragma unroll
            for (int m = 0; m < 4; ++m)
#pragma unroll
                for (int n = 0; n < 2; ++n) acc[a][b][m][n] = (f32x4){z0, z0, z0, z0}; }
    bf16x8 Atb16[F8 ? 1 : 4][2], B0b16[F8 ? 1 : 2][2], B1b16[F8 ? 1 : 2][2]; i32x8 At[F8 ? 4 : 1], B0[F8 ? 2 : 1], B1[F8 ? 2 : 1]; (void)Atb16; (void)B0b16; (void)B1b16; (void)At; (void)B0; (void)B1;
    unsigned cOff0[2], cOff1[2];
#define PG8_ROWS(u) do { if constexpr (GATHER) { _Pragma("unroll") for (int _i = 0; _i < 2; ++_i) { int R_, C_; stage_rc(tid * 16 + _i * 8192, R_, C_); cOff0[_i] = S.a_off(u, R_) + voffA[_i]; cOff1[_i] = S.a_off(u, HALF + R_) + voffA[_i]; } } } while (0)
#define PG8_STAGE_A(bufoff, h, ptr) do { if constexpr (GATHER) { if ((h) == 0) PG8_STAGE(bufoff, ptr, cOff0); else PG8_STAGE(bufoff, ptr, cOff1); } else { PG8_STAGE(bufoff, (ptr) + (h) * hstep, voffA); } } while (0)
    const char* cA = Abase; if constexpr (!GATHER) cA = Abase + S.a_base(cur);
    PG8_ROWS(cur);
    const char* cB = S.b_base(cur);
    S.a_ready(cur);
    {
        PG8_STAGE(PG8_SB(0, 0), cB, voffB); PG8_STAGE(PG8_SB(0, 1), cB + hstep, voffB); PG8_STAGE_A(PG8_SA(0, 0), 0, cA); PG8_STAGE_A(PG8_SA(0, 1), 1, cA);
        if (wr == 1) PG8_BAR;
        PG8_WAIT_V(2); PG8_BAR;
        PG8_STAGE(PG8_SB(1, 0), cB + kstep, voffB); PG8_STAGE_A(PG8_SA(1, 0), 0, cA + kstep); PG8_STAGE(PG8_SB(1, 1), cB + hstep + kstep, voffB);
        PG8_WAIT_V(6); PG8_BAR;
    }
    for (;;) {
        const bool has_next = S.next(ui + 1, nxt);
        unsigned nOff0[2] = {0u, 0u}, nOff1[2] = {0u, 0u};
        if constexpr (GATHER) { if (has_next) { _Pragma("unroll") for (int _i = 0; _i < 2; ++_i) { int R_, C_; stage_rc(tid * 16 + _i * 8192, R_, C_); nOff0[_i] = S.a_off(nxt, R_); nOff1[_i] = S.a_off(nxt, HALF + R_); } } }
        const char* nA = cA; if constexpr (!GATHER) { if (has_next) nA = Abase + S.a_base(nxt); }
        const char* nB = has_next ? S.b_base(nxt) : cB;
#pragma nounroll
        for (int t = 0; t < nt; t += 2) {
            const bool last = (t == nt - 2);
            const char* a1 = cA + (size_t)(t + 1) * kstep;
            const char* a2 = last ? nA : cA + (size_t)(t + 2) * kstep; const char* b2 = last ? nB : cB + (size_t)(t + 2) * kstep;
            const char* a3 = a2 + kstep; const char* b3 = b2 + kstep;
            if (last && has_next) S.a_ready(nxt);
            if constexpr (SP2) {
            PG8_LDB(B0, 0, 0); PG8_LDB(B1, 0, 1); PG8_SCHED; PG8_LDA(At, 0, 0); PG8_STAGE_A(PG8_SA(1, 1), 1, a1);
            if constexpr (GATHER) { if (last && has_next) { _Pragma("unroll") for (int _i = 0; _i < 2; ++_i) { cOff0[_i] = nOff0[_i] + voffA[_i]; cOff1[_i] = nOff1[_i] + voffA[_i]; } } }
            PG8_WAIT_V(8); PG8_WAIT_L(0); PG8_BAR; PG8_MMA(0, 0, At, B0); PG8_MMA(0, 1, At, B1); PG8_BAR; PG8_SCHED;
            PG8_LDA(At, 0, 1); PG8_STAGE(PG8_SB(0, 0), b2, voffB); PG8_STAGE(PG8_SB(0, 1), b2 + hstep, voffB); PG8_STAGE_A(PG8_SA(0, 0), 0, a2);
            PG8_WAIT_V(8); PG8_WAIT_L(0); PG8_BAR; PG8_MMA(1, 0, At, B0); PG8_MMA(1, 1, At, B1); PG8_BAR; PG8_SCHED;
            PG8_LDB(B0, 1, 0); PG8_LDB(B1, 1, 1); PG8_SCHED; PG8_LDA(At, 1, 0); PG8_STAGE_A(PG8_SA(0, 1), 1, a2);
            PG8_WAIT_V(8); PG8_WAIT_L(0); PG8_BAR; PG8_MMA(0, 0, At, B0); PG8_MMA(0, 1, At, B1); PG8_BAR; PG8_SCHED;
            PG8_LDA(At, 1, 1); PG8_STAGE(PG8_SB(1, 0), b3, voffB); PG8_STAGE(PG8_SB(1, 1), b3 + hstep, voffB); PG8_STAGE_A(PG8_SA(1, 0), 0, a3);
            PG8_WAIT_V(8); PG8_WAIT_L(0); PG8_BAR; PG8_MMA(1, 0, At, B0); PG8_MMA(1, 1, At, B1); PG8_BAR; PG8_SCHED;
            } else { static_assert(SP2, "only the two-super-phase loop is kept"); }
        }
        if constexpr (ALIGN_EPI) { if (wr == 0) PG8_BAR; }
        E(acc, cur, wr, wc, fr, fq); S.done(cur);
        if (!has_next) break;
        { float z0 = 0.f; asm volatile("" : "+v"(z0));
#pragma unroll
        for (int a = 0; a < 2; ++a)
#pragma unroll
            for (int b = 0; b < 2; ++b)
#pragma unroll
                for (int m = 0; m < 4; ++m)
#pragma unroll
                    for (int n = 0; n < 2; ++n) acc[a][b][m][n] = (f32x4){z0, z0, z0, z0}; }
        cur = nxt; cA = nA; cB = nB; ++ui;
        if constexpr (ALIGN_EPI) { if (wr == 1) PG8_BAR; }
    }
    PG8_WAIT_V(0);
    if constexpr (!ALIGN_EPI) { if (wr == 0) PG8_BAR; }
    PG8_BAR;
#undef PG8_SA
#undef PG8_SB
#undef PG8_STAGE
#undef PG8_STAGE_A
#undef PG8_ROWS
#undef PG8_LDA
#undef PG8_LDB
#undef PG8_MMA
#undef PG8_WAIT_V
#undef PG8_WAIT_L
#undef PG8_BAR
#undef PG8_SCHED
}
}

namespace pg8 {
__device__ __forceinline__ u32x4 pack8(const f32x4 v0, const f32x4 v1) { u32x4 w; w.x = cvt_pk_bf16(v0[0], v0[1]); w.y = cvt_pk_bf16(v0[2], v0[3]); w.z = cvt_pk_bf16(v1[0], v1[1]); w.w = cvt_pk_bf16(v1[2], v1[3]); return w; }

__device__ __forceinline__ unsigned pk4_fp8(float a, float b, float c, float d) {
    a = __builtin_amdgcn_fmed3f(a, -448.f, 448.f); b = __builtin_amdgcn_fmed3f(b, -448.f, 448.f); c = __builtin_amdgcn_fmed3f(c, -448.f, 448.f); d = __builtin_amdgcn_fmed3f(d, -448.f, 448.f);
    unsigned r = 0u; r = (unsigned)__builtin_amdgcn_cvt_pk_fp8_f32(a, b, (int)r, false); r = (unsigned)__builtin_amdgcn_cvt_pk_fp8_f32(c, d, (int)r, true); return r; }
__device__ __forceinline__ u32x2 pack8_fp8(const f32x4 v0, const f32x4 v1) { u32x2 w; w.x = pk4_fp8(v0[0], v0[1], v0[2], v0[3]); w.y = pk4_fp8(v1[0], v1[1], v1[2], v1[3]); return w; }
constexpr float F8_ASC = 16.f, F8_WGU = 64.f, F8_HSC = 8.f, F8_WDN = 256.f;
struct EpiIn {
    static constexpr bool PERM = true;
    bf16 *Q, *Kb, *V, *QI, *KI, *U; float* WI; int pn_off; float dsc; int glu_from;
    __device__ __forceinline__ void operator()(const f32x4 (&acc)[2][2][4][2], const Unit& u, int wr, int wc, int fr, int fq) const {
        const int row0 = u.pm * BM + wr * 64 + fr; const int pn = (u.pn >= glu_from) ? u.pn - glu_from + 9 : u.pn + pn_off;
        if (pn < 2 || (pn >= 6 && pn < 8)) {
            bf16* base = (pn < 2) ? Q : QI;
            const float sc = ((pn < 2) ? QSCALE : 1.0f) * dsc;
            const int col0 = (pn & 1) * 256 + wc * 32 + 8 * fq;
#pragma unroll
            for (int ai = 0; ai < 2; ++ai)
#pragma unroll
                for (int m = 0; m < 4; ++m) { bf16* rowp = base + (size_t)(row0 + ai * HALF + m * 16) * AW + col0;
#pragma unroll
                    for (int bj = 0; bj < 2; ++bj) *(u32x4*)(rowp + bj * HALF) = pack8(acc[ai][bj][m][0] * sc, acc[ai][bj][m][1] * sc); }
        } else if (pn < 6) {
            const bool isK = pn < 4; bf16* base = isK ? Kb : V;
#pragma unroll
            for (int ai = 0; ai < 2; ++ai)
#pragma unroll
                for (int m = 0; m < 4; ++m) { const int row = row0 + ai * HALF + m * 16, bb = row >> 12, t = row & 4095, tile = t >> 6, r = t & 63;
#pragma unroll
                    for (int bj = 0; bj < 2; ++bj) { const int col = (pn & 1) * 256 + bj * HALF + wc * 32 + 8 * fq, h = col >> 6, d = col & 63;
                        const size_t tb = ((size_t)((bb * NH + h) * 64 + tile)) * 4096;
                        const size_t off = isK ? tb + (d >> 3) * 512 + r * 8 : tb + (d >> 5) * 2048 + r * 32 + (d & 31);
                        *(u32x4*)(base + off) = pack8(acc[ai][bj][m][0] * dsc, acc[ai][bj][m][1] * dsc); } }
        } else if (pn == 8) {
#pragma unroll
            for (int ai = 0; ai < 2; ++ai)
#pragma unroll
                for (int m = 0; m < 4; ++m) { const size_t row = (size_t)(row0 + ai * HALF + m * 16);
                    if (wc < 2) { const int c8 = wc * 4 + fq;
                        *(u32x4*)(KI + (row >> 5) * 2048 + (c8 >> 1) * 512 + (c8 & 1) * 256 + (row & 31) * 8) = pack8(acc[ai][0][m][0] * dsc, acc[ai][0][m][1] * dsc); }
                    else if (wc == 2 && fq == 0) { *(f32x4*)(WI + row * 8) = acc[ai][0][m][0] * dsc; *(f32x4*)(WI + row * 8 + 4) = acc[ai][0][m][1] * dsc; } }
        } else {
            const int col0 = (pn - 9) * 128 + wc * 32 + 8 * fq;
#pragma unroll
            for (int ai = 0; ai < 2; ++ai)
#pragma unroll
                for (int m = 0; m < 4; ++m) { f32x4 o[2];
#pragma unroll
                    for (int n = 0; n < 2; ++n) { const f32x4 a = acc[ai][0][m][n], g = acc[ai][1][m][n];
#pragma unroll
                        for (int e = 0; e < 4; ++e) o[n][e] = a[e] * dsc * fsigmoid(g[e] * dsc); }
                    *(u32x4*)(U + (size_t)(row0 + ai * HALF + m * 16) * CCH + col0) = pack8(o[0], o[1]); }
        }
    }
};
struct EpiRes {
    static constexpr bool PERM = true;
    const bf16* base; bf16* out; float asc;
    __device__ __forceinline__ void operator()(const f32x4 (&acc)[2][2][4][2], const Unit& u, int wr, int wc, int fr, int fq) const {
        const int row0 = u.pm * BM + wr * 64 + fr, col0 = u.pn * BM + wc * 32 + 8 * fq;
#pragma unroll
        for (int ai = 0; ai < 2; ++ai) {
            u32x4 bsv[4][2];
#pragma unroll
            for (int m = 0; m < 4; ++m)
#pragma unroll
                for (int bj = 0; bj < 2; ++bj) bsv[m][bj] = __builtin_nontemporal_load((const u32x4*)(base + (size_t)(row0 + ai * HALF + m * 16) * DM + col0 + bj * HALF));
#pragma unroll
            for (int m = 0; m < 4; ++m) { const size_t off = (size_t)(row0 + ai * HALF + m * 16) * DM + col0;
#pragma unroll
                for (int bj = 0; bj < 2; ++bj) { const u32x4 bs = bsv[m][bj];
                    f32x4 b0, b1; b0[0] = __uint_as_float(bs.x << 16); b0[1] = __uint_as_float(bs.x & 0xffff0000u); b0[2] = __uint_as_float(bs.y << 16); b0[3] = __uint_as_float(bs.y & 0xffff0000u);
                    b1[0] = __uint_as_float(bs.z << 16); b1[1] = __uint_as_float(bs.z & 0xffff0000u); b1[2] = __uint_as_float(bs.w << 16); b1[3] = __uint_as_float(bs.w & 0xffff0000u);
                    *(u32x4*)(out + off + bj * HALF) = pack8(b0 * DN_ALPHA + acc[ai][bj][m][0] * asc, b1 * DN_ALPHA + acc[ai][bj][m][1] * asc); } }
        }
    }
};
struct EpiSwi {
    static constexpr bool PERM = true;
    unsigned char* H; int ldh;
    __device__ __forceinline__ void operator()(const f32x4 (&acc)[2][2][4][2], const Unit& u, int wr, int wc, int fr, int fq) const {
        const int row0 = u.pm * BM + wr * 64 + fr, col0 = u.pn * 128 + wc * 32 + 8 * fq;
        constexpr float ds = 1.0f / (F8_ASC * F8_WGU);
#pragma unroll
        for (int ai = 0; ai < 2; ++ai)
#pragma unroll
            for (int m = 0; m < 4; ++m) { f32x4 o[2];
#pragma unroll
                for (int n = 0; n < 2; ++n) { const f32x4 ga = acc[ai][0][m][n], ua = acc[ai][1][m][n];
#pragma unroll
                    for (int e = 0; e < 4; ++e) o[n][e] = (ga[e] * ua[e]) * ((ds * ds * F8_HSC) * __builtin_amdgcn_rcpf(1.0f + __builtin_amdgcn_exp2f(ga[e] * (-ds * LOG2E)))); }
                *(u32x2*)(H + (size_t)(row0 + ai * HALF + m * 16) * ldh + col0) = pack8_fp8(o[0], o[1]); }
    }
};
struct EpiMoeDown {
    static constexpr bool PERM = true;
    bf16* Yd; const float* rowgate; int tlo;
    __device__ __forceinline__ void operator()(const f32x4 (&acc)[2][2][4][2], const Unit& u, int wr, int wc, int fr, int fq) const {
        const int row0 = (tlo + u.pm) * BM + wr * 64 + fr, col0 = u.pn * BM + wc * 32 + 8 * fq;
#pragma unroll
        for (int ai = 0; ai < 2; ++ai)
#pragma unroll
            for (int m = 0; m < 4; ++m) { const int row = row0 + ai * HALF + m * 16; const float gt = rowgate[row] * (1.0f / (F8_HSC * F8_WDN)); bf16* rowp = Yd + (size_t)row * DM + col0;
#pragma unroll
                for (int bj = 0; bj < 2; ++bj) *(u32x4*)(rowp + bj * HALF) = pack8(acc[ai][bj][m][0] * gt, acc[ai][bj][m][1] * gt); }
    }
};
struct MoeGuOrder : OrderBase {
    static constexpr bool GATHER = true;
    const int* rowlist; const LAS int* texp; int tlo; const char* W; size_t estride;
    __device__ __forceinline__ size_t a_base(const Unit&) const { return 0; }
    __device__ __forceinline__ unsigned a_off(const Unit& u, int r) const { return (unsigned)rowlist[(tlo + u.pm) * BM + r] * (unsigned)DM; }
    __device__ __forceinline__ const char* b_base(const Unit& u) const { return W + (size_t)texp[tlo + u.pm] * estride + (size_t)u.pn * ((size_t)BM * DM); }
};
struct MoeDnOrder : OrderBase {
    static constexpr bool GATHER = true;
    const LAS int* texp; int tlo; const char* W; size_t estride;
    __device__ __forceinline__ size_t a_base(const Unit&) const { return 0; }
    __device__ __forceinline__ unsigned a_off(const Unit& u, int r) const { return (unsigned)(u.pm * BM + r) * (unsigned)DFE; }
    __device__ __forceinline__ const char* b_base(const Unit& u) const { return W + (size_t)texp[tlo + u.pm] * estride + (size_t)u.pn * ((size_t)BM * DFE); }
};
}

typedef GAS unsigned gu32;
#define RLX_AGENT __ATOMIC_RELAXED, __HIP_MEMORY_SCOPE_AGENT
#define XB_TMO      128
#define XB_XCNT(j)  (256  + 64 * (j))
#define XB_XSUB(j)  (1280 + 64 * (j))
#define XB_XGEN(j)  (2304 + 64 * (j))
#define XB_TOP      3328
#define XB_TOPGEN   3392
#define XCD_BAR_WORDS 3456
#define XB_SPIN_CAP (1u << 18)

__device__ __forceinline__ unsigned xb_ld(unsigned* p)              { return __hip_atomic_load(p, __ATOMIC_RELAXED, __HIP_MEMORY_SCOPE_AGENT); }
__device__ __forceinline__ unsigned xb_add(unsigned* p, unsigned v) { return __hip_atomic_fetch_add(p, v, __ATOMIC_RELAXED, __HIP_MEMORY_SCOPE_AGENT); }
__device__ __forceinline__ unsigned xb_xcc_id() { return (unsigned)__builtin_amdgcn_s_getreg((3 << 11) | 20) & 0xFu; }
#define XB_SPIN(cond, bar) do { unsigned _sp = 0; while (cond) { __builtin_amdgcn_s_sleep(1); \
    if ((++_sp & 255u) == 0u) { if (xb_ld(&(bar)[XB_TMO])) break; if (_sp > XB_SPIN_CAP) { atomicAdd(&(bar)[XB_TMO], 1u); break; } } } } while (0)

struct XcdBarrier {
    unsigned* bar; unsigned x;
    volatile LAS unsigned* st;
};
__device__ __forceinline__ XcdBarrier xcd_barrier_post(unsigned* bar, volatile LAS unsigned* st) {
    XcdBarrier b; b.bar = bar; b.x = xb_xcc_id(); b.st = st;
    if (threadIdx.x == 0) (void)xb_add(&bar[XB_XCNT(b.x)], 1u);
    return b;
}
__device__ __forceinline__ void xcd_barrier_complete(unsigned* bar, unsigned x, unsigned& nloc, unsigned& nx) {
    const unsigned G = gridDim.x * gridDim.y * gridDim.z;
    unsigned sum, cnt, mine, sp = 0u;
    for (;;) {
        sum = 0u; cnt = 0u; mine = 0u;
#pragma unroll
        for (unsigned j = 0; j < 16; ++j) { const unsigned c = xb_ld(&bar[XB_XCNT(j)]); sum += c; cnt += (c > 0u) ? 1u : 0u; mine = (j == x) ? c : mine; }
        if (sum == G) break;
        __builtin_amdgcn_s_sleep(1);
        if ((++sp & 255u) == 0u) { if (xb_ld(&bar[XB_TMO])) break; if (sp > XB_SPIN_CAP) { atomicAdd(&bar[XB_TMO], 1u); break; } }
    }
    nloc = mine > 0u ? mine : 1u; nx = cnt > 0u ? cnt : 1u;
}
__device__ __forceinline__ void xcd_barrier(const XcdBarrier& b) {
    asm volatile("s_waitcnt vmcnt(0)" ::: "memory");
    __syncthreads();
    if (threadIdx.x == 0) {
        unsigned* bar = b.bar;
        __builtin_amdgcn_s_waitcnt(0);
        unsigned nloc = b.st[0], nx = b.st[1];
        if (nloc == 0u) { xcd_barrier_complete(bar, b.x, nloc, nx); b.st[0] = nloc; b.st[1] = nx; }
        const unsigned old = xb_add(&bar[XB_XSUB(b.x)], 1u);
        const unsigned gen = old / nloc;
        if (old + 1u == (gen + 1u) * nloc) {
            __builtin_amdgcn_fence(__ATOMIC_RELEASE, "agent");
            asm volatile("s_waitcnt vmcnt(0)" ::: "memory");
            const unsigned og = xb_add(&bar[XB_TOP], 1u);
            const unsigned tg = og / nx;
            if (og + 1u == (tg + 1u) * nx) xb_add(&bar[XB_TOPGEN], 1u);
            else XB_SPIN(xb_ld(&bar[XB_TOPGEN]) == tg, bar);
            __builtin_amdgcn_fence(__ATOMIC_ACQUIRE, "agent");
            xb_add(&bar[XB_XGEN(b.x)], 1u);
            asm volatile("s_waitcnt vmcnt(0)" ::: "memory");
        } else {
            XB_SPIN(xb_ld(&bar[XB_XGEN(b.x)]) == gen, bar);
            __builtin_amdgcn_fence(__ATOMIC_ACQUIRE, "agent");
            asm volatile("s_waitcnt vmcnt(0)" ::: "memory");
        }
    }
    __syncthreads();
}

struct Frame {
    LAS unsigned char* lds;
    int tid, lane, wave, vcu, G;
    unsigned char* ws;
};
__device__ __forceinline__ const float* arg_in(int k) { return (const float*)*(const GAS float* const volatile CAS*)((const CAS char*)__builtin_amdgcn_kernarg_segment_ptr() + 8 * k); }
__device__ __forceinline__ float* arg_out() { return (float*)*(GAS float* const volatile CAS*)((const CAS char*)__builtin_amdgcn_kernarg_segment_ptr() + 160); }
#define WSP(T, off) ((T*)(F.ws + (off)))
__device__ __forceinline__ Frame fresh(const Frame& F0) {
    Frame F = F0; int wv = F0.wave, v = F0.vcu, g = F0.G; asm volatile("" : "+s"(wv), "+s"(v), "+s"(g)); F.wave = wv; F.vcu = v; F.G = g;
    int ln; asm volatile("v_mbcnt_lo_u32_b32 %0, -1, 0\n\tv_mbcnt_hi_u32_b32 %0, -1, %0" : "=v"(ln)); F.lane = ln; F.tid = wv * 64 + ln;
    GAS unsigned char* w = (GAS unsigned char*)F0.ws; asm volatile("" : "+s"(w)); F.ws = (unsigned char*)w;
    return F;
}

__device__ __forceinline__ float wave_sum(float v) {
#define WS_DPP(x, ctrl) __int_as_float(__builtin_amdgcn_update_dpp(0, __float_as_int(x), (ctrl), 0xf, 0xf, false))
    v += WS_DPP(v, 0xB1); v += WS_DPP(v, 0x4E); v += WS_DPP(v, 0x141); v += WS_DPP(v, 0x140);
#undef WS_DPP
    const float r0 = __int_as_float(__builtin_amdgcn_readlane(__float_as_int(v), 0)), r1 = __int_as_float(__builtin_amdgcn_readlane(__float_as_int(v), 16)),
                r2 = __int_as_float(__builtin_amdgcn_readlane(__float_as_int(v), 32)), r3 = __int_as_float(__builtin_amdgcn_readlane(__float_as_int(v), 48));
    return (r0 + r1) + (r2 + r3);
}

template <bool FP8> __device__ __forceinline__ void tr_item64(const float* W, int ldw, int c0, int nvalid, int k0, void* WT, int Kd, int r0, float scale, LAS float* scr, int lane) {
    const int n4 = 4 * (lane & 15); const bool ok = n4 < nvalid;
    const float* src = W + (size_t)(k0 + (lane >> 4)) * ldw + c0 + n4;
#pragma unroll 8
    for (int i = 0; i < 16; ++i) { f32x4 v = {0.f, 0.f, 0.f, 0.f}; if (ok) v = *(const f32x4*)(src + (size_t)(4 * i) * ldw);
        LAS float* d = scr + (4 * i + (lane >> 4)) * 65 + n4; d[0] = v[0]; d[1] = v[1]; d[2] = v[2]; d[3] = v[3]; }
    LDS_WAIT(); asm volatile("" ::: "memory");
    const int c = lane & 7;
#pragma unroll
    for (int j = 0; j < 8; ++j) { const int nn = (lane >> 3) + 8 * j; const LAS float* s = scr + (8 * c) * 65 + nn;
        if constexpr (FP8) { u32x2 o; o.x = pg8::pk4_fp8(s[0 * 65] * scale, s[1 * 65] * scale, s[2 * 65] * scale, s[3 * 65] * scale); o.y = pg8::pk4_fp8(s[4 * 65] * scale, s[5 * 65] * scale, s[6 * 65] * scale, s[7 * 65] * scale);
            *(u32x2*)((unsigned char*)WT + (size_t)(r0 + nn) * Kd + k0 + 8 * c) = o; }
        else { u32x4 o; o.x = cvt_pk_bf16(s[0 * 65], s[1 * 65]); o.y = cvt_pk_bf16(s[2 * 65], s[3 * 65]); o.z = cvt_pk_bf16(s[4 * 65], s[5 * 65]); o.w = cvt_pk_bf16(s[6 * 65], s[7 * 65]);
            *(u32x4*)((bf16*)WT + (size_t)(r0 + nn) * Kd + k0 + 8 * c) = o; } }
    LDS_WAIT(); asm volatile("" ::: "memory");
}

__device__ __forceinline__ void convert_weights(Frame& F, int l) {
    LAS float* scr = (LAS float*)(F.lds + RING_OFF + F.wave * 16640);
    const int gw = F.vcu * NWAVES + F.wave, NGW = F.G * NWAVES, lane = F.lane;
    bf16* WinT = WSP(bf16, WS_WIN); bf16* WoutT = WSP(bf16, WS_WOUT); unsigned char* Wff = WSP(unsigned char, WS_WFF);
    const float* w_in = arg_in(1) + (size_t)l * DM * IN_COLS;
    const float* w_out = arg_in(8) + (size_t)l * DM * DM;
    constexpr int I_IN = (NIN / 64) * 16, I_OUT = 16 * 16;
    for (int it = gw; it < I_IN + I_OUT; it += NGW) {
        if (it < I_IN) {
            const int nb = it >> 4, kb = it & 15; int c0 = 0, nv = 64;
            if (nb < 33) c0 = 64 * nb;
            else if (nb == 33) { c0 = OFF_WI; nv = 8; }
            else if (nb < 36) { nv = 0; }
            else { const int rr = 64 * (nb - 36), p = rr >> 8, w = rr & 255; c0 = (w < 128) ? (OFF_GLU + 128 * p + w) : (OFF_GLU + CCH + 128 * p + (w - 128)); }
            if (nb < 24) tr_item64<true>(w_in, IN_COLS, c0, nv, 64 * kb, WinT, DM, 64 * nb, pg8::F8_WGU, scr, lane);
            else if (nb >= 36) tr_item64<true>(w_in, IN_COLS, c0, nv, 64 * kb, WinT, DM, 64 * (nb - 12), pg8::F8_WGU, scr, lane);
            else tr_item64<false>(w_in, IN_COLS, c0, nv, 64 * kb, WinT, DM, 64 * nb, 1.f, scr, lane);
        } else { const int r = it - I_IN, nb = r >> 4, kb = r & 15; tr_item64<false>(w_out, DM, 64 * nb, 64, 64 * kb, WoutT, DM, 64 * nb, 1.f, scr, lane); }
    }
    if ((l & 1) == 0) {
        const int d = l >> 1;
        const float* wg = arg_in(13) + (size_t)d * DM * DFF; const float* wu = arg_in(14) + (size_t)d * DM * DFF; const float* wd = arg_in(15) + (size_t)d * DFF * DM;
        unsigned char* Wgu = Wff; unsigned char* Wdn = Wgu + (size_t)2 * DFF * DM;
        constexpr int I_GU = (2 * DFF / 64) * 16, I_DN = 16 * (DFF / 64);
        for (int it = gw; it < I_GU + I_DN; it += NGW) {
            if (it < I_GU) { const int nb = it >> 4, kb = it & 15, rr = 64 * nb, p = rr >> 8, w = rr & 255;
                tr_item64<true>((w < 128) ? wg : wu, DFF, 128 * p + (w & 127), 64, 64 * kb, Wgu, DM, rr, pg8::F8_WGU, scr, lane); }
            else { const int r = it - I_GU, nb = r / (DFF / 64), kb = r % (DFF / 64); tr_item64<true>(wd, DM, 64 * nb, 64, 64 * kb, Wdn, DFF, 64 * nb, pg8::F8_WDN, scr, lane); }
        }
    } else {
        const int d = l >> 1;
        constexpr int I_GU = (2 * DFE / 64) * 16, I_DN = 16 * (DFE / 64), I_E = I_GU + I_DN;
        for (int it = gw; it < NE * I_E; it += NGW) {
            const int e = it / I_E, r0 = it % I_E;
            const float* wg = arg_in(17) + ((size_t)d * NE + e) * DM * DFE; const float* wu = arg_in(18) + ((size_t)d * NE + e) * DM * DFE; const float* wd = arg_in(19) + ((size_t)d * NE + e) * DFE * DM;
            unsigned char* Wgu = Wff + (size_t)e * (3 * (size_t)DFE * DM); unsigned char* Wdn = Wgu + (size_t)2 * DFE * DM;
            if (r0 < I_GU) { const int nb = r0 >> 4, kb = r0 & 15, rr = 64 * nb, p = rr >> 8, w = rr & 255;
                tr_item64<true>((w < 128) ? wg : wu, DFE, 128 * p + (w & 127), 64, 64 * kb, Wgu, DM, rr, pg8::F8_WGU, scr, lane); }
            else { const int r = r0 - I_GU, nb = r / (DFE / 64), kb = r % (DFE / 64); tr_item64<true>(wd, DM, 64 * nb, 64, 64 * kb, Wdn, DFE, 64 * nb, pg8::F8_WDN, scr, lane); }
        }
    }
}

__device__ __forceinline__ void cvt_x(Frame& F) {
    const float* x = arg_in(0); bf16* XB = WSP(bf16, WS_XB); unsigned char* XQ = WSP(unsigned char, WS_XQ);
    const int gw = F.vcu * NWAVES + F.wave, NGW = F.G * NWAVES;
    for (int m = gw; m < M; m += NGW) {
        const f32x4* xr = (const f32x4*)(x + (size_t)m * DM) + F.lane; u32x2* o = (u32x2*)(XB + (size_t)m * DM) + F.lane; unsigned* o8 = (unsigned*)(XQ + (size_t)m * DM) + F.lane;
#pragma unroll
        for (int j = 0; j < 4; ++j) { const f32x4 v = xr[64 * j]; u32x2 w; w.x = cvt_pk_bf16(v[0], v[1]); w.y = cvt_pk_bf16(v[2], v[3]); o[64 * j] = w;
            o8[64 * j] = pg8::pk4_fp8(v[0] * pg8::F8_ASC, v[1] * pg8::F8_ASC, v[2] * pg8::F8_ASC, v[3] * pg8::F8_ASC); }
    }
}

__device__ __forceinline__ void ln_load(const bf16* row, f32x4 (&v)[4], int lane) {
#pragma unroll
    for (int j = 0; j < 4; ++j) { const u32x2 a = ((const u32x2*)row)[lane + 64 * j]; v[j][0] = __uint_as_float(a.x << 16); v[j][1] = __uint_as_float(a.x & 0xffff0000u); v[j][2] = __uint_as_float(a.y << 16); v[j][3] = __uint_as_float(a.y & 0xffff0000u); }
}
template <bool FP8OUT> __device__ __forceinline__ void ln_finish(f32x4 (&v)[4], const f32x4 (&g)[4], const f32x4 (&bb)[4], bf16* brow, unsigned char* qrow, float* frow, int lane) {
    float s = 0.f;
#pragma unroll
    for (int j = 0; j < 4; ++j) s += (v[j][0] + v[j][1]) + (v[j][2] + v[j][3]);
    const float mean = wave_sum(s) * (1.f / DM); float s2 = 0.f;
#pragma unroll
    for (int j = 0; j < 4; ++j) { v[j] = v[j] - mean; s2 += (v[j][0] * v[j][0] + v[j][1] * v[j][1]) + (v[j][2] * v[j][2] + v[j][3] * v[j][3]); }
    const float rstd = 1.f / sqrtf(wave_sum(s2) * (1.f / DM) + LN_EPS);
#pragma unroll
    for (int j = 0; j < 4; ++j) { v[j] = v[j] * rstd * g[j] + bb[j];
        { u32x2 w; w.x = cvt_pk_bf16(v[j][0], v[j][1]); w.y = cvt_pk_bf16(v[j][2], v[j][3]); ((u32x2*)brow)[lane + 64 * j] = w; }
        if constexpr (FP8OUT) { ((unsigned*)qrow)[lane + 64 * j] = pg8::pk4_fp8(v[j][0] * pg8::F8_ASC, v[j][1] * pg8::F8_ASC, v[j][2] * pg8::F8_ASC, v[j][3] * pg8::F8_ASC); }
        else { if (frow) ((f32x4*)frow)[lane + 64 * j] = v[j];
               if (qrow) ((unsigned*)qrow)[lane + 64 * j] = pg8::pk4_fp8(v[j][0] * pg8::F8_ASC, v[j][1] * pg8::F8_ASC, v[j][2] * pg8::F8_ASC, v[j][3] * pg8::F8_ASC); } }
}

__device__ __forceinline__ void p_ln1(Frame& F, int l) {
    bf16* R1 = WSP(bf16, WS_R1); bf16* XB = WSP(bf16, WS_XB);
    const bool moe = (l & 1) != 0;
    LAS int* cntL = (LAS int*)(F.lds + LDSCTL_OFF + 1152);
    if (F.tid < 8) cntL[F.tid] = 0;
    __syncthreads();
    f32x4 g[4], bb[4];
#pragma unroll
    for (int j = 0; j < 4; ++j) { g[j] = ((const f32x4*)(arg_in(9) + (size_t)l * DM))[F.lane + 64 * j]; bb[j] = ((const f32x4*)(arg_in(10) + (size_t)l * DM))[F.lane + 64 * j]; }
    const float* router = arg_in(16) + (size_t)(l >> 1) * DM * NE;
    u32x4* route = WSP(u32x4, WS_ROUTE);
    f32x4 vn[4]; ln_load(R1 + (size_t)(F.vcu * 128 + F.wave * 16) * DM, vn, F.lane);
    for (int i = 0; i < 16; ++i) {
        const int m = F.vcu * 128 + F.wave * 16 + i;
        f32x4 v[4];
#pragma unroll
        for (int j = 0; j < 4; ++j) v[j] = vn[j];
        if (i + 1 < 16) ln_load(R1 + (size_t)(m + 1) * DM, vn, F.lane);
        ln_finish<true>(v, g, bb, R1 + (size_t)m * DM, (unsigned char*)XB + (size_t)m * DM, nullptr, F.lane);
        if (moe) {
            float lg[8];
#pragma unroll
            for (int e = 0; e < 8; ++e) lg[e] = 0.f;
#pragma unroll
            for (int j = 0; j < 4; ++j)
#pragma unroll
                for (int c = 0; c < 4; ++c) { const float* rp = router + (size_t)(4 * F.lane + 256 * j + c) * NE; const f32x4 r0 = *(const f32x4*)rp, r1 = *(const f32x4*)(rp + 4); const float xv = v[j][c];
                    lg[0] += xv * r0[0]; lg[1] += xv * r0[1]; lg[2] += xv * r0[2]; lg[3] += xv * r0[3]; lg[4] += xv * r1[0]; lg[5] += xv * r1[1]; lg[6] += xv * r1[2]; lg[7] += xv * r1[3]; }
#pragma unroll
            for (int e = 0; e < 8; ++e) lg[e] = wave_sum(lg[e]);
            int e1 = 0; float v1 = lg[0];
#pragma unroll
            for (int e = 1; e < 8; ++e) if (lg[e] > v1) { v1 = lg[e]; e1 = e; }
            int e2 = -1; float v2 = -3.0e38f;
#pragma unroll
            for (int e = 0; e < 8; ++e) if (e != e1 && (e2 < 0 || lg[e] > v2)) { v2 = lg[e]; e2 = e; }
            const float g1 = 1.0f / (1.0f + __expf(v2 - v1)), g2 = 1.0f - g1;
            if (F.lane == 0) { u32x4 r; r.x = (unsigned)e1; r.y = (unsigned)e2; r.z = __float_as_uint(g1); r.w = __float_as_uint(g2); route[m] = r;
                __hip_atomic_fetch_add(cntL + e1, 1, __ATOMIC_RELAXED, __HIP_MEMORY_SCOPE_WORKGROUP); __hip_atomic_fetch_add(cntL + e2, 1, __ATOMIC_RELAXED, __HIP_MEMORY_SCOPE_WORKGROUP); }
        }
    }
    __syncthreads();
    if (moe && F.tid < 8) WSP(int, WS_CNTWG)[F.vcu * 8 + F.tid] = cntL[F.tid];
}

__device__ __forceinline__ void p_ln2(Frame& F, int l) {
    const bf16* R1 = WSP(bf16, WS_R1); bf16* XB = WSP(bf16, WS_XB); float* outp = (l == DEPTH - 1) ? arg_out() : nullptr;
    f32x4 g[4], bb[4];
#pragma unroll
    for (int j = 0; j < 4; ++j) { g[j] = ((const f32x4*)(arg_in(11) + (size_t)l * DM))[F.lane + 64 * j]; bb[j] = ((const f32x4*)(arg_in(12) + (size_t)l * DM))[F.lane + 64 * j]; }
    f32x4 vn[4]; ln_load(R1 + (size_t)(F.vcu * 128 + F.wave * 16) * DM, vn, F.lane);
    for (int i = 0; i < 16; ++i) {
        const int m = F.vcu * 128 + F.wave * 16 + i;
        f32x4 v[4];
#pragma unroll
        for (int j = 0; j < 4; ++j) v[j] = vn[j];
        if (i + 1 < 16) ln_load(R1 + (size_t)(m + 1) * DM, vn, F.lane);
        ln_finish<false>(v, g, bb, XB + (size_t)m * DM, WSP(unsigned char, WS_XQ) + (size_t)m * DM, outp ? outp + (size_t)m * DM : nullptr, F.lane);
    }
}

__device__ __forceinline__ void moe_tables(Frame& F) {
    LAS int* texp = (LAS int*)(F.lds + LDSCTL_OFF);
    LAS int* tot = (LAS int*)(F.lds + LDSCTL_OFF + 1088);
    LAS int* tbase = (LAS int*)(F.lds + LDSCTL_OFF + 1200);
    const int* cnt = WSP(int, WS_CNTWG);
    LAS int* tmp = (LAS int*)(F.lds + AUX_OFF);
    __syncthreads();
    if (F.tid < 256) { typedef int i32x4_ __attribute__((ext_vector_type(4))); const i32x4_ a = ((const i32x4_*)cnt)[2 * F.tid], b = ((const i32x4_*)cnt)[2 * F.tid + 1];
        *(LAS i32x4_*)(tmp + 8 * F.tid) = a; *(LAS i32x4_*)(tmp + 8 * F.tid + 4) = b; }
    __syncthreads();
    if (F.tid < 8) { int t = 0, off = 0; for (int w = 0; w < 256; ++w) { const int c = tmp[w * 8 + F.tid]; if (w < F.vcu) off += c; t += c; } tot[F.tid] = t; tot[8 + F.tid] = off; }
    __syncthreads();
    if (F.tid == 0) { int b = 0; for (int e = 0; e < 8; ++e) { tbase[e] = b; b += (tot[e] + 255) >> 8; } tbase[8] = b; }
    __syncthreads();
    if (F.tid < MAXT) { int e = 0;
#pragma unroll
        for (int j = 1; j < 8; ++j) e += (F.tid >= tbase[j]) ? 1 : 0;
        texp[F.tid] = e; }
    __syncthreads();
}

__device__ __forceinline__ void p_list(Frame& F) {
    moe_tables(F);
    LAS int* tot = (LAS int*)(F.lds + LDSCTL_OFF + 1088); LAS int* tbase = (LAS int*)(F.lds + LDSCTL_OFF + 1200);
    const u32x4* route = WSP(u32x4, WS_ROUTE);
    int* rowlist = WSP(int, WS_ROWLIST); float* rowgate = WSP(float, WS_ROWGATE); int* slotrow = WSP(int, WS_SLOTROW);
    if (F.wave == 0) {
        int run[8];
#pragma unroll
        for (int e = 0; e < 8; ++e) run[e] = tot[8 + e];
        for (int blk = 0; blk < 2; ++blk) {
            const int t = F.vcu * 128 + blk * 64 + F.lane; const u32x4 r = route[t]; const int e1 = (int)r.x, e2 = (int)r.y;
            int p1 = 0, p2 = 0;
            const unsigned long long lt = (1ull << F.lane) - 1ull;
#pragma unroll
            for (int e = 0; e < 8; ++e) { const unsigned long long mk = __ballot(e1 == e || e2 == e); const int rk = run[e] + __popcll(mk & lt); if (e1 == e) p1 = rk; if (e2 == e) p2 = rk; run[e] += __popcll(mk); }
            const int row1 = tbase[e1] * 256 + p1, row2 = tbase[e2] * 256 + p2;
            rowlist[row1] = t; rowgate[row1] = __uint_as_float(r.z); rowlist[row2] = t; rowgate[row2] = __uint_as_float(r.w);
            slotrow[2 * t] = row1; slotrow[2 * t + 1] = row2;
        }
    }
    if (F.vcu < 8) { const int e = F.vcu, mt = (tot[e] + 255) >> 8; for (int p = tot[e] + F.tid; p < mt * 256; p += NTHR) { rowlist[tbase[e] * 256 + p] = 0; rowgate[tbase[e] * 256 + p] = 0.f; } }
}

__device__ __forceinline__ void p_comb(Frame& F, int l) {
    const bf16* R1 = WSP(bf16, WS_R1); bf16* XB = WSP(bf16, WS_XB); const bf16* Yd = WSP(bf16, WS_YD); const int* slotrow = WSP(int, WS_SLOTROW); float* outp = (l == DEPTH - 1) ? arg_out() : nullptr;
    f32x4 g[4], bb[4];
#pragma unroll
    for (int j = 0; j < 4; ++j) { g[j] = ((const f32x4*)(arg_in(11) + (size_t)l * DM))[F.lane + 64 * j]; bb[j] = ((const f32x4*)(arg_in(12) + (size_t)l * DM))[F.lane + 64 * j]; }
    const int m0 = F.vcu * 128 + F.wave * 16;
    const int myslot = (F.lane < 32) ? slotrow[2 * m0 + F.lane] : 0;
    f32x4 xn[4], an[4], bn[4];
#define COMB_LOAD(i_) do { const int ra_ = __builtin_amdgcn_readlane(myslot, 2 * (i_)), rb_ = __builtin_amdgcn_readlane(myslot, 2 * (i_) + 1); \
        ln_load(R1 + (size_t)(m0 + (i_)) * DM, xn, F.lane); ln_load(Yd + (size_t)ra_ * DM, an, F.lane); ln_load(Yd + (size_t)rb_ * DM, bn, F.lane); } while (0)
    COMB_LOAD(0);
    for (int i = 0; i < 16; ++i) {
        const int m = m0 + i;
        f32x4 v[4];
#pragma unroll
        for (int j = 0; j < 4; ++j) v[j] = xn[j] * DN_ALPHA + (an[j] + bn[j]);
        if (i + 1 < 16) COMB_LOAD(i + 1);
        ln_finish<false>(v, g, bb, XB + (size_t)m * DM, WSP(unsigned char, WS_XQ) + (size_t)m * DM, outp ? outp + (size_t)m * DM : nullptr, F.lane);
    }
#undef COMB_LOAD
}

#define DPP_I(v, ctrl) __builtin_amdgcn_update_dpp(0, (v), (ctrl), 0xf, 0xf, false)
__device__ __forceinline__ int wave_isum(int v) {
    v += DPP_I(v, 0xB1); v += DPP_I(v, 0x4E); v += DPP_I(v, 0x141); v += DPP_I(v, 0x140);
    return __builtin_amdgcn_readlane(v, 0) + __builtin_amdgcn_readlane(v, 16) + __builtin_amdgcn_readlane(v, 32) + __builtin_amdgcn_readlane(v, 48);
}
#define DPP_F(v, ctrl) __int_as_float(__builtin_amdgcn_update_dpp(0, __float_as_int(v), (ctrl), 0xf, 0xf, false))
typedef unsigned short u16x2 __attribute__((__vector_size__(4)));
#define IDX_BAR() asm volatile("s_waitcnt lgkmcnt(0)\n\ts_barrier" ::: "memory")
__device__ __forceinline__ void p_idx(Frame& F, int l) {
    constexpr int QP = 16;
    LAS unsigned short* bins = (LAS unsigned short*)(F.lds + RING_OFF);
    LAS unsigned* hq = (LAS unsigned*)(F.lds + AUX_OFF);
    LAS unsigned* hist = (LAS unsigned*)(F.lds + AUX_OFF + 16384) + F.wave * 256;
    LAS int* ci = (LAS int*)(F.lds + AUX_OFF + 24576) + F.wave * 64;
    LAS float* wtab = (LAS float*)(F.lds + LDSCTL_OFF + 1280);
    LAS float* sqp = (LAS float*)(F.lds + LDSCTL_OFF + 1792);
    const bf16* QI = WSP(bf16, WS_QI); const bf16* KI = WSP(bf16, WS_KI); const float* WI = WSP(float, WS_WI);
    unsigned long long* maskQ = WSP(unsigned long long, WS_MASK);
    const int lane = F.lane, wave = F.wave, tid = F.tid, w = F.vcu;
    const int am = lane & 31, ahm = (am >> 2) & 1, arr = (am & 3) + 4 * (am >> 3), atl = 2 * ahm + (arr >> 3), ah = arr & 7, kg = lane >> 5, hi = lane >> 5, n = lane & 31;
    bf16x8 af[4][4]; float wreg = 0.f;
#define IDX_UNIT(s8_, qb32_, b_) do { const int ui_ = (s8_) >> 1; const int up_ = (ui_ == 0) ? w : (ui_ == 1) ? 511 - w : (ui_ == 2) ? 512 + w : 1023 - w; qb32_ = up_ >> 3; b_ = up_ & 7; } while (0)
#define IDX_LOADQ(s8_) do { int qb_, bb_; IDX_UNIT(s8_, qb_, bb_); const size_t r0_ = (size_t)bb_ * SEQ + qb_ * 32 + ((s8_) & 1) * QP; \
        _Pragma("unroll") for (int rt = 0; rt < 4; ++rt) _Pragma("unroll") for (int ks = 0; ks < 4; ++ks) af[rt][ks] = *(const bf16x8*)(QI + (r0_ + 4 * rt + atl) * AW + ah * 64 + ks * 16 + 8 * kg); \
        if (tid < 128) wreg = WI[(r0_ + (tid >> 3)) * 8 + (tid & 7)]; } while (0)
#define IDX_WTAB(par_) do { if (tid < 128) { wtab[tid] = wreg; float sm = wreg, sq2 = wreg * wreg; \
        sm += DPP_F(sm, 0xB1); sq2 += DPP_F(sq2, 0xB1); sm += DPP_F(sm, 0x4E); sq2 += DPP_F(sq2, 0x4E); sm += DPP_F(sm, 0x141); sq2 += DPP_F(sq2, 0x141); \
        if ((tid & 7) == 0) { const float a_ = 1.0f / (28.02f * sqrtf(sq2) + 1.0e-20f); sqp[32 * (par_) + 2 * (tid >> 3)] = a_; sqp[32 * (par_) + 2 * (tid >> 3) + 1] = 0.33333f - 3.19f * sm * a_; } } } while (0)
    IDX_LOADQ(0);
    IDX_WTAB(0);
    for (int i = tid; i < QP * 256; i += NTHR) hq[i] = 0u;
    IDX_BAR();
    for (int s8 = 0; s8 < 8; ++s8) {
        int qb32, b; IDX_UNIT(s8, qb32, b);
        const int sub = s8 & 1, c = qb32 >> 1, N = 64 * (c + 1), NT32 = 2 * (c + 1);
        const size_t rowb = (size_t)b * SEQ;
        const bool dosel = N > TOPK;
        for (int repA_ = 0; repA_ < (((PROBE_MASK) >> 12) & 1) + 1; ++repA_) {
            const int ntw = (NT32 - wave + 7) >> 3;
            constexpr int BT = 2; const int nbat = (ntw + BT - 1) / BT;
            bf16x8 b0[BT][4], b1[BT][4];
            const LAS float* sqc = sqp + 32 * (s8 & 1);
#define IDX_LOADB(dst, bb_) do { _Pragma("unroll") for (int u = 0; u < BT; ++u) { int j_ = wave + 8 * (BT * (bb_) + u); j_ = j_ < NT32 ? j_ : NT32 - 1; \
            _Pragma("unroll") for (int ks = 0; ks < 4; ++ks) dst[u][ks] = *(const bf16x8*)(KI + (rowb + 32 * j_) * 64 + ks * 512 + kg * 256 + n * 8); } } while (0)
#define IDX_RELU(x) __int_as_float(max(__float_as_int(x), 0))
#define IDX_COMP(src, bb_) do { _Pragma("unroll") for (int rp = 0; rp < 2; ++rp) { \
            f32x4 wq_[4][2];   \
            _Pragma("unroll") for (int rq = 0; rq < 4; ++rq) { const int qi_ = 4 * (2 * rp + (rq >> 1)) + 2 * hi + (rq & 1); const LAS f32x4* wp_ = (const LAS f32x4*)(wtab + qi_ * 8); wq_[rq][0] = wp_[0]; wq_[rq][1] = wp_[1]; } \
            _Pragma("unroll") for (int u = 0; u < BT; ++u) { const int j_ = wave + 8 * (BT * (bb_) + u); if (j_ < NT32) { f32x16 acc0 = {}, acc1 = {}; \
                _Pragma("unroll") for (int ks = 0; ks < 4; ++ks) { acc0 = __builtin_amdgcn_mfma_f32_32x32x16_bf16(af[2 * rp][ks], src[u][ks], acc0, 0, 0, 0); acc1 = __builtin_amdgcn_mfma_f32_32x32x16_bf16(af[2 * rp + 1][ks], src[u][ks], acc1, 0, 0, 0); } \
                _Pragma("unroll") for (int r2 = 0; r2 < 2; ++r2) { const int rt = 2 * rp + r2; const f32x16& ac_ = r2 ? acc1 : acc0; float t_[2]; \
                    _Pragma("unroll") for (int q = 0; q < 2; ++q) { const f32x4 w0_ = wq_[2 * r2 + q][0], w1_ = wq_[2 * r2 + q][1]; \
                        f32x2 s2_ = (f32x2){w0_[0], w0_[1]} * (f32x2){IDX_RELU(ac_[8 * q + 0]), IDX_RELU(ac_[8 * q + 1])}; \
                        s2_ = __builtin_elementwise_fma((f32x2){w0_[2], w0_[3]}, (f32x2){IDX_RELU(ac_[8 * q + 2]), IDX_RELU(ac_[8 * q + 3])}, s2_); \
                        s2_ = __builtin_elementwise_fma((f32x2){w1_[0], w1_[1]}, (f32x2){IDX_RELU(ac_[8 * q + 4]), IDX_RELU(ac_[8 * q + 5])}, s2_); \
                        s2_ = __builtin_elementwise_fma((f32x2){w1_[2], w1_[3]}, (f32x2){IDX_RELU(ac_[8 * q + 6]), IDX_RELU(ac_[8 * q + 7])}, s2_); \
                        const f32x2 mc_ = *(const LAS f32x2*)(sqc + 2 * (4 * rt + 2 * hi + q)); t_[q] = __builtin_fmaf(s2_[0] + s2_[1], mc_[0], mc_[1]); } \
                    const u16x2 pk_ = __builtin_amdgcn_cvt_pknorm_u16(t_[0], t_[1]); \
                    _Pragma("unroll") for (int q = 0; q < 2; ++q) { const int qi_ = 4 * rt + 2 * hi + q; const unsigned short ky_ = q ? pk_[1] : pk_[0]; bins[qi_ * 4096 + 32 * j_ + n] = ky_; \
                        if (dosel) __hip_atomic_fetch_add(hq + qi_ * 256 + ((unsigned)ky_ >> 8), 1u, __ATOMIC_RELAXED, __HIP_MEMORY_SCOPE_WORKGROUP); } } } } } } while (0)
            IDX_LOADB(b0, 0);
            for (int bb = 0; bb < nbat; bb += 2) {
                IDX_LOADB(b1, bb + 1);
                IDX_COMP(b0, bb);
                IDX_LOADB(b0, bb + 2);
                IDX_COMP(b1, bb + 1);
            }
#undef IDX_LOADB
#undef IDX_COMP
#undef IDX_RELU
        }
        if (s8 + 1 < 8) IDX_LOADQ(s8 + 1);
        IDX_BAR();
        for (int repB_ = 0; repB_ < (((PROBE_MASK) >> 13) & 1) + 1; ++repB_)
        for (int qq = 0; qq < 2; ++qq) {
            const int q = wave + 8 * qq;
            const int nch = (N + 511) >> 9;
            const LAS unsigned short* brow = bins + q * 4096;
            LAS unsigned char* st8 = (LAS unsigned char*)hist + 512 * qq;
            { unsigned z0 = 0u; asm volatile("" : "+v"(z0)); *(LAS u32x2*)(st8 + 8 * lane) = (u32x2){z0, z0}; }
#define IDX_SCAN(K, HD, TARGET) \
            int tl_ = 0; _Pragma("unroll") for (int i = 0; i < K; ++i) tl_ += HD[i]; \
            int P_ = tl_; P_ += DPP_I(P_, 0x111); P_ += DPP_I(P_, 0x112); P_ += DPP_I(P_, 0x114); P_ += DPP_I(P_, 0x118); \
            { const int R0 = __builtin_amdgcn_readlane(P_, 15), R1 = __builtin_amdgcn_readlane(P_, 31), R2 = __builtin_amdgcn_readlane(P_, 47); P_ += (lane >= 16 ? R0 : 0) + (lane >= 32 ? R1 : 0) + (lane >= 48 ? R2 : 0); } \
            const unsigned long long over_ = __ballot(P_ >= (TARGET)); const int Lc_ = over_ ? (int)__builtin_ctzll(over_) : 63; \
            int cumL_ = P_ - tl_, bsel_ = 0, cbv_ = 0; bool fnd_ = false; \
            _Pragma("unroll") for (int i = K - 1; i >= 0; --i) { if (!fnd_) { if (cumL_ + HD[i] >= (TARGET) || i == 0) { fnd_ = true; bsel_ = i; cbv_ = HD[i]; } else cumL_ += HD[i]; } } \
            Bs = K * (63 - Lc_) + __builtin_amdgcn_readlane(bsel_, Lc_); cb = __builtin_amdgcn_readlane(cbv_, Lc_); cumv = __builtin_amdgcn_readlane(cumL_, Lc_);
#define IDX_CODE(v, j) ((int)(((j) & 1) ? ((v)[(j) >> 1] >> 16) : ((v)[(j) >> 1] & 0xffffu)))
            int Bs = -1, cb = 0, need = 0, sh = 8; bool fast_ok = true;
            LAS unsigned* crow = hq + q * 256;
            if (dosel) {
                { const u32x4 h4 = *(const LAS u32x4*)(crow + 4 * (63 - lane)); const int hd4[4] = {(int)h4[0], (int)h4[1], (int)h4[2], (int)h4[3]};
                  int cumv; IDX_SCAN(4, hd4, TOPK)
                  need = TOPK - cumv; fast_ok = over_ != 0ull && need >= 1 && need <= cb; }
                if (fast_ok && cb > 64) {
                    { unsigned z0 = 0u; asm volatile("" : "+v"(z0)); *(LAS u32x4*)(crow + 4 * lane) = (u32x4){z0, z0, z0, z0}; }
                    for (int ch = 0; ch < nch; ++ch) { const u32x4 v = *(const LAS u32x4*)(brow + 512 * ch + 8 * lane); const bool okl = 512 * ch + 8 * lane < N;
#pragma unroll
                        for (int j = 0; j < 8; ++j) { const int kj = IDX_CODE(v, j); const bool m = okl && (kj >> 8) == Bs;
                            __hip_atomic_fetch_add(m ? crow + (kj & 255) : (LAS unsigned*)ci + lane, 1u, __ATOMIC_RELAXED, __HIP_MEMORY_SCOPE_WORKGROUP); } }
                    asm volatile("s_waitcnt lgkmcnt(0)" ::: "memory");
                    const u32x4 h4 = *(const LAS u32x4*)(crow + 4 * (63 - lane)); const int hd4[4] = {(int)h4[0], (int)h4[1], (int)h4[2], (int)h4[3]};
                    int nB, nC, nV; bool ok2;
                    { int Bs, cb, cumv; IDX_SCAN(4, hd4, need)
                      nB = Bs; nC = cb; nV = cumv; ok2 = over_ != 0ull; }
                    Bs = (Bs << 8) | nB; sh = 0; need -= nV; cb = nC;
                    fast_ok = ok2 && need >= 1 && need <= cb;
                }
                fast_ok = fast_ok && cb <= 64;
            }
#undef IDX_SCAN
            if (fast_ok) {
                int nc = 0;
                u32x4 vn = *(const LAS u32x4*)(brow + 8 * lane);
                for (int ch = 0; ch < nch; ++ch) { const u32x4 v = vn; const int e0 = 512 * ch + 8 * lane; const bool okl = e0 < N; unsigned byte = 0u;
                    if (ch + 1 < nch) vn = *(const LAS u32x4*)(brow + 512 * (ch + 1) + 8 * lane);
                    int bj[8], cl = 0;
#pragma unroll
                    for (int j = 0; j < 8; ++j) { bj[j] = okl ? (IDX_CODE(v, j) >> sh) : -2; cl += (bj[j] == Bs) ? 1 : 0; byte |= (unsigned)(Bs - bj[j]) >> 31 << j; }
                    int ps = cl;
                    ps += DPP_I(ps, 0x111); ps += DPP_I(ps, 0x112); ps += DPP_I(ps, 0x114); ps += DPP_I(ps, 0x118);
                    ps += __builtin_amdgcn_update_dpp(0, ps, 0x142, 0xa, 0xf, false); ps += __builtin_amdgcn_update_dpp(0, ps, 0x143, 0xc, 0xf, false);
                    int off = nc + ps - cl;
#pragma unroll
                    for (int j = 0; j < 8; ++j) { const bool eq = bj[j] == Bs; crow[eq ? off : 64 + lane] = (unsigned)((IDX_CODE(v, j) << 12) | (e0 + j)); off += eq ? 1 : 0; }
                    nc += __builtin_amdgcn_readlane(ps, 63);
                    st8[64 * ch + lane] = (unsigned char)byte; }
                if (dosel) {
                    asm volatile("s_waitcnt lgkmcnt(0)" ::: "memory");
                    const int mc = (lane < cb) ? (int)crow[lane] : 0; const int mord = (mc & ~4095) | (4095 - (mc & 4095)); int rank = 0;
                    for (int j = 0; j < cb; ++j) { const int oj = __builtin_amdgcn_readlane(mord, j); rank += (oj > mord) ? 1 : 0; }
                    if (lane < cb && rank < need) __hip_atomic_fetch_or((LAS unsigned*)st8 + ((mc & 4095) >> 5), 1u << (mc & 31), __ATOMIC_RELAXED, __HIP_MEMORY_SCOPE_WORKGROUP);
                }
            } else {
                int Tk = -1; unsigned Jx = 0xffffffffu;
                for (int bit = 15; bit >= 0; --bit) {
                    const int cand = Tk < 0 ? (1 << bit) : (Tk | (1 << bit)); int cl = 0;
                    for (int ch = 0; ch < nch; ++ch) { const u32x4 v = *(const LAS u32x4*)(brow + 512 * ch + 8 * lane); const int e0 = 512 * ch + 8 * lane;
#pragma unroll
                        for (int j = 0; j < 8; ++j) cl += (e0 < N && IDX_CODE(v, j) >= cand) ? 1 : 0; }
                    if (wave_isum(cl) >= TOPK) Tk = cand;
                }
                if (Tk < 0) Tk = 0;
                int cg = 0, ce = 0;
                for (int ch = 0; ch < nch; ++ch) { const u32x4 v = *(const LAS u32x4*)(brow + 512 * ch + 8 * lane); const int e0 = 512 * ch + 8 * lane;
#pragma unroll
                    for (int j = 0; j < 8; ++j) if (e0 < N) { cg += (IDX_CODE(v, j) > Tk) ? 1 : 0; ce += (IDX_CODE(v, j) == Tk) ? 1 : 0; } }
                const int nd = TOPK - wave_isum(cg), ceq = wave_isum(ce);
                if (ceq > nd) {
                    unsigned Jc = 0u;
                    for (int bit = 11; bit >= 0; --bit) {
                        const unsigned cj = Jc | (1u << bit); int cl = 0;
                        for (int ch = 0; ch < nch; ++ch) { const u32x4 v = *(const LAS u32x4*)(brow + 512 * ch + 8 * lane); const int e0 = 512 * ch + 8 * lane;
#pragma unroll
                            for (int j = 0; j < 8; ++j) cl += (e0 < N && IDX_CODE(v, j) == Tk && (unsigned)(e0 + j) < cj) ? 1 : 0; }
                        if (wave_isum(cl) < nd) Jc = cj;
                    }
                    Jx = Jc;
                }
                for (int ch = 0; ch < nch; ++ch) { const u32x4 v = *(const LAS u32x4*)(brow + 512 * ch + 8 * lane); const int e0 = 512 * ch + 8 * lane; unsigned byte = 0u;
#pragma unroll
                    for (int j = 0; j < 8; ++j) { const int kj = IDX_CODE(v, j); byte |= (unsigned)((kj > Tk || (kj == Tk && (unsigned)(e0 + j) <= Jx)) ? 1 : 0) << j; }
                    st8[64 * ch + lane] = (unsigned char)(e0 < N ? byte : 0u); }
            }
#undef IDX_CODE
            { unsigned z0 = 0u; asm volatile("" : "+v"(z0)); *(LAS u32x4*)(crow + 4 * lane) = (u32x4){z0, z0, z0, z0}; }
        }
        IDX_WTAB((s8 + 1) & 1);
        IDX_BAR();
        {
            const int tile = tid >> 3, w8 = tid & 7, NJw = 4 * ((qb32 >> 3) + 1);
            if (tile < NJw) {
#pragma unroll
                for (int qq = 0; qq < 2; ++qq) { const u32x2 mk = *(const LAS u32x2*)((const LAS unsigned*)(F.lds + AUX_OFF + 16384) + w8 * 256 + 128 * qq + 2 * tile);
                    maskQ[((size_t)(b * 128 + qb32) * 64 + tile) * 32 + QP * sub + 8 * qq + w8] = ((unsigned long long)mk.y << 32) | mk.x; } }
        }
    }
#undef IDX_UNIT
#undef IDX_LOADQ
#undef IDX_WTAB
#undef IDX_BAR
}

__device__ __forceinline__ void p_conv(Frame& F, int l) {
    LAS bf16* Ut = (LAS bf16*)(F.lds + RING_OFF);
    LAS float* Yt = (LAS float*)(F.lds + RING_OFF + 65536);
    const bf16* U = WSP(bf16, WS_U); bf16* MIX = WSP(bf16, WS_MIX);
    const float* cw = arg_in(2) + (size_t)l * CK * CCH; const int c = F.tid, lane = F.lane;
    float wj[CK];
#pragma unroll
    for (int j = 0; j < CK; ++j) wj[j] = cw[j * CCH + c];
    const float cb = arg_in(3)[l * CCH + c];
    f32x4 lg0 = *(const f32x4*)(arg_in(4) + l * CCH + 8 * lane), lg1 = *(const f32x4*)(arg_in(4) + l * CCH + 8 * lane + 4);
    f32x4 lb0 = *(const f32x4*)(arg_in(5) + l * CCH + 8 * lane), lb1 = *(const f32x4*)(arg_in(5) + l * CCH + 8 * lane + 4);
    f32x4 ms0 = *(const f32x4*)(arg_in(6) + l * DM + CCH + 8 * lane), ms1 = *(const f32x4*)(arg_in(6) + l * DM + CCH + 8 * lane + 4);
    u32x4 tp[8];
#define CONV_LOAD(it_) do { const int un_ = F.vcu + 256 * (it_), b_ = un_ >> 7, t0_ = (un_ & 127) * 32; \
        _Pragma("unroll") for (int k = 0; k < 8; ++k) { const int ch = F.tid + NTHR * k, r = ch >> 6, cc = ch & 63, t = t0_ - 30 + r; unsigned z0 = 0u; asm volatile("" : "+v"(z0)); tp[k] = (u32x4){z0, z0, z0, z0}; \
            if (ch < 62 * 64 && t >= 0) tp[k] = *(const u32x4*)(U + ((size_t)b_ * SEQ + t) * CCH + cc * 8); } } while (0)
    CONV_LOAD(0);
    for (int it = 0; it < 4; ++it) {
        const int unit = F.vcu + 256 * it, b = unit >> 7, tt0 = (unit & 127) * 32;
#pragma unroll
        for (int k = 0; k < 8; ++k) { const int ch = F.tid + NTHR * k, r = ch >> 6, cc = ch & 63; if (ch < 62 * 64) *(LAS u32x4*)(Ut + r * CCH + cc * 8) = tp[k]; }
        if (it + 1 < 4) CONV_LOAD(it + 1);
        __syncthreads();
        float acc[32], uu[62];
#pragma unroll
        for (int s = 0; s < 62; ++s) uu[s] = bf2f(Ut[s * CCH + c]);
#pragma unroll
        for (int tt = 0; tt < 32; ++tt) acc[tt] = cb;
#pragma unroll
        for (int j = 0; j < CK; ++j)
#pragma unroll
            for (int tt = 0; tt < 32; ++tt) acc[tt] = __builtin_fmaf(wj[j], uu[tt + j], acc[tt]);
#pragma unroll
        for (int tt = 0; tt < 32; ++tt) Yt[tt * CCH + c] = acc[tt];
        __syncthreads();
#pragma unroll
        for (int k = 0; k < 4; ++k) { const int tt = F.wave * 4 + k;
            f32x4 y0 = *(const LAS f32x4*)(Yt + tt * CCH + 8 * lane), y1 = *(const LAS f32x4*)(Yt + tt * CCH + 8 * lane + 4);
            const float mean = wave_sum((y0[0] + y0[1]) + (y0[2] + y0[3]) + (y1[0] + y1[1]) + (y1[2] + y1[3])) * (1.f / CCH);
            y0 = y0 - mean; y1 = y1 - mean;
            const float var = wave_sum((y0[0] * y0[0] + y0[1] * y0[1]) + (y0[2] * y0[2] + y0[3] * y0[3]) + (y1[0] * y1[0] + y1[1] * y1[1]) + (y1[2] * y1[2] + y1[3] * y1[3])) * (1.f / CCH);
            const float rstd = 1.f / sqrtf(var + LN_EPS);
            y0 = y0 * rstd * lg0 + lb0; y1 = y1 * rstd * lg1 + lb1;
#pragma unroll
            for (int e = 0; e < 4; ++e) { y0[e] = y0[e] * fsigmoid(y0[e]) * ms0[e]; y1[e] = y1[e] * fsigmoid(y1[e]) * ms1[e]; }
            *(u32x4*)(MIX + ((size_t)b * SEQ + tt0 + tt) * DM + CCH + 8 * lane) = pg8::pack8(y0, y1); }
        __syncthreads();
    }
#undef CONV_LOAD
}

namespace at {
constexpr int QBLK = 32, QB = 256, KVBLK = 64, NSLOT = 3, SLOTB = 8192;
constexpr int LDS_K = 0, LDS_V = NSLOT * SLOTB, LDS_WS = 2 * NSLOT * SLOTB, LDS_OST = LDS_WS + 8 * 64 * 4, LDS_BIAS = LDS_OST + 8 * 4096, LDS_END = LDS_BIAS + 1024;
static_assert(LDS_END <= RING_BYTES, "attention LDS");
constexpr float NEGV = -200.0f;
__device__ __forceinline__ int crow(int r, int hi) { return (r & 3) + 8 * (r >> 2) + 4 * hi; }
#define SBAR() __builtin_amdgcn_sched_barrier(0)
__device__ __forceinline__ void glds16(const void* gsrc, unsigned lds_dst) { unsigned keep;
    asm volatile("s_mov_b32 %0, m0\n\ts_mov_b32 m0, %2\n\ts_nop 0\n\tglobal_load_lds_dwordx4 %1, off\n\ts_mov_b32 m0, %0" : "=&s"(keep) : "v"(gsrc), "s"(lds_dst) : "memory"); }
__device__ __forceinline__ float max3f(float a, float b, float c) { float r; asm("v_max3_f32 %0, %1, %2, %3" : "=v"(r) : "v"(a), "v"(b), "v"(c)); return r; }
__device__ __forceinline__ float max2f(float a, float b) { float r; asm("v_max_f32_e32 %0, %1, %2" : "=v"(r) : "v"(a), "v"(b)); return r; }
__device__ __forceinline__ float fadd_s(float a, float b) { float r; asm("v_add_f32_e32 %0, %1, %2" : "=v"(r) : "v"(a), "v"(b)); return r; }
__device__ __forceinline__ float fsub_s(float a, float b) { float r; asm("v_sub_f32_e32 %0, %1, %2" : "=v"(r) : "v"(a), "v"(b)); return r; }
typedef float f32x2_t __attribute__((ext_vector_type(2))); typedef __bf16 bf16x2_t __attribute__((ext_vector_type(2)));
__device__ __forceinline__ unsigned cvtpk_s(float lo, float hi) { f32x2_t v = {lo, hi}; bf16x2_t b = __builtin_convertvector(v, bf16x2_t); return __builtin_bit_cast(unsigned, b); }
typedef LAS const char* lds_cptr;
typedef short v4i16_t __attribute__((ext_vector_type(4)));
__device__ __forceinline__ void kload8(bf16x8* kf, lds_cptr kp) {
    kf[0] = *(const LAS bf16x8*)(kp);        kf[1] = *(const LAS bf16x8*)(kp + 512);  kf[2] = *(const LAS bf16x8*)(kp + 2048); kf[3] = *(const LAS bf16x8*)(kp + 2560);
    kf[4] = *(const LAS bf16x8*)(kp + 4096); kf[5] = *(const LAS bf16x8*)(kp + 4608); kf[6] = *(const LAS bf16x8*)(kp + 6144); kf[7] = *(const LAS bf16x8*)(kp + 6656); }
__device__ __forceinline__ void kload2(bf16x8* kf, lds_cptr kp, int j) { kf[2 * j] = *(const LAS bf16x8*)(kp + j * 2048); kf[2 * j + 1] = *(const LAS bf16x8*)(kp + j * 2048 + 512); }
__device__ __forceinline__ s16x4 vtr(lds_cptr p) { return __builtin_bit_cast(s16x4, __builtin_amdgcn_ds_read_tr16_b64_v4i16((LAS v4i16_t*)p)); }
__device__ __forceinline__ float rowmax(const f32x16& p0, const f32x16& p1) {
    float a = max3f(p0[0], p0[1], p1[0]), b = max3f(p0[2], p0[3], p1[1]); a = max3f(a, p1[2], p1[3]);
#pragma unroll
    for (int r = 4; r < 16; r += 4) { a = max3f(a, p0[r], p0[r + 1]); b = max3f(b, p0[r + 2], p0[r + 3]); a = max3f(a, p1[r], p1[r + 1]); b = max3f(b, p1[r + 2], p1[r + 3]); }
    const float m = max2f(a, b);
    auto rr = __builtin_amdgcn_permlane32_swap(__float_as_uint(m), __float_as_uint(m), false, false);
    return max2f(__uint_as_float(rr[0]), __uint_as_float(rr[1]));
}
__device__ __forceinline__ void pv(f32x16* o, int vb, bf16x8 pa0, bf16x8 pa1, bf16x8 pa2, bf16x8 pa3) {
#pragma unroll
    for (int d0 = 0; d0 < 2; ++d0) { s16x4 lo[4], hi[4];
#pragma unroll
        for (int ks = 0; ks < 4; ++ks) {
            asm volatile("ds_read_b64_tr_b16 %0,%1 offset:%c2" : "=&v"(lo[ks]) : "v"(vb), "i"(d0 * 4096 + ks * 1024) : "memory");
            asm volatile("ds_read_b64_tr_b16 %0,%1 offset:%c2" : "=&v"(hi[ks]) : "v"(vb), "i"(d0 * 4096 + ks * 1024 + 512) : "memory"); }
        asm volatile("s_waitcnt lgkmcnt(0)" ::: "memory"); SBAR();
#define AT_PK(k) (bf16x8){lo[k][0], lo[k][1], lo[k][2], lo[k][3], hi[k][0], hi[k][1], hi[k][2], hi[k][3]}
        o[d0] = __builtin_amdgcn_mfma_f32_32x32x16_bf16(pa0, AT_PK(0), o[d0], 0, 0, 0);
        o[d0] = __builtin_amdgcn_mfma_f32_32x32x16_bf16(pa1, AT_PK(1), o[d0], 0, 0, 0);
        o[d0] = __builtin_amdgcn_mfma_f32_32x32x16_bf16(pa2, AT_PK(2), o[d0], 0, 0, 0);
        o[d0] = __builtin_amdgcn_mfma_f32_32x32x16_bf16(pa3, AT_PK(3), o[d0], 0, 0, 0);
#undef AT_PK
    }
}
template <int THRL> __device__ __forceinline__ void attn_unit(int b, int h, int qb, const bf16* Q, const bf16* __restrict__ Kt, const bf16* __restrict__ Vt, const unsigned long long* maskQ,
                                                              bf16* MIX, float ms0, float ms1, LAS unsigned char* shm, int tid) {
    const int lane = tid & 63, r32 = lane & 31, hi = lane >> 5; const int wid = __builtin_amdgcn_readfirstlane(tid >> 6);
    const size_t rowbase = (size_t)b * SEQ; const int q0 = qb * QB, qw = q0 + wid * QBLK, cwv = qw >> 6;
    const bf16* Qw = Q + (rowbase + qw) * AW + h * HD;
    const unsigned lds0 = (unsigned)(uintptr_t)shm; const lds_cptr shm3 = (lds_cptr)shm;
    LAS float* wsf = (LAS float*)(shm + LDS_WS) + wid * 64;
    const LAS float* biasT = (const LAS float*)(shm + LDS_BIAS);
    const bf16* ksrc = Kt + ((size_t)(b * NH + h) * 64) * 4096 + wid * 512 + lane * 8;
    const bf16* vsrc = Vt + ((size_t)(b * NH + h) * 64) * 4096 + wid * 512 + lane * 8;
    const unsigned kdst = lds0 + LDS_K + wid * 1024, vdst = lds0 + LDS_V + wid * 1024;
#define DMA_K(t, slot) glds16(ksrc + (size_t)(t) * 4096, (unsigned)__builtin_amdgcn_readfirstlane(kdst + (slot)))
#define DMA_V(t, slot) glds16(vsrc + (size_t)(t) * 4096, (unsigned)__builtin_amdgcn_readfirstlane(vdst + (slot)))
    int r32m = r32; asm volatile("" : "+v"(r32m));
    const unsigned long long* mrow = maskQ + ((size_t)(b * 128 + (qw >> 5)) * 64) * 32 + r32m;
#define MLOAD(dst, t) dst = *(const GAS u32x2*)((const GAS unsigned long long*)mrow + (size_t)(t) * 32)
#define MLOAD_UNUSED(dst, t) dst = *(const u32x2*)(mrow + (size_t)(t) * 32)
#define WAIT_BAR(N, M) asm volatile("s_waitcnt vmcnt(" #N ") lgkmcnt(0)\n\ts_barrier" ::: "memory")
    const int vb0 = (int)(lds0 + LDS_V) + ((lane >> 4) & 1) * 32 + (lane & 3) * 8 + (4 * hi + ((lane & 15) >> 2)) * 64;
    bf16x8 kf[8];
    const lds_cptr kp0 = shm3 + LDS_K + hi * 1024 + r32 * 16; const lds_cptr vp0 = shm3 + LDS_V + ((lane >> 4) & 1) * 32 + (lane & 3) * 8 + (4 * hi + ((lane & 15) >> 2)) * 64;
    const int NT = (q0 + QB) / KVBLK;
    u32x2 mA, mB;
    MLOAD(mA, 0);
    DMA_K(0, 0); DMA_V(0, 0); DMA_K(1, SLOTB);
    const lds_cptr qp = shm3 + LDS_OST + wid * 4096 + hi * 512 + r32 * 16;
#pragma unroll
    for (int d0 = 0; d0 < 4; ++d0) { const bf16x8 qv = *(const bf16x8*)(Qw + (size_t)r32 * AW + d0 * 16 + hi * 8); *(LAS bf16x8*)(shm + LDS_OST + wid * 4096 + hi * 512 + r32 * 16 + d0 * 1024) = qv; }
#define QRD(d0) (*(const LAS bf16x8*)(qp + (d0) * 1024))
    float mhat = 0.f, l_reg = 0.f; f32x16 o[2]; o[0] = f32x16{}; o[1] = f32x16{}; f32x16 negm = f32x16{}; asm volatile("" : "+v"(negm));
#define MASKB(P0, P1, t, MW) do { \
        if (64 * (t) + 63 - qw >= -90 && (t) <= cwv) { const int bi_ = 64 * (t) - (qw + r32) + 128 + 4 * hi; \
            _Pragma("unroll") for (int r = 0; r < 16; ++r) { const int k0_ = (r & 3) + 8 * (r >> 2); int i0_ = bi_ + k0_; i0_ = i0_ < 0 ? 0 : i0_; int i1_ = bi_ + k0_ + 32; i1_ = i1_ < 0 ? 0 : i1_; P0[r] += biasT[i0_]; P1[r] += biasT[i1_]; } } \
        { const unsigned ml_ = MW.x >> (4 * hi), mh_ = MW.y >> (4 * hi); const unsigned nv_ = __float_as_uint(NEGV); \
            _Pragma("unroll") for (int r = 0; r < 16; ++r) { const unsigned s0_ = (unsigned)__builtin_amdgcn_sbfe((int)ml_, (r & 3) + 8 * (r >> 2), 1), s1_ = (unsigned)__builtin_amdgcn_sbfe((int)mh_, (r & 3) + 8 * (r >> 2), 1); \
                P0[r] = __uint_as_float((s0_ & __float_as_uint(P0[r])) | (~s0_ & nv_)); P1[r] = __uint_as_float((s1_ & __float_as_uint(P1[r])) | (~s1_ & nv_)); } } } while (0)
    bool resc = false;
#define START(P0, P1) do { const float rm = rowmax(P0, P1); resc = false; \
    { const float dl = rm; mhat = fadd_s(mhat, dl); \
      _Pragma("unroll") for (int r = 0; r < 16; ++r) { P0[r] = fsub_s(P0[r], dl); P1[r] = fsub_s(P1[r], dl); } \
      _Pragma("unroll") for (int r = 0; r < 16; ++r) negm[r] = -mhat; asm volatile("" : "+v"(negm)); } \
    _Pragma("unroll") for (int r = 0; r < 16; ++r) P0[r] = __builtin_amdgcn_exp2f(P0[r]); } while (0)
#define RESC() do { if (resc) { asm volatile("s_waitcnt lgkmcnt(0)" ::: "memory"); \
      _Pragma("unroll") for (int d_ = 0; d_ < 2; ++d_) _Pragma("unroll") for (int r = 0; r < 16; ++r) o[d_][r] *= wsf[crow(r, hi)]; } } while (0)
    f32x16 pA0, pA1, pB0, pB1;
    int sl_prev = 0, sl_cur = 0, sl_next = SLOTB;
#define ROT() do { sl_prev = sl_cur; sl_cur = sl_next; sl_next = (sl_next == (NSLOT - 1) * SLOTB) ? 0 : sl_next + SLOTB; } while (0)
    DMA_K(2, 2 * SLOTB);
    WAIT_BAR(3, mA);
    {
        const lds_cptr kb = kp0;
        pA0 = f32x16{}; pA1 = f32x16{};
#pragma unroll
        for (int d0 = 0; d0 < 4; ++d0) { const bf16x8 b0 = *(const LAS bf16x8*)(kb + d0 * 2048), b1 = *(const LAS bf16x8*)(kb + d0 * 2048 + 512);
            const bf16x8 qv = QRD(d0); pA0 = __builtin_amdgcn_mfma_f32_32x32x16_bf16(b0, qv, pA0, 0, 0, 0); pA1 = __builtin_amdgcn_mfma_f32_32x32x16_bf16(b1, qv, pA1, 0, 0, 0); }
        MASKB(pA0, pA1, 0, mA);
        asm volatile("s_nop 15\n\ts_nop 7" : "+v"(pA0), "+v"(pA1));
        START(pA0, pA1);
#pragma unroll
        for (int r = 0; r < 16; ++r) pA1[r] = __builtin_amdgcn_exp2f(pA1[r]);
    }
    WAIT_BAR(0, mA);
    MLOAD(mB, 1);
    DMA_K(3, 0); DMA_V(1, SLOTB);
    ROT();
    kload8(kf, kp0 + sl_cur);
    WAIT_BAR(2, mB);
    s16x4 vlo[8], vhi[8]; u32x4 pw0, pw1, pw2, pw3;
#define PKW(P, B) cvtpk_s(P[B], P[B + 1])
#define PAF(k) __builtin_bit_cast(bf16x8, pw##k)
#define VFR(i) (bf16x8){vlo[i][0], vlo[i][1], vlo[i][2], vlo[i][3], vhi[i][0], vhi[i][1], vhi[i][2], vhi[i][3]}
#define PIN(x) asm volatile("" : "+v"(x))
#define MX3(a, b, c) __builtin_fmaxf(__builtin_fmaxf((a), (b)), (c))
#define GAPA(MF, A0, A1, A2, A3, W0, W1, PW) do { MF; sacc += A0; sacc += A1; sacc += A2; sacc += A3; PIN(sacc); W0; W1; PIN(PW); SBAR(); } while (0)
#define EX(v) __builtin_amdgcn_exp2f(v)
#define GAPB(MF, X, B) do { MF; X[B] = EX(X[B]); X[B + 1] = EX(X[B + 1]); X[B + 2] = EX(X[B + 2]); X[B + 3] = EX(X[B + 3]); PIN(X); SBAR(); } while (0)
#define VRD(i) do { vlo[i] = vtr(vp_ + (((i) >> 2) * 4096 + ((i) & 3) * 1024)); vhi[i] = vtr(vp_ + (((i) >> 2) * 4096 + ((i) & 3) * 1024 + 512)); } while (0)
#define KRD(G, j) do { if (G) { kload2(kf, kp0 + sl_next, j); SBAR(); } } while (0)
#define STEP(C0, C1, P0, P1, t, MC, MN, GM, GK, GV, GL) do { SBAR(); \
    const lds_cptr vp_ = vp0 + sl_prev; \
    bf16x8 qa_ = QRD(0), qb_; VRD(0); SBAR(); float sacc = (P0[0] + P0[1]); \
    GAPA(C0 = __builtin_amdgcn_mfma_f32_32x32x16_bf16(kf[0], qa_, negm, 0, 0, 0), P0[2], P0[3], P0[4], P0[5],     pw0[0] = PKW(P0, 0), pw0[1] = PKW(P0, 2), pw0); \
    VRD(4); SBAR(); GAPA(C1 = __builtin_amdgcn_mfma_f32_32x32x16_bf16(kf[1], qa_, negm, 0, 0, 0), P0[6], P0[7], P0[8], P0[9],     pw0[2] = PKW(P0, 4), pw0[3] = PKW(P0, 6), pw0); \
    qb_ = QRD(1); VRD(1); SBAR(); GAPA(C0 = __builtin_amdgcn_mfma_f32_32x32x16_bf16(kf[2], qb_, C0, 0, 0, 0),   P0[10], P0[11], P0[12], P0[13], pw1[0] = PKW(P0, 8), pw1[1] = PKW(P0, 10), pw1); \
    VRD(5); SBAR(); GAPA(C1 = __builtin_amdgcn_mfma_f32_32x32x16_bf16(kf[3], qb_, C1, 0, 0, 0),   P0[14], P0[15], P1[0], P1[1],   pw1[2] = PKW(P0, 12), pw1[3] = PKW(P0, 14), pw1); \
    qa_ = QRD(2); VRD(2); SBAR(); GAPA(C0 = __builtin_amdgcn_mfma_f32_32x32x16_bf16(kf[4], qa_, C0, 0, 0, 0),   P1[2], P1[3], P1[4], P1[5],     pw2[0] = PKW(P1, 0), pw2[1] = PKW(P1, 2), pw2); \
    VRD(6); SBAR(); GAPA(C1 = __builtin_amdgcn_mfma_f32_32x32x16_bf16(kf[5], qa_, C1, 0, 0, 0),   P1[6], P1[7], P1[8], P1[9],     pw2[2] = PKW(P1, 4), pw2[3] = PKW(P1, 6), pw2); \
    qb_ = QRD(3); VRD(3); SBAR(); GAPA(C0 = __builtin_amdgcn_mfma_f32_32x32x16_bf16(kf[6], qb_, C0, 0, 0, 0),   P1[10], P1[11], P1[12], P1[13], pw3[0] = PKW(P1, 8), pw3[1] = PKW(P1, 10), pw3); \
    VRD(7); SBAR(); GAPA(C1 = __builtin_amdgcn_mfma_f32_32x32x16_bf16(kf[7], qb_, C1, 0, 0, 0),   P1[14], P1[15], 0.f, 0.f,       pw3[2] = PKW(P1, 12), pw3[3] = PKW(P1, 14), pw3); \
    l_reg += sacc; \
    MASKB(C0, C1, t, MC); \
    if (GM) { MLOAD(MN, (t) + 1); } if (GK) { DMA_K((t) + 3, sl_cur); } if (GV) { DMA_V((t) + 1, sl_next); } \
    { float a = MX3(C0[0], C0[1], C1[0]), b_ = MX3(C0[2], C0[3], C1[1]); a = MX3(a, C1[2], C1[3]); \
      _Pragma("unroll") for (int r = 4; r < 16; r += 4) { a = MX3(a, C0[r], C0[r + 1]); b_ = MX3(b_, C0[r + 2], C0[r + 3]); a = MX3(a, C1[r], C1[r + 1]); b_ = MX3(b_, C1[r + 2], C1[r + 3]); } \
      float rm = __builtin_fmaxf(a, b_); { auto rr = __builtin_amdgcn_permlane32_swap(__float_as_uint(rm), __float_as_uint(rm), false, false); rm = __builtin_fmaxf(__uint_as_float(rr[0]), __uint_as_float(rr[1])); } \
      resc = false; \
      if (__builtin_expect(__any(rm > (float)THRL), 0)) { const float dl = __builtin_fmaxf(rm, 0.f); mhat += dl; \
        _Pragma("unroll") for (int r = 0; r < 16; ++r) { C0[r] -= dl; C1[r] -= dl; } \
        _Pragma("unroll") for (int r = 0; r < 16; ++r) negm[r] = -mhat; asm volatile("" : "+v"(negm)); \
        const float f = __builtin_amdgcn_exp2f(-dl); l_reg *= f; if (hi == 0) wsf[r32] = f; resc = true; } } \
    SBAR(); \
    GAPB(o[0] = __builtin_amdgcn_mfma_f32_32x32x16_bf16(PAF(0), VFR(0), o[0], 0, 0, 0), C0, 0); \
    GAPB(o[1] = __builtin_amdgcn_mfma_f32_32x32x16_bf16(PAF(0), VFR(4), o[1], 0, 0, 0), C0, 4); \
    KRD(GL, 0); GAPB(o[0] = __builtin_amdgcn_mfma_f32_32x32x16_bf16(PAF(1), VFR(1), o[0], 0, 0, 0), C0, 8); \
    KRD(GL, 1); GAPB(o[1] = __builtin_amdgcn_mfma_f32_32x32x16_bf16(PAF(1), VFR(5), o[1], 0, 0, 0), C0, 12); \
    KRD(GL, 2); GAPB(o[0] = __builtin_amdgcn_mfma_f32_32x32x16_bf16(PAF(2), VFR(2), o[0], 0, 0, 0), C1, 0); \
    KRD(GL, 3); GAPB(o[1] = __builtin_amdgcn_mfma_f32_32x32x16_bf16(PAF(2), VFR(6), o[1], 0, 0, 0), C1, 4); \
    GAPB(o[0] = __builtin_amdgcn_mfma_f32_32x32x16_bf16(PAF(3), VFR(3), o[0], 0, 0, 0), C1, 8); \
    GAPB(o[1] = __builtin_amdgcn_mfma_f32_32x32x16_bf16(PAF(3), VFR(7), o[1], 0, 0, 0), C1, 12); \
    } while (0)
    int t = 1;
    for (; t + 5 < NT; t += 2) {
        STEP(pB0, pB1, pA0, pA1, t, mB, mA, true, true, true, true);       WAIT_BAR(2, mA); RESC(); ROT();
        STEP(pA0, pA1, pB0, pB1, t + 1, mA, mB, true, true, true, true);   WAIT_BAR(2, mB); RESC(); ROT();
    }
#define ENDW(tt, M) do { if ((tt) + 3 < NT) { WAIT_BAR(2, M); } else if ((tt) + 2 < NT) { WAIT_BAR(1, M); } else { WAIT_BAR(0, M); } } while (0)
    for (; t + 1 < NT; t += 2) {
        STEP(pB0, pB1, pA0, pA1, t, mB, mA, (t + 1 < NT), (t + 3 < NT), (t + 1 < NT), (t + 1 < NT));         ENDW(t, mA);     RESC(); ROT();
        STEP(pA0, pA1, pB0, pB1, t + 1, mA, mB, (t + 2 < NT), (t + 4 < NT), (t + 2 < NT), (t + 2 < NT));     ENDW(t + 1, mB); RESC(); ROT();
    }
    STEP(pB0, pB1, pA0, pA1, NT - 1, mB, mA, false, false, false, false); RESC();
    { float sacc = pB0[0] + pB0[1];
#pragma unroll
      for (int r = 2; r < 16; ++r) sacc += pB0[r];
#pragma unroll
      for (int r = 0; r < 16; ++r) sacc += pB1[r];
      l_reg += sacc;
      pw0 = (u32x4){PKW(pB0, 0), PKW(pB0, 2), PKW(pB0, 4), PKW(pB0, 6)}; pw1 = (u32x4){PKW(pB0, 8), PKW(pB0, 10), PKW(pB0, 12), PKW(pB0, 14)};
      pw2 = (u32x4){PKW(pB1, 0), PKW(pB1, 2), PKW(pB1, 4), PKW(pB1, 6)}; pw3 = (u32x4){PKW(pB1, 8), PKW(pB1, 10), PKW(pB1, 12), PKW(pB1, 14)};
      SBAR(); pv(o, vb0 + sl_cur, PAF(0), PAF(1), PAF(2), PAF(3)); }
    { auto rr = __builtin_amdgcn_permlane32_swap(__float_as_uint(l_reg), __float_as_uint(l_reg), false, false); l_reg = __uint_as_float(rr[0]) + __uint_as_float(rr[1]); }
    if (hi == 0) wsf[32 + r32] = l_reg; asm volatile("s_waitcnt lgkmcnt(0)" ::: "memory");
    float rli[16];
#pragma unroll
    for (int r = 0; r < 16; ++r) rli[r] = __builtin_amdgcn_rcpf(wsf[32 + crow(r, hi)]);
    { LAS bf16* stg = (LAS bf16*)(shm + LDS_OST) + wid * 2048;
#pragma unroll
      for (int r = 0; r < 16; ++r) { const int orow = crow(r, hi);
          stg[orow * 64 + r32] = (bf16)(cvtpk_s(o[0][r] * rli[r] * ms0, 0.f) & 0xffffu); stg[orow * 64 + 32 + r32] = (bf16)(cvtpk_s(o[1][r] * rli[r] * ms1, 0.f) & 0xffffu); }
      asm volatile("s_waitcnt lgkmcnt(0)" ::: "memory");
      int ln2 = lane; asm volatile("" : "+v"(ln2));
#pragma unroll
      for (int i = 0; i < 4; ++i) { const int row = i * 8 + (ln2 >> 3), ch = ln2 & 7; const u32x4 v = *(const LAS u32x4*)(stg + row * 64 + ch * 8);
          *(u32x4*)(MIX + (rowbase + qw + row) * DM + h * HD + ch * 8) = v; } }
    asm volatile("s_waitcnt lgkmcnt(0)\n\ts_barrier" ::: "memory");
#undef QRD
#undef DMA_K
#undef DMA_V
#undef MLOAD
#undef WAIT_BAR
#undef MASKB
#undef START
#undef RESC
#undef ROT
#undef PKW
#undef PAF
#undef VFR
#undef PIN
#undef MX3
#undef GAPA
#undef GAPB
#undef EX
#undef VRD
#undef KRD
#undef STEP
#undef ENDW
}
#undef SBAR
}

__device__ __forceinline__ void p_attn(Frame& F, int l) {
    const bf16* Q = WSP(bf16, WS_Q); const bf16* Kg = WSP(bf16, WS_K); const bf16* Vg = WSP(bf16, WS_V); bf16* MIX = WSP(bf16, WS_MIX);
    const unsigned long long* maskQ = WSP(unsigned long long, WS_MASK);
    LAS unsigned char* shm = F.lds + RING_OFF;
    const int tid = F.tid, lane = F.lane, r32 = lane & 31;
    const int bh = F.vcu >> 2, sq = F.vcu & 3, b = bh >> 3, h = bh & 7;
    LAS float* biasT = (LAS float*)(shm + at::LDS_BIAS);
    if (tid < 192) { const int rel = tid - 128, nn = rel < 0 ? -rel : rel; int bk = nn;
        if (nn >= 8) bk = 8 + (nn >= 12) + (nn >= 16) + (nn >= 23) + (nn >= 32) + (nn >= 46) + (nn >= 64) + (nn >= 91);
        bk += (rel > 0) ? 16 : 0;
        biasT[tid] = (arg_in(7)[bk * NH + h] - arg_in(7)[15 * NH + h]) * LOG2E; }
    __syncthreads();
    const float ms0 = arg_in(6)[l * DM + h * 64 + r32], ms1 = arg_in(6)[l * DM + h * 64 + 32 + r32];
    for (int ui = 0; ui < 4; ++ui) {
        const int qb = (ui == 0) ? sq : (ui == 1) ? 7 - sq : (ui == 2) ? 8 + sq : 15 - sq;
        at::attn_unit<8>(b, h, qb, Q, Kg, Vg, maskQ, MIX, ms0, ms1, shm, tid);
    }
}


#define REP(bit) for (int rep_ = 0; rep_ < (((PROBE_MASK) >> (bit)) & 1) + 1; ++rep_)
struct Args { const float* in[20]; float* out; unsigned char* ws; int seg_lo, seg_hi; };
constexpr int N_SEG = 1 + 2 * 8 + 2 * 9;

__global__ void __launch_bounds__(NTHR, 2) fwd_kernel(Args a) {
    extern __shared__ __attribute__((aligned(16))) unsigned char lds_raw[];
    Frame F0;
    F0.lds = (LAS unsigned char*)lds_raw;
    F0.tid = threadIdx.x; F0.lane = F0.tid & 63; F0.wave = __builtin_amdgcn_readfirstlane(F0.tid >> 6);
    F0.G = gridDim.x; { const int bx = blockIdx.x; F0.vcu = (F0.G % 8 == 0) ? (bx % 8) * (F0.G / 8) + bx / 8 : bx; }
    F0.ws = a.ws;
    for (int u = F0.tid; u < (LDS_BYTES - LDSCTL_OFF) / 4; u += NTHR) ((LAS unsigned*)(F0.lds + LDSCTL_OFF))[u] = 0u;
    __syncthreads();
    unsigned* ctl = (unsigned*)(F0.ws + WS_CTL);
    XcdBarrier bar = xcd_barrier_post(ctl + CW_BAR, (volatile LAS unsigned*)(F0.lds + MISC_OFF + 32));
    int sg = 0;
    const int lo = a.seg_lo, hi = a.seg_hi;
#define ACTIVE (lo <= sg && sg < hi)
#define SEAM() do { if (lo <= sg && sg + 1 < hi) xcd_barrier(bar); ++sg; } while (0)

    if (ACTIVE) { Frame F = fresh(F0); cvt_x(F); convert_weights(F, 0); }
    SEAM();
    for (int l = 0; l < DEPTH; ++l) {
        if (ACTIVE) REP(3) {
            {
                Frame F = fresh(F0);
                pg8::DenseOrderG S; S.init_tiles(M / 256, 10, F.G, (int)(F.G % 8 == 0 ? (F.vcu % (F.G / 8)) * 8 + F.vcu / (F.G / 8) : F.vcu)); S.Bt = (const char*)WSP(unsigned char, WS_WIN); S.K = DM / 2;
                pg8::EpiIn E{WSP(bf16, WS_Q), WSP(bf16, WS_K), WSP(bf16, WS_V), WSP(bf16, WS_QI), WSP(bf16, WS_KI), WSP(bf16, WS_U), WSP(float, WS_WI), 0, 1.0f / (pg8::F8_ASC * pg8::F8_WGU), 6};
                pg8::gemm_phase<pg8::EpiIn, pg8::DenseOrderG, true, true, true>(F.tid, F.lds + RING_OFF, (const char*)WSP(unsigned char, WS_XQ), DM / 2, S, E);
            }
            {
                Frame F = fresh(F0);
                pg8::DenseOrder S; S.init_tiles(M / 256, 3, F.G, (int)(F.G % 8 == 0 ? (F.vcu % (F.G / 8)) * 8 + F.vcu / (F.G / 8) : F.vcu)); S.Bt = (const char*)(WSP(bf16, WS_WIN) + (size_t)1536 * DM); S.K = DM;
                pg8::EpiIn E{WSP(bf16, WS_Q), WSP(bf16, WS_K), WSP(bf16, WS_V), WSP(bf16, WS_QI), WSP(bf16, WS_KI), WSP(bf16, WS_U), WSP(float, WS_WI), 6, 1.0f, 99};
                pg8::gemm_phase<pg8::EpiIn, pg8::DenseOrder, true, true>(F.tid, F.lds + RING_OFF, (const char*)WSP(bf16, WS_XB), DM, S, E);
            }
        }
        SEAM();
        if (ACTIVE) {
#ifndef NO_IDX
            REP(0) { Frame F = fresh(F0); p_idx(F, l); }
#endif
#ifndef NO_CONV
            REP(1) { Frame F = fresh(F0); p_conv(F, l); }
#endif
        }
        SEAM();
        if (ACTIVE) {
#ifndef NO_ATTN
            REP(2) { Frame F = fresh(F0); p_attn(F, l); }
#endif
        }
        SEAM();
        if (ACTIVE) REP(4) { Frame F = fresh(F0); bf16* R1 = WSP(bf16, WS_R1);
            pg8::DenseOrder S; S.init_tiles(M / 256, DM / 256, F.G, (int)(F.G % 8 == 0 ? (F.vcu % (F.G / 8)) * 8 + F.vcu / (F.G / 8) : F.vcu)); S.Bt = (const char*)WSP(bf16, WS_WOUT); S.K = DM;
            pg8::EpiRes E{WSP(bf16, WS_XB), R1, 1.0f};
            pg8::gemm_phase<pg8::EpiRes, pg8::DenseOrder, true, true>(F.tid, F.lds + RING_OFF, (const char*)WSP(bf16, WS_MIX), DM, S, E);
        }
        SEAM();
        if (ACTIVE) { Frame F = fresh(F0); p_ln1(F, l); }
        SEAM();
        if ((l & 1) == 0) {
            if (ACTIVE) REP(5) { Frame F = fresh(F0); bf16* XB = WSP(bf16, WS_XB);
                pg8::DenseOrderG S; S.init_tiles(M / 256, 2 * DFF / 256, F.G, (int)(F.G % 8 == 0 ? (F.vcu % (F.G / 8)) * 8 + F.vcu / (F.G / 8) : F.vcu)); S.Bt = (const char*)WSP(bf16, WS_WFF); S.K = DM / 2;
                pg8::EpiSwi E{WSP(unsigned char, WS_H), DFF};
                pg8::gemm_phase<pg8::EpiSwi, pg8::DenseOrderG, true, true, true>(F.tid, F.lds + RING_OFF, (const char*)XB, DM / 2, S, E);
            }
            SEAM();
            if (ACTIVE) { Frame F = fresh(F0); bf16* R1 = WSP(bf16, WS_R1);
                pg8::DenseOrderG S; S.init_tiles(M / 256, DM / 256, F.G, (int)(F.G % 8 == 0 ? (F.vcu % (F.G / 8)) * 8 + F.vcu / (F.G / 8) : F.vcu)); S.Bt = (const char*)(WSP(unsigned char, WS_WFF) + (size_t)2 * DFF * DM); S.K = DFF / 2;
                pg8::EpiRes E{R1, R1, 1.0f / (pg8::F8_HSC * pg8::F8_WDN)};
                pg8::gemm_phase<pg8::EpiRes, pg8::DenseOrderG, true, true, true>(F.tid, F.lds + RING_OFF, (const char*)WSP(unsigned char, WS_H), DFF / 2, S, E);
            }
            SEAM();
            if (ACTIVE) { REP(11) { Frame F = fresh(F0); p_ln2(F, l); } if (l + 1 < DEPTH) REP(8) { Frame F = fresh(F0); convert_weights(F, l + 1); } }
            SEAM();
        } else {
            if (ACTIVE) { Frame F = fresh(F0); p_list(F); }
            SEAM();
            for (int r = 0; r < 1; ++r) {
                if (ACTIVE) REP(6) { Frame F = fresh(F0); bf16* XB = WSP(bf16, WS_XB);
                    moe_tables(F);
                    const int Tm = ((LAS int*)(F.lds + LDSCTL_OFF + 1200))[8]; const int tlo = r * RT; int nMr = Tm - tlo; nMr = nMr < 0 ? 0 : (nMr > RT ? RT : nMr);
                    pg8::MoeGuOrder S; S.init_tiles(nMr, 2 * DFE / 256, F.G, (int)(F.G % 8 == 0 ? (F.vcu % (F.G / 8)) * 8 + F.vcu / (F.G / 8) : F.vcu)); S.rowlist = WSP(int, WS_ROWLIST); S.texp = (const LAS int*)(F.lds + LDSCTL_OFF); S.tlo = tlo;
                    S.W = (const char*)WSP(unsigned char, WS_WFF); S.estride = (size_t)3 * DFE * DM;
                    pg8::EpiSwi E{WSP(unsigned char, WS_H), DFE};
                    pg8::gemm_phase<pg8::EpiSwi, pg8::MoeGuOrder, true, true, true>(F.tid, F.lds + RING_OFF, (const char*)XB, DM / 2, S, E);
                }
                SEAM();
                if (ACTIVE) REP(7) { Frame F = fresh(F0);
                    moe_tables(F);
                    const int Tm = ((LAS int*)(F.lds + LDSCTL_OFF + 1200))[8]; const int tlo = r * RT; int nMr = Tm - tlo; nMr = nMr < 0 ? 0 : (nMr > RT ? RT : nMr);
                    pg8::MoeDnOrder S; S.init_tiles(nMr, DM / 256, F.G, (int)(F.G % 8 == 0 ? (F.vcu % (F.G / 8)) * 8 + F.vcu / (F.G / 8) : F.vcu)); S.texp = (const LAS int*)(F.lds + LDSCTL_OFF); S.tlo = tlo;
                    S.W = (const char*)(WSP(unsigned char, WS_WFF) + (size_t)2 * DFE * DM); S.estride = (size_t)3 * DFE * DM;
                    pg8::EpiMoeDown E{WSP(bf16, WS_YD), WSP(float, WS_ROWGATE), tlo};
                    pg8::gemm_phase<pg8::EpiMoeDown, pg8::MoeDnOrder, true, true, true>(F.tid, F.lds + RING_OFF, (const char*)WSP(unsigned char, WS_H), DFE / 2, S, E);
                }
                SEAM();
            }
            if (ACTIVE) { REP(10) { Frame F = fresh(F0); p_comb(F, l); } if (l + 1 < DEPTH) REP(8) { Frame F = fresh(F0); convert_weights(F, l + 1); } }
            SEAM();
        }
    }
#undef ACTIVE
#undef SEAM
}

#ifndef MK_MULTI
#define MK_MULTI 0
#endif
extern "C" void kernel_launch(void* const* d_in, const int* in_sizes, int n_in, void* d_out, int out_size, void* d_ws, size_t ws_size, hipStream_t stream) {
    static int grid = 0;
    if (grid == 0) {
        if (n_in != 20 || in_sizes[0] != M * DM || out_size != M * DM || ws_size < WS_END) { fprintf(stderr, "kernel_launch: unexpected shapes (n_in %d, in0 %d, out %d, ws %zu, need %zu); nothing launched\n", n_in, n_in > 0 ? in_sizes[0] : -1, out_size, ws_size, (size_t)WS_END); grid = -1; return; }
        int dev = 0, cus = 0, per_cu = 0;
        if (hipGetDevice(&dev) != hipSuccess || hipDeviceGetAttribute(&cus, hipDeviceAttributeMultiprocessorCount, dev) != hipSuccess) { grid = -1; return; }
        if (hipFuncSetAttribute((const void*)fwd_kernel, hipFuncAttributeMaxDynamicSharedMemorySize, LDS_BYTES) != hipSuccess) { fprintf(stderr, "kernel_launch: hipFuncSetAttribute failed\n"); grid = -1; return; }
        if (hipOccupancyMaxActiveBlocksPerMultiprocessor(&per_cu, (const void*)fwd_kernel, NTHR, LDS_BYTES) != hipSuccess || per_cu < 1) fprintf(stderr, "kernel_launch: occupancy query reports %d\n", per_cu);
        (void)hipGetLastError();
        grid = cus;
        if (grid != 256) { fprintf(stderr, "kernel_launch: built for 256 CUs, device has %d; nothing launched\n", cus); grid = -1; return; }
    }
    if (grid < 0) return;
    if (hipMemsetAsync((char*)d_ws + WS_CTL, 0, CTL_ZERO_BYTES, stream) != hipSuccess) return;
    Args a{};
    for (int i = 0; i < 20; ++i) a.in[i] = (const float*)d_in[i];
    a.out = (float*)d_out; a.ws = (unsigned char*)d_ws;
#if MK_MULTI
    for (int s = 0; s < N_SEG; ++s) { a.seg_lo = s; a.seg_hi = s + 1; hipLaunchKernelGGL(fwd_kernel, dim3(grid), dim3(NTHR), LDS_BYTES, stream, a); }
#else
    a.seg_lo = 0; a.seg_hi = N_SEG;
    hipLaunchKernelGGL(fwd_kernel, dim3(grid), dim3(NTHR), LDS_BYTES, stream, a);
#endif
    const hipError_t le = hipPeekAtLastError();
    if (le != hipSuccess) fprintf(stderr, "kernel_launch: launch failed: %s\n", hipGetErrorName(le));
}
```

```cpp
#include <hip/hip_runtime.h>
#include <cstdio>
#include <cstdint>

#define GAS __attribute__((address_space(1)))
#define LAS __attribute__((address_space(3)))
#define CAS __attribute__((address_space(4)))
typedef unsigned short bf16;
typedef short bf16x8 __attribute__((ext_vector_type(8)));
typedef short s16x4 __attribute__((ext_vector_type(4)));
typedef float f32x2 __attribute__((ext_vector_type(2)));
typedef float f32x4 __attribute__((ext_vector_type(4)));
typedef float f32x16 __attribute__((ext_vector_type(16)));
typedef unsigned u32x2 __attribute__((ext_vector_type(2)));
typedef unsigned u32x4 __attribute__((ext_vector_type(4)));
typedef int i32x8 __attribute__((ext_vector_type(8)));

#ifndef PROBE_MASK
#define PROBE_MASK 0
#endif
constexpr int BATCH = 8, SEQ = 4096, DM = 1024, M = BATCH * SEQ, DEPTH = 4;
constexpr int AW = 512, NH = 8, HD = 64, CCH = 512, CK = 31;
constexpr int IN_COLS = 3144, NIN = 3328;
constexpr int OFF_KI = 2048, OFF_WI = 2112, OFF_GLU = 2120;
constexpr int DFF = 2816, DFE = 3584, NE = 8;
constexpr int TOPK = 256;
constexpr float DN_ALPHA = 1.6817928305074290f;
constexpr float LN_EPS = 1e-5f;
constexpr float LOG2E = 1.4426950408889634f;
constexpr float QSCALE = 0.125f * LOG2E;
constexpr int NWAVES = 8, NTHR = 512;
constexpr int MAXT = 272, RT = 272;

constexpr size_t MiB = 1u << 20;
constexpr size_t WS_CTL = 0, CTL_ZERO_BYTES = 1 * MiB;
constexpr size_t WS_WIN = 1 * MiB, WS_WOUT = 8 * MiB, WS_WFF = 10 * MiB;
constexpr size_t WS_R1 = 178 * MiB, WS_XB = 306 * MiB, WS_A = 370 * MiB;
constexpr size_t WS_Q = WS_A, WS_K = WS_A + 32 * MiB, WS_V = WS_A + 64 * MiB, WS_QI = WS_A + 96 * MiB, WS_KI = WS_A + 128 * MiB, WS_WI = WS_A + 132 * MiB,
                 WS_U = WS_A + 133 * MiB, WS_MIX = WS_A + 165 * MiB, WS_H = WS_A;
constexpr size_t WS_YD = 616 * MiB, WS_ROUTE = 752 * MiB, WS_ROWLIST = WS_ROUTE + 512 * 1024, WS_ROWGATE = WS_ROWLIST + 320 * 1024, WS_SLOTROW = WS_ROWGATE + 320 * 1024,
                 WS_CNTWG = WS_SLOTROW + 256 * 1024, WS_MASK = 754 * MiB, WS_XQ = 820 * MiB, WS_END = 852 * MiB;
static_assert((size_t)RT * 256 * DFE <= 246 * MiB && (size_t)M * DFF <= 246 * MiB, "H overlay (fp8)");
static_assert((size_t)MAXT * 256 * DM * 2 <= 136 * MiB, "Yd");
static_assert(WS_CNTWG + 8192 <= WS_MASK && WS_MASK + (size_t)DEPTH * BATCH * 128 * 4096 * 4 <= WS_XQ, "route / masks");
constexpr int CW_BAR = 4096;

constexpr int RING_OFF = 0, RING_BYTES = 131072;
constexpr int AUX_OFF = 131072, AUX_BYTES = 26624;
constexpr int LDSCTL_OFF = AUX_OFF + AUX_BYTES, MISC_OFF = LDSCTL_OFF + 2048;
constexpr int LDS_BYTES = 157 * 1024;
static_assert(MISC_OFF + 128 <= LDS_BYTES, "LDS map");

__device__ __forceinline__ unsigned cvt_pk_bf16(float lo, float hi) { unsigned r; asm volatile("v_cvt_pk_bf16_f32 %0, %1, %2" : "=v"(r) : "v"(lo), "v"(hi)); return r; }
__device__ __forceinline__ float bf2f(unsigned short b) { return __uint_as_float((unsigned)b << 16); }
__device__ __forceinline__ float fsigmoid(float x) { return __builtin_amdgcn_rcpf(1.0f + __builtin_amdgcn_exp2f(-x * LOG2E)); }
#define LDS_WAIT() asm volatile("s_waitcnt lgkmcnt(0)" ::: "memory")
#define VM_WAIT() asm volatile("s_waitcnt vmcnt(0)" ::: "memory")

namespace pg8 {
constexpr int BM = 256, BK = 64, HALF = 128, HTB = HALF * BK * 2, STAGE_BYTES = 8 * HTB, NXCD = 8, WGM = 8;
__host__ __device__ __forceinline__ int lds_byte(int r, int c) { const int st = (r >> 4) * 2 + (c >> 5), rr = r & 15, cc = c & 31, ob = rr * 64 + cc * 2; return st * 1024 + (ob ^ (((ob >> 9) & 1) << 5)); }
__host__ __device__ __forceinline__ void stage_rc(int b, int& R, int& C) { const int st = b / 1024, sb = b % 1024, swz = sb ^ (((sb >> 9) & 1) << 5); R = (st >> 1) * 16 + swz / 64; C = (st & 1) * 32 + (swz % 64) / 2; }
__host__ __device__ __forceinline__ int perm32(int rho) { const int n = rho >> 4, i = rho & 15; return 8 * (i >> 2) + 4 * n + (i & 3); }
struct Unit { int pm, pn; };

struct OrderBase {
    int nM, nN, nwg, G, c;
    __device__ __forceinline__ void init_tiles(int nM_, int nN_, int G_, int c_) { nM = nM_; nN = nN_; nwg = nM * nN; G = G_; c = c_; }
    __device__ __forceinline__ bool next(int i, Unit& u) const { const long L = (long)i * G + c; if (L >= nwg) return false; unit_of((int)L, u); return true; }
    __device__ __forceinline__ void unit_of(int L, Unit& u) const {
        int wgid = L; { const int q = nwg / NXCD, r = nwg % NXCD, xcd = wgid % NXCD, off = wgid / NXCD; wgid = (xcd < r ? xcd * (q + 1) : r * (q + 1) + (xcd - r) * q) + off; }
        const int nig = WGM * nN, gid = wgid / nig, fm = gid * WGM, gsz = (nM - fm) < WGM ? (nM - fm) : WGM;
        u.pm = fm + ((wgid % nig) % gsz); u.pn = (wgid % nig) / gsz;
    }
    __device__ __forceinline__ void a_ready(const Unit&) const {}
    __device__ __forceinline__ void done(const Unit&) const {}
};
struct DenseOrder : OrderBase {
    static constexpr bool GATHER = false;
    const char* Bt; int K;
    __device__ __forceinline__ size_t a_base(const Unit& u) const { return (size_t)u.pm * ((size_t)BM * K * 2); }
    __device__ __forceinline__ unsigned a_off(const Unit&, int) const { return 0u; }
    __device__ __forceinline__ const char* b_base(const Unit& u) const { return Bt + (size_t)u.pn * ((size_t)BM * K * 2); }
};

struct DenseOrderG : OrderBase {
    static constexpr bool GATHER = true;
    const char* Bt; int K;
    __device__ __forceinline__ size_t a_base(const Unit&) const { return 0; }
    __device__ __forceinline__ unsigned a_off(const Unit& u, int r) const { return (unsigned)(u.pm * BM + r) * (unsigned)(K * 2); }
    __device__ __forceinline__ const char* b_base(const Unit& u) const { return Bt + (size_t)u.pn * ((size_t)BM * K * 2); }
};

template <class Epi, class Sched, bool ALIGN_EPI, bool SP2, bool F8 = false>
__device__ __forceinline__ void gemm_phase(const int tid, LAS unsigned char* lds, const char* Abase, const int K, const Sched& S, const Epi& E) {
    const int wid = __builtin_amdgcn_readfirstlane(tid >> 6), lane = tid & 63, wr = wid >> 2, wc = wid & 3, fr = lane & 15, fq = lane >> 4;
    const int nt = K / BK;
    constexpr bool GATHER = Sched::GATHER;
    unsigned voffA[2], voffB[2];
#pragma unroll
    for (int i = 0; i < 2; ++i) { int R, C; stage_rc(tid * 16 + i * 8192, R, C); const int Rb = Epi::PERM ? ((R & ~31) + perm32(R & 31)) : R;
        voffA[i] = GATHER ? (unsigned)C * 2u : (unsigned)(R * K + C) * 2u; voffB[i] = (unsigned)(Rb * K + C) * 2u; }
    const size_t kstep = (size_t)(BK * 2);
    const size_t hstep = (size_t)HALF * K * 2;
    const unsigned ldsw = (unsigned)wid * 1024u;
    const int aoff = lds_byte(wr * 64 + fr, fq * 8), boff = lds_byte(wc * 32 + fr, fq * 8);
#define PG8_SA(b, h) (((b) * 2 + (h)) * HTB)
#define PG8_SB(b, h) ((4 + (b) * 2 + (h)) * HTB)
#define PG8_STAGE(bufoff, gbase, voff) do { _Pragma("unroll") for (int _i = 0; _i < 2; ++_i) \
        __builtin_amdgcn_global_load_lds((const unsigned*)((const char*)(gbase) + (voff)[_i]), (LAS unsigned*)(lds + (bufoff) + ldsw + _i * 8192), 16, 0, 0); } while (0)
typedef int i32x4_t __attribute__((ext_vector_type(4)));
#define PG8_LDA(dst, b, h) do { _Pragma("unroll") for (int m = 0; m < 4; ++m) { if constexpr (F8) { dst[m].lo = *(const LAS i32x4_t*)(lds + PG8_SA(b, h) + aoff + m * 2048); dst[m].hi = *(const LAS i32x4_t*)(lds + PG8_SA(b, h) + aoff + m * 2048 + 1024); } \
        else { _Pragma("unroll") for (int k = 0; k < 2; ++k) dst##b16[m][k] = *(const LAS bf16x8*)(lds + PG8_SA(b, h) + aoff + m * 2048 + k * 1024); } } } while (0)
#define PG8_LDB(dst, b, h) do { _Pragma("unroll") for (int n = 0; n < 2; ++n) { if constexpr (F8) { dst[n].lo = *(const LAS i32x4_t*)(lds + PG8_SB(b, h) + boff + n * 2048); dst[n].hi = *(const LAS i32x4_t*)(lds + PG8_SB(b, h) + boff + n * 2048 + 1024); } \
        else { _Pragma("unroll") for (int k = 0; k < 2; ++k) dst##b16[n][k] = *(const LAS bf16x8*)(lds + PG8_SB(b, h) + boff + n * 2048 + k * 1024); } } } while (0)
#define PG8_MMA(ai, bj, At, Bt) do { __builtin_amdgcn_s_setprio(1); _Pragma("unroll") for (int m = 0; m < 4; ++m) _Pragma("unroll") for (int n = 0; n < 2; ++n) { \
        if constexpr (F8) { acc[ai][bj][m][n] = __builtin_amdgcn_mfma_scale_f32_16x16x128_f8f6f4(Bt[n], At[m], acc[ai][bj][m][n], 0, 0, 0, 0x7f7f7f7f, 0, 0x7f7f7f7f); } \
        else { _Pragma("unroll") for (int k = 0; k < 2; ++k) acc[ai][bj][m][n] = __builtin_amdgcn_mfma_f32_16x16x32_bf16(Bt##b16[n][k], At##b16[m][k], acc[ai][bj][m][n], 0, 0, 0); } } __builtin_amdgcn_s_setprio(0); } while (0)
#define PG8_WAIT_V(n) asm volatile("s_waitcnt vmcnt(" #n ")" ::: "memory")
#define PG8_WAIT_L(n) asm volatile("s_waitcnt lgkmcnt(" #n ")" ::: "memory")
#define PG8_BAR __builtin_amdgcn_s_barrier()
#define PG8_SCHED __builtin_amdgcn_sched_barrier(0)
    Unit cur, nxt; int ui = 0;
    if (!S.next(0, cur)) return;
    f32x4 acc[2][2][4][2];
    { float z0 = 0.f; asm volatile("" : "+v"(z0));
#pragma unroll
    for (int a = 0; a < 2; ++a)
#pragma unroll
        for (int b = 0; b < 2; ++b)
#pragma unroll
            for (int m = 0; m < 4; ++m)
#pragma unroll
                for (int n = 0; n < 2; ++n) acc[a][b][m][n] = (f32x4){z0, z0, z0, z0}; }
    bf16x8 Atb16[F8 ? 1 : 4][2], B0b16[F8 ? 1 : 2][2], B1b16[F8 ? 1 : 2][2]; i32x8 At[F8 ? 4 : 1], B0[F8 ? 2 : 1], B1[F8 ? 2 : 1]; (void)Atb16; (void)B0b16; (void)B1b16; (void)At; (void)B0; (void)B1;
    unsigned cOff0[2], cOff1[2];
#define PG8_ROWS(u) do { if constexpr (GATHER) { _Pragma("unroll") for (int _i = 0; _i < 2; ++_i) { int R_, C_; stage_rc(tid * 16 + _i * 8192, R_, C_); cOff0[_i] = S.a_off(u, R_) + voffA[_i]; cOff1[_i] = S.a_off(u, HALF + R_) + voffA[_i]; } } } while (0)
#define PG8_STAGE_A(bufoff, h, ptr) do { if constexpr (GATHER) { if ((h) == 0) PG8_STAGE(bufoff, ptr, cOff0); else PG8_STAGE(bufoff, ptr, cOff1); } else { PG8_STAGE(bufoff, (ptr) + (h) * hstep, voffA); } } while (0)
    const char* cA = Abase; if constexpr (!GATHER) cA = Abase + S.a_base(cur);
    PG8_ROWS(cur);
    const char* cB = S.b_base(cur);
    S.a_ready(cur);
    {
        PG8_STAGE(PG8_SB(0, 0), cB, voffB); PG8_STAGE(PG8_SB(0, 1), cB + hstep, voffB); PG8_STAGE_A(PG8_SA(0, 0), 0, cA); PG8_STAGE_A(PG8_SA(0, 1), 1, cA);
        if (wr == 1) PG8_BAR;
        PG8_WAIT_V(2); PG8_BAR;
        PG8_STAGE(PG8_SB(1, 0), cB + kstep, voffB); PG8_STAGE_A(PG8_SA(1, 0), 0, cA + kstep); PG8_STAGE(PG8_SB(1, 1), cB + hstep + kstep, voffB);
        PG8_WAIT_V(6); PG8_BAR;
    }
    for (;;) {
        const bool has_next = S.next(ui + 1, nxt);
        unsigned nOff0[2] = {0u, 0u}, nOff1[2] = {0u, 0u};
        if constexpr (GATHER) { if (has_next) { _Pragma("unroll") for (int _i = 0; _i < 2; ++_i) { int R_, C_; stage_rc(tid * 16 + _i * 8192, R_, C_); nOff0[_i] = S.a_off(nxt, R_); nOff1[_i] = S.a_off(nxt, HALF + R_); } } }
        const char* nA = cA; if constexpr (!GATHER) { if (has_next) nA = Abase + S.a_base(nxt); }
        const char* nB = has_next ? S.b_base(nxt) : cB;
#pragma nounroll
        for (int t = 0; t < nt; t += 2) {
            const bool last = (t == nt - 2);
            const char* a1 = cA + (size_t)(t + 1) * kstep;
            const char* a2 = last ? nA : cA + (size_t)(t + 2) * kstep; const char* b2 = last ? nB : cB + (size_t)(t + 2) * kstep;
            const char* a3 = a2 + kstep; const char* b3 = b2 + kstep;
            if (last && has_next) S.a_ready(nxt);
            if constexpr (SP2) {
            PG8_LDB(B0, 0, 0); PG8_LDB(B1, 0, 1); PG8_SCHED; PG8_LDA(At, 0, 0); PG8_STAGE_A(PG8_SA(1, 1), 1, a1);
            if constexpr (GATHER) { if (last && has_next) { _Pragma("unroll") for (int _i = 0; _i < 2; ++_i) { cOff0[_i] = nOff0[_i] + voffA[_i]; cOff1[_i] = nOff1[_i] + voffA[_i]; } } }
            PG8_WAIT_V(8); PG8_WAIT_L(0); PG8_BAR; PG8_MMA(0, 0, At, B0); PG8_MMA(0, 1, At, B1); PG8_BAR; PG8_SCHED;
            PG8_LDA(At, 0, 1); PG8_STAGE(PG8_SB(0, 0), b2, voffB); PG8_STAGE(PG8_SB(0, 1), b2 + hstep, voffB); PG8_STAGE_A(PG8_SA(0, 0), 0, a2);
            PG8_WAIT_V(8); PG8_WAIT_L(0); PG8_BAR; PG8_MMA(1, 0, At, B0); PG8_MMA(1, 1, At, B1); PG8_BAR; PG8_SCHED;
            PG8_LDB(B0, 1, 0); PG8_LDB(B1, 1, 1); PG8_SCHED; PG8_LDA(At, 1, 0); PG8_STAGE_A(PG8_SA(0, 1), 1, a2);
            PG8_WAIT_V(8); PG8_WAIT_L(0); PG8_BAR; PG8_MMA(0, 0, At, B0); PG8_MMA(0, 1, At, B1); PG8_BAR; PG8_SCHED;
            PG8_LDA(At, 1, 1); PG8_STAGE(PG8_SB(1, 0), b3, voffB); PG8_STAGE(PG8_SB(1, 1), b3 + hstep, voffB); PG8_STAGE_A(PG8_SA(1, 0), 0, a3);
            PG8_WAIT_V(8); PG8_WAIT_L(0); PG8_BAR; PG8_MMA(1, 0, At, B0); PG8_MMA(1, 1, At, B1); PG8_BAR; PG8_SCHED;
            } else { static_assert(SP2, "only the two-super-phase loop is kept"); }
        }
        if constexpr (ALIGN_EPI) { if (wr == 0) PG8_BAR; }
        E(acc, cur, wr, wc, fr, fq); S.done(cur);
        if (!has_next) break;
        { float z0 = 0.f; asm volatile("" : "+v"(z0));
#pragma unroll
        for (int a = 0; a < 2; ++a)
#pragma unroll
            for (int b = 0; b < 2; ++b)
#pragma unroll
                for (int m = 0; m < 4; ++m)
#pragma unroll
                    for (int n = 0; n < 2; ++n) acc[a][b][m][n] = (f32x4){z0, z0, z0, z0}; }
        cur = nxt; cA = nA; cB = nB; ++ui;
        if constexpr (ALIGN_EPI) { if (wr == 1) PG8_BAR; }
    }
    PG8_WAIT_V(0);
    if constexpr (!ALIGN_EPI) { if (wr == 0) PG8_BAR; }
    PG8_BAR;
#undef PG8_SA
#undef PG8_SB
#undef PG8_STAGE
#undef PG8_STAGE_A
#undef PG8_ROWS
#undef PG8_LDA
#undef PG8_LDB
#undef PG8_MMA
#undef PG8_WAIT_V
#undef PG8_WAIT_L
#undef PG8_BAR
#undef PG8_SCHED
}
}

namespace pg8 {
__device__ __forceinline__ u32x4 pack8(const f32x4 v0, const f32x4 v1) { u32x4 w; w.x = cvt_pk_bf16(v0[0], v0[1]); w.y = cvt_pk_bf16(v0[2], v0[3]); w.z = cvt_pk_bf16(v1[0], v1[1]); w.w = cvt_pk_bf16(v1[2], v1[3]); return w; }

__device__ __forceinline__ unsigned pk4_fp8(float a, float b, float c, float d) {
    a = __builtin_amdgcn_fmed3f(a, -448.f, 448.f); b = __builtin_amdgcn_fmed3f(b, -448.f, 448.f); c = __builtin_amdgcn_fmed3f(c, -448.f, 448.f); d = __builtin_amdgcn_fmed3f(d, -448.f, 448.f);
    unsigned r = 0u; r = (unsigned)__builtin_amdgcn_cvt_pk_fp8_f32(a, b, (int)r, false); r = (unsigned)__builtin_amdgcn_cvt_pk_fp8_f32(c, d, (int)r, true); return r; }
__device__ __forceinline__ u32x2 pack8_fp8(const f32x4 v0, const f32x4 v1) { u32x2 w; w.x = pk4_fp8(v0[0], v0[1], v0[2], v0[3]); w.y = pk4_fp8(v1[0], v1[1], v1[2], v1[3]); return w; }
constexpr float F8_ASC = 16.f, F8_WGU = 64.f, F8_HSC = 8.f, F8_WDN = 256.f;
struct EpiIn {
    static constexpr bool PERM = true;
    bf16 *Q, *Kb, *V, *QI, *KI, *U; float* WI; int pn_off; float dsc; int glu_from;
    __device__ __forceinline__ void operator()(const f32x4 (&acc)[2][2][4][2], const Unit& u, int wr, int wc, int fr, int fq) const {
        const int row0 = u.pm * BM + wr * 64 + fr; const int pn = (u.pn >= glu_from) ? u.pn - glu_from + 9 : u.pn + pn_off;
        if (pn < 2 || (pn >= 6 && pn < 8)) {
            bf16* base = (pn < 2) ? Q : QI;
            const float sc = ((pn < 2) ? QSCALE : 1.0f) * dsc;
            const int col0 = (pn & 1) * 256 + wc * 32 + 8 * fq;
#pragma unroll
            for (int ai = 0; ai < 2; ++ai)
#pragma unroll
                for (int m = 0; m < 4; ++m) { bf16* rowp = base + (size_t)(row0 + ai * HALF + m * 16) * AW + col0;
#pragma unroll
                    for (int bj = 0; bj < 2; ++bj) *(u32x4*)(rowp + bj * HALF) = pack8(acc[ai][bj][m][0] * sc, acc[ai][bj][m][1] * sc); }
        } else if (pn < 6) {
            const bool isK = pn < 4; bf16* base = isK ? Kb : V;
#pragma unroll
            for (int ai = 0; ai < 2; ++ai)
#pragma unroll
                for (int m = 0; m < 4; ++m) { const int row = row0 + ai * HALF + m * 16, bb = row >> 12, t = row & 4095, tile = t >> 6, r = t & 63;
#pragma unroll
                    for (int bj = 0; bj < 2; ++bj) { const int col = (pn & 1) * 256 + bj * HALF + wc * 32 + 8 * fq, h = col >> 6, d = col & 63;
                        const size_t tb = ((size_t)((bb * NH + h) * 64 + tile)) * 4096;
                        const size_t off = isK ? tb + (d >> 3) * 512 + r * 8 : tb + (d >> 5) * 2048 + r * 32 + (d & 31);
                        *(u32x4*)(base + off) = pack8(acc[ai][bj][m][0] * dsc, acc[ai][bj][m][1] * dsc); } }
        } else if (pn == 8) {
#pragma unroll
            for (int ai = 0; ai < 2; ++ai)
#pragma unroll
                for (int m = 0; m < 4; ++m) { const size_t row = (size_t)(row0 + ai * HALF + m * 16);
                    if (wc < 2) { const int c8 = wc * 4 + fq;
                        *(u32x4*)(KI + (row >> 5) * 2048 + (c8 >> 1) * 512 + (c8 & 1) * 256 + (row & 31) * 8) = pack8(acc[ai][0][m][0] * dsc, acc[ai][0][m][1] * dsc); }
                    else if (wc == 2 && fq == 0) { *(f32x4*)(WI + row * 8) = acc[ai][0][m][0] * dsc; *(f32x4*)(WI + row * 8 + 4) = acc[ai][0][m][1] * dsc; } }
        } else {
            const int col0 = (pn - 9) * 128 + wc * 32 + 8 * fq;
#pragma unroll
            for (int ai = 0; ai < 2; ++ai)
#pragma unroll
                for (int m = 0; m < 4; ++m) { f32x4 o[2];
#pragma unroll
                    for (int n = 0; n < 2; ++n) { const f32x4 a = acc[ai][0][m][n], g = acc[ai][1][m][n];
#pragma unroll
                        for (int e = 0; e < 4; ++e) o[n][e] = a[e] * dsc * fsigmoid(g[e] * dsc); }
                    *(u32x4*)(U + (size_t)(row0 + ai * HALF + m * 16) * CCH + col0) = pack8(o[0], o[1]); }
        }
    }
};
struct EpiRes {
    static constexpr bool PERM = true;
    const bf16* base; bf16* out; float asc;
    __device__ __forceinline__ void operator()(const f32x4 (&acc)[2][2][4][2], const Unit& u, int wr, int wc, int fr, int fq) const {
        const int row0 = u.pm * BM + wr * 64 + fr, col0 = u.pn * BM + wc * 32 + 8 * fq;
#pragma unroll
        for (int ai = 0; ai < 2; ++ai) {
            u32x4 bsv[4][2];
#pragma unroll
            for (int m = 0; m < 4; ++m)
#pragma unroll
                for (int bj = 0; bj < 2; ++bj) bsv[m][bj] = __builtin_nontemporal_load((const u32x4*)(base + (size_t)(row0 + ai * HALF + m * 16) * DM + col0 + bj * HALF));
#pragma unroll
            for (int m = 0; m < 4; ++m) { const size_t off = (size_t)(row0 + ai * HALF + m * 16) * DM + col0;
#pragma unroll
                for (int bj = 0; bj < 2; ++bj) { const u32x4 bs = bsv[m][bj];
                    f32x4 b0, b1; b0[0] = __uint_as_float(bs.x << 16); b0[1] = __uint_as_float(bs.x & 0xffff0000u); b0[2] = __uint_as_float(bs.y << 16); b0[3] = __uint_as_float(bs.y & 0xffff0000u);
                    b1[0] = __uint_as_float(bs.z << 16); b1[1] = __uint_as_float(bs.z & 0xffff0000u); b1[2] = __uint_as_float(bs.w << 16); b1[3] = __uint_as_float(bs.w & 0xffff0000u);
                    *(u32x4*)(out + off + bj * HALF) = pack8(b0 * DN_ALPHA + acc[ai][bj][m][0] * asc, b1 * DN_ALPHA + acc[ai][bj][m][1] * asc); } }
        }
    }
};
struct EpiSwi {
    static constexpr bool PERM = true;
    unsigned char* H; int ldh;
    __device__ __forceinline__ void operator()(const f32x4 (&acc)[2][2][4][2], const Unit& u, int wr, int wc, int fr, int fq) const {
        const int row0 = u.pm * BM + wr * 64 + fr, col0 = u.pn * 128 + wc * 32 + 8 * fq;
        constexpr float ds = 1.0f / (F8_ASC * F8_WGU);
#pragma unroll
        for (int ai = 0; ai < 2; ++ai)
#pragma unroll
            for (int m = 0; m < 4; ++m) { f32x4 o[2];
#pragma unroll
                for (int n = 0; n < 2; ++n) { const f32x4 ga = acc[ai][0][m][n], ua = acc[ai][1][m][n];
#pragma unroll
                    for (int e = 0; e < 4; ++e) o[n][e] = (ga[e] * ua[e]) * ((ds * ds * F8_HSC) * __builtin_amdgcn_rcpf(1.0f + __builtin_amdgcn_exp2f(ga[e] * (-ds * LOG2E)))); }
                *(u32x2*)(H + (size_t)(row0 + ai * HALF + m * 16) * ldh + col0) = pack8_fp8(o[0], o[1]); }
    }
};
struct EpiMoeDown {
    static constexpr bool PERM = true;
    bf16* Yd; const float* rowgate; int tlo;
    __device__ __forceinline__ void operator()(const f32x4 (&acc)[2][2][4][2], const Unit& u, int wr, int wc, int fr, int fq) const {
        const int row0 = (tlo + u.pm) * BM + wr * 64 + fr, col0 = u.pn * BM + wc * 32 + 8 * fq;
#pragma unroll
        for (int ai = 0; ai < 2; ++ai)
#pragma unroll
            for (int m = 0; m < 4; ++m) { const int row = row0 + ai * HALF + m * 16; const float gt = rowgate[row] * (1.0f / (F8_HSC * F8_WDN)); bf16* rowp = Yd + (size_t)row * DM + col0;
#pragma unroll
                for (int bj = 0; bj < 2; ++bj) *(u32x4*)(rowp + bj * HALF) = pack8(acc[ai][bj][m][0] * gt, acc[ai][bj][m][1] * gt); }
    }
};
struct MoeGuOrder : OrderBase {
    static constexpr bool GATHER = true;
    const int* rowlist; const LAS int* texp; int tlo; const char* W; size_t estride;
    __device__ __forceinline__ size_t a_base(const Unit&) const { return 0; }
    __device__ __forceinline__ unsigned a_off(const Unit& u, int r) const { return (unsigned)rowlist[(tlo + u.pm) * BM + r] * (unsigned)DM; }
    __device__ __forceinline__ const char* b_base(const Unit& u) const { return W + (size_t)texp[tlo + u.pm] * estride + (size_t)u.pn * ((size_t)BM * DM); }
};
struct MoeDnOrder : OrderBase {
    static constexpr bool GATHER = true;
    const LAS int* texp; int tlo; const char* W; size_t estride;
    __device__ __forceinline__ size_t a_base(const Unit&) const { return 0; }
    __device__ __forceinline__ unsigned a_off(const Unit& u, int r) const { return (unsigned)(u.pm * BM + r) * (unsigned)DFE; }
    __device__ __forceinline__ const char* b_base(const Unit& u) const { return W + (size_t)texp[tlo + u.pm] * estride + (size_t)u.pn * ((size_t)BM * DFE); }
};
}

typedef GAS unsigned gu32;
#define RLX_AGENT __ATOMIC_RELAXED, __HIP_MEMORY_SCOPE_AGENT
#define XB_TMO      128
#define XB_XCNT(j)  (256  + 64 * (j))
#define XB_XSUB(j)  (1280 + 64 * (j))
#define XB_XGEN(j)  (2304 + 64 * (j))
#define XB_TOP      3328
#define XB_TOPGEN   3392
#define XCD_BAR_WORDS 3456
#define XB_SPIN_CAP (1u << 18)

__device__ __forceinline__ unsigned xb_ld(unsigned* p)              { return __hip_atomic_load(p, __ATOMIC_RELAXED, __HIP_MEMORY_SCOPE_AGENT); }
__device__ __forceinline__ unsigned xb_add(unsigned* p, unsigned v) { return __hip_atomic_fetch_add(p, v, __ATOMIC_RELAXED, __HIP_MEMORY_SCOPE_AGENT); }
__device__ __forceinline__ unsigned xb_xcc_id() { return (unsigned)__builtin_amdgcn_s_getreg((3 << 11) | 20) & 0xFu; }
#define XB_SPIN(cond, bar) do { unsigned _sp = 0; while (cond) { __builtin_amdgcn_s_sleep(1); \
    if ((++_sp & 255u) == 0u) { if (xb_ld(&(bar)[XB_TMO])) break; if (_sp > XB_SPIN_CAP) { atomicAdd(&(bar)[XB_TMO], 1u); break; } } } } while (0)

struct XcdBarrier {
    unsigned* bar; unsigned x;
    volatile LAS unsigned* st;
};
__device__ __forceinline__ XcdBarrier xcd_barrier_post(unsigned* bar, volatile LAS unsigned* st) {
    XcdBarrier b; b.bar = bar; b.x = xb_xcc_id(); b.st = st;
    if (threadIdx.x == 0) (void)xb_add(&bar[XB_XCNT(b.x)], 1u);
    return b;
}
__device__ __forceinline__ void xcd_barrier_complete(unsigned* bar, unsigned x, unsigned& nloc, unsigned& nx) {
    const unsigned G = gridDim.x * gridDim.y * gridDim.z;
    unsigned sum, cnt, mine, sp = 0u;
    for (;;) {
        sum = 0u; cnt = 0u; mine = 0u;
#pragma unroll
        for (unsigned j = 0; j < 16; ++j) { const unsigned c = xb_ld(&bar[XB_XCNT(j)]); sum += c; cnt += (c > 0u) ? 1u : 0u; mine = (j == x) ? c : mine; }
        if (sum == G) break;
        __builtin_amdgcn_s_sleep(1);
        if ((++sp & 255u) == 0u) { if (xb_ld(&bar[XB_TMO])) break; if (sp > XB_SPIN_CAP) { atomicAdd(&bar[XB_TMO], 1u); break; } }
    }
    nloc = mine > 0u ? mine : 1u; nx = cnt > 0u ? cnt : 1u;
}
__device__ __forceinline__ void xcd_barrier(const XcdBarrier& b) {
    asm volatile("s_waitcnt vmcnt(0)" ::: "memory");
    __syncthreads();
    if (threadIdx.x == 0) {
        unsigned* bar = b.bar;
        __builtin_amdgcn_s_waitcnt(0);
        unsigned nloc = b.st[0], nx = b.st[1];
        if (nloc == 0u) { xcd_barrier_complete(bar, b.x, nloc, nx); b.st[0] = nloc; b.st[1] = nx; }
        const unsigned old = xb_add(&bar[XB_XSUB(b.x)], 1u);
        const unsigned gen = old / nloc;
        if (old + 1u == (gen + 1u) * nloc) {
            __builtin_amdgcn_fence(__ATOMIC_RELEASE, "agent");
            asm volatile("s_waitcnt vmcnt(0)" ::: "memory");
            const unsigned og = xb_add(&bar[XB_TOP], 1u);
            const unsigned tg = og / nx;
            if (og + 1u == (tg + 1u) * nx) xb_add(&bar[XB_TOPGEN], 1u);
            else XB_SPIN(xb_ld(&bar[XB_TOPGEN]) == tg, bar);
            __builtin_amdgcn_fence(__ATOMIC_ACQUIRE, "agent");
            xb_add(&bar[XB_XGEN(b.x)], 1u);
            asm volatile("s_waitcnt vmcnt(0)" ::: "memory");
        } else {
            XB_SPIN(xb_ld(&bar[XB_XGEN(b.x)]) == gen, bar);
            __builtin_amdgcn_fence(__ATOMIC_ACQUIRE, "agent");
            asm volatile("s_waitcnt vmcnt(0)" ::: "memory");
        }
    }
    __syncthreads();
}

struct Frame {
    LAS unsigned char* lds;
    int tid, lane, wave, vcu, G;
    unsigned char* ws;
};
__device__ __forceinline__ const float* arg_in(int k) { return (const float*)*(const GAS float* const volatile CAS*)((const CAS char*)__builtin_amdgcn_kernarg_segment_ptr() + 8 * k); }
__device__ __forceinline__ float* arg_out() { return (float*)*(GAS float* const volatile CAS*)((const CAS char*)__builtin_amdgcn_kernarg_segment_ptr() + 160); }
#define WSP(T, off) ((T*)(F.ws + (off)))
__device__ __forceinline__ Frame fresh(const Frame& F0) {
    Frame F = F0; int wv = F0.wave, v = F0.vcu, g = F0.G; asm volatile("" : "+s"(wv), "+s"(v), "+s"(g)); F.wave = wv; F.vcu = v; F.G = g;
    int ln; asm volatile("v_mbcnt_lo_u32_b32 %0, -1, 0\n\tv_mbcnt_hi_u32_b32 %0, -1, %0" : "=v"(ln)); F.lane = ln; F.tid = wv * 64 + ln;
    GAS unsigned char* w = (GAS unsigned char*)F0.ws; asm volatile("" : "+s"(w)); F.ws = (unsigned char*)w;
    return F;
}

__device__ __forceinline__ float wave_sum(float v) {
#define WS_DPP(x, ctrl) __int_as_float(__builtin_amdgcn_update_dpp(0, __float_as_int(x), (ctrl), 0xf, 0xf, false))
    v += WS_DPP(v, 0xB1); v += WS_DPP(v, 0x4E); v += WS_DPP(v, 0x141); v += WS_DPP(v, 0x140);
#undef WS_DPP
    const float r0 = __int_as_float(__builtin_amdgcn_readlane(__float_as_int(v), 0)), r1 = __int_as_float(__builtin_amdgcn_readlane(__float_as_int(v), 16)),
                r2 = __int_as_float(__builtin_amdgcn_readlane(__float_as_int(v), 32)), r3 = __int_as_float(__builtin_amdgcn_readlane(__float_as_int(v), 48));
    return (r0 + r1) + (r2 + r3);
}

struct TrItem { const float* W; int ldw, c0, nv, k0; void* WT; int Kd, r0; float scale; bool fp8; };
__device__ __forceinline__ void tr_load(const TrItem& t, f32x4 (&v)[16], int lane) {
    const int n4 = 4 * (lane & 15); const int nc = n4 < t.nv ? n4 : 0;
    const float* src = t.W + (size_t)(t.k0 + (lane >> 4)) * t.ldw + t.c0 + nc;
#pragma unroll
    for (int i = 0; i < 16; ++i) v[i] = *(const f32x4*)(src + (size_t)(4 * i) * t.ldw);
}
__device__ __forceinline__ void tr_to_lds(const TrItem& t, const f32x4 (&v)[16], LAS float* scr, int lane) {
    const int n4 = 4 * (lane & 15); const float ok = n4 < t.nv ? 1.f : 0.f;
#pragma unroll
    for (int i = 0; i < 16; ++i) { LAS float* d = scr + (4 * i + (lane >> 4)) * 65 + n4; d[0] = v[i][0] * ok; d[1] = v[i][1] * ok; d[2] = v[i][2] * ok; d[3] = v[i][3] * ok; }
}
__device__ __forceinline__ void tr_from_lds(const TrItem& t, LAS float* scr, int lane) {
    LDS_WAIT(); asm volatile("" ::: "memory");
    const int c = lane & 7; const float scale = t.scale;
    if (t.fp8) {
#pragma unroll
        for (int j = 0; j < 8; ++j) { const int nn = (lane >> 3) + 8 * j; const LAS float* s = scr + (8 * c) * 65 + nn;
            u32x2 o; o.x = pg8::pk4_fp8(s[0 * 65] * scale, s[1 * 65] * scale, s[2 * 65] * scale, s[3 * 65] * scale); o.y = pg8::pk4_fp8(s[4 * 65] * scale, s[5 * 65] * scale, s[6 * 65] * scale, s[7 * 65] * scale);
            *(u32x2*)((unsigned char*)t.WT + (size_t)(t.r0 + nn) * t.Kd + t.k0 + 8 * c) = o; }
    } else {
#pragma unroll
        for (int j = 0; j < 8; ++j) { const int nn = (lane >> 3) + 8 * j; const LAS float* s = scr + (8 * c) * 65 + nn;
            u32x4 o; o.x = cvt_pk_bf16(s[0 * 65], s[1 * 65]); o.y = cvt_pk_bf16(s[2 * 65], s[3 * 65]); o.z = cvt_pk_bf16(s[4 * 65], s[5 * 65]); o.w = cvt_pk_bf16(s[6 * 65], s[7 * 65]);
            *(u32x4*)((bf16*)t.WT + (size_t)(t.r0 + nn) * t.Kd + t.k0 + 8 * c) = o; }
    }
    LDS_WAIT(); asm volatile("" ::: "memory");
}
template <class Dec> __device__ __forceinline__ void tr_loop(const Dec& dec, int nitems, int gw, int NGW, LAS float* scr, int lane) {
    int it = gw; if (it >= nitems) return;
    TrItem cur = dec(it); f32x4 v[16]; tr_load(cur, v, lane);
    for (;;) {
        tr_to_lds(cur, v, scr, lane);
        const int nx = it + NGW; const bool hn = nx < nitems;
        const TrItem nxt = dec(hn ? nx : it);
        tr_load(nxt, v, lane);
        tr_from_lds(cur, scr, lane);
        if (!hn) break;
        cur = nxt; it = nx;
    }
}

__device__ __forceinline__ void convert_weights(Frame& F, int l) {
    LAS float* scr = (LAS float*)(F.lds + RING_OFF + F.wave * 16640);
    const int gw = F.vcu * NWAVES + F.wave, NGW = F.G * NWAVES, lane = F.lane;
    bf16* WinT = WSP(bf16, WS_WIN); bf16* WoutT = WSP(bf16, WS_WOUT); unsigned char* Wff = WSP(unsigned char, WS_WFF);
    const float* w_in = arg_in(1) + (size_t)l * DM * IN_COLS;
    const float* w_out = arg_in(8) + (size_t)l * DM * DM;
    constexpr int I_IN = (NIN / 64) * 16, I_OUT = 16 * 16;
    tr_loop([=](int it) __attribute__((always_inline)) -> TrItem {
        if (it < I_IN) {
            const int nb = it >> 4, kb = it & 15; int c0 = 0, nv = 64;
            if (nb < 33) c0 = 64 * nb;
            else if (nb == 33) { c0 = OFF_WI; nv = 8; }
            else if (nb < 36) { nv = 0; }
            else { const int rr = 64 * (nb - 36), p = rr >> 8, w = rr & 255; c0 = (w < 128) ? (OFF_GLU + 128 * p + w) : (OFF_GLU + CCH + 128 * p + (w - 128)); }
            if (nb < 24) return TrItem{w_in, IN_COLS, c0, nv, 64 * kb, WinT, DM, 64 * nb, pg8::F8_WGU, true};
            if (nb >= 36) return TrItem{w_in, IN_COLS, c0, nv, 64 * kb, WinT, DM, 64 * (nb - 12), pg8::F8_WGU, true};
            return TrItem{w_in, IN_COLS, c0, nv, 64 * kb, WinT, DM, 64 * nb, 1.f, false};
        }
        const int r = it - I_IN, nb = r >> 4, kb = r & 15; return TrItem{w_out, DM, 64 * nb, 64, 64 * kb, WoutT, DM, 64 * nb, 1.f, false};
    }, I_IN + I_OUT, gw, NGW, scr, lane);
    if ((l & 1) == 0) {
        const int d = l >> 1;
        const float* wg = arg_in(13) + (size_t)d * DM * DFF; const float* wu = arg_in(14) + (size_t)d * DM * DFF; const float* wd = arg_in(15) + (size_t)d * DFF * DM;
        unsigned char* Wgu = Wff; unsigned char* Wdn = Wgu + (size_t)2 * DFF * DM;
        constexpr int I_GU = (2 * DFF / 64) * 16, I_DN = 16 * (DFF / 64);
        const ptrdiff_t dgu = wu - wg;
        tr_loop([=](int it) __attribute__((always_inline)) -> TrItem {
            if (it < I_GU) { const int nb = it >> 4, kb = it & 15, rr = 64 * nb, p = rr >> 8, w = rr & 255;
                return TrItem{wg + ((w < 128) ? (ptrdiff_t)0 : dgu), DFF, 128 * p + (w & 127), 64, 64 * kb, Wgu, DM, rr, pg8::F8_WGU, true}; }
            const int r = it - I_GU, nb = r / (DFF / 64), kb = r % (DFF / 64); return TrItem{wd, DM, 64 * nb, 64, 64 * kb, Wdn, DFF, 64 * nb, pg8::F8_WDN, true};
        }, I_GU + I_DN, gw, NGW, scr, lane);
    } else {
        const int d = l >> 1;
        constexpr int I_GU = (2 * DFE / 64) * 16, I_DN = 16 * (DFE / 64), I_E = I_GU + I_DN;
        const float* wg0 = arg_in(17) + (size_t)d * NE * DM * DFE; const float* wu0 = arg_in(18) + (size_t)d * NE * DM * DFE; const float* wd0 = arg_in(19) + (size_t)d * NE * DFE * DM;
        const ptrdiff_t dgu = wu0 - wg0;
        tr_loop([=](int it) __attribute__((always_inline)) -> TrItem {
            const int e = it / I_E, r0 = it % I_E;
            const float* wg = wg0 + (size_t)e * DM * DFE; const float* wd = wd0 + (size_t)e * DFE * DM;
            unsigned char* Wgu = Wff + (size_t)e * (3 * (size_t)DFE * DM); unsigned char* Wdn = Wgu + (size_t)2 * DFE * DM;
            if (r0 < I_GU) { const int nb = r0 >> 4, kb = r0 & 15, rr = 64 * nb, p = rr >> 8, w = rr & 255;
                return TrItem{wg + ((w < 128) ? (ptrdiff_t)0 : dgu), DFE, 128 * p + (w & 127), 64, 64 * kb, Wgu, DM, rr, pg8::F8_WGU, true}; }
            const int r = r0 - I_GU, nb = r / (DFE / 64), kb = r % (DFE / 64); return TrItem{wd, DM, 64 * nb, 64, 64 * kb, Wdn, DFE, 64 * nb, pg8::F8_WDN, true};
        }, NE * I_E, gw, NGW, scr, lane);
    }
}

__device__ __forceinline__ void cvt_x(Frame& F) {
    const float* x = arg_in(0); bf16* XB = WSP(bf16, WS_XB); unsigned char* XQ = WSP(unsigned char, WS_XQ);
    const int gw = F.vcu * NWAVES + F.wave, NGW = F.G * NWAVES;
    for (int m = gw; m < M; m += NGW) {
        const f32x4* xr = (const f32x4*)(x + (size_t)m * DM) + F.lane; u32x2* o = (u32x2*)(XB + (size_t)m * DM) + F.lane; unsigned* o8 = (unsigned*)(XQ + (size_t)m * DM) + F.lane;
#pragma unroll
        for (int j = 0; j < 4; ++j) { const f32x4 v = xr[64 * j]; u32x2 w; w.x = cvt_pk_bf16(v[0], v[1]); w.y = cvt_pk_bf16(v[2], v[3]); o[64 * j] = w;
            o8[64 * j] = pg8::pk4_fp8(v[0] * pg8::F8_ASC, v[1] * pg8::F8_ASC, v[2] * pg8::F8_ASC, v[3] * pg8::F8_ASC); }
    }
}

__device__ __forceinline__ void ln_load(const bf16* row, f32x4 (&v)[4], int lane) {
#pragma unroll
    for (int j = 0; j < 4; ++j) { const u32x2 a = ((const u32x2*)row)[lane + 64 * j]; v[j][0] = __uint_as_float(a.x << 16); v[j][1] = __uint_as_float(a.x & 0xffff0000u); v[j][2] = __uint_as_float(a.y << 16); v[j][3] = __uint_as_float(a.y & 0xffff0000u); }
}
template <bool FP8OUT> __device__ __forceinline__ void ln_finish(f32x4 (&v)[4], const f32x4 (&g)[4], const f32x4 (&bb)[4], bf16* brow, unsigned char* qrow, float* frow, int lane) {
    float s = 0.f;
#pragma unroll
    for (int j = 0; j < 4; ++j) s += (v[j][0] + v[j][1]) + (v[j][2] + v[j][3]);
    const float mean = wave_sum(s) * (1.f / DM); float s2 = 0.f;
#pragma unroll
    for (int j = 0; j < 4; ++j) { v[j] = v[j] - mean; s2 += (v[j][0] * v[j][0] + v[j][1] * v[j][1]) + (v[j][2] * v[j][2] + v[j][3] * v[j][3]); }
    const float rstd = 1.f / sqrtf(wave_sum(s2) * (1.f / DM) + LN_EPS);
#pragma unroll
    for (int j = 0; j < 4; ++j) { v[j] = v[j] * rstd * g[j] + bb[j];
        { u32x2 w; w.x = cvt_pk_bf16(v[j][0], v[j][1]); w.y = cvt_pk_bf16(v[j][2], v[j][3]); ((u32x2*)brow)[lane + 64 * j] = w; }
        if constexpr (FP8OUT) { ((unsigned*)qrow)[lane + 64 * j] = pg8::pk4_fp8(v[j][0] * pg8::F8_ASC, v[j][1] * pg8::F8_ASC, v[j][2] * pg8::F8_ASC, v[j][3] * pg8::F8_ASC); }
        else { if (frow) ((f32x4*)frow)[lane + 64 * j] = v[j];
               if (qrow) ((unsigned*)qrow)[lane + 64 * j] = pg8::pk4_fp8(v[j][0] * pg8::F8_ASC, v[j][1] * pg8::F8_ASC, v[j][2] * pg8::F8_ASC, v[j][3] * pg8::F8_ASC); } }
}

__device__ __forceinline__ void p_ln1(Frame& F, int l) {
    bf16* R1 = WSP(bf16, WS_R1); bf16* XB = WSP(bf16, WS_XB);
    const bool moe = (l & 1) != 0;
    LAS int* cntL = (LAS int*)(F.lds + LDSCTL_OFF + 1152);
    if (F.tid < 8) cntL[F.tid] = 0;
    __syncthreads();
    f32x4 g[4], bb[4];
#pragma unroll
    for (int j = 0; j < 4; ++j) { g[j] = ((const f32x4*)(arg_in(9) + (size_t)l * DM))[F.lane + 64 * j]; bb[j] = ((const f32x4*)(arg_in(10) + (size_t)l * DM))[F.lane + 64 * j]; }
    const float* router = arg_in(16) + (size_t)(l >> 1) * DM * NE;
    u32x4* route = WSP(u32x4, WS_ROUTE);
    f32x4 vn[4]; ln_load(R1 + (size_t)(F.vcu * 128 + F.wave * 16) * DM, vn, F.lane);
    for (int i = 0; i < 16; ++i) {
        const int m = F.vcu * 128 + F.wave * 16 + i;
        f32x4 v[4];
#pragma unroll
        for (int j = 0; j < 4; ++j) v[j] = vn[j];
        if (i + 1 < 16) ln_load(R1 + (size_t)(m + 1) * DM, vn, F.lane);
        ln_finish<true>(v, g, bb, R1 + (size_t)m * DM, (unsigned char*)XB + (size_t)m * DM, nullptr, F.lane);
        if (moe) {
            float lg[8];
#pragma unroll
            for (int e = 0; e < 8; ++e) lg[e] = 0.f;
#pragma unroll
            for (int j = 0; j < 4; ++j)
#pragma unroll
                for (int c = 0; c < 4; ++c) { const float* rp = router + (size_t)(4 * F.lane + 256 * j + c) * NE; const f32x4 r0 = *(const f32x4*)rp, r1 = *(const f32x4*)(rp + 4); const float xv = v[j][c];
                    lg[0] += xv * r0[0]; lg[1] += xv * r0[1]; lg[2] += xv * r0[2]; lg[3] += xv * r0[3]; lg[4] += xv * r1[0]; lg[5] += xv * r1[1]; lg[6] += xv * r1[2]; lg[7] += xv * r1[3]; }
#pragma unroll
            for (int e = 0; e < 8; ++e) lg[e] = wave_sum(lg[e]);
            int e1 = 0; float v1 = lg[0];
#pragma unroll
            for (int e = 1; e < 8; ++e) if (lg[e] > v1) { v1 = lg[e]; e1 = e; }
            int e2 = -1; float v2 = -3.0e38f;
#pragma unroll
            for (int e = 0; e < 8; ++e) if (e != e1 && (e2 < 0 || lg[e] > v2)) { v2 = lg[e]; e2 = e; }
            const float g1 = 1.0f / (1.0f + __expf(v2 - v1)), g2 = 1.0f - g1;
            if (F.lane == 0) { u32x4 r; r.x = (unsigned)e1; r.y = (unsigned)e2; r.z = __float_as_uint(g1); r.w = __float_as_uint(g2); route[m] = r;
                __hip_atomic_fetch_add(cntL + e1, 1, __ATOMIC_RELAXED, __HIP_MEMORY_SCOPE_WORKGROUP); __hip_atomic_fetch_add(cntL + e2, 1, __ATOMIC_RELAXED, __HIP_MEMORY_SCOPE_WORKGROUP); }
        }
    }
    __syncthreads();
    if (moe && F.tid < 8) WSP(int, WS_CNTWG)[F.vcu * 8 + F.tid] = cntL[F.tid];
}

__device__ __forceinline__ void p_ln2(Frame& F, int l) {
    const bf16* R1 = WSP(bf16, WS_R1); bf16* XB = WSP(bf16, WS_XB); float* outp = (l == DEPTH - 1) ? arg_out() : nullptr;
    f32x4 g[4], bb[4];
#pragma unroll
    for (int j = 0; j < 4; ++j) { g[j] = ((const f32x4*)(arg_in(11) + (size_t)l * DM))[F.lane + 64 * j]; bb[j] = ((const f32x4*)(arg_in(12) + (size_t)l * DM))[F.lane + 64 * j]; }
    f32x4 vn[4]; ln_load(R1 + (size_t)(F.vcu * 128 + F.wave * 16) * DM, vn, F.lane);
    for (int i = 0; i < 16; ++i) {
        const int m = F.vcu * 128 + F.wave * 16 + i;
        f32x4 v[4];
#pragma unroll
        for (int j = 0; j < 4; ++j) v[j] = vn[j];
        if (i + 1 < 16) ln_load(R1 + (size_t)(m + 1) * DM, vn, F.lane);
        ln_finish<false>(v, g, bb, XB + (size_t)m * DM, WSP(unsigned char, WS_XQ) + (size_t)m * DM, outp ? outp + (size_t)m * DM : nullptr, F.lane);
    }
}

__device__ __forceinline__ void moe_tables(Frame& F) {
    LAS int* texp = (LAS int*)(F.lds + LDSCTL_OFF);
    LAS int* tot = (LAS int*)(F.lds + LDSCTL_OFF + 1088);
    LAS int* tbase = (LAS int*)(F.lds + LDSCTL_OFF + 1200);
    const int* cnt = WSP(int, WS_CNTWG);
    LAS int* tmp = (LAS int*)(F.lds + AUX_OFF);
    __syncthreads();
    if (F.tid < 256) { typedef int i32x4_ __attribute__((ext_vector_type(4))); const i32x4_ a = ((const i32x4_*)cnt)[2 * F.tid], b = ((const i32x4_*)cnt)[2 * F.tid + 1];
        *(LAS i32x4_*)(tmp + 8 * F.tid) = a; *(LAS i32x4_*)(tmp + 8 * F.tid + 4) = b; }
    __syncthreads();
    if (F.tid < 8) { int t = 0, off = 0; for (int w = 0; w < 256; ++w) { const int c = tmp[w * 8 + F.tid]; if (w < F.vcu) off += c; t += c; } tot[F.tid] = t; tot[8 + F.tid] = off; }
    __syncthreads();
    if (F.tid == 0) { int b = 0; for (int e = 0; e < 8; ++e) { tbase[e] = b; b += (tot[e] + 255) >> 8; } tbase[8] = b; }
    __syncthreads();
    if (F.tid < MAXT) { int e = 0;
#pragma unroll
        for (int j = 1; j < 8; ++j) e += (F.tid >= tbase[j]) ? 1 : 0;
        texp[F.tid] = e; }
    __syncthreads();
}

__device__ __forceinline__ void p_list(Frame& F) {
    moe_tables(F);
    LAS int* tot = (LAS int*)(F.lds + LDSCTL_OFF + 1088); LAS int* tbase = (LAS int*)(F.lds + LDSCTL_OFF + 1200);
    const u32x4* route = WSP(u32x4, WS_ROUTE);
    int* rowlist = WSP(int, WS_ROWLIST); float* rowgate = WSP(float, WS_ROWGATE); int* slotrow = WSP(int, WS_SLOTROW);
    if (F.wave == 0) {
        int run[8];
#pragma unroll
        for (int e = 0; e < 8; ++e) run[e] = tot[8 + e];
        for (int blk = 0; blk < 2; ++blk) {
            const int t = F.vcu * 128 + blk * 64 + F.lane; const u32x4 r = route[t]; const int e1 = (int)r.x, e2 = (int)r.y;
            int p1 = 0, p2 = 0;
            const unsigned long long lt = (1ull << F.lane) - 1ull;
#pragma unroll
            for (int e = 0; e < 8; ++e) { const unsigned long long mk = __ballot(e1 == e || e2 == e); const int rk = run[e] + __popcll(mk & lt); if (e1 == e) p1 = rk; if (e2 == e) p2 = rk; run[e] += __popcll(mk); }
            const int row1 = tbase[e1] * 256 + p1, row2 = tbase[e2] * 256 + p2;
            rowlist[row1] = t; rowgate[row1] = __uint_as_float(r.z); rowlist[row2] = t; rowgate[row2] = __uint_as_float(r.w);
            slotrow[2 * t] = row1; slotrow[2 * t + 1] = row2;
        }
    }
    if (F.vcu < 8) { const int e = F.vcu, mt = (tot[e] + 255) >> 8; for (int p = tot[e] + F.tid; p < mt * 256; p += NTHR) { rowlist[tbase[e] * 256 + p] = 0; rowgate[tbase[e] * 256 + p] = 0.f; } }
}

__device__ __forceinline__ void p_comb(Frame& F, int l) {
    const bf16* R1 = WSP(bf16, WS_R1); bf16* XB = WSP(bf16, WS_XB); const bf16* Yd = WSP(bf16, WS_YD); const int* slotrow = WSP(int, WS_SLOTROW); float* outp = (l == DEPTH - 1) ? arg_out() : nullptr;
    f32x4 g[4], bb[4];
#pragma unroll
    for (int j = 0; j < 4; ++j) { g[j] = ((const f32x4*)(arg_in(11) + (size_t)l * DM))[F.lane + 64 * j]; bb[j] = ((const f32x4*)(arg_in(12) + (size_t)l * DM))[F.lane + 64 * j]; }
    const int m0 = F.vcu * 128 + F.wave * 16;
    const int myslot = (F.lane < 32) ? slotrow[2 * m0 + F.lane] : 0;
    f32x4 xn[4], an[4], bn[4];
#define COMB_LOAD(i_) do { const int ra_ = __builtin_amdgcn_readlane(myslot, 2 * (i_)), rb_ = __builtin_amdgcn_readlane(myslot, 2 * (i_) + 1); \
        ln_load(R1 + (size_t)(m0 + (i_)) * DM, xn, F.lane); ln_load(Yd + (size_t)ra_ * DM, an, F.lane); ln_load(Yd + (size_t)rb_ * DM, bn, F.lane); } while (0)
    COMB_LOAD(0);
    for (int i = 0; i < 16; ++i) {
        const int m = m0 + i;
        f32x4 v[4];
#pragma unroll
        for (int j = 0; j < 4; ++j) v[j] = xn[j] * DN_ALPHA + (an[j] + bn[j]);
        if (i + 1 < 16) COMB_LOAD(i + 1);
        ln_finish<false>(v, g, bb, XB + (size_t)m * DM, WSP(unsigned char, WS_XQ) + (size_t)m * DM, outp ? outp + (size_t)m * DM : nullptr, F.lane);
    }
#undef COMB_LOAD
}

#define DPP_I(v, ctrl) __builtin_amdgcn_update_dpp(0, (v), (ctrl), 0xf, 0xf, false)
__device__ __forceinline__ int wave_isum(int v) {
    v += DPP_I(v, 0xB1); v += DPP_I(v, 0x4E); v += DPP_I(v, 0x141); v += DPP_I(v, 0x140);
    return __builtin_amdgcn_readlane(v, 0) + __builtin_amdgcn_readlane(v, 16) + __builtin_amdgcn_readlane(v, 32) + __builtin_amdgcn_readlane(v, 48);
}
#define DPP_F(v, ctrl) __int_as_float(__builtin_amdgcn_update_dpp(0, __float_as_int(v), (ctrl), 0xf, 0xf, false))
typedef unsigned short u16x2 __attribute__((__vector_size__(4)));
#define IDX_BAR() asm volatile("s_waitcnt lgkmcnt(0)\n\ts_barrier" ::: "memory")
__device__ __forceinline__ void p_idx(Frame& F, int l) {
    constexpr int QP = 16;
    LAS unsigned short* bins = (LAS unsigned short*)(F.lds + RING_OFF);
    LAS unsigned* hq = (LAS unsigned*)(F.lds + AUX_OFF);
    LAS unsigned* hist = (LAS unsigned*)(F.lds + AUX_OFF + 16384) + F.wave * 256;
    LAS int* ci = (LAS int*)(F.lds + AUX_OFF + 24576) + F.wave * 64;
    LAS float* wtab = (LAS float*)(F.lds + LDSCTL_OFF + 1280);
    LAS float* sqp = (LAS float*)(F.lds + LDSCTL_OFF + 1792);
    const bf16* QI = WSP(bf16, WS_QI); const bf16* KI = WSP(bf16, WS_KI); const float* WI = WSP(float, WS_WI);
    unsigned long long* maskQ = WSP(unsigned long long, WS_MASK);
    const int lane = F.lane, wave = F.wave, tid = F.tid, w = F.vcu;
    const int am = lane & 31, ahm = (am >> 2) & 1, arr = (am & 3) + 4 * (am >> 3), atl = 2 * ahm + (arr >> 3), ah = arr & 7, kg = lane >> 5, hi = lane >> 5, n = lane & 31;
    bf16x8 af[4][4]; float wreg = 0.f;
#define IDX_UNIT(s8_, qb32_, b_) do { const int ui_ = (s8_) >> 1; const int up_ = (ui_ == 0) ? w : (ui_ == 1) ? 511 - w : (ui_ == 2) ? 512 + w : 1023 - w; qb32_ = up_ >> 3; b_ = up_ & 7; } while (0)
#define IDX_LOADQ(s8_) do { int qb_, bb_; IDX_UNIT(s8_, qb_, bb_); const size_t r0_ = (size_t)bb_ * SEQ + qb_ * 32 + ((s8_) & 1) * QP; \
        _Pragma("unroll") for (int rt = 0; rt < 4; ++rt) _Pragma("unroll") for (int ks = 0; ks < 4; ++ks) af[rt][ks] = *(const bf16x8*)(QI + (r0_ + 4 * rt + atl) * AW + ah * 64 + ks * 16 + 8 * kg); \
        if (tid < 128) wreg = WI[(r0_ + (tid >> 3)) * 8 + (tid & 7)]; } while (0)
#define IDX_WTAB(par_) do { if (tid < 128) { wtab[tid] = wreg; float sm = wreg, sq2 = wreg * wreg; \
        sm += DPP_F(sm, 0xB1); sq2 += DPP_F(sq2, 0xB1); sm += DPP_F(sm, 0x4E); sq2 += DPP_F(sq2, 0x4E); sm += DPP_F(sm, 0x141); sq2 += DPP_F(sq2, 0x141); \
        if ((tid & 7) == 0) { const float a_ = 1.0f / (28.02f * sqrtf(sq2) + 1.0e-20f); sqp[32 * (par_) + 2 * (tid >> 3)] = a_; sqp[32 * (par_) + 2 * (tid >> 3) + 1] = 0.33333f - 3.19f * sm * a_; } } } while (0)
    IDX_LOADQ(0);
    IDX_WTAB(0);
    for (int i = tid; i < QP * 256; i += NTHR) hq[i] = 0u;
    IDX_BAR();
    for (int s8 = 0; s8 < 8; ++s8) {
        int qb32, b; IDX_UNIT(s8, qb32, b);
        const int sub = s8 & 1, c = qb32 >> 1, N = 64 * (c + 1), NT32 = 2 * (c + 1);
        const size_t rowb = (size_t)b * SEQ;
        const bool dosel = N > TOPK;
        for (int repA_ = 0; repA_ < (((PROBE_MASK) >> 12) & 1) + 1; ++repA_) {
            const int ntw = (NT32 - wave + 7) >> 3;
            constexpr int BT = 2; const int nbat = (ntw + BT - 1) / BT;
            bf16x8 b0[BT][4], b1[BT][4];
            const LAS float* sqc = sqp + 32 * (s8 & 1);
#define IDX_LOADB(dst, bb_) do { _Pragma("unroll") for (int u = 0; u < BT; ++u) { int j_ = wave + 8 * (BT * (bb_) + u); j_ = j_ < NT32 ? j_ : NT32 - 1; \
            _Pragma("unroll") for (int ks = 0; ks < 4; ++ks) dst[u][ks] = *(const bf16x8*)(KI + (rowb + 32 * j_) * 64 + ks * 512 + kg * 256 + n * 8); } } while (0)
#define IDX_RELU(x) __int_as_float(max(__float_as_int(x), 0))
#define IDX_COMP(src, bb_) do { _Pragma("unroll") for (int rp = 0; rp < 2; ++rp) { \
            f32x4 wq_[4][2];   \
            _Pragma("unroll") for (int rq = 0; rq < 4; ++rq) { const int qi_ = 4 * (2 * rp + (rq >> 1)) + 2 * hi + (rq & 1); const LAS f32x4* wp_ = (const LAS f32x4*)(wtab + qi_ * 8); wq_[rq][0] = wp_[0]; wq_[rq][1] = wp_[1]; } \
            _Pragma("unroll") for (int u = 0; u < BT; ++u) { const int j_ = wave + 8 * (BT * (bb_) + u); if (j_ < NT32) { f32x16 acc0 = {}, acc1 = {}; \
                _Pragma("unroll") for (int ks = 0; ks < 4; ++ks) { acc0 = __builtin_amdgcn_mfma_f32_32x32x16_bf16(af[2 * rp][ks], src[u][ks], acc0, 0, 0, 0); acc1 = __builtin_amdgcn_mfma_f32_32x32x16_bf16(af[2 * rp + 1][ks], src[u][ks], acc1, 0, 0, 0); } \
                _Pragma("unroll") for (int r2 = 0; r2 < 2; ++r2) { const int rt = 2 * rp + r2; const f32x16& ac_ = r2 ? acc1 : acc0; float t_[2]; \
                    _Pragma("unroll") for (int q = 0; q < 2; ++q) { const f32x4 w0_ = wq_[2 * r2 + q][0], w1_ = wq_[2 * r2 + q][1]; \
                        f32x2 s2_ = (f32x2){w0_[0], w0_[1]} * (f32x2){IDX_RELU(ac_[8 * q + 0]), IDX_RELU(ac_[8 * q + 1])}; \
                        s2_ = __builtin_elementwise_fma((f32x2){w0_[2], w0_[3]}, (f32x2){IDX_RELU(ac_[8 * q + 2]), IDX_RELU(ac_[8 * q + 3])}, s2_); \
                        s2_ = __builtin_elementwise_fma((f32x2){w1_[0], w1_[1]}, (f32x2){IDX_RELU(ac_[8 * q + 4]), IDX_RELU(ac_[8 * q + 5])}, s2_); \
                        s2_ = __builtin_elementwise_fma((f32x2){w1_[2], w1_[3]}, (f32x2){IDX_RELU(ac_[8 * q + 6]), IDX_RELU(ac_[8 * q + 7])}, s2_); \
                        const f32x2 mc_ = *(const LAS f32x2*)(sqc + 2 * (4 * rt + 2 * hi + q)); t_[q] = __builtin_fmaf(s2_[0] + s2_[1], mc_[0], mc_[1]); } \
                    const u16x2 pk_ = __builtin_amdgcn_cvt_pknorm_u16(t_[0], t_[1]); \
                    _Pragma("unroll") for (int q = 0; q < 2; ++q) { const int qi_ = 4 * rt + 2 * hi + q; const unsigned short ky_ = q ? pk_[1] : pk_[0]; bins[qi_ * 4096 + 32 * j_ + n] = ky_; \
                        if (dosel) __hip_atomic_fetch_add(hq + qi_ * 256 + ((unsigned)ky_ >> 8), 1u, __ATOMIC_RELAXED, __HIP_MEMORY_SCOPE_WORKGROUP); } } } } } } while (0)
            IDX_LOADB(b0, 0);
            for (int bb = 0; bb < nbat; bb += 2) {
                IDX_LOADB(b1, bb + 1);
                IDX_COMP(b0, bb);
                IDX_LOADB(b0, bb + 2);
                IDX_COMP(b1, bb + 1);
            }
#undef IDX_LOADB
#undef IDX_COMP
#undef IDX_RELU
        }
        if (s8 + 1 < 8) IDX_LOADQ(s8 + 1);
        IDX_BAR();
        for (int repB_ = 0; repB_ < (((PROBE_MASK) >> 13) & 1) + 1; ++repB_)
        for (int qq = 0; qq < 2; ++qq) {
            const int q = wave + 8 * qq;
            const int nch = (N + 511) >> 9;
            const LAS unsigned short* brow = bins + q * 4096;
            LAS unsigned char* st8 = (LAS unsigned char*)hist + 512 * qq;
            { unsigned z0 = 0u; asm volatile("" : "+v"(z0)); *(LAS u32x2*)(st8 + 8 * lane) = (u32x2){z0, z0}; }
#define IDX_SCAN(K, HD, TARGET) \
            int tl_ = 0; _Pragma("unroll") for (int i = 0; i < K; ++i) tl_ += HD[i]; \
            int P_ = tl_; P_ += DPP_I(P_, 0x111); P_ += DPP_I(P_, 0x112); P_ += DPP_I(P_, 0x114); P_ += DPP_I(P_, 0x118); \
            { const int R0 = __builtin_amdgcn_readlane(P_, 15), R1 = __builtin_amdgcn_readlane(P_, 31), R2 = __builtin_amdgcn_readlane(P_, 47); P_ += (lane >= 16 ? R0 : 0) + (lane >= 32 ? R1 : 0) + (lane >= 48 ? R2 : 0); } \
            const unsigned long long over_ = __ballot(P_ >= (TARGET)); const int Lc_ = over_ ? (int)__builtin_ctzll(over_) : 63; \
            int cumL_ = P_ - tl_, bsel_ = 0, cbv_ = 0; bool fnd_ = false; \
            _Pragma("unroll") for (int i = K - 1; i >= 0; --i) { if (!fnd_) { if (cumL_ + HD[i] >= (TARGET) || i == 0) { fnd_ = true; bsel_ = i; cbv_ = HD[i]; } else cumL_ += HD[i]; } } \
            Bs = K * (63 - Lc_) + __builtin_amdgcn_readlane(bsel_, Lc_); cb = __builtin_amdgcn_readlane(cbv_, Lc_); cumv = __builtin_amdgcn_readlane(cumL_, Lc_);
#define IDX_CODE(v, j) ((int)(((j) & 1) ? ((v)[(j) >> 1] >> 16) : ((v)[(j) >> 1] & 0xffffu)))
            int Bs = -1, cb = 0, need = 0, sh = 8; bool fast_ok = true;
            LAS unsigned* crow = hq + q * 256;
            if (dosel) {
                { const u32x4 h4 = *(const LAS u32x4*)(crow + 4 * (63 - lane)); const int hd4[4] = {(int)h4[0], (int)h4[1], (int)h4[2], (int)h4[3]};
                  int cumv; IDX_SCAN(4, hd4, TOPK)
                  need = TOPK - cumv; fast_ok = over_ != 0ull && need >= 1 && need <= cb; }
                if (fast_ok && cb > 64) {
                    { unsigned z0 = 0u; asm volatile("" : "+v"(z0)); *(LAS u32x4*)(crow + 4 * lane) = (u32x4){z0, z0, z0, z0}; }
                    for (int ch = 0; ch < nch; ++ch) { const u32x4 v = *(const LAS u32x4*)(brow + 512 * ch + 8 * lane); const bool okl = 512 * ch + 8 * lane < N;
#pragma unroll
                        for (int j = 0; j < 8; ++j) { const int kj = IDX_CODE(v, j); const bool m = okl && (kj >> 8) == Bs;
                            __hip_atomic_fetch_add(m ? crow + (kj & 255) : (LAS unsigned*)ci + lane, 1u, __ATOMIC_RELAXED, __HIP_MEMORY_SCOPE_WORKGROUP); } }
                    asm volatile("s_waitcnt lgkmcnt(0)" ::: "memory");
                    const u32x4 h4 = *(const LAS u32x4*)(crow + 4 * (63 - lane)); const int hd4[4] = {(int)h4[0], (int)h4[1], (int)h4[2], (int)h4[3]};
                    int nB, nC, nV; bool ok2;
                    { int Bs, cb, cumv; IDX_SCAN(4, hd4, need)
                      nB = Bs; nC = cb; nV = cumv; ok2 = over_ != 0ull; }
                    Bs = (Bs << 8) | nB; sh = 0; need -= nV; cb = nC;
                    fast_ok = ok2 && need >= 1 && need <= cb;
                }
                fast_ok = fast_ok && cb <= 64;
            }
#undef IDX_SCAN
            if (fast_ok) {
                int nc = 0;
                u32x4 vn = *(const LAS u32x4*)(brow + 8 * lane);
                for (int ch = 0; ch < nch; ++ch) { const u32x4 v = vn; const int e0 = 512 * ch + 8 * lane; const bool okl = e0 < N; unsigned byte = 0u;
                    if (ch + 1 < nch) vn = *(const LAS u32x4*)(brow + 512 * (ch + 1) + 8 * lane);
                    int bj[8], cl = 0;
#pragma unroll
                    for (int j = 0; j < 8; ++j) { bj[j] = okl ? (IDX_CODE(v, j) >> sh) : -2; cl += (bj[j] == Bs) ? 1 : 0; byte |= (unsigned)(Bs - bj[j]) >> 31 << j; }
                    int ps = cl;
                    ps += DPP_I(ps, 0x111); ps += DPP_I(ps, 0x112); ps += DPP_I(ps, 0x114); ps += DPP_I(ps, 0x118);
                    ps += __builtin_amdgcn_update_dpp(0, ps, 0x142, 0xa, 0xf, false); ps += __builtin_amdgcn_update_dpp(0, ps, 0x143, 0xc, 0xf, false);
                    int off = nc + ps - cl;
#pragma unroll
                    for (int j = 0; j < 8; ++j) { const bool eq = bj[j] == Bs; crow[eq ? off : 64 + lane] = (unsigned)((IDX_CODE(v, j) << 12) | (e0 + j)); off += eq ? 1 : 0; }
                    nc += __builtin_amdgcn_readlane(ps, 63);
                    st8[64 * ch + lane] = (unsigned char)byte; }
                if (dosel) {
                    asm volatile("s_waitcnt lgkmcnt(0)" ::: "memory");
                    const int mc = (lane < cb) ? (int)crow[lane] : 0; const int mord = (mc & ~4095) | (4095 - (mc & 4095)); int rank = 0;
                    for (int j = 0; j < cb; ++j) { const int oj = __builtin_amdgcn_readlane(mord, j); rank += (oj > mord) ? 1 : 0; }
                    if (lane < cb && rank < need) __hip_atomic_fetch_or((LAS unsigned*)st8 + ((mc & 4095) >> 5), 1u << (mc & 31), __ATOMIC_RELAXED, __HIP_MEMORY_SCOPE_WORKGROUP);
                }
            } else {
                int Tk = -1; unsigned Jx = 0xffffffffu;
                for (int bit = 15; bit >= 0; --bit) {
                    const int cand = Tk < 0 ? (1 << bit) : (Tk | (1 << bit)); int cl = 0;
                    for (int ch = 0; ch < nch; ++ch) { const u32x4 v = *(const LAS u32x4*)(brow + 512 * ch + 8 * lane); const int e0 = 512 * ch + 8 * lane;
#pragma unroll
                        for (int j = 0; j < 8; ++j) cl += (e0 < N && IDX_CODE(v, j) >= cand) ? 1 : 0; }
                    if (wave_isum(cl) >= TOPK) Tk = cand;
                }
                if (Tk < 0) Tk = 0;
                int cg = 0, ce = 0;
                for (int ch = 0; ch < nch; ++ch) { const u32x4 v = *(const LAS u32x4*)(brow + 512 * ch + 8 * lane); const int e0 = 512 * ch + 8 * lane;
#pragma unroll
                    for (int j = 0; j < 8; ++j) if (e0 < N) { cg += (IDX_CODE(v, j) > Tk) ? 1 : 0; ce += (IDX_CODE(v, j) == Tk) ? 1 : 0; } }
                const int nd = TOPK - wave_isum(cg), ceq = wave_isum(ce);
                if (ceq > nd) {
                    unsigned Jc = 0u;
                    for (int bit = 11; bit >= 0; --bit) {
                        const unsigned cj = Jc | (1u << bit); int cl = 0;
                        for (int ch = 0; ch < nch; ++ch) { const u32x4 v = *(const LAS u32x4*)(brow + 512 * ch + 8 * lane); const int e0 = 512 * ch + 8 * lane;
#pragma unroll
                            for (int j = 0; j < 8; ++j) cl += (e0 < N && IDX_CODE(v, j) == Tk && (unsigned)(e0 + j) < cj) ? 1 : 0; }
                        if (wave_isum(cl) < nd) Jc = cj;
                    }
                    Jx = Jc;
                }
                for (int ch = 0; ch < nch; ++ch) { const u32x4 v = *(const LAS u32x4*)(brow + 512 * ch + 8 * lane); const int e0 = 512 * ch + 8 * lane; unsigned byte = 0u;
#pragma unroll
                    for (int j = 0; j < 8; ++j) { const int kj = IDX_CODE(v, j); byte |= (unsigned)((kj > Tk || (kj == Tk && (unsigned)(e0 + j) <= Jx)) ? 1 : 0) << j; }
                    st8[64 * ch + lane] = (unsigned char)(e0 < N ? byte : 0u); }
            }
#undef IDX_CODE
            { unsigned z0 = 0u; asm volatile("" : "+v"(z0)); *(LAS u32x4*)(crow + 4 * lane) = (u32x4){z0, z0, z0, z0}; }
        }
        IDX_WTAB((s8 + 1) & 1);
        IDX_BAR();
        {
            const int tile = tid >> 3, w8 = tid & 7, NJw = 4 * ((qb32 >> 3) + 1);
            if (tile < NJw) {
#pragma unroll
                for (int qq = 0; qq < 2; ++qq) { const u32x2 mk = *(const LAS u32x2*)((const LAS unsigned*)(F.lds + AUX_OFF + 16384) + w8 * 256 + 128 * qq + 2 * tile);
                    maskQ[((size_t)(b * 128 + qb32) * 64 + tile) * 32 + QP * sub + 8 * qq + w8] = ((unsigned long long)mk.y << 32) | mk.x; } }
        }
    }
#undef IDX_UNIT
#undef IDX_LOADQ
#undef IDX_WTAB
#undef IDX_BAR
}

__device__ __forceinline__ void p_conv(Frame& F, int l) {
    LAS bf16* Ut = (LAS bf16*)(F.lds + RING_OFF);
    LAS float* Yt = (LAS float*)(F.lds + RING_OFF + 65536);
    const bf16* U = WSP(bf16, WS_U); bf16* MIX = WSP(bf16, WS_MIX);
    const float* cw = arg_in(2) + (size_t)l * CK * CCH; const int c = F.tid, lane = F.lane;
    float wj[CK];
#pragma unroll
    for (int j = 0; j < CK; ++j) wj[j] = cw[j * CCH + c];
    const float cb = arg_in(3)[l * CCH + c];
    f32x4 lg0 = *(const f32x4*)(arg_in(4) + l * CCH + 8 * lane), lg1 = *(const f32x4*)(arg_in(4) + l * CCH + 8 * lane + 4);
    f32x4 lb0 = *(const f32x4*)(arg_in(5) + l * CCH + 8 * lane), lb1 = *(const f32x4*)(arg_in(5) + l * CCH + 8 * lane + 4);
    f32x4 ms0 = *(const f32x4*)(arg_in(6) + l * DM + CCH + 8 * lane), ms1 = *(const f32x4*)(arg_in(6) + l * DM + CCH + 8 * lane + 4);
    u32x4 tp[8];
#define CONV_LOAD(it_) do { const int un_ = F.vcu + 256 * (it_), b_ = un_ >> 7, t0_ = (un_ & 127) * 32; \
        _Pragma("unroll") for (int k = 0; k < 8; ++k) { const int ch = F.tid + NTHR * k, r = ch >> 6, cc = ch & 63, t = t0_ - 30 + r; unsigned z0 = 0u; asm volatile("" : "+v"(z0)); tp[k] = (u32x4){z0, z0, z0, z0}; \
            if (ch < 62 * 64 && t >= 0) tp[k] = *(const u32x4*)(U + ((size_t)b_ * SEQ + t) * CCH + cc * 8); } } while (0)
    CONV_LOAD(0);
    for (int it = 0; it < 4; ++it) {
        const int unit = F.vcu + 256 * it, b = unit >> 7, tt0 = (unit & 127) * 32;
#pragma unroll
        for (int k = 0; k < 8; ++k) { const int ch = F.tid + NTHR * k, r = ch >> 6, cc = ch & 63; if (ch < 62 * 64) *(LAS u32x4*)(Ut + r * CCH + cc * 8) = tp[k]; }
        if (it + 1 < 4) CONV_LOAD(it + 1);
        __syncthreads();
        float acc[32], uu[62];
#pragma unroll
        for (int s = 0; s < 62; ++s) uu[s] = bf2f(Ut[s * CCH + c]);
#pragma unroll
        for (int tt = 0; tt < 32; ++tt) acc[tt] = cb;
#pragma unroll
        for (int j = 0; j < CK; ++j)
#pragma unroll
            for (int tt = 0; tt < 32; ++tt) acc[tt] = __builtin_fmaf(wj[j], uu[tt + j], acc[tt]);
#pragma unroll
        for (int tt = 0; tt < 32; ++tt) Yt[tt * CCH + c] = acc[tt];
        __syncthreads();
#pragma unroll
        for (int k = 0; k < 4; ++k) { const int tt = F.wave * 4 + k;
            f32x4 y0 = *(const LAS f32x4*)(Yt + tt * CCH + 8 * lane), y1 = *(const LAS f32x4*)(Yt + tt * CCH + 8 * lane + 4);
            const float mean = wave_sum((y0[0] + y0[1]) + (y0[2] + y0[3]) + (y1[0] + y1[1]) + (y1[2] + y1[3])) * (1.f / CCH);
            y0 = y0 - mean; y1 = y1 - mean;
            const float var = wave_sum((y0[0] * y0[0] + y0[1] * y0[1]) + (y0[2] * y0[2] + y0[3] * y0[3]) + (y1[0] * y1[0] + y1[1] * y1[1]) + (y1[2] * y1[2] + y1[3] * y1[3])) * (1.f / CCH);
            const float rstd = 1.f / sqrtf(var + LN_EPS);
            y0 = y0 * rstd * lg0 + lb0; y1 = y1 * rstd * lg1 + lb1;
#pragma unroll
            for (int e = 0; e < 4; ++e) { y0[e] = y0[e] * fsigmoid(y0[e]) * ms0[e]; y1[e] = y1[e] * fsigmoid(y1[e]) * ms1[e]; }
            *(u32x4*)(MIX + ((size_t)b * SEQ + tt0 + tt) * DM + CCH + 8 * lane) = pg8::pack8(y0, y1); }
        __syncthreads();
    }
#undef CONV_LOAD
}

namespace at {
constexpr int QBLK = 32, QB = 256, KVBLK = 64, NSLOT = 3, SLOTB = 8192;
constexpr int LDS_K = 0, LDS_V = NSLOT * SLOTB, LDS_WS = 2 * NSLOT * SLOTB, LDS_OST = LDS_WS + 8 * 64 * 4, LDS_BIAS = LDS_OST + 8 * 4096, LDS_END = LDS_BIAS + 1024;
static_assert(LDS_END <= RING_BYTES, "attention LDS");
constexpr float NEGV = -200.0f;
__device__ __forceinline__ int crow(int r, int hi) { return (r & 3) + 8 * (r >> 2) + 4 * hi; }
#define SBAR() __builtin_amdgcn_sched_barrier(0)
__device__ __forceinline__ void glds16(const void* gsrc, unsigned lds_dst) { unsigned keep;
    asm volatile("s_mov_b32 %0, m0\n\ts_mov_b32 m0, %2\n\ts_nop 0\n\tglobal_load_lds_dwordx4 %1, off\n\ts_mov_b32 m0, %0" : "=&s"(keep) : "v"(gsrc), "s"(lds_dst) : "memory"); }
__device__ __forceinline__ float max3f(float a, float b, float c) { float r; asm("v_max3_f32 %0, %1, %2, %3" : "=v"(r) : "v"(a), "v"(b), "v"(c)); return r; }
__device__ __forceinline__ float max2f(float a, float b) { float r; asm("v_max_f32_e32 %0, %1, %2" : "=v"(r) : "v"(a), "v"(b)); return r; }
__device__ __forceinline__ float fadd_s(float a, float b) { float r; asm("v_add_f32_e32 %0, %1, %2" : "=v"(r) : "v"(a), "v"(b)); return r; }
__device__ __forceinline__ float fsub_s(float a, float b) { float r; asm("v_sub_f32_e32 %0, %1, %2" : "=v"(r) : "v"(a), "v"(b)); return r; }
typedef float f32x2_t __attribute__((ext_vector_type(2))); typedef __bf16 bf16x2_t __attribute__((ext_vector_type(2)));
__device__ __forceinline__ unsigned cvtpk_s(float lo, float hi) { f32x2_t v = {lo, hi}; bf16x2_t b = __builtin_convertvector(v, bf16x2_t); return __builtin_bit_cast(unsigned, b); }
typedef LAS const char* lds_cptr;
typedef short v4i16_t __attribute__((ext_vector_type(4)));
__device__ __forceinline__ void kload8(bf16x8* kf, lds_cptr kp) {
    kf[0] = *(const LAS bf16x8*)(kp);        kf[1] = *(const LAS bf16x8*)(kp + 512);  kf[2] = *(const LAS bf16x8*)(kp + 2048); kf[3] = *(const LAS bf16x8*)(kp + 2560);
    kf[4] = *(const LAS bf16x8*)(kp + 4096); kf[5] = *(const LAS bf16x8*)(kp + 4608); kf[6] = *(const LAS bf16x8*)(kp + 6144); kf[7] = *(const LAS bf16x8*)(kp + 6656); }
__device__ __forceinline__ void kload2(bf16x8* kf, lds_cptr kp, int j) { kf[2 * j] = *(const LAS bf16x8*)(kp + j * 2048); kf[2 * j + 1] = *(const LAS bf16x8*)(kp + j * 2048 + 512); }
__device__ __forceinline__ s16x4 vtr(lds_cptr p) { return __builtin_bit_cast(s16x4, __builtin_amdgcn_ds_read_tr16_b64_v4i16((LAS v4i16_t*)p)); }
__device__ __forceinline__ float rowmax(const f32x16& p0, const f32x16& p1) {
    float a = max3f(p0[0], p0[1], p1[0]), b = max3f(p0[2], p0[3], p1[1]); a = max3f(a, p1[2], p1[3]);
#pragma unroll
    for (int r = 4; r < 16; r += 4) { a = max3f(a, p0[r], p0[r + 1]); b = max3f(b, p0[r + 2], p0[r + 3]); a = max3f(a, p1[r], p1[r + 1]); b = max3f(b, p1[r + 2], p1[r + 3]); }
    const float m = max2f(a, b);
    auto rr = __builtin_amdgcn_permlane32_swap(__float_as_uint(m), __float_as_uint(m), false, false);
    return max2f(__uint_as_float(rr[0]), __uint_as_float(rr[1]));
}
__device__ __forceinline__ void pv(f32x16* o, int vb, bf16x8 pa0, bf16x8 pa1, bf16x8 pa2, bf16x8 pa3) {
#pragma unroll
    for (int d0 = 0; d0 < 2; ++d0) { s16x4 lo[4], hi[4];
#pragma unroll
        for (int ks = 0; ks < 4; ++ks) {
            asm volatile("ds_read_b64_tr_b16 %0,%1 offset:%c2" : "=&v"(lo[ks]) : "v"(vb), "i"(d0 * 4096 + ks * 1024) : "memory");
            asm volatile("ds_read_b64_tr_b16 %0,%1 offset:%c2" : "=&v"(hi[ks]) : "v"(vb), "i"(d0 * 4096 + ks * 1024 + 512) : "memory"); }
        asm volatile("s_waitcnt lgkmcnt(0)" ::: "memory"); SBAR();
#define AT_PK(k) (bf16x8){lo[k][0], lo[k][1], lo[k][2], lo[k][3], hi[k][0], hi[k][1], hi[k][2], hi[k][3]}
        o[d0] = __builtin_amdgcn_mfma_f32_32x32x16_bf16(pa0, AT_PK(0), o[d0], 0, 0, 0);
        o[d0] = __builtin_amdgcn_mfma_f32_32x32x16_bf16(pa1, AT_PK(1), o[d0], 0, 0, 0);
        o[d0] = __builtin_amdgcn_mfma_f32_32x32x16_bf16(pa2, AT_PK(2), o[d0], 0, 0, 0);
        o[d0] = __builtin_amdgcn_mfma_f32_32x32x16_bf16(pa3, AT_PK(3), o[d0], 0, 0, 0);
#undef AT_PK
    }
}
template <int THRL> __device__ __forceinline__ void attn_unit(int b, int h, int qb, const bf16* Q, const bf16* __restrict__ Kt, const bf16* __restrict__ Vt, const unsigned long long* maskQ,
                                                              bf16* MIX, float ms0, float ms1, LAS unsigned char* shm, int tid) {
    const int lane = tid & 63, r32 = lane & 31, hi = lane >> 5; const int wid = __builtin_amdgcn_readfirstlane(tid >> 6);
    const size_t rowbase = (size_t)b * SEQ; const int q0 = qb * QB, qw = q0 + wid * QBLK, cwv = qw >> 6;
    const bf16* Qw = Q + (rowbase + qw) * AW + h * HD;
    const unsigned lds0 = (unsigned)(uintptr_t)shm; const lds_cptr shm3 = (lds_cptr)shm;
    LAS float* wsf = (LAS float*)(shm + LDS_WS) + wid * 64;
    const LAS float* biasT = (const LAS float*)(shm + LDS_BIAS);
    const bf16* ksrc = Kt + ((size_t)(b * NH + h) * 64) * 4096 + wid * 512 + lane * 8;
    const bf16* vsrc = Vt + ((size_t)(b * NH + h) * 64) * 4096 + wid * 512 + lane * 8;
    const unsigned kdst = lds0 + LDS_K + wid * 1024, vdst = lds0 + LDS_V + wid * 1024;
#define DMA_K(t, slot) glds16(ksrc + (size_t)(t) * 4096, (unsigned)__builtin_amdgcn_readfirstlane(kdst + (slot)))
#define DMA_V(t, slot) glds16(vsrc + (size_t)(t) * 4096, (unsigned)__builtin_amdgcn_readfirstlane(vdst + (slot)))
    int r32m = r32; asm volatile("" : "+v"(r32m));
    const unsigned long long* mrow = maskQ + ((size_t)(b * 128 + (qw >> 5)) * 64) * 32 + r32m;
#define MLOAD(dst, t) dst = *(const GAS u32x2*)((const GAS unsigned long long*)mrow + (size_t)(t) * 32)
#define MLOAD_UNUSED(dst, t) dst = *(const u32x2*)(mrow + (size_t)(t) * 32)
#define WAIT_BAR(N, M) asm volatile("s_waitcnt vmcnt(" #N ") lgkmcnt(0)\n\ts_barrier" ::: "memory")
    const int vb0 = (int)(lds0 + LDS_V) + ((lane >> 4) & 1) * 32 + (lane & 3) * 8 + (4 * hi + ((lane & 15) >> 2)) * 64;
    bf16x8 kf[8];
    const lds_cptr kp0 = shm3 + LDS_K + hi * 1024 + r32 * 16; const lds_cptr vp0 = shm3 + LDS_V + ((lane >> 4) & 1) * 32 + (lane & 3) * 8 + (4 * hi + ((lane & 15) >> 2)) * 64;
    const int NT = (q0 + QB) / KVBLK;
    u32x2 mA, mB;
    MLOAD(mA, 0);
    DMA_K(0, 0); DMA_V(0, 0); DMA_K(1, SLOTB);
    const lds_cptr qp = shm3 + LDS_OST + wid * 4096 + hi * 512 + r32 * 16;
#pragma unroll
    for (int d0 = 0; d0 < 4; ++d0) { const bf16x8 qv = *(const bf16x8*)(Qw + (size_t)r32 * AW + d0 * 16 + hi * 8); *(LAS bf16x8*)(shm + LDS_OST + wid * 4096 + hi * 512 + r32 * 16 + d0 * 1024) = qv; }
#define QRD(d0) (*(const LAS bf16x8*)(qp + (d0) * 1024))
    float mhat = 0.f, l_reg = 0.f; f32x16 o[2]; o[0] = f32x16{}; o[1] = f32x16{}; f32x16 negm = f32x16{}; asm volatile("" : "+v"(negm));
#define MASKB(P0, P1, t, MW) do { \
        if (64 * (t) + 63 - qw >= -90 && (t) <= cwv) { const int bi_ = 64 * (t) - (qw + r32) + 128 + 4 * hi; \
            _Pragma("unroll") for (int r = 0; r < 16; ++r) { const int k0_ = (r & 3) + 8 * (r >> 2); int i0_ = bi_ + k0_; i0_ = i0_ < 0 ? 0 : i0_; int i1_ = bi_ + k0_ + 32; i1_ = i1_ < 0 ? 0 : i1_; P0[r] += biasT[i0_]; P1[r] += biasT[i1_]; } } \
        { const unsigned ml_ = MW.x >> (4 * hi), mh_ = MW.y >> (4 * hi); const unsigned nv_ = __float_as_uint(NEGV); \
            _Pragma("unroll") for (int r = 0; r < 16; ++r) { const unsigned s0_ = (unsigned)__builtin_amdgcn_sbfe((int)ml_, (r & 3) + 8 * (r >> 2), 1), s1_ = (unsigned)__builtin_amdgcn_sbfe((int)mh_, (r & 3) + 8 * (r >> 2), 1); \
                P0[r] = __uint_as_float((s0_ & __float_as_uint(P0[r])) | (~s0_ & nv_)); P1[r] = __uint_as_float((s1_ & __float_as_uint(P1[r])) | (~s1_ & nv_)); } } } while (0)
    bool resc = false;
#define START(P0, P1) do { const float rm = rowmax(P0, P1); resc = false; \
    { const float dl = rm; mhat = fadd_s(mhat, dl); \
      _Pragma("unroll") for (int r = 0; r < 16; ++r) { P0[r] = fsub_s(P0[r], dl); P1[r] = fsub_s(P1[r], dl); } \
      _Pragma("unroll") for (int r = 0; r < 16; ++r) negm[r] = -mhat; asm volatile("" : "+v"(negm)); } \
    _Pragma("unroll") for (int r = 0; r < 16; ++r) P0[r] = __builtin_amdgcn_exp2f(P0[r]); } while (0)
#define RESC() do { if (resc) { asm volatile("s_waitcnt lgkmcnt(0)" ::: "memory"); \
      _Pragma("unroll") for (int d_ = 0; d_ < 2; ++d_) _Pragma("unroll") for (int r = 0; r < 16; ++r) o[d_][r] *= wsf[crow(r, hi)]; } } while (0)
    f32x16 pA0, pA1, pB0, pB1;
    int sl_prev = 0, sl_cur = 0, sl_next = SLOTB;
#define ROT() do { sl_prev = sl_cur; sl_cur = sl_next; sl_next = (sl_next == (NSLOT - 1) * SLOTB) ? 0 : sl_next + SLOTB; } while (0)
    DMA_K(2, 2 * SLOTB);
    WAIT_BAR(3, mA);
    {
        const lds_cptr kb = kp0;
        pA0 = f32x16{}; pA1 = f32x16{};
#pragma unroll
        for (int d0 = 0; d0 < 4; ++d0) { const bf16x8 b0 = *(const LAS bf16x8*)(kb + d0 * 2048), b1 = *(const LAS bf16x8*)(kb + d0 * 2048 + 512);
            const bf16x8 qv = QRD(d0); pA0 = __builtin_amdgcn_mfma_f32_32x32x16_bf16(b0, qv, pA0, 0, 0, 0); pA1 = __builtin_amdgcn_mfma_f32_32x32x16_bf16(b1, qv, pA1, 0, 0, 0); }
        MASKB(pA0, pA1, 0, mA);
        asm volatile("s_nop 15\n\ts_nop 7" : "+v"(pA0), "+v"(pA1));
        START(pA0, pA1);
#pragma unroll
        for (int r = 0; r < 16; ++r) pA1[r] = __builtin_amdgcn_exp2f(pA1[r]);
    }
    WAIT_BAR(0, mA);
    MLOAD(mB, 1);
    DMA_K(3, 0); DMA_V(1, SLOTB);
    ROT();
    kload8(kf, kp0 + sl_cur);
    WAIT_BAR(2, mB);
    s16x4 vlo[8], vhi[8]; u32x4 pw0, pw1, pw2, pw3;
#define PKW(P, B) cvtpk_s(P[B], P[B + 1])
#define PAF(k) __builtin_bit_cast(bf16x8, pw##k)
#define VFR(i) (bf16x8){vlo[i][0], vlo[i][1], vlo[i][2], vlo[i][3], vhi[i][0], vhi[i][1], vhi[i][2], vhi[i][3]}
#define PIN(x) asm volatile("" : "+v"(x))
#define MX3(a, b, c) __builtin_fmaxf(__builtin_fmaxf((a), (b)), (c))
#define GAPA(MF, A0, A1, A2, A3, W0, W1, PW) do { MF; sacc += A0; sacc += A1; sacc += A2; sacc += A3; PIN(sacc); W0; W1; PIN(PW); SBAR(); } while (0)
#define EX(v) __builtin_amdgcn_exp2f(v)
#define GAPB(MF, X, B) do { MF; X[B] = EX(X[B]); X[B + 1] = EX(X[B + 1]); X[B + 2] = EX(X[B + 2]); X[B + 3] = EX(X[B + 3]); PIN(X); SBAR(); } while (0)
#define VRD(i) do { vlo[i] = vtr(vp_ + (((i) >> 2) * 4096 + ((i) & 3) * 1024)); vhi[i] = vtr(vp_ + (((i) >> 2) * 4096 + ((i) & 3) * 1024 + 512)); } while (0)
#define KRD(G, j) do { if (G) { kload2(kf, kp0 + sl_next, j); SBAR(); } } while (0)
#define STEP(C0, C1, P0, P1, t, MC, MN, GM, GK, GV, GL) do { SBAR(); \
    const lds_cptr vp_ = vp0 + sl_prev; \
    bf16x8 qa_ = QRD(0), qb_; VRD(0); SBAR(); float sacc = (P0[0] + P0[1]); \
    GAPA(C0 = __builtin_amdgcn_mfma_f32_32x32x16_bf16(kf[0], qa_, negm, 0, 0, 0), P0[2], P0[3], P0[4], P0[5],     pw0[0] = PKW(P0, 0), pw0[1] = PKW(P0, 2), pw0); \
    VRD(4); SBAR(); GAPA(C1 = __builtin_amdgcn_mfma_f32_32x32x16_bf16(kf[1], qa_, negm, 0, 0, 0), P0[6], P0[7], P0[8], P0[9],     pw0[2] = PKW(P0, 4), pw0[3] = PKW(P0, 6), pw0); \
    qb_ = QRD(1); VRD(1); SBAR(); GAPA(C0 = __builtin_amdgcn_mfma_f32_32x32x16_bf16(kf[2], qb_, C0, 0, 0, 0),   P0[10], P0[11], P0[12], P0[13], pw1[0] = PKW(P0, 8), pw1[1] = PKW(P0, 10), pw1); \
    VRD(5); SBAR(); GAPA(C1 = __builtin_amdgcn_mfma_f32_32x32x16_bf16(kf[3], qb_, C1, 0, 0, 0),   P0[14], P0[15], P1[0], P1[1],   pw1[2] = PKW(P0, 12), pw1[3] = PKW(P0, 14), pw1); \
    qa_ = QRD(2); VRD(2); SBAR(); GAPA(C0 = __builtin_amdgcn_mfma_f32_32x32x16_bf16(kf[4], qa_, C0, 0, 0, 0),   P1[2], P1[3], P1[4], P1[5],     pw2[0] = PKW(P1, 0), pw2[1] = PKW(P1, 2), pw2); \
    VRD(6); SBAR(); GAPA(C1 = __builtin_amdgcn_mfma_f32_32x32x16_bf16(kf[5], qa_, C1, 0, 0, 0),   P1[6], P1[7], P1[8], P1[9],     pw2[2] = PKW(P1, 4), pw2[3] = PKW(P1, 6), pw2); \
    qb_ = QRD(3); VRD(3); SBAR(); GAPA(C0 = __builtin_amdgcn_mfma_f32_32x32x16_bf16(kf[6], qb_, C0, 0, 0, 0),   P1[10], P1[11], P1[12], P1[13], pw3[0] = PKW(P1, 8), pw3[1] = PKW(P1, 10), pw3); \
    VRD(7); SBAR(); GAPA(C1 = __builtin_amdgcn_mfma_f32_32x32x16_bf16(kf[7], qb_, C1, 0, 0, 0),   P1[14], P1[15], 0.f, 0.f,       pw3[2] = PKW(P1, 12), pw3[3] = PKW(P1, 14), pw3); \
    l_reg += sacc; \
    MASKB(C0, C1, t, MC); \
    if (GM) { MLOAD(MN, (t) + 1); } if (GK) { DMA_K((t) + 3, sl_cur); } if (GV) { DMA_V((t) + 1, sl_next); } \
    { float a = MX3(C0[0], C0[1], C1[0]), b_ = MX3(C0[2], C0[3], C1[1]); a = MX3(a, C1[2], C1[3]); \
      _Pragma("unroll") for (int r = 4; r < 16; r += 4) { a = MX3(a, C0[r], C0[r + 1]); b_ = MX3(b_, C0[r + 2], C0[r + 3]); a = MX3(a, C1[r], C1[r + 1]); b_ = MX3(b_, C1[r + 2], C1[r + 3]); } \
      float rm = __builtin_fmaxf(a, b_); { auto rr = __builtin_amdgcn_permlane32_swap(__float_as_uint(rm), __float_as_uint(rm), false, false); rm = __builtin_fmaxf(__uint_as_float(rr[0]), __uint_as_float(rr[1])); } \
      resc = false; \
      if (__builtin_expect(__any(rm > (float)THRL), 0)) { const float dl = __builtin_fmaxf(rm, 0.f); mhat += dl; \
        _Pragma("unroll") for (int r = 0; r < 16; ++r) { C0[r] -= dl; C1[r] -= dl; } \
        _Pragma("unroll") for (int r = 0; r < 16; ++r) negm[r] = -mhat; asm volatile("" : "+v"(negm)); \
        const float f = __builtin_amdgcn_exp2f(-dl); l_reg *= f; if (hi == 0) wsf[r32] = f; resc = true; } } \
    SBAR(); \
    GAPB(o[0] = __builtin_amdgcn_mfma_f32_32x32x16_bf16(PAF(0), VFR(0), o[0], 0, 0, 0), C0, 0); \
    GAPB(o[1] = __builtin_amdgcn_mfma_f32_32x32x16_bf16(PAF(0), VFR(4), o[1], 0, 0, 0), C0, 4); \
    KRD(GL, 0); GAPB(o[0] = __builtin_amdgcn_mfma_f32_32x32x16_bf16(PAF(1), VFR(1), o[0], 0, 0, 0), C0, 8); \
    KRD(GL, 1); GAPB(o[1] = __builtin_amdgcn_mfma_f32_32x32x16_bf16(PAF(1), VFR(5), o[1], 0, 0, 0), C0, 12); \
    KRD(GL, 2); GAPB(o[0] = __builtin_amdgcn_mfma_f32_32x32x16_bf16(PAF(2), VFR(2), o[0], 0, 0, 0), C1, 0); \
    KRD(GL, 3); GAPB(o[1] = __builtin_amdgcn_mfma_f32_32x32x16_bf16(PAF(2), VFR(6), o[1], 0, 0, 0), C1, 4); \
    GAPB(o[0] = __builtin_amdgcn_mfma_f32_32x32x16_bf16(PAF(3), VFR(3), o[0], 0, 0, 0), C1, 8); \
    GAPB(o[1] = __builtin_amdgcn_mfma_f32_32x32x16_bf16(PAF(3), VFR(7), o[1], 0, 0, 0), C1, 12); \
    } while (0)
    int t = 1;
    for (; t + 5 < NT; t += 2) {
        STEP(pB0, pB1, pA0, pA1, t, mB, mA, true, true, true, true);       WAIT_BAR(2, mA); RESC(); ROT();
        STEP(pA0, pA1, pB0, pB1, t + 1, mA, mB, true, true, true, true);   WAIT_BAR(2, mB); RESC(); ROT();
    }
#define ENDW(tt, M) do { if ((tt) + 3 < NT) { WAIT_BAR(2, M); } else if ((tt) + 2 < NT) { WAIT_BAR(1, M); } else { WAIT_BAR(0, M); } } while (0)
    for (; t + 1 < NT; t += 2) {
        STEP(pB0, pB1, pA0, pA1, t, mB, mA, (t + 1 < NT), (t + 3 < NT), (t + 1 < NT), (t + 1 < NT));         ENDW(t, mA);     RESC(); ROT();
        STEP(pA0, pA1, pB0, pB1, t + 1, mA, mB, (t + 2 < NT), (t + 4 < NT), (t + 2 < NT), (t + 2 < NT));     ENDW(t + 1, mB); RESC(); ROT();
    }
    STEP(pB0, pB1, pA0, pA1, NT - 1, mB, mA, false, false, false, false); RESC();
    { float sacc = pB0[0] + pB0[1];
#pragma unroll
      for (int r = 2; r < 16; ++r) sacc += pB0[r];
#pragma unroll
      for (int r = 0; r < 16; ++r) sacc += pB1[r];
      l_reg += sacc;
      pw0 = (u32x4){PKW(pB0, 0), PKW(pB0, 2), PKW(pB0, 4), PKW(pB0, 6)}; pw1 = (u32x4){PKW(pB0, 8), PKW(pB0, 10), PKW(pB0, 12), PKW(pB0, 14)};
      pw2 = (u32x4){PKW(pB1, 0), PKW(pB1, 2), PKW(pB1, 4), PKW(pB1, 6)}; pw3 = (u32x4){PKW(pB1, 8), PKW(pB1, 10), PKW(pB1, 12), PKW(pB1, 14)};
      SBAR(); pv(o, vb0 + sl_cur, PAF(0), PAF(1), PAF(2), PAF(3)); }
    { auto rr = __builtin_amdgcn_permlane32_swap(__float_as_uint(l_reg), __float_as_uint(l_reg), false, false); l_reg = __uint_as_float(rr[0]) + __uint_as_float(rr[1]); }
    if (hi == 0) wsf[32 + r32] = l_reg; asm volatile("s_waitcnt lgkmcnt(0)" ::: "memory");
    float rli[16];
#pragma unroll
    for (int r = 0; r < 16; ++r) rli[r] = __builtin_amdgcn_rcpf(wsf[32 + crow(r, hi)]);
    { LAS bf16* stg = (LAS bf16*)(shm + LDS_OST) + wid * 2048;
#pragma unroll
      for (int r = 0; r < 16; ++r) { const int orow = crow(r, hi);
          stg[orow * 64 + r32] = (bf16)(cvtpk_s(o[0][r] * rli[r] * ms0, 0.f) & 0xffffu); stg[orow * 64 + 32 + r32] = (bf16)(cvtpk_s(o[1][r] * rli[r] * ms1, 0.f) & 0xffffu); }
      asm volatile("s_waitcnt lgkmcnt(0)" ::: "memory");
      int ln2 = lane; asm volatile("" : "+v"(ln2));
#pragma unroll
      for (int i = 0; i < 4; ++i) { const int row = i * 8 + (ln2 >> 3), ch = ln2 & 7; const u32x4 v = *(const LAS u32x4*)(stg + row * 64 + ch * 8);
          *(u32x4*)(MIX + (rowbase + qw + row) * DM + h * HD + ch * 8) = v; } }
    asm volatile("s_waitcnt lgkmcnt(0)\n\ts_barrier" ::: "memory");
#undef QRD
#undef DMA_K
#undef DMA_V
#undef MLOAD
#undef WAIT_BAR
#undef MASKB
#undef START
#undef RESC
#undef ROT
#undef PKW
#undef PAF
#undef VFR
#undef PIN
#undef MX3
#undef GAPA
#undef GAPB
#undef EX
#undef VRD
#undef KRD
#undef STEP
#undef ENDW
}
#undef SBAR
}

__device__ __forceinline__ void p_attn(Frame& F, int l) {
    const bf16* Q = WSP(bf16, WS_Q); const bf16* Kg = WSP(bf16, WS_K); const bf16* Vg = WSP(bf16, WS_V); bf16* MIX = WSP(bf16, WS_MIX);
    const unsigned long long* maskQ = WSP(unsigned long long, WS_MASK);
    LAS unsigned char* shm = F.lds + RING_OFF;
    const int tid = F.tid, lane = F.lane, r32 = lane & 31;
    const int bh = F.vcu >> 2, sq = F.vcu & 3, b = bh >> 3, h = bh & 7;
    LAS float* biasT = (LAS float*)(shm + at::LDS_BIAS);
    if (tid < 192) { const int rel = tid - 128, nn = rel < 0 ? -rel : rel; int bk = nn;
        if (nn >= 8) bk = 8 + (nn >= 12) + (nn >= 16) + (nn >= 23) + (nn >= 32) + (nn >= 46) + (nn >= 64) + (nn >= 91);
        bk += (rel > 0) ? 16 : 0;
        biasT[tid] = (arg_in(7)[bk * NH + h] - arg_in(7)[15 * NH + h]) * LOG2E; }
    __syncthreads();
    const float ms0 = arg_in(6)[l * DM + h * 64 + r32], ms1 = arg_in(6)[l * DM + h * 64 + 32 + r32];
    for (int ui = 0; ui < 4; ++ui) {
        const int qb = (ui == 0) ? sq : (ui == 1) ? 7 - sq : (ui == 2) ? 8 + sq : 15 - sq;
        at::attn_unit<8>(b, h, qb, Q, Kg, Vg, maskQ, MIX, ms0, ms1, shm, tid);
    }
}


#define REP(bit) for (int rep_ = 0; rep_ < (((PROBE_MASK) >> (bit)) & 1) + 1; ++rep_)
struct Args { const float* in[20]; float* out; unsigned char* ws; int seg_lo, seg_hi; };
constexpr int N_SEG = 1 + 2 * 8 + 2 * 9;

__global__ void __launch_bounds__(NTHR, 2) fwd_kernel(Args a) {
    extern __shared__ __attribute__((aligned(16))) unsigned char lds_raw[];
    Frame F0;
    F0.lds = (LAS unsigned char*)lds_raw;
    F0.tid = threadIdx.x; F0.lane = F0.tid & 63; F0.wave = __builtin_amdgcn_readfirstlane(F0.tid >> 6);
    F0.G = gridDim.x; { const int bx = blockIdx.x; F0.vcu = (F0.G % 8 == 0) ? (bx % 8) * (F0.G / 8) + bx / 8 : bx; }
    F0.ws = a.ws;
    for (int u = F0.tid; u < (LDS_BYTES - LDSCTL_OFF) / 4; u += NTHR) ((LAS unsigned*)(F0.lds + LDSCTL_OFF))[u] = 0u;
    __syncthreads();
    unsigned* ctl = (unsigned*)(F0.ws + WS_CTL);
    XcdBarrier bar = xcd_barrier_post(ctl + CW_BAR, (volatile LAS unsigned*)(F0.lds + MISC_OFF + 32));
    int sg = 0;
    const int lo = a.seg_lo, hi = a.seg_hi;
#define ACTIVE (lo <= sg && sg < hi)
#define SEAM() do { if (lo <= sg && sg + 1 < hi) xcd_barrier(bar); ++sg; } while (0)

    if (ACTIVE) { Frame F = fresh(F0); cvt_x(F); convert_weights(F, 0); }
    SEAM();
    for (int l = 0; l < DEPTH; ++l) {
        if (ACTIVE) REP(3) {
            {
                Frame F = fresh(F0);
                pg8::DenseOrderG S; S.init_tiles(M / 256, 10, F.G, (int)(F.G % 8 == 0 ? (F.vcu % (F.G / 8)) * 8 + F.vcu / (F.G / 8) : F.vcu)); S.Bt = (const char*)WSP(unsigned char, WS_WIN); S.K = DM / 2;
                pg8::EpiIn E{WSP(bf16, WS_Q), WSP(bf16, WS_K), WSP(bf16, WS_V), WSP(bf16, WS_QI), WSP(bf16, WS_KI), WSP(bf16, WS_U), WSP(float, WS_WI), 0, 1.0f / (pg8::F8_ASC * pg8::F8_WGU), 6};
                pg8::gemm_phase<pg8::EpiIn, pg8::DenseOrderG, true, true, true>(F.tid, F.lds + RING_OFF, (const char*)WSP(unsigned char, WS_XQ), DM / 2, S, E);
            }
            {
                Frame F = fresh(F0);
                pg8::DenseOrder S; S.init_tiles(M / 256, 3, F.G, (int)(F.G % 8 == 0 ? (F.vcu % (F.G / 8)) * 8 + F.vcu / (F.G / 8) : F.vcu)); S.Bt = (const char*)(WSP(bf16, WS_WIN) + (size_t)1536 * DM); S.K = DM;
                pg8::EpiIn E{WSP(bf16, WS_Q), WSP(bf16, WS_K), WSP(bf16, WS_V), WSP(bf16, WS_QI), WSP(bf16, WS_KI), WSP(bf16, WS_U), WSP(float, WS_WI), 6, 1.0f, 99};
                pg8::gemm_phase<pg8::EpiIn, pg8::DenseOrder, true, true>(F.tid, F.lds + RING_OFF, (const char*)WSP(bf16, WS_XB), DM, S, E);
            }
        }
        SEAM();
        if (ACTIVE) {
#ifndef NO_IDX
            REP(0) { Frame F = fresh(F0); p_idx(F, l); }
#endif
#ifndef NO_CONV
            REP(1) { Frame F = fresh(F0); p_conv(F, l); }
#endif
        }
        SEAM();
        if (ACTIVE) {
#ifndef NO_ATTN
            REP(2) { Frame F = fresh(F0); p_attn(F, l); }
#endif
        }
        SEAM();
        if (ACTIVE) REP(4) { Frame F = fresh(F0); bf16* R1 = WSP(bf16, WS_R1);
            pg8::DenseOrder S; S.init_tiles(M / 256, DM / 256, F.G, (int)(F.G % 8 == 0 ? (F.vcu % (F.G / 8)) * 8 + F.vcu / (F.G / 8) : F.vcu)); S.Bt = (const char*)WSP(bf16, WS_WOUT); S.K = DM;
            pg8::EpiRes E{WSP(bf16, WS_XB), R1, 1.0f};
            pg8::gemm_phase<pg8::EpiRes, pg8::DenseOrder, true, true>(F.tid, F.lds + RING_OFF, (const char*)WSP(bf16, WS_MIX), DM, S, E);
        }
        SEAM();
        if (ACTIVE) { Frame F = fresh(F0); p_ln1(F, l); }
        SEAM();
        if ((l & 1) == 0) {
            if (ACTIVE) REP(5) { Frame F = fresh(F0); bf16* XB = WSP(bf16, WS_XB);
                pg8::DenseOrderG S; S.init_tiles(M / 256, 2 * DFF / 256, F.G, (int)(F.G % 8 == 0 ? (F.vcu % (F.G / 8)) * 8 + F.vcu / (F.G / 8) : F.vcu)); S.Bt = (const char*)WSP(bf16, WS_WFF); S.K = DM / 2;
                pg8::EpiSwi E{WSP(unsigned char, WS_H), DFF};
                pg8::gemm_phase<pg8::EpiSwi, pg8::DenseOrderG, true, true, true>(F.tid, F.lds + RING_OFF, (const char*)XB, DM / 2, S, E);
            }
            SEAM();
            if (ACTIVE) { Frame F = fresh(F0); bf16* R1 = WSP(bf16, WS_R1);
                pg8::DenseOrderG S; S.init_tiles(M / 256, DM / 256, F.G, (int)(F.G % 8 == 0 ? (F.vcu % (F.G / 8)) * 8 + F.vcu / (F.G / 8) : F.vcu)); S.Bt = (const char*)(WSP(unsigned char, WS_WFF) + (size_t)2 * DFF * DM); S.K = DFF / 2;
                pg8::EpiRes E{R1, R1, 1.0f / (pg8::F8_HSC * pg8::F8_WDN)};
                pg8::gemm_phase<pg8::EpiRes, pg8::DenseOrderG, true, true, true>(F.tid, F.lds + RING_OFF, (const char*)WSP(unsigned char, WS_H), DFF / 2, S, E);
            }
            SEAM();
            if (ACTIVE) { REP(11) { Frame F = fresh(F0); p_ln2(F, l); } if (l + 1 < DEPTH) REP(8) { Frame F = fresh(F0); convert_weights(F, l + 1); } }
            SEAM();
        } else {
            if (ACTIVE) { Frame F = fresh(F0); p_list(F); }
            SEAM();
            for (int r = 0; r < 1; ++r) {
                if (ACTIVE) REP(6) { Frame F = fresh(F0); bf16* XB = WSP(bf16, WS_XB);
                    moe_tables(F);
                    const int Tm = ((LAS int*)(F.lds + LDSCTL_OFF + 1200))[8]; const int tlo = r * RT; int nMr = Tm - tlo; nMr = nMr < 0 ? 0 : (nMr > RT ? RT : nMr);
                    pg8::MoeGuOrder S; S.init_tiles(nMr, 2 * DFE / 256, F.G, (int)(F.G % 8 == 0 ? (F.vcu % (F.G / 8)) * 8 + F.vcu / (F.G / 8) : F.vcu)); S.rowlist = WSP(int, WS_ROWLIST); S.texp = (const LAS int*)(F.lds + LDSCTL_OFF); S.tlo = tlo;
                    S.W = (const char*)WSP(unsigned char, WS_WFF); S.estride = (size_t)3 * DFE * DM;
                    pg8::EpiSwi E{WSP(unsigned char, WS_H), DFE};
                    pg8::gemm_phase<pg8::EpiSwi, pg8::MoeGuOrder, true, true, true>(F.tid, F.lds + RING_OFF, (const char*)XB, DM / 2, S, E);
                }
                SEAM();
                if (ACTIVE) REP(7) { Frame F = fresh(F0);
                    moe_tables(F);
                    const int Tm = ((LAS int*)(F.lds + LDSCTL_OFF + 1200))[8]; const int tlo = r * RT; int nMr = Tm - tlo; nMr = nMr < 0 ? 0 : (nMr > RT ? RT : nMr);
                    pg8::MoeDnOrder S; S.init_tiles(nMr, DM / 256, F.G, (int)(F.G % 8 == 0 ? (F.vcu % (F.G / 8)) * 8 + F.vcu / (F.G / 8) : F.vcu)); S.texp = (const LAS int*)(F.lds + LDSCTL_OFF); S.tlo = tlo;
                    S.W = (const char*)(WSP(unsigned char, WS_WFF) + (size_t)2 * DFE * DM); S.estride = (size_t)3 * DFE * DM;
                    pg8::EpiMoeDown E{WSP(bf16, WS_YD), WSP(float, WS_ROWGATE), tlo};
                    pg8::gemm_phase<pg8::EpiMoeDown, pg8::MoeDnOrder, true, true, true>(F.tid, F.lds + RING_OFF, (const char*)WSP(unsigned char, WS_H), DFE / 2, S, E);
                }
                SEAM();
            }
            if (ACTIVE) { REP(10) { Frame F = fresh(F0); p_comb(F, l); } if (l + 1 < DEPTH) REP(8) { Frame F = fresh(F0); convert_weights(F, l + 1); } }
            SEAM();
        }
    }
#undef ACTIVE
#undef SEAM
}

#ifndef MK_MULTI
#define MK_MULTI 0
#endif
extern "C" void kernel_launch(void* const* d_in, const int* in_sizes, int n_in, void* d_out, int out_size, void* d_ws, size_t ws_size, hipStream_t stream) {
    static int grid = 0;
    if (grid == 0) {
        if (n_in != 20 || in_sizes[0] != M * DM || out_size != M * DM || ws_size < WS_END) { fprintf(stderr, "kernel_launch: unexpected shapes (n_in %d, in0 %d, out %d, ws %zu, need %zu); nothing launched\n", n_in, n_in > 0 ? in_sizes[0] : -1, out_size, ws_size, (size_t)WS_END); grid = -1; return; }
        int dev = 0, cus = 0, per_cu = 0;
        if (hipGetDevice(&dev) != hipSuccess || hipDeviceGetAttribute(&cus, hipDeviceAttributeMultiprocessorCount, dev) != hipSuccess) { grid = -1; return; }
        if (hipFuncSetAttribute((const void*)fwd_kernel, hipFuncAttributeMaxDynamicSharedMemorySize, LDS_BYTES) != hipSuccess) { fprintf(stderr, "kernel_launch: hipFuncSetAttribute failed\n"); grid = -1; return; }
        if (hipOccupancyMaxActiveBlocksPerMultiprocessor(&per_cu, (const void*)fwd_kernel, NTHR, LDS_BYTES) != hipSuccess || per_cu < 1) fprintf(stderr, "kernel_launch: occupancy query reports %d\n", per_cu);
        (void)hipGetLastError();
        grid = cus;
        if (grid != 256) { fprintf(stderr, "kernel_launch: built for 256 CUs, device has %d; nothing launched\n", cus); grid = -1; return; }
    }
    if (grid < 0) return;
    if (hipMemsetAsync((char*)d_ws + WS_CTL, 0, CTL_ZERO_BYTES, stream) != hipSuccess) return;
    Args a{};
    for (int i = 0; i < 20; ++i) a.in[i] = (const float*)d_in[i];
    a.out = (float*)d_out; a.ws = (unsigned char*)d_ws;
#if MK_MULTI
    for (int s = 0; s < N_SEG; ++s) { a.seg_lo = s; a.seg_hi = s + 1; hipLaunchKernelGGL(fwd_kernel, dim3(grid), dim3(NTHR), LDS_BYTES, stream, a); }
#else
    a.seg_lo = 0; a.seg_hi = N_SEG;
    hipLaunchKernelGGL(fwd_kernel, dim3(grid), dim3(NTHR), LDS_BYTES, stream, a);
#endif
    const hipError_t le = hipPeekAtLastError();
    if (le != hipSuccess) fprintf(stderr, "kernel_launch: launch failed: %s\n", hipGetErrorName(le));
}
```

```cpp
#include <hip/hip_runtime.h>
#include <cstdio>
#include <cstdint>

#define GAS __attribute__((address_space(1)))
#define LAS __attribute__((address_space(3)))
#define CAS __attribute__((address_space(4)))
typedef unsigned short bf16;
typedef short bf16x8 __attribute__((ext_vector_type(8)));
typedef short s16x4 __attribute__((ext_vector_type(4)));
typedef float f32x2 __attribute__((ext_vector_type(2)));
typedef float f32x4 __attribute__((ext_vector_type(4)));
typedef float f32x16 __attribute__((ext_vector_type(16)));
typedef unsigned u32x2 __attribute__((ext_vector_type(2)));
typedef unsigned u32x4 __attribute__((ext_vector_type(4)));
typedef int i32x8 __attribute__((ext_vector_type(8)));

#ifndef PROBE_MASK
#define PROBE_MASK 0
#endif
constexpr int BATCH = 8, SEQ = 4096, DM = 1024, M = BATCH * SEQ, DEPTH = 4;
constexpr int AW = 512, NH = 8, HD = 64, CCH = 512, CK = 31;
constexpr int IN_COLS = 3144, NIN = 3328;
constexpr int OFF_KI = 2048, OFF_WI = 2112, OFF_GLU = 2120;
constexpr int DFF = 2816, DFE = 3584, NE = 8;
constexpr int TOPK = 256;
constexpr float DN_ALPHA = 1.6817928305074290f;
constexpr float LN_EPS = 1e-5f;
constexpr float LOG2E = 1.4426950408889634f;
constexpr float QSCALE = 0.125f * LOG2E;
constexpr int NWAVES = 8, NTHR = 512;
constexpr int MAXT = 272, RT = 272;

constexpr size_t MiB = 1u << 20;
constexpr size_t WS_CTL = 0, CTL_ZERO_BYTES = 1 * MiB;
constexpr size_t WS_WIN = 1 * MiB, WS_WOUT = 8 * MiB, WS_WFF = 10 * MiB;
constexpr size_t WS_R1 = 178 * MiB, WS_XB = 306 * MiB, WS_A = 370 * MiB;
constexpr size_t WS_Q = WS_A, WS_K = WS_A + 32 * MiB, WS_V = WS_A + 64 * MiB, WS_QI = WS_A + 96 * MiB, WS_KI = WS_A + 128 * MiB, WS_WI = WS_A + 132 * MiB,
                 WS_U = WS_A + 133 * MiB, WS_MIX = WS_A + 165 * MiB, WS_H = WS_A;
constexpr size_t WS_YD = 616 * MiB, WS_ROUTE = 752 * MiB, WS_ROWLIST = WS_ROUTE + 512 * 1024, WS_ROWGATE = WS_ROWLIST + 320 * 1024, WS_SLOTROW = WS_ROWGATE + 320 * 1024,
                 WS_CNTWG = WS_SLOTROW + 256 * 1024, WS_MASK = 754 * MiB, WS_XQ = 820 * MiB, WS_END = 852 * MiB;
static_assert((size_t)RT * 256 * DFE <= 246 * MiB && (size_t)M * DFF <= 246 * MiB, "H overlay (fp8)");
static_assert((size_t)MAXT * 256 * DM * 2 <= 136 * MiB, "Yd");
static_assert(WS_CNTWG + 8192 <= WS_MASK && WS_MASK + (size_t)DEPTH * BATCH * 128 * 4096 * 4 <= WS_XQ, "route / masks");
constexpr int CW_BAR = 4096;

constexpr int RING_OFF = 0, RING_BYTES = 131072;
constexpr int AUX_OFF = 131072, AUX_BYTES = 26624;
constexpr int LDSCTL_OFF = AUX_OFF + AUX_BYTES, MISC_OFF = LDSCTL_OFF + 2048;
constexpr int LDS_BYTES = 157 * 1024;
static_assert(MISC_OFF + 128 <= LDS_BYTES, "LDS map");

__device__ __forceinline__ unsigned cvt_pk_bf16(float lo, float hi) { unsigned r; asm volatile("v_cvt_pk_bf16_f32 %0, %1, %2" : "=v"(r) : "v"(lo), "v"(hi)); return r; }
__device__ __forceinline__ float bf2f(unsigned short b) { return __uint_as_float((unsigned)b << 16); }
__device__ __forceinline__ float fsigmoid(float x) { return __builtin_amdgcn_rcpf(1.0f + __builtin_amdgcn_exp2f(-x * LOG2E)); }
#define LDS_WAIT() asm volatile("s_waitcnt lgkmcnt(0)" ::: "memory")
#define VM_WAIT() asm volatile("s_waitcnt vmcnt(0)" ::: "memory")

namespace pg8 {
constexpr int BM = 256, BK = 64, HALF = 128, HTB = HALF * BK * 2, STAGE_BYTES = 8 * HTB, NXCD = 8, WGM = 8;
__host__ __device__ __forceinline__ int lds_byte(int r, int c) { const int st = (r >> 4) * 2 + (c >> 5), rr = r & 15, cc = c & 31, ob = rr * 64 + cc * 2; return st * 1024 + (ob ^ (((ob >> 9) & 1) << 5)); }
__host__ __device__ __forceinline__ void stage_rc(int b, int& R, int& C) { const int st = b / 1024, sb = b % 1024, swz = sb ^ (((sb >> 9) & 1) << 5); R = (st >> 1) * 16 + swz / 64; C = (st & 1) * 32 + (swz % 64) / 2; }
__host__ __device__ __forceinline__ int perm32(int rho) { const int n = rho >> 4, i = rho & 15; return 8 * (i >> 2) + 4 * n + (i & 3); }
struct Unit { int pm, pn; };

struct OrderBase {
    int nM, nN, nwg, G, c;
    __device__ __forceinline__ void init_tiles(int nM_, int nN_, int G_, int c_) { nM = nM_; nN = nN_; nwg = nM * nN; G = G_; c = c_; }
    __device__ __forceinline__ bool next(int i, Unit& u) const { const long L = (long)i * G + c; if (L >= nwg) return false; unit_of((int)L, u); return true; }
    __device__ __forceinline__ void unit_of(int L, Unit& u) const {
        int wgid = L; { const int q = nwg / NXCD, r = nwg % NXCD, xcd = wgid % NXCD, off = wgid / NXCD; wgid = (xcd < r ? xcd * (q + 1) : r * (q + 1) + (xcd - r) * q) + off; }
        const int nig = WGM * nN, gid = wgid / nig, fm = gid * WGM, gsz = (nM - fm) < WGM ? (nM - fm) : WGM;
        u.pm = fm + ((wgid % nig) % gsz); u.pn = (wgid % nig) / gsz;
    }
    __device__ __forceinline__ void a_ready(const Unit&) const {}
    __device__ __forceinline__ void done(const Unit&) const {}
};
struct DenseOrder : OrderBase {
    static constexpr bool GATHER = false;
    const char* Bt; int K;
    __device__ __forceinline__ size_t a_base(const Unit& u) const { return (size_t)u.pm * ((size_t)BM * K * 2); }
    __device__ __forceinline__ unsigned a_off(const Unit&, int) const { return 0u; }
    __device__ __forceinline__ const char* b_base(const Unit& u) const { return Bt + (size_t)u.pn * ((size_t)BM * K * 2); }
};

struct DenseOrderG : OrderBase {
    static constexpr bool GATHER = true;
    const char* Bt; int K;
    __device__ __forceinline__ size_t a_base(const Unit&) const { return 0; }
    __device__ __forceinline__ unsigned a_off(const Unit& u, int r) const { return (unsigned)(u.pm * BM + r) * (unsigned)(K * 2); }
    __device__ __forceinline__ const char* b_base(const Unit& u) const { return Bt + (size_t)u.pn * ((size_t)BM * K * 2); }
};

template <class Epi, class Sched, bool ALIGN_EPI, bool SP2, bool F8 = false>
__device__ __forceinline__ void gemm_phase(const int tid, LAS unsigned char* lds, const char* Abase, const int K, const Sched& S, const Epi& E) {
    const int wid = __builtin_amdgcn_readfirstlane(tid >> 6), lane = tid & 63, wr = wid >> 2, wc = wid & 3, fr = lane & 15, fq = lane >> 4;
    const int nt = K / BK;
    constexpr bool GATHER = Sched::GATHER;
    unsigned voffA[2], voffB[2];
#pragma unroll
    for (int i = 0; i < 2; ++i) { int R, C; stage_rc(tid * 16 + i * 8192, R, C); const int Rb = Epi::PERM ? ((R & ~31) + perm32(R & 31)) : R;
        voffA[i] = GATHER ? (unsigned)C * 2u : (unsigned)(R * K + C) * 2u; voffB[i] = (unsigned)(Rb * K + C) * 2u; }
    const size_t kstep = (size_t)(BK * 2);
    const size_t hstep = (size_t)HALF * K * 2;
    const unsigned ldsw = (unsigned)wid * 1024u;
    const int aoff = lds_byte(wr * 64 + fr, fq * 8), boff = lds_byte(wc * 32 + fr, fq * 8);
#define PG8_SA(b, h) (((b) * 2 + (h)) * HTB)
#define PG8_SB(b, h) ((4 + (b) * 2 + (h)) * HTB)
#define PG8_STAGE(bufoff, gbase, voff) do { _Pragma("unroll") for (int _i = 0; _i < 2; ++_i) \
        __builtin_amdgcn_global_load_lds((const unsigned*)((const char*)(gbase) + (voff)[_i]), (LAS unsigned*)(lds + (bufoff) + ldsw + _i * 8192), 16, 0, 0); } while (0)
typedef int i32x4_t __attribute__((ext_vector_type(4)));
#define PG8_LDA(dst, b, h) do { _Pragma("unroll") for (int m = 0; m < 4; ++m) { if constexpr (F8) { dst[m].lo = *(const LAS i32x4_t*)(lds + PG8_SA(b, h) + aoff + m * 2048); dst[m].hi = *(const LAS i32x4_t*)(lds + PG8_SA(b, h) + aoff + m * 2048 + 1024); } \
        else { _Pragma("unroll") for (int k = 0; k < 2; ++k) dst##b16[m][k] = *(const LAS bf16x8*)(lds + PG8_SA(b, h) + aoff + m * 2048 + k * 1024); } } } while (0)
#define PG8_LDB(dst, b, h) do { _Pragma("unroll") for (int n = 0; n < 2; ++n) { if constexpr (F8) { dst[n].lo = *(const LAS i32x4_t*)(lds + PG8_SB(b, h) + boff + n * 2048); dst[n].hi = *(const LAS i32x4_t*)(lds + PG8_SB(b, h) + boff + n * 2048 + 1024); } \
        else { _Pragma("unroll") for (int k = 0; k < 2; ++k) dst##b16[n][k] = *(const LAS bf16x8*)(lds + PG8_SB(b, h) + boff + n * 2048 + k * 1024); } } } while (0)
#define PG8_MMA(ai, bj, At, Bt) do { __builtin_amdgcn_s_setprio(1); _Pragma("unroll") for (int m = 0; m < 4; ++m) _Pragma("unroll") for (int n = 0; n < 2; ++n) { \
        if constexpr (F8) { acc[ai][bj][m][n] = __builtin_amdgcn_mfma_scale_f32_16x16x128_f8f6f4(Bt[n], At[m], acc[ai][bj][m][n], 0, 0, 0, 0x7f7f7f7f, 0, 0x7f7f7f7f); } \
        else { _Pragma("unroll") for (int k = 0; k < 2; ++k) acc[ai][bj][m][n] = __builtin_amdgcn_mfma_f32_16x16x32_bf16(Bt##b16[n][k], At##b16[m][k], acc[ai][bj][m][n], 0, 0, 0); } } __builtin_amdgcn_s_setprio(0); } while (0)
#define PG8_WAIT_V(n) asm volatile("s_waitcnt vmcnt(" #n ")" ::: "memory")
#define PG8_WAIT_L(n) asm volatile("s_waitcnt lgkmcnt(" #n ")" ::: "memory")
#define PG8_BAR __builtin_amdgcn_s_barrier()
#define PG8_SCHED __builtin_amdgcn_sched_barrier(0)
    Unit cur, nxt; int ui = 0;
    if (!S.next(0, cur)) return;
    f32x4 acc[2][2][4][2];
    { float z0 = 0.f; asm volatile("" : "+v"(z0));
#pragma unroll
    for (int a = 0; a < 2; ++a)
#pragma unroll
        for (int b = 0; b < 2; ++b)
#pragma unroll
            for (int m = 0; m < 4; ++m)
#pragma unroll
                for (int n = 0; n < 2; ++n) acc[a][b][m][n] = (f32x4){z0, z0, z0, z0}; }
    bf16x8 Atb16[F8 ? 1 : 4][2], B0b16[F8 ? 1 : 2][2], B1b16[F8 ? 1 : 2][2]; i32x8 At[F8 ? 4 : 1], B0[F8 ? 2 : 1], B1[F8 ? 2 : 1]; (void)Atb16; (void)B0b16; (void)B1b16; (void)At; (void)B0; (void)B1;
    unsigned cOff0[2], cOff1[2];
#define PG8_ROWS(u) do { if constexpr (GATHER) { _Pragma("unroll") for (int _i = 0; _i < 2; ++_i) { int R_, C_; stage_rc(tid * 16 + _i * 8192, R_, C_); cOff0[_i] = S.a_off(u, R_) + voffA[_i]; cOff1[_i] = S.a_off(u, HALF + R_) + voffA[_i]; } } } while (0)
#define PG8_STAGE_A(bufoff, h, ptr) do { if constexpr (GATHER) { if ((h) == 0) PG8_STAGE(bufoff, ptr, cOff0); else PG8_STAGE(bufoff, ptr, cOff1); } else { PG8_STAGE(bufoff, (ptr) + (h) * hstep, voffA); } } while (0)
    const char* cA = Abase; if constexpr (!GATHER) cA = Abase + S.a_base(cur);
    PG8_ROWS(cur);
    const char* cB = S.b_base(cur);
    S.a_ready(cur);
    {
        PG8_STAGE(PG8_SB(0, 0), cB, voffB); PG8_STAGE(PG8_SB(0, 1), cB + hstep, voffB); PG8_STAGE_A(PG8_SA(0, 0), 0, cA); PG8_STAGE_A(PG8_SA(0, 1), 1, cA);
        if (wr == 1) PG8_BAR;
        PG8_WAIT_V(2); PG8_BAR;
        PG8_STAGE(PG8_SB(1, 0), cB + kstep, voffB); PG8_STAGE_A(PG8_SA(1, 0), 0, cA + kstep); PG8_STAGE(PG8_SB(1, 1), cB + hstep + kstep, voffB);
        PG8_WAIT_V(6); PG8_BAR;
    }
    for (;;) {
        const bool has_next = S.next(ui + 1, nxt);
        unsigned nOff0[2] = {0u, 0u}, nOff1[2] = {0u, 0u};
        if constexpr (GATHER) { if (has_next) { _Pragma("unroll") for (int _i = 0; _i < 2; ++_i) { int R_, C_; stage_rc(tid * 16 + _i * 8192, R_, C_); nOff0[_i] = S.a_off(nxt, R_); nOff1[_i] = S.a_off(nxt, HALF + R_); } } }
        const char* nA = cA; if constexpr (!GATHER) { if (has_next) nA = Abase + S.a_base(nxt); }
        const char* nB = has_next ? S.b_base(nxt) : cB;
#pragma nounroll
        for (int t = 0; t < nt; t += 2) {
            const bool last = (t == nt - 2);
            const char* a1 = cA + (size_t)(t + 1) * kstep;
            const char* a2 = last ? nA : cA + (size_t)(t + 2) * kstep; const char* b2 = last ? nB : cB + (size_t)(t + 2) * kstep;
            const char* a3 = a2 + kstep; const char* b3 = b2 + kstep;
            if (last && has_next) S.a_ready(nxt);
            if constexpr (SP2) {
            PG8_LDB(B0, 0, 0); PG8_LDB(B1, 0, 1); PG8_SCHED; PG8_LDA(At, 0, 0); PG8_STAGE_A(PG8_SA(1, 1), 1, a1);
            if constexpr (GATHER) { if (last && has_next) { _Pragma("unroll") for (int _i = 0; _i < 2; ++_i) { cOff0[_i] = nOff0[_i] + voffA[_i]; cOff1[_i] = nOff1[_i] + voffA[_i]; } } }
            PG8_WAIT_V(8); PG8_WAIT_L(0); PG8_BAR; PG8_MMA(0, 0, At, B0); PG8_MMA(0, 1, At, B1); PG8_BAR; PG8_SCHED;
            PG8_LDA(At, 0, 1); PG8_STAGE(PG8_SB(0, 0), b2, voffB); PG8_STAGE(PG8_SB(0, 1), b2 + hstep, voffB); PG8_STAGE_A(PG8_SA(0, 0), 0, a2);
            PG8_WAIT_V(8); PG8_WAIT_L(0); PG8_BAR; PG8_MMA(1, 0, At, B0); PG8_MMA(1, 1, At, B1); PG8_BAR; PG8_SCHED;
            PG8_LDB(B0, 1, 0); PG8_LDB(B1, 1, 1); PG8_SCHED; PG8_LDA(At, 1, 0); PG8_STAGE_A(PG8_SA(0, 1), 1, a2);
            PG8_WAIT_V(8); PG8_WAIT_L(0); PG8_BAR; PG8_MMA(0, 0, At, B0); PG8_MMA(0, 1, At, B1); PG8_BAR; PG8_SCHED;
            PG8_LDA(At, 1, 1); PG8_STAGE(PG8_SB(1, 0), b3, voffB); PG8_STAGE(PG8_SB(1, 1), b3 + hstep, voffB); PG8_STAGE_A(PG8_SA(1, 0), 0, a3);
            PG8_WAIT_V(8); PG8_WAIT_L(0); PG8_BAR; PG8_MMA(1, 0, At, B0); PG8_MMA(1, 1, At, B1); PG8_BAR; PG8_SCHED;
            } else { static_assert(SP2, "only the two-super-phase loop is kept"); }
        }
        if constexpr (ALIGN_EPI) { if (wr == 0) PG8_BAR; }
        E(acc, cur, wr, wc, fr, fq); S.done(cur);
        if (!has_next) break;
        { float z0 = 0.f; asm volatile("" : "+v"(z0));
#pragma unroll
        for (int a = 0; a < 2; ++a)
#pragma unroll
            for (int b = 0; b < 2; ++b)
#pragma unroll
                for (int m = 0; m < 4; ++m)
#pragma unroll
                    for (int n = 0; n < 2; ++n) acc[a][b][m][n] = (f32x4){z0, z0, z0, z0}; }
        cur = nxt; cA = nA; cB = nB; ++ui;
        if constexpr (ALIGN_EPI) { if (wr == 1) PG8_BAR; }
    }
    PG8_WAIT_V(0);
    if constexpr (!ALIGN_EPI) { if (wr == 0) PG8_BAR; }
    PG8_BAR;
#undef PG8_SA
#undef PG8_SB
#undef PG8_STAGE
#undef PG8_STAGE_A
#undef PG8_ROWS
#undef PG8_LDA
#undef PG8_LDB
#undef PG8_MMA
#undef PG8_WAIT_V
#undef PG8_WAIT_L
#undef PG8_BAR
#undef PG8_SCHED
}
}

namespace pg8 {
__device__ __forceinline__ u32x4 pack8(const f32x4 v0, const f32x4 v1) { u32x4 w; w.x = cvt_pk_bf16(v0[0], v0[1]); w.y = cvt_pk_bf16(v0[2], v0[3]); w.z = cvt_pk_bf16(v1[0], v1[1]); w.w = cvt_pk_bf16(v1[2], v1[3]); return w; }

__device__ __forceinline__ unsigned pk4_fp8(float a, float b, float c, float d) {
    a = __builtin_amdgcn_fmed3f(a, -448.f, 448.f); b = __builtin_amdgcn_fmed3f(b, -448.f, 448.f); c = __builtin_amdgcn_fmed3f(c, -448.f, 448.f); d = __builtin_amdgcn_fmed3f(d, -448.f, 448.f);
    unsigned r = 0u; r = (unsigned)__builtin_amdgcn_cvt_pk_fp8_f32(a, b, (int)r, false); r = (unsigned)__builtin_amdgcn_cvt_pk_fp8_f32(c, d, (int)r, true); return r; }
__device__ __forceinline__ u32x2 pack8_fp8(const f32x4 v0, const f32x4 v1) { u32x2 w; w.x = pk4_fp8(v0[0], v0[1], v0[2], v0[3]); w.y = pk4_fp8(v1[0], v1[1], v1[2], v1[3]); return w; }
constexpr float F8_ASC = 16.f, F8_WGU = 64.f, F8_HSC = 8.f, F8_WDN = 256.f;
struct EpiIn {
    static constexpr bool PERM = true;
    bf16 *Q, *Kb, *V, *QI, *KI, *U; float* WI; int pn_off; float dsc; int glu_from;
    __device__ __forceinline__ void operator()(const f32x4 (&acc)[2][2][4][2], const Unit& u, int wr, int wc, int fr, int fq) const {
        const int row0 = u.pm * BM + wr * 64 + fr; const int pn = (u.pn >= glu_from) ? u.pn - glu_from + 9 : u.pn + pn_off;
        if (pn < 2 || (pn >= 6 && pn < 8)) {
            bf16* base = (pn < 2) ? Q : QI;
            const float sc = ((pn < 2) ? QSCALE : 1.0f) * dsc;
            const int col0 = (pn & 1) * 256 + wc * 32 + 8 * fq;
#pragma unroll
            for (int ai = 0; ai < 2; ++ai)
#pragma unroll
                for (int m = 0; m < 4; ++m) { bf16* rowp = base + (size_t)(row0 + ai * HALF + m * 16) * AW + col0;
#pragma unroll
                    for (int bj = 0; bj < 2; ++bj) *(u32x4*)(rowp + bj * HALF) = pack8(acc[ai][bj][m][0] * sc, acc[ai][bj][m][1] * sc); }
        } else if (pn < 6) {
            const bool isK = pn < 4; bf16* base = isK ? Kb : V;
#pragma unroll
            for (int ai = 0; ai < 2; ++ai)
#pragma unroll
                for (int m = 0; m < 4; ++m) { const int row = row0 + ai * HALF + m * 16, bb = row >> 12, t = row & 4095, tile = t >> 6, r = t & 63;
#pragma unroll
                    for (int bj = 0; bj < 2; ++bj) { const int col = (pn & 1) * 256 + bj * HALF + wc * 32 + 8 * fq, h = col >> 6, d = col & 63;
                        const size_t tb = ((size_t)((bb * NH + h) * 64 + tile)) * 4096;
                        const size_t off = isK ? tb + (d >> 3) * 512 + r * 8 : tb + (d >> 5) * 2048 + r * 32 + (d & 31);
                        *(u32x4*)(base + off) = pack8(acc[ai][bj][m][0] * dsc, acc[ai][bj][m][1] * dsc); } }
        } else if (pn == 8) {
#pragma unroll
            for (int ai = 0; ai < 2; ++ai)
#pragma unroll
                for (int m = 0; m < 4; ++m) { const size_t row = (size_t)(row0 + ai * HALF + m * 16);
                    if (wc < 2) { const int c8 = wc * 4 + fq;
                        *(u32x4*)(KI + (row >> 5) * 2048 + (c8 >> 1) * 512 + (c8 & 1) * 256 + (row & 31) * 8) = pack8(acc[ai][0][m][0] * dsc, acc[ai][0][m][1] * dsc); }
                    else if (wc == 2 && fq == 0) { *(f32x4*)(WI + row * 8) = acc[ai][0][m][0] * dsc; *(f32x4*)(WI + row * 8 + 4) = acc[ai][0][m][1] * dsc; } }
        } else {
            const int col0 = (pn - 9) * 128 + wc * 32 + 8 * fq;
#pragma unroll
            for (int ai = 0; ai < 2; ++ai)
#pragma unroll
                for (int m = 0; m < 4; ++m) { f32x4 o[2];
#pragma unroll
                    for (int n = 0; n < 2; ++n) { const f32x4 a = acc[ai][0][m][n], g = acc[ai][1][m][n];
#pragma unroll
                        for (int e = 0; e < 4; ++e) o[n][e] = a[e] * dsc * fsigmoid(g[e] * dsc); }
                    *(u32x4*)(U + (size_t)(row0 + ai * HALF + m * 16) * CCH + col0) = pack8(o[0], o[1]); }
        }
    }
};
struct EpiRes {
    static constexpr bool PERM = true;
    const bf16* base; bf16* out; float asc;
    __device__ __forceinline__ void operator()(const f32x4 (&acc)[2][2][4][2], const Unit& u, int wr, int wc, int fr, int fq) const {
        const int row0 = u.pm * BM + wr * 64 + fr, col0 = u.pn * BM + wc * 32 + 8 * fq;
#pragma unroll
        for (int ai = 0; ai < 2; ++ai) {
            u32x4 bsv[4][2];
#pragma unroll
            for (int m = 0; m < 4; ++m)
#pragma unroll
                for (int bj = 0; bj < 2; ++bj) bsv[m][bj] = __builtin_nontemporal_load((const u32x4*)(base + (size_t)(row0 + ai * HALF + m * 16) * DM + col0 + bj * HALF));
#pragma unroll
            for (int m = 0; m < 4; ++m) { const size_t off = (size_t)(row0 + ai * HALF + m * 16) * DM + col0;
#pragma unroll
                for (int bj = 0; bj < 2; ++bj) { const u32x4 bs = bsv[m][bj];
                    f32x4 b0, b1; b0[0] = __uint_as_float(bs.x << 16); b0[1] = __uint_as_float(bs.x & 0xffff0000u); b0[2] = __uint_as_float(bs.y << 16); b0[3] = __uint_as_float(bs.y & 0xffff0000u);
                    b1[0] = __uint_as_float(bs.z << 16); b1[1] = __uint_as_float(bs.z & 0xffff0000u); b1[2] = __uint_as_float(bs.w << 16); b1[3] = __uint_as_float(bs.w & 0xffff0000u);
                    *(u32x4*)(out + off + bj * HALF) = pack8(b0 * DN_ALPHA + acc[ai][bj][m][0] * asc, b1 * DN_ALPHA + acc[ai][bj][m][1] * asc); } }
        }
    }
};
struct EpiSwi {
    static constexpr bool PERM = true;
    unsigned char* H; int ldh;
    __device__ __forceinline__ void operator()(const f32x4 (&acc)[2][2][4][2], const Unit& u, int wr, int wc, int fr, int fq) const {
        const int row0 = u.pm * BM + wr * 64 + fr, col0 = u.pn * 128 + wc * 32 + 8 * fq;
        constexpr float ds = 1.0f / (F8_ASC * F8_WGU);
#pragma unroll
        for (int ai = 0; ai < 2; ++ai)
#pragma unroll
            for (int m = 0; m < 4; ++m) { f32x4 o[2];
#pragma unroll
                for (int n = 0; n < 2; ++n) { const f32x4 ga = acc[ai][0][m][n], ua = acc[ai][1][m][n];
#pragma unroll
                    for (int e = 0; e < 4; ++e) o[n][e] = (ga[e] * ua[e]) * ((ds * ds * F8_HSC) * __builtin_amdgcn_rcpf(1.0f + __builtin_amdgcn_exp2f(ga[e] * (-ds * LOG2E)))); }
                *(u32x2*)(H + (size_t)(row0 + ai * HALF + m * 16) * ldh + col0) = pack8_fp8(o[0], o[1]); }
    }
};
struct EpiMoeDown {
    static constexpr bool PERM = true;
    bf16* Yd; const float* rowgate; int tlo;
    __device__ __forceinline__ void operator()(const f32x4 (&acc)[2][2][4][2], const Unit& u, int wr, int wc, int fr, int fq) const {
        const int row0 = (tlo + u.pm) * BM + wr * 64 + fr, col0 = u.pn * BM + wc * 32 + 8 * fq;
#pragma unroll
        for (int ai = 0; ai < 2; ++ai)
#pragma unroll
            for (int m = 0; m < 4; ++m) { const int row = row0 + ai * HALF + m * 16; const float gt = rowgate[row] * (1.0f / (F8_HSC * F8_WDN)); bf16* rowp = Yd + (size_t)row * DM + col0;
#pragma unroll
                for (int bj = 0; bj < 2; ++bj) *(u32x4*)(rowp + bj * HALF) = pack8(acc[ai][bj][m][0] * gt, acc[ai][bj][m][1] * gt); }
    }
};
struct MoeGuOrder : OrderBase {
    static constexpr bool GATHER = true;
    const int* rowlist; const LAS int* texp; int tlo; const char* W; size_t estride;
    __device__ __forceinline__ size_t a_base(const Unit&) const { return 0; }
    __device__ __forceinline__ unsigned a_off(const Unit& u, int r) const { return (unsigned)rowlist[(tlo + u.pm) * BM + r] * (unsigned)DM; }
    __device__ __forceinline__ const char* b_base(const Unit& u) const { return W + (size_t)texp[tlo + u.pm] * estride + (size_t)u.pn * ((size_t)BM * DM); }
};
struct MoeDnOrder : OrderBase {
    static constexpr bool GATHER = true;
    const LAS int* texp; int tlo; const char* W; size_t estride;
    __device__ __forceinline__ size_t a_base(const Unit&) const { return 0; }
    __device__ __forceinline__ unsigned a_off(const Unit& u, int r) const { return (unsigned)(u.pm * BM + r) * (unsigned)DFE; }
    __device__ __forceinline__ const char* b_base(const Unit& u) const { return W + (size_t)texp[tlo + u.pm] * estride + (size_t)u.pn * ((size_t)BM * DFE); }
};
}

typedef GAS unsigned gu32;
#define RLX_AGENT __ATOMIC_RELAXED, __HIP_MEMORY_SCOPE_AGENT
#define XB_TMO      128
#define XB_XCNT(j)  (256  + 64 * (j))
#define XB_XSUB(j)  (1280 + 64 * (j))
#define XB_XGEN(j)  (2304 + 64 * (j))
#define XB_TOP      3328
#define XB_TOPGEN   3392
#define XCD_BAR_WORDS 3456
#define XB_SPIN_CAP (1u << 18)

__device__ __forceinline__ unsigned xb_ld(unsigned* p)              { return __hip_atomic_load(p, __ATOMIC_RELAXED, __HIP_MEMORY_SCOPE_AGENT); }
__device__ __forceinline__ unsigned xb_add(unsigned* p, unsigned v) { return __hip_atomic_fetch_add(p, v, __ATOMIC_RELAXED, __HIP_MEMORY_SCOPE_AGENT); }
__device__ __forceinline__ unsigned xb_xcc_id() { return (unsigned)__builtin_amdgcn_s_getreg((3 << 11) | 20) & 0xFu; }
#define XB_SPIN(cond, bar) do { unsigned _sp = 0; while (cond) { __builtin_amdgcn_s_sleep(1); \
    if ((++_sp & 255u) == 0u) { if (xb_ld(&(bar)[XB_TMO])) break; if (_sp > XB_SPIN_CAP) { atomicAdd(&(bar)[XB_TMO], 1u); break; } } } } while (0)

struct XcdBarrier {
    unsigned* bar; unsigned x;
    volatile LAS unsigned* st;
};
__device__ __forceinline__ XcdBarrier xcd_barrier_post(unsigned* bar, volatile LAS unsigned* st) {
    XcdBarrier b; b.bar = bar; b.x = xb_xcc_id(); b.st = st;
    if (threadIdx.x == 0) (void)xb_add(&bar[XB_XCNT(b.x)], 1u);
    return b;
}
__device__ __forceinline__ void xcd_barrier_complete(unsigned* bar, unsigned x, unsigned& nloc, unsigned& nx) {
    const unsigned G = gridDim.x * gridDim.y * gridDim.z;
    unsigned sum, cnt, mine, sp = 0u;
    for (;;) {
        sum = 0u; cnt = 0u; mine = 0u;
#pragma unroll
        for (unsigned j = 0; j < 16; ++j) { const unsigned c = xb_ld(&bar[XB_XCNT(j)]); sum += c; cnt += (c > 0u) ? 1u : 0u; mine = (j == x) ? c : mine; }
        if (sum == G) break;
        __builtin_amdgcn_s_sleep(1);
        if ((++sp & 255u) == 0u) { if (xb_ld(&bar[XB_TMO])) break; if (sp > XB_SPIN_CAP) { atomicAdd(&bar[XB_TMO], 1u); break; } }
    }
    nloc = mine > 0u ? mine : 1u; nx = cnt > 0u ? cnt : 1u;
}
__device__ __forceinline__ void xcd_barrier(const XcdBarrier& b) {
    asm volatile("s_waitcnt vmcnt(0)" ::: "memory");
    __syncthreads();
    if (threadIdx.x == 0) {
        unsigned* bar = b.bar;
        __builtin_amdgcn_s_waitcnt(0);
        unsigned nloc = b.st[0], nx = b.st[1];
        if (nloc == 0u) { xcd_barrier_complete(bar, b.x, nloc, nx); b.st[0] = nloc; b.st[1] = nx; }
        const unsigned old = xb_add(&bar[XB_XSUB(b.x)], 1u);
        const unsigned gen = old / nloc;
        if (old + 1u == (gen + 1u) * nloc) {
            __builtin_amdgcn_fence(__ATOMIC_RELEASE, "agent");
            asm volatile("s_waitcnt vmcnt(0)" ::: "memory");
            const unsigned og = xb_add(&bar[XB_TOP], 1u);
            const unsigned tg = og / nx;
            if (og + 1u == (tg + 1u) * nx) xb_add(&bar[XB_TOPGEN], 1u);
            else XB_SPIN(xb_ld(&bar[XB_TOPGEN]) == tg, bar);
            __builtin_amdgcn_fence(__ATOMIC_ACQUIRE, "agent");
            xb_add(&bar[XB_XGEN(b.x)], 1u);
            asm volatile("s_waitcnt vmcnt(0)" ::: "memory");
        } else {
            XB_SPIN(xb_ld(&bar[XB_XGEN(b.x)]) == gen, bar);
            __builtin_amdgcn_fence(__ATOMIC_ACQUIRE, "agent");
            asm volatile("s_waitcnt vmcnt(0)" ::: "memory");
        }
    }
    __syncthreads();
}

struct Frame {
    LAS unsigned char* lds;
    int tid, lane, wave, vcu, G;
    unsigned char* ws;
};
__device__ __forceinline__ const float* arg_in(int k) { return (const float*)*(const GAS float* const volatile CAS*)((const CAS char*)__builtin_amdgcn_kernarg_segment_ptr() + 8 * k); }
__device__ __forceinline__ float* arg_out() { return (float*)*(GAS float* const volatile CAS*)((const CAS char*)__builtin_amdgcn_kernarg_segment_ptr() + 160); }
#define WSP(T, off) ((T*)(F.ws + (off)))
__device__ __forceinline__ Frame fresh(const Frame& F0) {
    Frame F = F0; int wv = F0.wave, v = F0.vcu, g = F0.G; asm volatile("" : "+s"(wv), "+s"(v), "+s"(g)); F.wave = wv; F.vcu = v; F.G = g;
    int ln; asm volatile("v_mbcnt_lo_u32_b32 %0, -1, 0\n\tv_mbcnt_hi_u32_b32 %0, -1, %0" : "=v"(ln)); F.lane = ln; F.tid = wv * 64 + ln;
    GAS unsigned char* w = (GAS unsigned char*)F0.ws; asm volatile("" : "+s"(w)); F.ws = (unsigned char*)w;
    return F;
}

__device__ __forceinline__ float wave_sum(float v) {
#define WS_DPP(x, ctrl) __int_as_float(__builtin_amdgcn_update_dpp(0, __float_as_int(x), (ctrl), 0xf, 0xf, false))
    v += WS_DPP(v, 0xB1); v += WS_DPP(v, 0x4E); v += WS_DPP(v, 0x141); v += WS_DPP(v, 0x140);
#undef WS_DPP
    const float r0 = __int_as_float(__builtin_amdgcn_readlane(__float_as_int(v), 0)), r1 = __int_as_float(__builtin_amdgcn_readlane(__float_as_int(v), 16)),
                r2 = __int_as_float(__builtin_amdgcn_readlane(__float_as_int(v), 32)), r3 = __int_as_float(__builtin_amdgcn_readlane(__float_as_int(v), 48));
    return (r0 + r1) + (r2 + r3);
}

struct TrItem { const float* W; int ldw, c0, nv, k0; void* WT; int Kd, r0; float scale; bool fp8; };
__device__ __forceinline__ void tr_load(const TrItem& t, f32x4 (&v)[16], int lane) {
    const int n4 = 4 * (lane & 15); const int nc = n4 < t.nv ? n4 : 0;
    const float* src = t.W + (size_t)(t.k0 + (lane >> 4)) * t.ldw + t.c0 + nc;
#pragma unroll
    for (int i = 0; i < 16; ++i) v[i] = *(const f32x4*)(src + (size_t)(4 * i) * t.ldw);
}
__device__ __forceinline__ void tr_to_lds(const TrItem& t, const f32x4 (&v)[16], LAS float* scr, int lane) {
    const int n4 = 4 * (lane & 15); const float ok = n4 < t.nv ? 1.f : 0.f;
#pragma unroll
    for (int i = 0; i < 16; ++i) { LAS float* d = scr + (4 * i + (lane >> 4)) * 65 + n4; d[0] = v[i][0] * ok; d[1] = v[i][1] * ok; d[2] = v[i][2] * ok; d[3] = v[i][3] * ok; }
}
__device__ __forceinline__ void tr_from_lds(const TrItem& t, LAS float* scr, int lane) {
    LDS_WAIT(); asm volatile("" ::: "memory");
    const int c = lane & 7; const float scale = t.scale;
    if (t.fp8) {
#pragma unroll
        for (int j = 0; j < 8; ++j) { const int nn = (lane >> 3) + 8 * j; const LAS float* s = scr + (8 * c) * 65 + nn;
            u32x2 o; o.x = pg8::pk4_fp8(s[0 * 65] * scale, s[1 * 65] * scale, s[2 * 65] * scale, s[3 * 65] * scale); o.y = pg8::pk4_fp8(s[4 * 65] * scale, s[5 * 65] * scale, s[6 * 65] * scale, s[7 * 65] * scale);
            *(u32x2*)((unsigned char*)t.WT + (size_t)(t.r0 + nn) * t.Kd + t.k0 + 8 * c) = o; }
    } else {
#pragma unroll
        for (int j = 0; j < 8; ++j) { const int nn = (lane >> 3) + 8 * j; const LAS float* s = scr + (8 * c) * 65 + nn;
            u32x4 o; o.x = cvt_pk_bf16(s[0 * 65], s[1 * 65]); o.y = cvt_pk_bf16(s[2 * 65], s[3 * 65]); o.z = cvt_pk_bf16(s[4 * 65], s[5 * 65]); o.w = cvt_pk_bf16(s[6 * 65], s[7 * 65]);
            *(u32x4*)((bf16*)t.WT + (size_t)(t.r0 + nn) * t.Kd + t.k0 + 8 * c) = o; }
    }
    LDS_WAIT(); asm volatile("" ::: "memory");
}
template <class Dec> __device__ __forceinline__ void tr_loop(const Dec& dec, int nitems, int gw, int NGW, LAS float* scr, int lane) {
    int it = gw; if (it >= nitems) return;
    TrItem cur = dec(it); f32x4 v[16]; tr_load(cur, v, lane);
    for (;;) {
        tr_to_lds(cur, v, scr, lane);
        const int nx = it + NGW; const bool hn = nx < nitems;
        const TrItem nxt = dec(hn ? nx : it);
        tr_load(nxt, v, lane);
        tr_from_lds(cur, scr, lane);
        if (!hn) break;
        cur = nxt; it = nx;
    }
}

__device__ __forceinline__ void convert_weights(Frame& F, int l) {
    LAS float* scr = (LAS float*)(F.lds + RING_OFF + F.wave * 16640);
    const int gw = F.vcu * NWAVES + F.wave, NGW = F.G * NWAVES, lane = F.lane;
    bf16* WinT = WSP(bf16, WS_WIN); bf16* WoutT = WSP(bf16, WS_WOUT); unsigned char* Wff = WSP(unsigned char, WS_WFF);
    const float* w_in = arg_in(1) + (size_t)l * DM * IN_COLS;
    const float* w_out = arg_in(8) + (size_t)l * DM * DM;
    constexpr int I_IN = (NIN / 64) * 16, I_OUT = 16 * 16;
    tr_loop([=](int it) __attribute__((always_inline)) -> TrItem {
        if (it < I_IN) {
            const int nb = it >> 4, kb = it & 15; int c0 = 0, nv = 64;
            if (nb < 33) c0 = 64 * nb;
            else if (nb == 33) { c0 = OFF_WI; nv = 8; }
            else if (nb < 36) { nv = 0; }
            else { const int rr = 64 * (nb - 36), p = rr >> 8, w = rr & 255; c0 = (w < 128) ? (OFF_GLU + 128 * p + w) : (OFF_GLU + CCH + 128 * p + (w - 128)); }
            if (nb < 24) return TrItem{w_in, IN_COLS, c0, nv, 64 * kb, WinT, DM, 64 * nb, pg8::F8_WGU, true};
            if (nb >= 36) return TrItem{w_in, IN_COLS, c0, nv, 64 * kb, WinT, DM, 64 * (nb - 12), pg8::F8_WGU, true};
            return TrItem{w_in, IN_COLS, c0, nv, 64 * kb, WinT, DM, 64 * nb, 1.f, false};
        }
        const int r = it - I_IN, nb = r >> 4, kb = r & 15; return TrItem{w_out, DM, 64 * nb, 64, 64 * kb, WoutT, DM, 64 * nb, 1.f, false};
    }, I_IN + I_OUT, gw, NGW, scr, lane);
    if ((l & 1) == 0) {
        const int d = l >> 1;
        const float* wg = arg_in(13) + (size_t)d * DM * DFF; const float* wu = arg_in(14) + (size_t)d * DM * DFF; const float* wd = arg_in(15) + (size_t)d * DFF * DM;
        unsigned char* Wgu = Wff; unsigned char* Wdn = Wgu + (size_t)2 * DFF * DM;
        constexpr int I_GU = (2 * DFF / 64) * 16, I_DN = 16 * (DFF / 64);
        const ptrdiff_t dgu = wu - wg;
        tr_loop([=](int it) __attribute__((always_inline)) -> TrItem {
            if (it < I_GU) { const int nb = it >> 4, kb = it & 15, rr = 64 * nb, p = rr >> 8, w = rr & 255;
                return TrItem{wg + ((w < 128) ? (ptrdiff_t)0 : dgu), DFF, 128 * p + (w & 127), 64, 64 * kb, Wgu, DM, rr, pg8::F8_WGU, true}; }
            const int r = it - I_GU, nb = r / (DFF / 64), kb = r % (DFF / 64); return TrItem{wd, DM, 64 * nb, 64, 64 * kb, Wdn, DFF, 64 * nb, pg8::F8_WDN, true};
        }, I_GU + I_DN, gw, NGW, scr, lane);
    } else {
        const int d = l >> 1;
        constexpr int I_GU = (2 * DFE / 64) * 16, I_DN = 16 * (DFE / 64), I_E = I_GU + I_DN;
        const float* wg0 = arg_in(17) + (size_t)d * NE * DM * DFE; const float* wu0 = arg_in(18) + (size_t)d * NE * DM * DFE; const float* wd0 = arg_in(19) + (size_t)d * NE * DFE * DM;
        const ptrdiff_t dgu = wu0 - wg0;
        tr_loop([=](int it) __attribute__((always_inline)) -> TrItem {
            const int e = it / I_E, r0 = it % I_E;
            const float* wg = wg0 + (size_t)e * DM * DFE; const float* wd = wd0 + (size_t)e * DFE * DM;
            unsigned char* Wgu = Wff + (size_t)e * (3 * (size_t)DFE * DM); unsigned char* Wdn = Wgu + (size_t)2 * DFE * DM;
            if (r0 < I_GU) { const int nb = r0 >> 4, kb = r0 & 15, rr = 64 * nb, p = rr >> 8, w = rr & 255;
                return TrItem{wg + ((w < 128) ? (ptrdiff_t)0 : dgu), DFE, 128 * p + (w & 127), 64, 64 * kb, Wgu, DM, rr, pg8::F8_WGU, true}; }
            const int r = r0 - I_GU, nb = r / (DFE / 64), kb = r % (DFE / 64); return TrItem{wd, DM, 64 * nb, 64, 64 * kb, Wdn, DFE, 64 * nb, pg8::F8_WDN, true};
        }, NE * I_E, gw, NGW, scr, lane);
    }
}

__device__ __forceinline__ void cvt_x(Frame& F) {
    const float* x = arg_in(0); bf16* XB = WSP(bf16, WS_XB); unsigned char* XQ = WSP(unsigned char, WS_XQ);
    const int gw = F.vcu * NWAVES + F.wave, NGW = F.G * NWAVES;
    f32x4 vn[4];
    { const f32x4* xr = (const f32x4*)(x + (size_t)gw * DM) + F.lane;
#pragma unroll
      for (int j = 0; j < 4; ++j) vn[j] = xr[64 * j]; }
    for (int m = gw; m < M; m += NGW) {
        f32x4 v[4];
#pragma unroll
        for (int j = 0; j < 4; ++j) v[j] = vn[j];
        { const int mn = (m + NGW < M) ? m + NGW : m; const f32x4* xr = (const f32x4*)(x + (size_t)mn * DM) + F.lane;
#pragma unroll
          for (int j = 0; j < 4; ++j) vn[j] = xr[64 * j]; }
        u32x2* o = (u32x2*)(XB + (size_t)m * DM) + F.lane; unsigned* o8 = (unsigned*)(XQ + (size_t)m * DM) + F.lane;
#pragma unroll
        for (int j = 0; j < 4; ++j) { u32x2 w; w.x = cvt_pk_bf16(v[j][0], v[j][1]); w.y = cvt_pk_bf16(v[j][2], v[j][3]); o[64 * j] = w;
            o8[64 * j] = pg8::pk4_fp8(v[j][0] * pg8::F8_ASC, v[j][1] * pg8::F8_ASC, v[j][2] * pg8::F8_ASC, v[j][3] * pg8::F8_ASC); }
    }
}

__device__ __forceinline__ void ln_load(const bf16* row, f32x4 (&v)[4], int lane) {
#pragma unroll
    for (int j = 0; j < 4; ++j) { const u32x2 a = ((const u32x2*)row)[lane + 64 * j]; v[j][0] = __uint_as_float(a.x << 16); v[j][1] = __uint_as_float(a.x & 0xffff0000u); v[j][2] = __uint_as_float(a.y << 16); v[j][3] = __uint_as_float(a.y & 0xffff0000u); }
}
template <bool FP8OUT> __device__ __forceinline__ void ln_finish(f32x4 (&v)[4], const f32x4 (&g)[4], const f32x4 (&bb)[4], bf16* brow, unsigned char* qrow, float* frow, int lane) {
    float s = 0.f;
#pragma unroll
    for (int j = 0; j < 4; ++j) s += (v[j][0] + v[j][1]) + (v[j][2] + v[j][3]);
    const float mean = wave_sum(s) * (1.f / DM); float s2 = 0.f;
#pragma unroll
    for (int j = 0; j < 4; ++j) { v[j] = v[j] - mean; s2 += (v[j][0] * v[j][0] + v[j][1] * v[j][1]) + (v[j][2] * v[j][2] + v[j][3] * v[j][3]); }
    const float rstd = 1.f / sqrtf(wave_sum(s2) * (1.f / DM) + LN_EPS);
#pragma unroll
    for (int j = 0; j < 4; ++j) { v[j] = v[j] * rstd * g[j] + bb[j];
        { u32x2 w; w.x = cvt_pk_bf16(v[j][0], v[j][1]); w.y = cvt_pk_bf16(v[j][2], v[j][3]); ((u32x2*)brow)[lane + 64 * j] = w; }
        if constexpr (FP8OUT) { ((unsigned*)qrow)[lane + 64 * j] = pg8::pk4_fp8(v[j][0] * pg8::F8_ASC, v[j][1] * pg8::F8_ASC, v[j][2] * pg8::F8_ASC, v[j][3] * pg8::F8_ASC); }
        else { if (frow) ((f32x4*)frow)[lane + 64 * j] = v[j];
               if (qrow) ((unsigned*)qrow)[lane + 64 * j] = pg8::pk4_fp8(v[j][0] * pg8::F8_ASC, v[j][1] * pg8::F8_ASC, v[j][2] * pg8::F8_ASC, v[j][3] * pg8::F8_ASC); } }
}

__device__ __forceinline__ void p_ln1(Frame& F, int l) {
    bf16* R1 = WSP(bf16, WS_R1); bf16* XB = WSP(bf16, WS_XB);
    const bool moe = (l & 1) != 0;
    LAS int* cntL = (LAS int*)(F.lds + LDSCTL_OFF + 1152);
    if (F.tid < 8) cntL[F.tid] = 0;
    __syncthreads();
    f32x4 g[4], bb[4];
#pragma unroll
    for (int j = 0; j < 4; ++j) { g[j] = ((const f32x4*)(arg_in(9) + (size_t)l * DM))[F.lane + 64 * j]; bb[j] = ((const f32x4*)(arg_in(10) + (size_t)l * DM))[F.lane + 64 * j]; }
    const float* router = arg_in(16) + (size_t)(l >> 1) * DM * NE;
    u32x4* route = WSP(u32x4, WS_ROUTE);
    f32x4 vn[4]; ln_load(R1 + (size_t)(F.vcu * 128 + F.wave * 16) * DM, vn, F.lane);
    for (int i = 0; i < 16; ++i) {
        const int m = F.vcu * 128 + F.wave * 16 + i;
        f32x4 v[4];
#pragma unroll
        for (int j = 0; j < 4; ++j) v[j] = vn[j];
        if (i + 1 < 16) ln_load(R1 + (size_t)(m + 1) * DM, vn, F.lane);
        ln_finish<true>(v, g, bb, R1 + (size_t)m * DM, (unsigned char*)XB + (size_t)m * DM, nullptr, F.lane);
        if (moe) {
            float lg[8];
#pragma unroll
            for (int e = 0; e < 8; ++e) lg[e] = 0.f;
#pragma unroll
            for (int j = 0; j < 4; ++j)
#pragma unroll
                for (int c = 0; c < 4; ++c) { const float* rp = router + (size_t)(4 * F.lane + 256 * j + c) * NE; const f32x4 r0 = *(const f32x4*)rp, r1 = *(const f32x4*)(rp + 4); const float xv = v[j][c];
                    lg[0] += xv * r0[0]; lg[1] += xv * r0[1]; lg[2] += xv * r0[2]; lg[3] += xv * r0[3]; lg[4] += xv * r1[0]; lg[5] += xv * r1[1]; lg[6] += xv * r1[2]; lg[7] += xv * r1[3]; }
#pragma unroll
            for (int e = 0; e < 8; ++e) lg[e] = wave_sum(lg[e]);
            int e1 = 0; float v1 = lg[0];
#pragma unroll
            for (int e = 1; e < 8; ++e) if (lg[e] > v1) { v1 = lg[e]; e1 = e; }
            int e2 = -1; float v2 = -3.0e38f;
#pragma unroll
            for (int e = 0; e < 8; ++e) if (e != e1 && (e2 < 0 || lg[e] > v2)) { v2 = lg[e]; e2 = e; }
            const float g1 = 1.0f / (1.0f + __expf(v2 - v1)), g2 = 1.0f - g1;
            if (F.lane == 0) { u32x4 r; r.x = (unsigned)e1; r.y = (unsigned)e2; r.z = __float_as_uint(g1); r.w = __float_as_uint(g2); route[m] = r;
                __hip_atomic_fetch_add(cntL + e1, 1, __ATOMIC_RELAXED, __HIP_MEMORY_SCOPE_WORKGROUP); __hip_atomic_fetch_add(cntL + e2, 1, __ATOMIC_RELAXED, __HIP_MEMORY_SCOPE_WORKGROUP); }
        }
    }
    __syncthreads();
    if (moe && F.tid < 8) WSP(int, WS_CNTWG)[F.vcu * 8 + F.tid] = cntL[F.tid];
}

__device__ __forceinline__ void p_ln2(Frame& F, int l) {
    const bf16* R1 = WSP(bf16, WS_R1); bf16* XB = WSP(bf16, WS_XB); float* outp = (l == DEPTH - 1) ? arg_out() : nullptr;
    f32x4 g[4], bb[4];
#pragma unroll
    for (int j = 0; j < 4; ++j) { g[j] = ((const f32x4*)(arg_in(11) + (size_t)l * DM))[F.lane + 64 * j]; bb[j] = ((const f32x4*)(arg_in(12) + (size_t)l * DM))[F.lane + 64 * j]; }
    f32x4 vn[4]; ln_load(R1 + (size_t)(F.vcu * 128 + F.wave * 16) * DM, vn, F.lane);
    for (int i = 0; i < 16; ++i) {
        const int m = F.vcu * 128 + F.wave * 16 + i;
        f32x4 v[4];
#pragma unroll
        for (int j = 0; j < 4; ++j) v[j] = vn[j];
        if (i + 1 < 16) ln_load(R1 + (size_t)(m + 1) * DM, vn, F.lane);
        ln_finish<false>(v, g, bb, XB + (size_t)m * DM, WSP(unsigned char, WS_XQ) + (size_t)m * DM, outp ? outp + (size_t)m * DM : nullptr, F.lane);
    }
}

__device__ __forceinline__ void moe_tables(Frame& F) {
    LAS int* texp = (LAS int*)(F.lds + LDSCTL_OFF);
    LAS int* tot = (LAS int*)(F.lds + LDSCTL_OFF + 1088);
    LAS int* tbase = (LAS int*)(F.lds + LDSCTL_OFF + 1200);
    const int* cnt = WSP(int, WS_CNTWG);
    LAS int* tmp = (LAS int*)(F.lds + AUX_OFF);
    __syncthreads();
    if (F.tid < 256) { typedef int i32x4_ __attribute__((ext_vector_type(4))); const i32x4_ a = ((const i32x4_*)cnt)[2 * F.tid], b = ((const i32x4_*)cnt)[2 * F.tid + 1];
        *(LAS i32x4_*)(tmp + 8 * F.tid) = a; *(LAS i32x4_*)(tmp + 8 * F.tid + 4) = b; }
    __syncthreads();
    if (F.tid < 8) { int t = 0, off = 0; for (int w = 0; w < 256; ++w) { const int c = tmp[w * 8 + F.tid]; if (w < F.vcu) off += c; t += c; } tot[F.tid] = t; tot[8 + F.tid] = off; }
    __syncthreads();
    if (F.tid == 0) { int b = 0; for (int e = 0; e < 8; ++e) { tbase[e] = b; b += (tot[e] + 255) >> 8; } tbase[8] = b; }
    __syncthreads();
    if (F.tid < MAXT) { int e = 0;
#pragma unroll
        for (int j = 1; j < 8; ++j) e += (F.tid >= tbase[j]) ? 1 : 0;
        texp[F.tid] = e; }
    __syncthreads();
}

__device__ __forceinline__ void p_list(Frame& F) {
    moe_tables(F);
    LAS int* tot = (LAS int*)(F.lds + LDSCTL_OFF + 1088); LAS int* tbase = (LAS int*)(F.lds + LDSCTL_OFF + 1200);
    const u32x4* route = WSP(u32x4, WS_ROUTE);
    int* rowlist = WSP(int, WS_ROWLIST); float* rowgate = WSP(float, WS_ROWGATE); int* slotrow = WSP(int, WS_SLOTROW);
    if (F.wave == 0) {
        int run[8];
#pragma unroll
        for (int e = 0; e < 8; ++e) run[e] = tot[8 + e];
        for (int blk = 0; blk < 2; ++blk) {
            const int t = F.vcu * 128 + blk * 64 + F.lane; const u32x4 r = route[t]; const int e1 = (int)r.x, e2 = (int)r.y;
            int p1 = 0, p2 = 0;
            const unsigned long long lt = (1ull << F.lane) - 1ull;
#pragma unroll
            for (int e = 0; e < 8; ++e) { const unsigned long long mk = __ballot(e1 == e || e2 == e); const int rk = run[e] + __popcll(mk & lt); if (e1 == e) p1 = rk; if (e2 == e) p2 = rk; run[e] += __popcll(mk); }
            const int row1 = tbase[e1] * 256 + p1, row2 = tbase[e2] * 256 + p2;
            rowlist[row1] = t; rowgate[row1] = __uint_as_float(r.z); rowlist[row2] = t; rowgate[row2] = __uint_as_float(r.w);
            slotrow[2 * t] = row1; slotrow[2 * t + 1] = row2;
        }
    }
    if (F.vcu < 8) { const int e = F.vcu, mt = (tot[e] + 255) >> 8; for (int p = tot[e] + F.tid; p < mt * 256; p += NTHR) { rowlist[tbase[e] * 256 + p] = 0; rowgate[tbase[e] * 256 + p] = 0.f; } }
}

__device__ __forceinline__ void p_comb(Frame& F, int l) {
    const bf16* R1 = WSP(bf16, WS_R1); bf16* XB = WSP(bf16, WS_XB); const bf16* Yd = WSP(bf16, WS_YD); const int* slotrow = WSP(int, WS_SLOTROW); float* outp = (l == DEPTH - 1) ? arg_out() : nullptr;
    f32x4 g[4], bb[4];
#pragma unroll
    for (int j = 0; j < 4; ++j) { g[j] = ((const f32x4*)(arg_in(11) + (size_t)l * DM))[F.lane + 64 * j]; bb[j] = ((const f32x4*)(arg_in(12) + (size_t)l * DM))[F.lane + 64 * j]; }
    const int m0 = F.vcu * 128 + F.wave * 16;
    const int myslot = (F.lane < 32) ? slotrow[2 * m0 + F.lane] : 0;
    f32x4 xn[4], an[4], bn[4];
#define COMB_LOAD(i_) do { const int ra_ = __builtin_amdgcn_readlane(myslot, 2 * (i_)), rb_ = __builtin_amdgcn_readlane(myslot, 2 * (i_) + 1); \
        ln_load(R1 + (size_t)(m0 + (i_)) * DM, xn, F.lane); ln_load(Yd + (size_t)ra_ * DM, an, F.lane); ln_load(Yd + (size_t)rb_ * DM, bn, F.lane); } while (0)
    COMB_LOAD(0);
    for (int i = 0; i < 16; ++i) {
        const int m = m0 + i;
        f32x4 v[4];
#pragma unroll
        for (int j = 0; j < 4; ++j) v[j] = xn[j] * DN_ALPHA + (an[j] + bn[j]);
        if (i + 1 < 16) COMB_LOAD(i + 1);
        ln_finish<false>(v, g, bb, XB + (size_t)m * DM, WSP(unsigned char, WS_XQ) + (size_t)m * DM, outp ? outp + (size_t)m * DM : nullptr, F.lane);
    }
#undef COMB_LOAD
}

#define DPP_I(v, ctrl) __builtin_amdgcn_update_dpp(0, (v), (ctrl), 0xf, 0xf, false)
__device__ __forceinline__ int wave_isum(int v) {
    v += DPP_I(v, 0xB1); v += DPP_I(v, 0x4E); v += DPP_I(v, 0x141); v += DPP_I(v, 0x140);
    return __builtin_amdgcn_readlane(v, 0) + __builtin_amdgcn_readlane(v, 16) + __builtin_amdgcn_readlane(v, 32) + __builtin_amdgcn_readlane(v, 48);
}
#define DPP_F(v, ctrl) __int_as_float(__builtin_amdgcn_update_dpp(0, __float_as_int(v), (ctrl), 0xf, 0xf, false))
typedef unsigned short u16x2 __attribute__((__vector_size__(4)));
#define IDX_BAR() asm volatile("s_waitcnt lgkmcnt(0)\n\ts_barrier" ::: "memory")
__device__ __forceinline__ void p_idx(Frame& F, int l) {
    constexpr int QP = 16;
    LAS unsigned short* bins = (LAS unsigned short*)(F.lds + RING_OFF);
    LAS unsigned* hq = (LAS unsigned*)(F.lds + AUX_OFF);
    LAS unsigned* hist = (LAS unsigned*)(F.lds + AUX_OFF + 16384) + F.wave * 256;
    LAS int* ci = (LAS int*)(F.lds + AUX_OFF + 24576) + F.wave * 64;
    LAS float* wtab = (LAS float*)(F.lds + LDSCTL_OFF + 1280);
    LAS float* sqp = (LAS float*)(F.lds + LDSCTL_OFF + 1792);
    const bf16* QI = WSP(bf16, WS_QI); const bf16* KI = WSP(bf16, WS_KI); const float* WI = WSP(float, WS_WI);
    unsigned long long* maskQ = WSP(unsigned long long, WS_MASK);
    const int lane = F.lane, wave = F.wave, tid = F.tid, w = F.vcu;
    const int am = lane & 31, ahm = (am >> 2) & 1, arr = (am & 3) + 4 * (am >> 3), atl = 2 * ahm + (arr >> 3), ah = arr & 7, kg = lane >> 5, hi = lane >> 5, n = lane & 31;
    bf16x8 af[4][4]; float wreg = 0.f;
#define IDX_UNIT(s8_, qb32_, b_) do { const int ui_ = (s8_) >> 1; const int up_ = (ui_ == 0) ? w : (ui_ == 1) ? 511 - w : (ui_ == 2) ? 512 + w : 1023 - w; qb32_ = up_ >> 3; b_ = up_ & 7; } while (0)
#define IDX_LOADQ(s8_) do { int qb_, bb_; IDX_UNIT(s8_, qb_, bb_); const size_t r0_ = (size_t)bb_ * SEQ + qb_ * 32 + ((s8_) & 1) * QP; \
        _Pragma("unroll") for (int rt = 0; rt < 4; ++rt) _Pragma("unroll") for (int ks = 0; ks < 4; ++ks) af[rt][ks] = *(const bf16x8*)(QI + (r0_ + 4 * rt + atl) * AW + ah * 64 + ks * 16 + 8 * kg); \
        if (tid < 128) wreg = WI[(r0_ + (tid >> 3)) * 8 + (tid & 7)]; } while (0)
#define IDX_WTAB(par_) do { if (tid < 128) { wtab[tid] = wreg; float sm = wreg, sq2 = wreg * wreg; \
        sm += DPP_F(sm, 0xB1); sq2 += DPP_F(sq2, 0xB1); sm += DPP_F(sm, 0x4E); sq2 += DPP_F(sq2, 0x4E); sm += DPP_F(sm, 0x141); sq2 += DPP_F(sq2, 0x141); \
        if ((tid & 7) == 0) { const float a_ = 1.0f / (28.02f * sqrtf(sq2) + 1.0e-20f); sqp[32 * (par_) + 2 * (tid >> 3)] = a_; sqp[32 * (par_) + 2 * (tid >> 3) + 1] = 0.33333f - 3.19f * sm * a_; } } } while (0)
    IDX_LOADQ(0);
    IDX_WTAB(0);
    for (int i = tid; i < QP * 256; i += NTHR) hq[i] = 0u;
    IDX_BAR();
    for (int s8 = 0; s8 < 8; ++s8) {
        int qb32, b; IDX_UNIT(s8, qb32, b);
        const int sub = s8 & 1, c = qb32 >> 1, N = 64 * (c + 1), NT32 = 2 * (c + 1);
        const size_t rowb = (size_t)b * SEQ;
        const bool dosel = N > TOPK;
        for (int repA_ = 0; repA_ < (((PROBE_MASK) >> 12) & 1) + 1; ++repA_) {
            const int ntw = (NT32 - wave + 7) >> 3;
            constexpr int BT = 2; const int nbat = (ntw + BT - 1) / BT;
            bf16x8 b0[BT][4], b1[BT][4];
            const LAS float* sqc = sqp + 32 * (s8 & 1);
#define IDX_LOADB(dst, bb_) do { _Pragma("unroll") for (int u = 0; u < BT; ++u) { int j_ = wave + 8 * (BT * (bb_) + u); j_ = j_ < NT32 ? j_ : NT32 - 1; \
            _Pragma("unroll") for (int ks = 0; ks < 4; ++ks) dst[u][ks] = *(const bf16x8*)(KI + (rowb + 32 * j_) * 64 + ks * 512 + kg * 256 + n * 8); } } while (0)
#define IDX_RELU(x) __int_as_float(max(__float_as_int(x), 0))
#define IDX_COMP(src, bb_) do { _Pragma("unroll") for (int rp = 0; rp < 2; ++rp) { \
            f32x4 wq_[4][2];   \
            _Pragma("unroll") for (int rq = 0; rq < 4; ++rq) { const int qi_ = 4 * (2 * rp + (rq >> 1)) + 2 * hi + (rq & 1); const LAS f32x4* wp_ = (const LAS f32x4*)(wtab + qi_ * 8); wq_[rq][0] = wp_[0]; wq_[rq][1] = wp_[1]; } \
            _Pragma("unroll") for (int u = 0; u < BT; ++u) { const int j_ = wave + 8 * (BT * (bb_) + u); if (j_ < NT32) { f32x16 acc0 = {}, acc1 = {}; \
                _Pragma("unroll") for (int ks = 0; ks < 4; ++ks) { acc0 = __builtin_amdgcn_mfma_f32_32x32x16_bf16(af[2 * rp][ks], src[u][ks], acc0, 0, 0, 0); acc1 = __builtin_amdgcn_mfma_f32_32x32x16_bf16(af[2 * rp + 1][ks], src[u][ks], acc1, 0, 0, 0); } \
                _Pragma("unroll") for (int r2 = 0; r2 < 2; ++r2) { const int rt = 2 * rp + r2; const f32x16& ac_ = r2 ? acc1 : acc0; float t_[2]; \
                    _Pragma("unroll") for (int q = 0; q < 2; ++q) { const f32x4 w0_ = wq_[2 * r2 + q][0], w1_ = wq_[2 * r2 + q][1]; \
                        f32x2 s2_ = (f32x2){w0_[0], w0_[1]} * (f32x2){IDX_RELU(ac_[8 * q + 0]), IDX_RELU(ac_[8 * q + 1])}; \
                        s2_ = __builtin_elementwise_fma((f32x2){w0_[2], w0_[3]}, (f32x2){IDX_RELU(ac_[8 * q + 2]), IDX_RELU(ac_[8 * q + 3])}, s2_); \
                        s2_ = __builtin_elementwise_fma((f32x2){w1_[0], w1_[1]}, (f32x2){IDX_RELU(ac_[8 * q + 4]), IDX_RELU(ac_[8 * q + 5])}, s2_); \
                        s2_ = __builtin_elementwise_fma((f32x2){w1_[2], w1_[3]}, (f32x2){IDX_RELU(ac_[8 * q + 6]), IDX_RELU(ac_[8 * q + 7])}, s2_); \
                        const f32x2 mc_ = *(const LAS f32x2*)(sqc + 2 * (4 * rt + 2 * hi + q)); t_[q] = __builtin_fmaf(s2_[0] + s2_[1], mc_[0], mc_[1]); } \
                    const u16x2 pk_ = __builtin_amdgcn_cvt_pknorm_u16(t_[0], t_[1]); \
                    _Pragma("unroll") for (int q = 0; q < 2; ++q) { const int qi_ = 4 * rt + 2 * hi + q; const unsigned short ky_ = q ? pk_[1] : pk_[0]; bins[qi_ * 4096 + 32 * j_ + n] = ky_; \
                        if (dosel) __hip_atomic_fetch_add(hq + qi_ * 256 + ((unsigned)ky_ >> 8), 1u, __ATOMIC_RELAXED, __HIP_MEMORY_SCOPE_WORKGROUP); } } } } } } while (0)
            IDX_LOADB(b0, 0);
            for (int bb = 0; bb < nbat; bb += 2) {
                IDX_LOADB(b1, bb + 1);
                IDX_COMP(b0, bb);
                IDX_LOADB(b0, bb + 2);
                IDX_COMP(b1, bb + 1);
            }
#undef IDX_LOADB
#undef IDX_COMP
#undef IDX_RELU
        }
        if (s8 + 1 < 8) IDX_LOADQ(s8 + 1);
        IDX_BAR();
        for (int repB_ = 0; repB_ < (((PROBE_MASK) >> 13) & 1) + 1; ++repB_)
        for (int qq = 0; qq < 2; ++qq) {
            const int q = wave + 8 * qq;
            const int nch = (N + 511) >> 9;
            const LAS unsigned short* brow = bins + q * 4096;
            LAS unsigned char* st8 = (LAS unsigned char*)hist + 512 * qq;
            { unsigned z0 = 0u; asm volatile("" : "+v"(z0)); *(LAS u32x2*)(st8 + 8 * lane) = (u32x2){z0, z0}; }
#define IDX_SCAN(K, HD, TARGET) \
            int tl_ = 0; _Pragma("unroll") for (int i = 0; i < K; ++i) tl_ += HD[i]; \
            int P_ = tl_; P_ += DPP_I(P_, 0x111); P_ += DPP_I(P_, 0x112); P_ += DPP_I(P_, 0x114); P_ += DPP_I(P_, 0x118); \
            { const int R0 = __builtin_amdgcn_readlane(P_, 15), R1 = __builtin_amdgcn_readlane(P_, 31), R2 = __builtin_amdgcn_readlane(P_, 47); P_ += (lane >= 16 ? R0 : 0) + (lane >= 32 ? R1 : 0) + (lane >= 48 ? R2 : 0); } \
            const unsigned long long over_ = __ballot(P_ >= (TARGET)); const int Lc_ = over_ ? (int)__builtin_ctzll(over_) : 63; \
            int cumL_ = P_ - tl_, bsel_ = 0, cbv_ = 0; bool fnd_ = false; \
            _Pragma("unroll") for (int i = K - 1; i >= 0; --i) { if (!fnd_) { if (cumL_ + HD[i] >= (TARGET) || i == 0) { fnd_ = true; bsel_ = i; cbv_ = HD[i]; } else cumL_ += HD[i]; } } \
            Bs = K * (63 - Lc_) + __builtin_amdgcn_readlane(bsel_, Lc_); cb = __builtin_amdgcn_readlane(cbv_, Lc_); cumv = __builtin_amdgcn_readlane(cumL_, Lc_);
#define IDX_CODE(v, j) ((int)(((j) & 1) ? ((v)[(j) >> 1] >> 16) : ((v)[(j) >> 1] & 0xffffu)))
            int Bs = -1, cb = 0, need = 0, sh = 8; bool fast_ok = true;
            LAS unsigned* crow = hq + q * 256;
            if (dosel) {
                { const u32x4 h4 = *(const LAS u32x4*)(crow + 4 * (63 - lane)); const int hd4[4] = {(int)h4[0], (int)h4[1], (int)h4[2], (int)h4[3]};
                  int cumv; IDX_SCAN(4, hd4, TOPK)
                  need = TOPK - cumv; fast_ok = over_ != 0ull && need >= 1 && need <= cb; }
                if (fast_ok && cb > 64) {
                    { unsigned z0 = 0u; asm volatile("" : "+v"(z0)); *(LAS u32x4*)(crow + 4 * lane) = (u32x4){z0, z0, z0, z0}; }
                    for (int ch = 0; ch < nch; ++ch) { const u32x4 v = *(const LAS u32x4*)(brow + 512 * ch + 8 * lane); const bool okl = 512 * ch + 8 * lane < N;
#pragma unroll
                        for (int j = 0; j < 8; ++j) { const int kj = IDX_CODE(v, j); const bool m = okl && (kj >> 8) == Bs;
                            __hip_atomic_fetch_add(m ? crow + (kj & 255) : (LAS unsigned*)ci + lane, 1u, __ATOMIC_RELAXED, __HIP_MEMORY_SCOPE_WORKGROUP); } }
                    asm volatile("s_waitcnt lgkmcnt(0)" ::: "memory");
                    const u32x4 h4 = *(const LAS u32x4*)(crow + 4 * (63 - lane)); const int hd4[4] = {(int)h4[0], (int)h4[1], (int)h4[2], (int)h4[3]};
                    int nB, nC, nV; bool ok2;
                    { int Bs, cb, cumv; IDX_SCAN(4, hd4, need)
                      nB = Bs; nC = cb; nV = cumv; ok2 = over_ != 0ull; }
                    Bs = (Bs << 8) | nB; sh = 0; need -= nV; cb = nC;
                    fast_ok = ok2 && need >= 1 && need <= cb;
                }
                fast_ok = fast_ok && cb <= 64;
            }
#undef IDX_SCAN
            if (fast_ok) {
                int nc = 0;
                u32x4 vn = *(const LAS u32x4*)(brow + 8 * lane);
                for (int ch = 0; ch < nch; ++ch) { const u32x4 v = vn; const int e0 = 512 * ch + 8 * lane; const bool okl = e0 < N; unsigned byte = 0u;
                    if (ch + 1 < nch) vn = *(const LAS u32x4*)(brow + 512 * (ch + 1) + 8 * lane);
                    int bj[8], cl = 0;
#pragma unroll
                    for (int j = 0; j < 8; ++j) { bj[j] = okl ? (IDX_CODE(v, j) >> sh) : -2; cl += (bj[j] == Bs) ? 1 : 0; byte |= (unsigned)(Bs - bj[j]) >> 31 << j; }
                    int ps = cl;
                    ps += DPP_I(ps, 0x111); ps += DPP_I(ps, 0x112); ps += DPP_I(ps, 0x114); ps += DPP_I(ps, 0x118);
                    ps += __builtin_amdgcn_update_dpp(0, ps, 0x142, 0xa, 0xf, false); ps += __builtin_amdgcn_update_dpp(0, ps, 0x143, 0xc, 0xf, false);
                    int off = nc + ps - cl;
#pragma unroll
                    for (int j = 0; j < 8; ++j) { const bool eq = bj[j] == Bs; crow[eq ? off : 64 + lane] = (unsigned)((IDX_CODE(v, j) << 12) | (e0 + j)); off += eq ? 1 : 0; }
                    nc += __builtin_amdgcn_readlane(ps, 63);
                    st8[64 * ch + lane] = (unsigned char)byte; }
                if (dosel) {
                    asm volatile("s_waitcnt lgkmcnt(0)" ::: "memory");
                    const int mc = (lane < cb) ? (int)crow[lane] : 0; const int mord = (mc & ~4095) | (4095 - (mc & 4095)); int rank = 0;
                    for (int j = 0; j < cb; ++j) { const int oj = __builtin_amdgcn_readlane(mord, j); rank += (oj > mord) ? 1 : 0; }
                    if (lane < cb && rank < need) __hip_atomic_fetch_or((LAS unsigned*)st8 + ((mc & 4095) >> 5), 1u << (mc & 31), __ATOMIC_RELAXED, __HIP_MEMORY_SCOPE_WORKGROUP);
                }
            } else {
                int Tk = -1; unsigned Jx = 0xffffffffu;
                for (int bit = 15; bit >= 0; --bit) {
                    const int cand = Tk < 0 ? (1 << bit) : (Tk | (1 << bit)); int cl = 0;
                    for (int ch = 0; ch < nch; ++ch) { const u32x4 v = *(const LAS u32x4*)(brow + 512 * ch + 8 * lane); const int e0 = 512 * ch + 8 * lane;
#pragma unroll
                        for (int j = 0; j < 8; ++j) cl += (e0 < N && IDX_CODE(v, j) >= cand) ? 1 : 0; }
                    if (wave_isum(cl) >= TOPK) Tk = cand;
                }
                if (Tk < 0) Tk = 0;
                int cg = 0, ce = 0;
                for (int ch = 0; ch < nch; ++ch) { const u32x4 v = *(const LAS u32x4*)(brow + 512 * ch + 8 * lane); const int e0 = 512 * ch + 8 * lane;
#pragma unroll
                    for (int j = 0; j < 8; ++j) if (e0 < N) { cg += (IDX_CODE(v, j) > Tk) ? 1 : 0; ce += (IDX_CODE(v, j) == Tk) ? 1 : 0; } }
                const int nd = TOPK - wave_isum(cg), ceq = wave_isum(ce);
                if (ceq > nd) {
                    unsigned Jc = 0u;
                    for (int bit = 11; bit >= 0; --bit) {
                        const unsigned cj = Jc | (1u << bit); int cl = 0;
                        for (int ch = 0; ch < nch; ++ch) { const u32x4 v = *(const LAS u32x4*)(brow + 512 * ch + 8 * lane); const int e0 = 512 * ch + 8 * lane;
#pragma unroll
                            for (int j = 0; j < 8; ++j) cl += (e0 < N && IDX_CODE(v, j) == Tk && (unsigned)(e0 + j) < cj) ? 1 : 0; }
                        if (wave_isum(cl) < nd) Jc = cj;
                    }
                    Jx = Jc;
                }
                for (int ch = 0; ch < nch; ++ch) { const u32x4 v = *(const LAS u32x4*)(brow + 512 * ch + 8 * lane); const int e0 = 512 * ch + 8 * lane; unsigned byte = 0u;
#pragma unroll
                    for (int j = 0; j < 8; ++j) { const int kj = IDX_CODE(v, j); byte |= (unsigned)((kj > Tk || (kj == Tk && (unsigned)(e0 + j) <= Jx)) ? 1 : 0) << j; }
                    st8[64 * ch + lane] = (unsigned char)(e0 < N ? byte : 0u); }
            }
#undef IDX_CODE
            { unsigned z0 = 0u; asm volatile("" : "+v"(z0)); *(LAS u32x4*)(crow + 4 * lane) = (u32x4){z0, z0, z0, z0}; }
        }
        IDX_WTAB((s8 + 1) & 1);
        IDX_BAR();
        {
            const int tile = tid >> 3, w8 = tid & 7, NJw = 4 * ((qb32 >> 3) + 1);
            if (tile < NJw) {
#pragma unroll
                for (int qq = 0; qq < 2; ++qq) { const u32x2 mk = *(const LAS u32x2*)((const LAS unsigned*)(F.lds + AUX_OFF + 16384) + w8 * 256 + 128 * qq + 2 * tile);
                    maskQ[((size_t)(b * 128 + qb32) * 64 + tile) * 32 + QP * sub + 8 * qq + w8] = ((unsigned long long)mk.y << 32) | mk.x; } }
        }
    }
#undef IDX_UNIT
#undef IDX_LOADQ
#undef IDX_WTAB
#undef IDX_BAR
}

__device__ __forceinline__ void p_conv(Frame& F, int l) {
    LAS bf16* Ut = (LAS bf16*)(F.lds + RING_OFF);
    LAS float* Yt = (LAS float*)(F.lds + RING_OFF + 65536);
    const bf16* U = WSP(bf16, WS_U); bf16* MIX = WSP(bf16, WS_MIX);
    const float* cw = arg_in(2) + (size_t)l * CK * CCH; const int c = F.tid, lane = F.lane;
    float wj[CK];
#pragma unroll
    for (int j = 0; j < CK; ++j) wj[j] = cw[j * CCH + c];
    const float cb = arg_in(3)[l * CCH + c];
    f32x4 lg0 = *(const f32x4*)(arg_in(4) + l * CCH + 8 * lane), lg1 = *(const f32x4*)(arg_in(4) + l * CCH + 8 * lane + 4);
    f32x4 lb0 = *(const f32x4*)(arg_in(5) + l * CCH + 8 * lane), lb1 = *(const f32x4*)(arg_in(5) + l * CCH + 8 * lane + 4);
    f32x4 ms0 = *(const f32x4*)(arg_in(6) + l * DM + CCH + 8 * lane), ms1 = *(const f32x4*)(arg_in(6) + l * DM + CCH + 8 * lane + 4);
    u32x4 tp[8];
#define CONV_LOAD(it_) do { const int un_ = F.vcu + 256 * (it_), b_ = un_ >> 7, t0_ = (un_ & 127) * 32; \
        _Pragma("unroll") for (int k = 0; k < 8; ++k) { const int ch = F.tid + NTHR * k, r = ch >> 6, cc = ch & 63, t = t0_ - 30 + r; unsigned z0 = 0u; asm volatile("" : "+v"(z0)); tp[k] = (u32x4){z0, z0, z0, z0}; \
            if (ch < 62 * 64 && t >= 0) tp[k] = *(const u32x4*)(U + ((size_t)b_ * SEQ + t) * CCH + cc * 8); } } while (0)
    CONV_LOAD(0);
    for (int it = 0; it < 4; ++it) {
        const int unit = F.vcu + 256 * it, b = unit >> 7, tt0 = (unit & 127) * 32;
#pragma unroll
        for (int k = 0; k < 8; ++k) { const int ch = F.tid + NTHR * k, r = ch >> 6, cc = ch & 63; if (ch < 62 * 64) *(LAS u32x4*)(Ut + r * CCH + cc * 8) = tp[k]; }
        if (it + 1 < 4) CONV_LOAD(it + 1);
        __syncthreads();
        float acc[32], uu[62];
#pragma unroll
        for (int s = 0; s < 62; ++s) uu[s] = bf2f(Ut[s * CCH + c]);
#pragma unroll
        for (int tt = 0; tt < 32; ++tt) acc[tt] = cb;
#pragma unroll
        for (int j = 0; j < CK; ++j)
#pragma unroll
            for (int tt = 0; tt < 32; ++tt) acc[tt] = __builtin_fmaf(wj[j], uu[tt + j], acc[tt]);
#pragma unroll
        for (int tt = 0; tt < 32; ++tt) Yt[tt * CCH + c] = acc[tt];
        __syncthreads();
#pragma unroll
        for (int k = 0; k < 4; ++k) { const int tt = F.wave * 4 + k;
            f32x4 y0 = *(const LAS f32x4*)(Yt + tt * CCH + 8 * lane), y1 = *(const LAS f32x4*)(Yt + tt * CCH + 8 * lane + 4);
            const float mean = wave_sum((y0[0] + y0[1]) + (y0[2] + y0[3]) + (y1[0] + y1[1]) + (y1[2] + y1[3])) * (1.f / CCH);
            y0 = y0 - mean; y1 = y1 - mean;
            const float var = wave_sum((y0[0] * y0[0] + y0[1] * y0[1]) + (y0[2] * y0[2] + y0[3] * y0[3]) + (y1[0] * y1[0] + y1[1] * y1[1]) + (y1[2] * y1[2] + y1[3] * y1[3])) * (1.f / CCH);
            const float rstd = 1.f / sqrtf(var + LN_EPS);
            y0 = y0 * rstd * lg0 + lb0; y1 = y1 * rstd * lg1 + lb1;
#pragma unroll
            for (int e = 0; e < 4; ++e) { y0[e] = y0[e] * fsigmoid(y0[e]) * ms0[e]; y1[e] = y1[e] * fsigmoid(y1[e]) * ms1[e]; }
            *(u32x4*)(MIX + ((size_t)b * SEQ + tt0 + tt) * DM + CCH + 8 * lane) = pg8::pack8(y0, y1); }
        __syncthreads();
    }
#undef CONV_LOAD
}

namespace at {
constexpr int QBLK = 32, QB = 256, KVBLK = 64, NSLOT = 3, SLOTB = 8192;
constexpr int LDS_K = 0, LDS_V = NSLOT * SLOTB, LDS_WS = 2 * NSLOT * SLOTB, LDS_OST = LDS_WS + 8 * 64 * 4, LDS_BIAS = LDS_OST + 8 * 4096, LDS_END = LDS_BIAS + 1024;
static_assert(LDS_END <= RING_BYTES, "attention LDS");
constexpr float NEGV = -200.0f;
__device__ __forceinline__ int crow(int r, int hi) { return (r & 3) + 8 * (r >> 2) + 4 * hi; }
#define SBAR() __builtin_amdgcn_sched_barrier(0)
__device__ __forceinline__ void glds16(const void* gsrc, unsigned lds_dst) { unsigned keep;
    asm volatile("s_mov_b32 %0, m0\n\ts_mov_b32 m0, %2\n\ts_nop 0\n\tglobal_load_lds_dwordx4 %1, off\n\ts_mov_b32 m0, %0" : "=&s"(keep) : "v"(gsrc), "s"(lds_dst) : "memory"); }
__device__ __forceinline__ float max3f(float a, float b, float c) { float r; asm("v_max3_f32 %0, %1, %2, %3" : "=v"(r) : "v"(a), "v"(b), "v"(c)); return r; }
__device__ __forceinline__ float max2f(float a, float b) { float r; asm("v_max_f32_e32 %0, %1, %2" : "=v"(r) : "v"(a), "v"(b)); return r; }
__device__ __forceinline__ float fadd_s(float a, float b) { float r; asm("v_add_f32_e32 %0, %1, %2" : "=v"(r) : "v"(a), "v"(b)); return r; }
__device__ __forceinline__ float fsub_s(float a, float b) { float r; asm("v_sub_f32_e32 %0, %1, %2" : "=v"(r) : "v"(a), "v"(b)); return r; }
typedef float f32x2_t __attribute__((ext_vector_type(2))); typedef __bf16 bf16x2_t __attribute__((ext_vector_type(2)));
__device__ __forceinline__ unsigned cvtpk_s(float lo, float hi) { f32x2_t v = {lo, hi}; bf16x2_t b = __builtin_convertvector(v, bf16x2_t); return __builtin_bit_cast(unsigned, b); }
typedef LAS const char* lds_cptr;
typedef short v4i16_t __attribute__((ext_vector_type(4)));
__device__ __forceinline__ void kload8(bf16x8* kf, lds_cptr kp) {
    kf[0] = *(const LAS bf16x8*)(kp);        kf[1] = *(const LAS bf16x8*)(kp + 512);  kf[2] = *(const LAS bf16x8*)(kp + 2048); kf[3] = *(const LAS bf16x8*)(kp + 2560);
    kf[4] = *(const LAS bf16x8*)(kp + 4096); kf[5] = *(const LAS bf16x8*)(kp + 4608); kf[6] = *(const LAS bf16x8*)(kp + 6144); kf[7] = *(const LAS bf16x8*)(kp + 6656); }
__device__ __forceinline__ void kload2(bf16x8* kf, lds_cptr kp, int j) { kf[2 * j] = *(const LAS bf16x8*)(kp + j * 2048); kf[2 * j + 1] = *(const LAS bf16x8*)(kp + j * 2048 + 512); }
__device__ __forceinline__ s16x4 vtr(lds_cptr p) { return __builtin_bit_cast(s16x4, __builtin_amdgcn_ds_read_tr16_b64_v4i16((LAS v4i16_t*)p)); }
__device__ __forceinline__ float rowmax(const f32x16& p0, const f32x16& p1) {
    float a = max3f(p0[0], p0[1], p1[0]), b = max3f(p0[2], p0[3], p1[1]); a = max3f(a, p1[2], p1[3]);
#pragma unroll
    for (int r = 4; r < 16; r += 4) { a = max3f(a, p0[r], p0[r + 1]); b = max3f(b, p0[r + 2], p0[r + 3]); a = max3f(a, p1[r], p1[r + 1]); b = max3f(b, p1[r + 2], p1[r + 3]); }
    const float m = max2f(a, b);
    auto rr = __builtin_amdgcn_permlane32_swap(__float_as_uint(m), __float_as_uint(m), false, false);
    return max2f(__uint_as_float(rr[0]), __uint_as_float(rr[1]));
}
__device__ __forceinline__ void pv(f32x16* o, int vb, bf16x8 pa0, bf16x8 pa1, bf16x8 pa2, bf16x8 pa3) {
#pragma unroll
    for (int d0 = 0; d0 < 2; ++d0) { s16x4 lo[4], hi[4];
#pragma unroll
        for (int ks = 0; ks < 4; ++ks) {
            asm volatile("ds_read_b64_tr_b16 %0,%1 offset:%c2" : "=&v"(lo[ks]) : "v"(vb), "i"(d0 * 4096 + ks * 1024) : "memory");
            asm volatile("ds_read_b64_tr_b16 %0,%1 offset:%c2" : "=&v"(hi[ks]) : "v"(vb), "i"(d0 * 4096 + ks * 1024 + 512) : "memory"); }
        asm volatile("s_waitcnt lgkmcnt(0)" ::: "memory"); SBAR();
#define AT_PK(k) (bf16x8){lo[k][0], lo[k][1], lo[k][2], lo[k][3], hi[k][0], hi[k][1], hi[k][2], hi[k][3]}
        o[d0] = __builtin_amdgcn_mfma_f32_32x32x16_bf16(pa0, AT_PK(0), o[d0], 0, 0, 0);
        o[d0] = __builtin_amdgcn_mfma_f32_32x32x16_bf16(pa1, AT_PK(1), o[d0], 0, 0, 0);
        o[d0] = __builtin_amdgcn_mfma_f32_32x32x16_bf16(pa2, AT_PK(2), o[d0], 0, 0, 0);
        o[d0] = __builtin_amdgcn_mfma_f32_32x32x16_bf16(pa3, AT_PK(3), o[d0], 0, 0, 0);
#undef AT_PK
    }
}
template <int THRL> __device__ __forceinline__ void attn_unit(int b, int h, int qb, const bf16* Q, const bf16* __restrict__ Kt, const bf16* __restrict__ Vt, const unsigned long long* maskQ,
                                                              bf16* MIX, float ms0, float ms1, LAS unsigned char* shm, int tid) {
    const int lane = tid & 63, r32 = lane & 31, hi = lane >> 5; const int wid = __builtin_amdgcn_readfirstlane(tid >> 6);
    const size_t rowbase = (size_t)b * SEQ; const int q0 = qb * QB, qw = q0 + wid * QBLK, cwv = qw >> 6;
    const bf16* Qw = Q + (rowbase + qw) * AW + h * HD;
    const unsigned lds0 = (unsigned)(uintptr_t)shm; const lds_cptr shm3 = (lds_cptr)shm;
    LAS float* wsf = (LAS float*)(shm + LDS_WS) + wid * 64;
    const LAS float* biasT = (const LAS float*)(shm + LDS_BIAS);
    const bf16* ksrc = Kt + ((size_t)(b * NH + h) * 64) * 4096 + wid * 512 + lane * 8;
    const bf16* vsrc = Vt + ((size_t)(b * NH + h) * 64) * 4096 + wid * 512 + lane * 8;
    const unsigned kdst = lds0 + LDS_K + wid * 1024, vdst = lds0 + LDS_V + wid * 1024;
#define DMA_K(t, slot) glds16(ksrc + (size_t)(t) * 4096, (unsigned)__builtin_amdgcn_readfirstlane(kdst + (slot)))
#define DMA_V(t, slot) glds16(vsrc + (size_t)(t) * 4096, (unsigned)__builtin_amdgcn_readfirstlane(vdst + (slot)))
    int r32m = r32; asm volatile("" : "+v"(r32m));
    const unsigned long long* mrow = maskQ + ((size_t)(b * 128 + (qw >> 5)) * 64) * 32 + r32m;
#define MLOAD(dst, t) dst = *(const GAS u32x2*)((const GAS unsigned long long*)mrow + (size_t)(t) * 32)
#define MLOAD_UNUSED(dst, t) dst = *(const u32x2*)(mrow + (size_t)(t) * 32)
#define WAIT_BAR(N, M) asm volatile("s_waitcnt vmcnt(" #N ") lgkmcnt(0)\n\ts_barrier" ::: "memory")
    const int vb0 = (int)(lds0 + LDS_V) + ((lane >> 4) & 1) * 32 + (lane & 3) * 8 + (4 * hi + ((lane & 15) >> 2)) * 64;
    bf16x8 kf[8];
    const lds_cptr kp0 = shm3 + LDS_K + hi * 1024 + r32 * 16; const lds_cptr vp0 = shm3 + LDS_V + ((lane >> 4) & 1) * 32 + (lane & 3) * 8 + (4 * hi + ((lane & 15) >> 2)) * 64;
    const int NT = (q0 + QB) / KVBLK;
    u32x2 mA, mB;
    MLOAD(mA, 0);
    DMA_K(0, 0); DMA_V(0, 0); DMA_K(1, SLOTB);
    const lds_cptr qp = shm3 + LDS_OST + wid * 4096 + hi * 512 + r32 * 16;
#pragma unroll
    for (int d0 = 0; d0 < 4; ++d0) { const bf16x8 qv = *(const bf16x8*)(Qw + (size_t)r32 * AW + d0 * 16 + hi * 8); *(LAS bf16x8*)(shm + LDS_OST + wid * 4096 + hi * 512 + r32 * 16 + d0 * 1024) = qv; }
#define QRD(d0) (*(const LAS bf16x8*)(qp + (d0) * 1024))
    float mhat = 0.f, l_reg = 0.f; f32x16 o[2]; o[0] = f32x16{}; o[1] = f32x16{}; f32x16 negm = f32x16{}; asm volatile("" : "+v"(negm));
#define MASKB(P0, P1, t, MW) do { \
        if (64 * (t) + 63 - qw >= -90 && (t) <= cwv) { const int bi_ = 64 * (t) - (qw + r32) + 128 + 4 * hi; \
            _Pragma("unroll") for (int r = 0; r < 16; ++r) { const int k0_ = (r & 3) + 8 * (r >> 2); int i0_ = bi_ + k0_; i0_ = i0_ < 0 ? 0 : i0_; int i1_ = bi_ + k0_ + 32; i1_ = i1_ < 0 ? 0 : i1_; P0[r] += biasT[i0_]; P1[r] += biasT[i1_]; } } \
        { const unsigned ml_ = MW.x >> (4 * hi), mh_ = MW.y >> (4 * hi); const unsigned nv_ = __float_as_uint(NEGV); \
            _Pragma("unroll") for (int r = 0; r < 16; ++r) { const unsigned s0_ = (unsigned)__builtin_amdgcn_sbfe((int)ml_, (r & 3) + 8 * (r >> 2), 1), s1_ = (unsigned)__builtin_amdgcn_sbfe((int)mh_, (r & 3) + 8 * (r >> 2), 1); \
                P0[r] = __uint_as_float((s0_ & __float_as_uint(P0[r])) | (~s0_ & nv_)); P1[r] = __uint_as_float((s1_ & __float_as_uint(P1[r])) | (~s1_ & nv_)); } } } while (0)
    bool resc = false;
#define START(P0, P1) do { const float rm = rowmax(P0, P1); resc = false; \
    { const float dl = rm; mhat = fadd_s(mhat, dl); \
      _Pragma("unroll") for (int r = 0; r < 16; ++r) { P0[r] = fsub_s(P0[r], dl); P1[r] = fsub_s(P1[r], dl); } \
      _Pragma("unroll") for (int r = 0; r < 16; ++r) negm[r] = -mhat; asm volatile("" : "+v"(negm)); } \
    _Pragma("unroll") for (int r = 0; r < 16; ++r) P0[r] = __builtin_amdgcn_exp2f(P0[r]); } while (0)
#define RESC() do { if (resc) { asm volatile("s_waitcnt lgkmcnt(0)" ::: "memory"); \
      _Pragma("unroll") for (int d_ = 0; d_ < 2; ++d_) _Pragma("unroll") for (int r = 0; r < 16; ++r) o[d_][r] *= wsf[crow(r, hi)]; } } while (0)
    f32x16 pA0, pA1, pB0, pB1;
    int sl_prev = 0, sl_cur = 0, sl_next = SLOTB;
#define ROT() do { sl_prev = sl_cur; sl_cur = sl_next; sl_next = (sl_next == (NSLOT - 1) * SLOTB) ? 0 : sl_next + SLOTB; } while (0)
    DMA_K(2, 2 * SLOTB);
    WAIT_BAR(3, mA);
    {
        const lds_cptr kb = kp0;
        pA0 = f32x16{}; pA1 = f32x16{};
#pragma unroll
        for (int d0 = 0; d0 < 4; ++d0) { const bf16x8 b0 = *(const LAS bf16x8*)(kb + d0 * 2048), b1 = *(const LAS bf16x8*)(kb + d0 * 2048 + 512);
            const bf16x8 qv = QRD(d0); pA0 = __builtin_amdgcn_mfma_f32_32x32x16_bf16(b0, qv, pA0, 0, 0, 0); pA1 = __builtin_amdgcn_mfma_f32_32x32x16_bf16(b1, qv, pA1, 0, 0, 0); }
        MASKB(pA0, pA1, 0, mA);
        asm volatile("s_nop 15\n\ts_nop 7" : "+v"(pA0), "+v"(pA1));
        START(pA0, pA1);
#pragma unroll
        for (int r = 0; r < 16; ++r) pA1[r] = __builtin_amdgcn_exp2f(pA1[r]);
    }
    WAIT_BAR(0, mA);
    MLOAD(mB, 1);
    DMA_K(3, 0); DMA_V(1, SLOTB);
    ROT();
    kload8(kf, kp0 + sl_cur);
    WAIT_BAR(2, mB);
    s16x4 vlo[8], vhi[8]; u32x4 pw0, pw1, pw2, pw3;
#define PKW(P, B) cvtpk_s(P[B], P[B + 1])
#define PAF(k) __builtin_bit_cast(bf16x8, pw##k)
#define VFR(i) (bf16x8){vlo[i][0], vlo[i][1], vlo[i][2], vlo[i][3], vhi[i][0], vhi[i][1], vhi[i][2], vhi[i][3]}
#define PIN(x) asm volatile("" : "+v"(x))
#define MX3(a, b, c) __builtin_fmaxf(__builtin_fmaxf((a), (b)), (c))
#define GAPA(MF, A0, A1, A2, A3, W0, W1, PW) do { MF; sacc += A0; sacc += A1; sacc += A2; sacc += A3; PIN(sacc); W0; W1; PIN(PW); SBAR(); } while (0)
#define EX(v) __builtin_amdgcn_exp2f(v)
#define GAPB(MF, X, B) do { MF; X[B] = EX(X[B]); X[B + 1] = EX(X[B + 1]); X[B + 2] = EX(X[B + 2]); X[B + 3] = EX(X[B + 3]); PIN(X); SBAR(); } while (0)
#define VRD(i) do { vlo[i] = vtr(vp_ + (((i) >> 2) * 4096 + ((i) & 3) * 1024)); vhi[i] = vtr(vp_ + (((i) >> 2) * 4096 + ((i) & 3) * 1024 + 512)); } while (0)
#define KRD(G, j) do { if (G) { kload2(kf, kp0 + sl_next, j); SBAR(); } } while (0)
#define STEP(C0, C1, P0, P1, t, MC, MN, GM, GK, GV, GL) do { SBAR(); \
    const lds_cptr vp_ = vp0 + sl_prev; \
    bf16x8 qa_ = QRD(0), qb_; VRD(0); SBAR(); float sacc = (P0[0] + P0[1]); \
    GAPA(C0 = __builtin_amdgcn_mfma_f32_32x32x16_bf16(kf[0], qa_, negm, 0, 0, 0), P0[2], P0[3], P0[4], P0[5],     pw0[0] = PKW(P0, 0), pw0[1] = PKW(P0, 2), pw0); \
    VRD(4); SBAR(); GAPA(C1 = __builtin_amdgcn_mfma_f32_32x32x16_bf16(kf[1], qa_, negm, 0, 0, 0), P0[6], P0[7], P0[8], P0[9],     pw0[2] = PKW(P0, 4), pw0[3] = PKW(P0, 6), pw0); \
    qb_ = QRD(1); VRD(1); SBAR(); GAPA(C0 = __builtin_amdgcn_mfma_f32_32x32x16_bf16(kf[2], qb_, C0, 0, 0, 0),   P0[10], P0[11], P0[12], P0[13], pw1[0] = PKW(P0, 8), pw1[1] = PKW(P0, 10), pw1); \
    VRD(5); SBAR(); GAPA(C1 = __builtin_amdgcn_mfma_f32_32x32x16_bf16(kf[3], qb_, C1, 0, 0, 0),   P0[14], P0[15], P1[0], P1[1],   pw1[2] = PKW(P0, 12), pw1[3] = PKW(P0, 14), pw1); \
    qa_ = QRD(2); VRD(2); SBAR(); GAPA(C0 = __builtin_amdgcn_mfma_f32_32x32x16_bf16(kf[4], qa_, C0, 0, 0, 0),   P1[2], P1[3], P1[4], P1[5],     pw2[0] = PKW(P1, 0), pw2[1] = PKW(P1, 2), pw2); \
    VRD(6); SBAR(); GAPA(C1 = __builtin_amdgcn_mfma_f32_32x32x16_bf16(kf[5], qa_, C1, 0, 0, 0),   P1[6], P1[7], P1[8], P1[9],     pw2[2] = PKW(P1, 4), pw2[3] = PKW(P1, 6), pw2); \
    qb_ = QRD(3); VRD(3); SBAR(); GAPA(C0 = __builtin_amdgcn_mfma_f32_32x32x16_bf16(kf[6], qb_, C0, 0, 0, 0),   P1[10], P1[11], P1[12], P1[13], pw3[0] = PKW(P1, 8), pw3[1] = PKW(P1, 10), pw3); \
    VRD(7); SBAR(); GAPA(C1 = __builtin_amdgcn_mfma_f32_32x32x16_bf16(kf[7], qb_, C1, 0, 0, 0),   P1[14], P1[15], 0.f, 0.f,       pw3[2] = PKW(P1, 12), pw3[3] = PKW(P1, 14), pw3); \
    l_reg += sacc; \
    MASKB(C0, C1, t, MC); \
    if (GM) { MLOAD(MN, (t) + 1); } if (GK) { DMA_K((t) + 3, sl_cur); } if (GV) { DMA_V((t) + 1, sl_next); } \
    { float a = MX3(C0[0], C0[1], C1[0]), b_ = MX3(C0[2], C0[3], C1[1]); a = MX3(a, C1[2], C1[3]); \
      _Pragma("unroll") for (int r = 4; r < 16; r += 4) { a = MX3(a, C0[r], C0[r + 1]); b_ = MX3(b_, C0[r + 2], C0[r + 3]); a = MX3(a, C1[r], C1[r + 1]); b_ = MX3(b_, C1[r + 2], C1[r + 3]); } \
      float rm = __builtin_fmaxf(a, b_); { auto rr = __builtin_amdgcn_permlane32_swap(__float_as_uint(rm), __float_as_uint(rm), false, false); rm = __builtin_fmaxf(__uint_as_float(rr[0]), __uint_as_float(rr[1])); } \
      resc = false; \
      if (__builtin_expect(__any(rm > (float)THRL), 0)) { const float dl = __builtin_fmaxf(rm, 0.f); mhat += dl; \
        _Pragma("unroll") for (int r = 0; r < 16; ++r) { C0[r] -= dl; C1[r] -= dl; } \
        _Pragma("unroll") for (int r = 0; r < 16; ++r) negm[r] = -mhat; asm volatile("" : "+v"(negm)); \
        const float f = __builtin_amdgcn_exp2f(-dl); l_reg *= f; if (hi == 0) wsf[r32] = f; resc = true; } } \
    SBAR(); \
    GAPB(o[0] = __builtin_amdgcn_mfma_f32_32x32x16_bf16(PAF(0), VFR(0), o[0], 0, 0, 0), C0, 0); \
    GAPB(o[1] = __builtin_amdgcn_mfma_f32_32x32x16_bf16(PAF(0), VFR(4), o[1], 0, 0, 0), C0, 4); \
    KRD(GL, 0); GAPB(o[0] = __builtin_amdgcn_mfma_f32_32x32x16_bf16(PAF(1), VFR(1), o[0], 0, 0, 0), C0, 8); \
    KRD(GL, 1); GAPB(o[1] = __builtin_amdgcn_mfma_f32_32x32x16_bf16(PAF(1), VFR(5), o[1], 0, 0, 0), C0, 12); \
    KRD(GL, 2); GAPB(o[0] = __builtin_amdgcn_mfma_f32_32x32x16_bf16(PAF(2), VFR(2), o[0], 0, 0, 0), C1, 0); \
    KRD(GL, 3); GAPB(o[1] = __builtin_amdgcn_mfma_f32_32x32x16_bf16(PAF(2), VFR(6), o[1], 0, 0, 0), C1, 4); \
    GAPB(o[0] = __builtin_amdgcn_mfma_f32_32x32x16_bf16(PAF(3), VFR(3), o[0], 0, 0, 0), C1, 8); \
    GAPB(o[1] = __builtin_amdgcn_mfma_f32_32x32x16_bf16(PAF(3), VFR(7), o[1], 0, 0, 0), C1, 12); \
    } while (0)
    int t = 1;
    for (; t + 5 < NT; t += 2) {
        STEP(pB0, pB1, pA0, pA1, t, mB, mA, true, true, true, true);       WAIT_BAR(2, mA); RESC(); ROT();
        STEP(pA0, pA1, pB0, pB1, t + 1, mA, mB, true, true, true, true);   WAIT_BAR(2, mB); RESC(); ROT();
    }
#define ENDW(tt, M) do { if ((tt) + 3 < NT) { WAIT_BAR(2, M); } else if ((tt) + 2 < NT) { WAIT_BAR(1, M); } else { WAIT_BAR(0, M); } } while (0)
    for (; t + 1 < NT; t += 2) {
        STEP(pB0, pB1, pA0, pA1, t, mB, mA, (t + 1 < NT), (t + 3 < NT), (t + 1 < NT), (t + 1 < NT));         ENDW(t, mA);     RESC(); ROT();
        STEP(pA0, pA1, pB0, pB1, t + 1, mA, mB, (t + 2 < NT), (t + 4 < NT), (t + 2 < NT), (t + 2 < NT));     ENDW(t + 1, mB); RESC(); ROT();
    }
    STEP(pB0, pB1, pA0, pA1, NT - 1, mB, mA, false, false, false, false); RESC();
    { float sacc = pB0[0] + pB0[1];
#pragma unroll
      for (int r = 2; r < 16; ++r) sacc += pB0[r];
#pragma unroll
      for (int r = 0; r < 16; ++r) sacc += pB1[r];
      l_reg += sacc;
      pw0 = (u32x4){PKW(pB0, 0), PKW(pB0, 2), PKW(pB0, 4), PKW(pB0, 6)}; pw1 = (u32x4){PKW(pB0, 8), PKW(pB0, 10), PKW(pB0, 12), PKW(pB0, 14)};
      pw2 = (u32x4){PKW(pB1, 0), PKW(pB1, 2), PKW(pB1, 4), PKW(pB1, 6)}; pw3 = (u32x4){PKW(pB1, 8), PKW(pB1, 10), PKW(pB1, 12), PKW(pB1, 14)};
      SBAR(); pv(o, vb0 + sl_cur, PAF(0), PAF(1), PAF(2), PAF(3)); }
    { auto rr = __builtin_amdgcn_permlane32_swap(__float_as_uint(l_reg), __float_as_uint(l_reg), false, false); l_reg = __uint_as_float(rr[0]) + __uint_as_float(rr[1]); }
    if (hi == 0) wsf[32 + r32] = l_reg; asm volatile("s_waitcnt lgkmcnt(0)" ::: "memory");
    float rli[16];
#pragma unroll
    for (int r = 0; r < 16; ++r) rli[r] = __builtin_amdgcn_rcpf(wsf[32 + crow(r, hi)]);
    { LAS bf16* stg = (LAS bf16*)(shm + LDS_OST) + wid * 2048;
#pragma unroll
      for (int r = 0; r < 16; ++r) { const int orow = crow(r, hi);
          stg[orow * 64 + r32] = (bf16)(cvtpk_s(o[0][r] * rli[r] * ms0, 0.f) & 0xffffu); stg[orow * 64 + 32 + r32] = (bf16)(cvtpk_s(o[1][r] * rli[r] * ms1, 0.f) & 0xffffu); }
      asm volatile("s_waitcnt lgkmcnt(0)" ::: "memory");
      int ln2 = lane; asm volatile("" : "+v"(ln2));
#pragma unroll
      for (int i = 0; i < 4; ++i) { const int row = i * 8 + (ln2 >> 3), ch = ln2 & 7; const u32x4 v = *(const LAS u32x4*)(stg + row * 64 + ch * 8);
          *(u32x4*)(MIX + (rowbase + qw + row) * DM + h * HD + ch * 8) = v; } }
    asm volatile("s_waitcnt lgkmcnt(0)\n\ts_barrier" ::: "memory");
#undef QRD
#undef DMA_K
#undef DMA_V
#undef MLOAD
#undef WAIT_BAR
#undef MASKB
#undef START
#undef RESC
#undef ROT
#undef PKW
#undef PAF
#undef VFR
#undef PIN
#undef MX3
#undef GAPA
#undef GAPB
#undef EX
#undef VRD
#undef KRD
#undef STEP
#undef ENDW
}
#undef SBAR
}

__device__ __forceinline__ void p_attn(Frame& F, int l) {
    const bf16* Q = WSP(bf16, WS_Q); const bf16* Kg = WSP(bf16, WS_K); const bf16* Vg = WSP(bf16, WS_V); bf16* MIX = WSP(bf16, WS_MIX);
    const unsigned long long* maskQ = WSP(unsigned long long, WS_MASK);
    LAS unsigned char* shm = F.lds + RING_OFF;
    const int tid = F.tid, lane = F.lane, r32 = lane & 31;
    const int bh = F.vcu >> 2, sq = F.vcu & 3, b = bh >> 3, h = bh & 7;
    LAS float* biasT = (LAS float*)(shm + at::LDS_BIAS);
    if (tid < 192) { const int rel = tid - 128, nn = rel < 0 ? -rel : rel; int bk = nn;
        if (nn >= 8) bk = 8 + (nn >= 12) + (nn >= 16) + (nn >= 23) + (nn >= 32) + (nn >= 46) + (nn >= 64) + (nn >= 91);
        bk += (rel > 0) ? 16 : 0;
        biasT[tid] = (arg_in(7)[bk * NH + h] - arg_in(7)[15 * NH + h]) * LOG2E; }
    __syncthreads();
    const float ms0 = arg_in(6)[l * DM + h * 64 + r32], ms1 = arg_in(6)[l * DM + h * 64 + 32 + r32];
    for (int ui = 0; ui < 4; ++ui) {
        const int qb = (ui == 0) ? sq : (ui == 1) ? 7 - sq : (ui == 2) ? 8 + sq : 15 - sq;
        at::attn_unit<8>(b, h, qb, Q, Kg, Vg, maskQ, MIX, ms0, ms1, shm, tid);
    }
}


#define REP(bit) for (int rep_ = 0; rep_ < (((PROBE_MASK) >> (bit)) & 1) + 1; ++rep_)
struct Args { const float* in[20]; float* out; unsigned char* ws; int seg_lo, seg_hi; };
constexpr int N_SEG = 1 + 2 * 8 + 2 * 9;

__global__ void __launch_bounds__(NTHR, 2) fwd_kernel(Args a) {
    extern __shared__ __attribute__((aligned(16))) unsigned char lds_raw[];
    Frame F0;
    F0.lds = (LAS unsigned char*)lds_raw;
    F0.tid = threadIdx.x; F0.lane = F0.tid & 63; F0.wave = __builtin_amdgcn_readfirstlane(F0.tid >> 6);
    F0.G = gridDim.x; { const int bx = blockIdx.x; F0.vcu = (F0.G % 8 == 0) ? (bx % 8) * (F0.G / 8) + bx / 8 : bx; }
    F0.ws = a.ws;
    for (int u = F0.tid; u < (LDS_BYTES - LDSCTL_OFF) / 4; u += NTHR) ((LAS unsigned*)(F0.lds + LDSCTL_OFF))[u] = 0u;
    __syncthreads();
    unsigned* ctl = (unsigned*)(F0.ws + WS_CTL);
    XcdBarrier bar = xcd_barrier_post(ctl + CW_BAR, (volatile LAS unsigned*)(F0.lds + MISC_OFF + 32));
    int sg = 0;
    const int lo = a.seg_lo, hi = a.seg_hi;
#define ACTIVE (lo <= sg && sg < hi)
#define SEAM() do { if (lo <= sg && sg + 1 < hi) xcd_barrier(bar); ++sg; } while (0)

    if (ACTIVE) { Frame F = fresh(F0); cvt_x(F); convert_weights(F, 0); }
    SEAM();
    for (int l = 0; l < DEPTH; ++l) {
        if (ACTIVE) REP(3) {
            {
                Frame F = fresh(F0);
                pg8::DenseOrderG S; S.init_tiles(M / 256, 10, F.G, (int)(F.G % 8 == 0 ? (F.vcu % (F.G / 8)) * 8 + F.vcu / (F.G / 8) : F.vcu)); S.Bt = (const char*)WSP(unsigned char, WS_WIN); S.K = DM / 2;
                pg8::EpiIn E{WSP(bf16, WS_Q), WSP(bf16, WS_K), WSP(bf16, WS_V), WSP(bf16, WS_QI), WSP(bf16, WS_KI), WSP(bf16, WS_U), WSP(float, WS_WI), 0, 1.0f / (pg8::F8_ASC * pg8::F8_WGU), 6};
                pg8::gemm_phase<pg8::EpiIn, pg8::DenseOrderG, true, true, true>(F.tid, F.lds + RING_OFF, (const char*)WSP(unsigned char, WS_XQ), DM / 2, S, E);
            }
            {
                Frame F = fresh(F0);
                pg8::DenseOrder S; S.init_tiles(M / 256, 3, F.G, (int)(F.G % 8 == 0 ? (F.vcu % (F.G / 8)) * 8 + F.vcu / (F.G / 8) : F.vcu)); S.Bt = (const char*)(WSP(bf16, WS_WIN) + (size_t)1536 * DM); S.K = DM;
                pg8::EpiIn E{WSP(bf16, WS_Q), WSP(bf16, WS_K), WSP(bf16, WS_V), WSP(bf16, WS_QI), WSP(bf16, WS_KI), WSP(bf16, WS_U), WSP(float, WS_WI), 6, 1.0f, 99};
                pg8::gemm_phase<pg8::EpiIn, pg8::DenseOrder, true, true>(F.tid, F.lds + RING_OFF, (const char*)WSP(bf16, WS_XB), DM, S, E);
            }
        }
        SEAM();
        if (ACTIVE) {
#ifndef NO_IDX
            REP(0) { Frame F = fresh(F0); p_idx(F, l); }
#endif
#ifndef NO_CONV
            REP(1) { Frame F = fresh(F0); p_conv(F, l); }
#endif
        }
        SEAM();
        if (ACTIVE) {
#ifndef NO_ATTN
            REP(2) { Frame F = fresh(F0); p_attn(F, l); }
#endif
        }
        SEAM();
        if (ACTIVE) REP(4) { Frame F = fresh(F0); bf16* R1 = WSP(bf16, WS_R1);
            pg8::DenseOrder S; S.init_tiles(M / 256, DM / 256, F.G, (int)(F.G % 8 == 0 ? (F.vcu % (F.G / 8)) * 8 + F.vcu / (F.G / 8) : F.vcu)); S.Bt = (const char*)WSP(bf16, WS_WOUT); S.K = DM;
            pg8::EpiRes E{WSP(bf16, WS_XB), R1, 1.0f};
            pg8::gemm_phase<pg8::EpiRes, pg8::DenseOrder, true, true>(F.tid, F.lds + RING_OFF, (const char*)WSP(bf16, WS_MIX), DM, S, E);
        }
        SEAM();
        if (ACTIVE) { Frame F = fresh(F0); p_ln1(F, l); }
        SEAM();
        if ((l & 1) == 0) {
            if (ACTIVE) REP(5) { Frame F = fresh(F0); bf16* XB = WSP(bf16, WS_XB);
                pg8::DenseOrderG S; S.init_tiles(M / 256, 2 * DFF / 256, F.G, (int)(F.G % 8 == 0 ? (F.vcu % (F.G / 8)) * 8 + F.vcu / (F.G / 8) : F.vcu)); S.Bt = (const char*)WSP(bf16, WS_WFF); S.K = DM / 2;
                pg8::EpiSwi E{WSP(unsigned char, WS_H), DFF};
                pg8::gemm_phase<pg8::EpiSwi, pg8::DenseOrderG, true, true, true>(F.tid, F.lds + RING_OFF, (const char*)XB, DM / 2, S, E);
            }
            SEAM();
            if (ACTIVE) { Frame F = fresh(F0); bf16* R1 = WSP(bf16, WS_R1);
                pg8::DenseOrderG S; S.init_tiles(M / 256, DM / 256, F.G, (int)(F.G % 8 == 0 ? (F.vcu % (F.G / 8)) * 8 + F.vcu / (F.G / 8) : F.vcu)); S.Bt = (const char*)(WSP(unsigned char, WS_WFF) + (size_t)2 * DFF * DM); S.K = DFF / 2;
                pg8::EpiRes E{R1, R1, 1.0f / (pg8::F8_HSC * pg8::F8_WDN)};
                pg8::gemm_phase<pg8::EpiRes, pg8::DenseOrderG, true, true, true>(F.tid, F.lds + RING_OFF, (const char*)WSP(unsigned char, WS_H), DFF / 2, S, E);
            }
            SEAM();
            if (ACTIVE) { REP(11) { Frame F = fresh(F0); p_ln2(F, l); } if (l + 1 < DEPTH) REP(8) { Frame F = fresh(F0); convert_weights(F, l + 1); } }
            SEAM();
        } else {
            if (ACTIVE) { Frame F = fresh(F0); p_list(F); }
            SEAM();
            for (int r = 0; r < 1; ++r) {
                if (ACTIVE) REP(6) { Frame F = fresh(F0); bf16* XB = WSP(bf16, WS_XB);
                    moe_tables(F);
                    const int Tm = ((LAS int*)(F.lds + LDSCTL_OFF + 1200))[8]; const int tlo = r * RT; int nMr = Tm - tlo; nMr = nMr < 0 ? 0 : (nMr > RT ? RT : nMr);
                    pg8::MoeGuOrder S; S.init_tiles(nMr, 2 * DFE / 256, F.G, (int)(F.G % 8 == 0 ? (F.vcu % (F.G / 8)) * 8 + F.vcu / (F.G / 8) : F.vcu)); S.rowlist = WSP(int, WS_ROWLIST); S.texp = (const LAS int*)(F.lds + LDSCTL_OFF); S.tlo = tlo;
                    S.W = (const char*)WSP(unsigned char, WS_WFF); S.estride = (size_t)3 * DFE * DM;
                    pg8::EpiSwi E{WSP(unsigned char, WS_H), DFE};
                    pg8::gemm_phase<pg8::EpiSwi, pg8::MoeGuOrder, true, true, true>(F.tid, F.lds + RING_OFF, (const char*)XB, DM / 2, S, E);
                }
                SEAM();
                if (ACTIVE) REP(7) { Frame F = fresh(F0);
                    moe_tables(F);
                    const int Tm = ((LAS int*)(F.lds + LDSCTL_OFF + 1200))[8]; const int tlo = r * RT; int nMr = Tm - tlo; nMr = nMr < 0 ? 0 : (nMr > RT ? RT : nMr);
                    pg8::MoeDnOrder S; S.init_tiles(nMr, DM / 256, F.G, (int)(F.G % 8 == 0 ? (F.vcu % (F.G / 8)) * 8 + F.vcu / (F.G / 8) : F.vcu)); S.texp = (const LAS int*)(F.lds + LDSCTL_OFF); S.tlo = tlo;
                    S.W = (const char*)(WSP(unsigned char, WS_WFF) + (size_t)2 * DFE * DM); S.estride = (size_t)3 * DFE * DM;
                    pg8::EpiMoeDown E{WSP(bf16, WS_YD), WSP(float, WS_ROWGATE), tlo};
                    pg8::gemm_phase<pg8::EpiMoeDown, pg8::MoeDnOrder, true, true, true>(F.tid, F.lds + RING_OFF, (const char*)WSP(unsigned char, WS_H), DFE / 2, S, E);
                }
                SEAM();
            }
            if (ACTIVE) { REP(10) { Frame F = fresh(F0); p_comb(F, l); } if (l + 1 < DEPTH) REP(8) { Frame F = fresh(F0); convert_weights(F, l + 1); } }
            SEAM();
        }
    }
#undef ACTIVE
#undef SEAM
}

#ifndef MK_MULTI
#define MK_MULTI 0
#endif
extern "C" void kernel_launch(void* const* d_in, const int* in_sizes, int n_in, void* d_out, int out_size, void* d_ws, size_t ws_size, hipStream_t stream) {
    static int grid = 0;
    if (grid == 0) {
        if (n_in != 20 || in_sizes[0] != M * DM || out_size != M * DM || ws_size < WS_END) { fprintf(stderr, "kernel_launch: unexpected shapes (n_in %d, in0 %d, out %d, ws %zu, need %zu); nothing launched\n", n_in, n_in > 0 ? in_sizes[0] : -1, out_size, ws_size, (size_t)WS_END); grid = -1; return; }
        int dev = 0, cus = 0, per_cu = 0;
        if (hipGetDevice(&dev) != hipSuccess || hipDeviceGetAttribute(&cus, hipDeviceAttributeMultiprocessorCount, dev) != hipSuccess) { grid = -1; return; }
        if (hipFuncSetAttribute((const void*)fwd_kernel, hipFuncAttributeMaxDynamicSharedMemorySize, LDS_BYTES) != hipSuccess) { fprintf(stderr, "kernel_launch: hipFuncSetAttribute failed\n"); grid = -1; return; }
        if (hipOccupancyMaxActiveBlocksPerMultiprocessor(&per_cu, (const void*)fwd_kernel, NTHR, LDS_BYTES) != hipSuccess || per_cu < 1) fprintf(stderr, "kernel_launch: occupancy query reports %d\n", per_cu);
        (void)hipGetLastError();
        grid = cus;
        if (grid != 256) { fprintf(stderr, "kernel_launch: built for 256 CUs, device has %d; nothing launched\n", cus); grid = -1; return; }
    }
    if (grid < 0) return;
    if (hipMemsetAsync((char*)d_ws + WS_CTL, 0, CTL_ZERO_BYTES, stream) != hipSuccess) return;
    Args a{};
    for (int i = 0; i < 20; ++i) a.in[i] = (const float*)d_in[i];
    a.out = (float*)d_out; a.ws = (unsigned char*)d_ws;
#if MK_MULTI
    for (int s = 0; s < N_SEG; ++s) { a.seg_lo = s; a.seg_hi = s + 1; hipLaunchKernelGGL(fwd_kernel, dim3(grid), dim3(NTHR), LDS_BYTES, stream, a); }
#else
    a.seg_lo = 0; a.seg_hi = N_SEG;
    hipLaunchKernelGGL(fwd_kernel, dim3(grid), dim3(NTHR), LDS_BYTES, stream, a);
#endif
    const hipError_t le = hipPeekAtLastError();
    if (le != hipSuccess) fprintf(stderr, "kernel_launch: launch failed: %s\n", hipGetErrorName(le));
}
```

```cpp
#include <hip/hip_runtime.h>
#include <cstdio>
#include <cstdint>

#define GAS __attribute__((address_space(1)))
#define LAS __attribute__((address_space(3)))
#define CAS __attribute__((address_space(4)))
typedef unsigned short bf16;
typedef short bf16x8 __attribute__((ext_vector_type(8)));
typedef short s16x4 __attribute__((ext_vector_type(4)));
typedef float f32x2 __attribute__((ext_vector_type(2)));
typedef float f32x4 __attribute__((ext_vector_type(4)));
typedef float f32x16 __attribute__((ext_vector_type(16)));
typedef unsigned u32x2 __attribute__((ext_vector_type(2)));
typedef unsigned u32x4 __attribute__((ext_vector_type(4)));
typedef int i32x8 __attribute__((ext_vector_type(8)));

#ifndef PROBE_MASK
#define PROBE_MASK 0
#endif
constexpr int BATCH = 8, SEQ = 4096, DM = 1024, M = BATCH * SEQ, DEPTH = 4;
constexpr int AW = 512, NH = 8, HD = 64, CCH = 512, CK = 31;
constexpr int IN_COLS = 3144, NIN = 3328;
constexpr int OFF_KI = 2048, OFF_WI = 2112, OFF_GLU = 2120;
constexpr int DFF = 2816, DFE = 3584, NE = 8;
constexpr int TOPK = 256;
constexpr float DN_ALPHA = 1.6817928305074290f;
constexpr float LN_EPS = 1e-5f;
constexpr float LOG2E = 1.4426950408889634f;
constexpr float QSCALE = 0.125f * LOG2E;
constexpr int NWAVES = 8, NTHR = 512;
constexpr int MAXT = 272, RT = 272;

constexpr size_t MiB = 1u << 20;
constexpr size_t WS_CTL = 0, CTL_ZERO_BYTES = 1 * MiB;
constexpr size_t WS_WIN = 1 * MiB, WS_WOUT = 8 * MiB, WS_WFF = 10 * MiB;
constexpr size_t WS_R1 = 178 * MiB, WS_XB = 306 * MiB, WS_A = 370 * MiB;
constexpr size_t WS_Q = WS_A, WS_K = WS_A + 32 * MiB, WS_V = WS_A + 64 * MiB, WS_QI = WS_A + 96 * MiB, WS_KI = WS_A + 128 * MiB, WS_WI = WS_A + 132 * MiB,
                 WS_U = WS_A + 133 * MiB, WS_MIX = WS_A + 165 * MiB, WS_H = WS_A;
constexpr size_t WS_YD = 616 * MiB, WS_ROUTE = 752 * MiB, WS_ROWLIST = WS_ROUTE + 512 * 1024, WS_ROWGATE = WS_ROWLIST + 320 * 1024, WS_SLOTROW = WS_ROWGATE + 320 * 1024,
                 WS_CNTWG = WS_SLOTROW + 256 * 1024, WS_MASK = 754 * MiB, WS_XQ = 820 * MiB, WS_END = 852 * MiB;
static_assert((size_t)RT * 256 * DFE <= 246 * MiB && (size_t)M * DFF <= 246 * MiB, "H overlay (fp8)");
static_assert((size_t)MAXT * 256 * DM * 2 <= 136 * MiB, "Yd");
static_assert(WS_CNTWG + 8192 <= WS_MASK && WS_MASK + (size_t)DEPTH * BATCH * 128 * 4096 * 4 <= WS_XQ, "route / masks");
constexpr int CW_BAR = 4096;

constexpr int RING_OFF = 0, RING_BYTES = 131072;
constexpr int AUX_OFF = 131072, AUX_BYTES = 26624;
constexpr int LDSCTL_OFF = AUX_OFF + AUX_BYTES, MISC_OFF = LDSCTL_OFF + 2048;
constexpr int LDS_BYTES = 157 * 1024;
static_assert(MISC_OFF + 128 <= LDS_BYTES, "LDS map");

__device__ __forceinline__ unsigned cvt_pk_bf16(float lo, float hi) { unsigned r; asm volatile("v_cvt_pk_bf16_f32 %0, %1, %2" : "=v"(r) : "v"(lo), "v"(hi)); return r; }
__device__ __forceinline__ float bf2f(unsigned short b) { return __uint_as_float((unsigned)b << 16); }
__device__ __forceinline__ float fsigmoid(float x) { return __builtin_amdgcn_rcpf(1.0f + __builtin_amdgcn_exp2f(-x * LOG2E)); }
#define LDS_WAIT() asm volatile("s_waitcnt lgkmcnt(0)" ::: "memory")
#define VM_WAIT() asm volatile("s_waitcnt vmcnt(0)" ::: "memory")

namespace pg8 {
constexpr int BM = 256, BK = 64, HALF = 128, HTB = HALF * BK * 2, STAGE_BYTES = 8 * HTB, NXCD = 8, WGM = 8;
__host__ __device__ __forceinline__ int lds_byte(int r, int c) { const int st = (r >> 4) * 2 + (c >> 5), rr = r & 15, cc = c & 31, ob = rr * 64 + cc * 2; return st * 1024 + (ob ^ (((ob >> 9) & 1) << 5)); }
__host__ __device__ __forceinline__ void stage_rc(int b, int& R, int& C) { const int st = b / 1024, sb = b % 1024, swz = sb ^ (((sb >> 9) & 1) << 5); R = (st >> 1) * 16 + swz / 64; C = (st & 1) * 32 + (swz % 64) / 2; }
__host__ __device__ __forceinline__ int perm32(int rho) { const int n = rho >> 4, i = rho & 15; return 8 * (i >> 2) + 4 * n + (i & 3); }
struct Unit { int pm, pn; };

struct OrderBase {
    int nM, nN, nwg, G, c;
    __device__ __forceinline__ void init_tiles(int nM_, int nN_, int G_, int c_) { nM = nM_; nN = nN_; nwg = nM * nN; G = G_; c = c_; }
    __device__ __forceinline__ bool next(int i, Unit& u) const { const long L = (long)i * G + c; if (L >= nwg) return false; unit_of((int)L, u); return true; }
    __device__ __forceinline__ void unit_of(int L, Unit& u) const {
        int wgid = L; { const int q = nwg / NXCD, r = nwg % NXCD, xcd = wgid % NXCD, off = wgid / NXCD; wgid = (xcd < r ? xcd * (q + 1) : r * (q + 1) + (xcd - r) * q) + off; }
        const int nig = WGM * nN, gid = wgid / nig, fm = gid * WGM, gsz = (nM - fm) < WGM ? (nM - fm) : WGM;
        u.pm = fm + ((wgid % nig) % gsz); u.pn = (wgid % nig) / gsz;
    }
    __device__ __forceinline__ void a_ready(const Unit&) const {}
    __device__ __forceinline__ void done(const Unit&) const {}
};
struct DenseOrder : OrderBase {
    static constexpr bool GATHER = false;
    const char* Bt; int K;
    __device__ __forceinline__ size_t a_base(const Unit& u) const { return (size_t)u.pm * ((size_t)BM * K * 2); }
    __device__ __forceinline__ unsigned a_off(const Unit&, int) const { return 0u; }
    __device__ __forceinline__ const char* b_base(const Unit& u) const { return Bt + (size_t)u.pn * ((size_t)BM * K * 2); }
};

struct DenseOrderG : OrderBase {
    static constexpr bool GATHER = true;
    const char* Bt; int K;
    __device__ __forceinline__ size_t a_base(const Unit&) const { return 0; }
    __device__ __forceinline__ unsigned a_off(const Unit& u, int r) const { return (unsigned)(u.pm * BM + r) * (unsigned)(K * 2); }
    __device__ __forceinline__ const char* b_base(const Unit& u) const { return Bt + (size_t)u.pn * ((size_t)BM * K * 2); }
};

template <class Epi, class Sched, bool ALIGN_EPI, bool SP2, bool F8 = false>
__device__ __forceinline__ void gemm_phase(const int tid, LAS unsigned char* lds, const char* Abase, const int K, const Sched& S, const Epi& E) {
    const int wid = __builtin_amdgcn_readfirstlane(tid >> 6), lane = tid & 63, wr = wid >> 2, wc = wid & 3, fr = lane & 15, fq = lane >> 4;
    const int nt = K / BK;
    constexpr bool GATHER = Sched::GATHER;
    unsigned voffA[2], voffB[2];
#pragma unroll
    for (int i = 0; i < 2; ++i) { int R, C; stage_rc(tid * 16 + i * 8192, R, C); const int Rb = Epi::PERM ? ((R & ~31) + perm32(R & 31)) : R;
        voffA[i] = GATHER ? (unsigned)C * 2u : (unsigned)(R * K + C) * 2u; voffB[i] = (unsigned)(Rb * K + C) * 2u; }
    const size_t kstep = (size_t)(BK * 2);
    const size_t hstep = (size_t)HALF * K * 2;
    const unsigned ldsw = (unsigned)wid * 1024u;
    const int aoff = lds_byte(wr * 64 + fr, fq * 8), boff = lds_byte(wc * 32 + fr, fq * 8);
#define PG8_SA(b, h) (((b) * 2 + (h)) * HTB)
#define PG8_SB(b, h) ((4 + (b) * 2 + (h)) * HTB)
#define PG8_STAGE(bufoff, gbase, voff) do { _Pragma("unroll") for (int _i = 0; _i < 2; ++_i) \
        __builtin_amdgcn_global_load_lds((const unsigned*)((const char*)(gbase) + (voff)[_i]), (LAS unsigned*)(lds + (bufoff) + ldsw + _i * 8192), 16, 0, 0); } while (0)
typedef int i32x4_t __attribute__((ext_vector_type(4)));
#define PG8_LDA(dst, b, h) do { _Pragma("unroll") for (int m = 0; m < 4; ++m) { if constexpr (F8) { dst[m].lo = *(const LAS i32x4_t*)(lds + PG8_SA(b, h) + aoff + m * 2048); dst[m].hi = *(const LAS i32x4_t*)(lds + PG8_SA(b, h) + aoff + m * 2048 + 1024); } \
        else { _Pragma("unroll") for (int k = 0; k < 2; ++k) dst##b16[m][k] = *(const LAS bf16x8*)(lds + PG8_SA(b, h) + aoff + m * 2048 + k * 1024); } } } while (0)
#define PG8_LDB(dst, b, h) do { _Pragma("unroll") for (int n = 0; n < 2; ++n) { if constexpr (F8) { dst[n].lo = *(const LAS i32x4_t*)(lds + PG8_SB(b, h) + boff + n * 2048); dst[n].hi = *(const LAS i32x4_t*)(lds + PG8_SB(b, h) + boff + n * 2048 + 1024); } \
        else { _Pragma("unroll") for (int k = 0; k < 2; ++k) dst##b16[n][k] = *(const LAS bf16x8*)(lds + PG8_SB(b, h) + boff + n * 2048 + k * 1024); } } } while (0)
#define PG8_MMA(ai, bj, At, Bt) do { __builtin_amdgcn_s_setprio(1); _Pragma("unroll") for (int m = 0; m < 4; ++m) _Pragma("unroll") for (int n = 0; n < 2; ++n) { \
        if constexpr (F8) { acc[ai][bj][m][n] = __builtin_amdgcn_mfma_scale_f32_16x16x128_f8f6f4(Bt[n], At[m], acc[ai][bj][m][n], 0, 0, 0, 0x7f7f7f7f, 0, 0x7f7f7f7f); } \
        else { _Pragma("unroll") for (int k = 0; k < 2; ++k) acc[ai][bj][m][n] = __builtin_amdgcn_mfma_f32_16x16x32_bf16(Bt##b16[n][k], At##b16[m][k], acc[ai][bj][m][n], 0, 0, 0); } } __builtin_amdgcn_s_setprio(0); } while (0)
#define PG8_WAIT_V(n) asm volatile("s_waitcnt vmcnt(" #n ")" ::: "memory")
#define PG8_WAIT_L(n) asm volatile("s_waitcnt lgkmcnt(" #n ")" ::: "memory")
#define PG8_BAR __builtin_amdgcn_s_barrier()
#define PG8_SCHED __builtin_amdgcn_sched_barrier(0)
    Unit cur, nxt; int ui = 0;
    if (!S.next(0, cur)) return;
    f32x4 acc[2][2][4][2];
    { float z0 = 0.f; asm volatile("" : "+v"(z0));
#pragma unroll
    for (int a = 0; a < 2; ++a)
#pragma unroll
        for (int b = 0; b < 2; ++b)
#pragma unroll
            for (int m = 0; m < 4; ++m)
#pragma unroll
                for (int n = 0; n < 2; ++n) acc[a][b][m][n] = (f32x4){z0, z0, z0, z0}; }
    bf16x8 Atb16[F8 ? 1 : 4][2], B0b16[F8 ? 1 : 2][2], B1b16[F8 ? 1 : 2][2]; i32x8 At[F8 ? 4 : 1], B0[F8 ? 2 : 1], B1[F8 ? 2 : 1]; (void)Atb16; (void)B0b16; (void)B1b16; (void)At; (void)B0; (void)B1;
    unsigned cOff0[2], cOff1[2];
#define PG8_ROWS(u) do { if constexpr (GATHER) { _Pragma("unroll") for (int _i = 0; _i < 2; ++_i) { int R_, C_; stage_rc(tid * 16 + _i * 8192, R_, C_); cOff0[_i] = S.a_off(u, R_) + voffA[_i]; cOff1[_i] = S.a_off(u, HALF + R_) + voffA[_i]; } } } while (0)
#define PG8_STAGE_A(bufoff, h, ptr) do { if constexpr (GATHER) { if ((h) == 0) PG8_STAGE(bufoff, ptr, cOff0); else PG8_STAGE(bufoff, ptr, cOff1); } else { PG8_STAGE(bufoff, (ptr) + (h) * hstep, voffA); } } while (0)
    const char* cA = Abase; if constexpr (!GATHER) cA = Abase + S.a_base(cur);
    PG8_ROWS(cur);
    const char* cB = S.b_base(cur);
    S.a_ready(cur);
    {
        PG8_STAGE(PG8_SB(0, 0), cB, voffB); PG8_STAGE(PG8_SB(0, 1), cB + hstep, voffB); PG8_STAGE_A(PG8_SA(0, 0), 0, cA); PG8_STAGE_A(PG8_SA(0, 1), 1, cA);
        if (wr == 1) PG8_BAR;
        PG8_WAIT_V(2); PG8_BAR;
        PG8_STAGE(PG8_SB(1, 0), cB + kstep, voffB); PG8_STAGE_A(PG8_SA(1, 0), 0, cA + kstep); PG8_STAGE(PG8_SB(1, 1), cB + hstep + kstep, voffB);
        PG8_WAIT_V(6); PG8_BAR;
    }
    for (;;) {
        const bool has_next = S.next(ui + 1, nxt);
        unsigned nOff0[2] = {0u, 0u}, nOff1[2] = {0u, 0u};
        if constexpr (GATHER) { if (has_next) { _Pragma("unroll") for (int _i = 0; _i < 2; ++_i) { int R_, C_; stage_rc(tid * 16 + _i * 8192, R_, C_); nOff0[_i] = S.a_off(nxt, R_); nOff1[_i] = S.a_off(nxt, HALF + R_); } } }
        const char* nA = cA; if constexpr (!GATHER) { if (has_next) nA = Abase + S.a_base(nxt); }
        const char* nB = has_next ? S.b_base(nxt) : cB;
#pragma nounroll
        for (int t = 0; t < nt; t += 2) {
            const bool last = (t == nt - 2);
            const char* a1 = cA + (size_t)(t + 1) * kstep;
            const char* a2 = last ? nA : cA + (size_t)(t + 2) * kstep; const char* b2 = last ? nB : cB + (size_t)(t + 2) * kstep;
            const char* a3 = a2 + kstep; const char* b3 = b2 + kstep;
            if (last && has_next) S.a_ready(nxt);
            if constexpr (SP2) {
            PG8_LDB(B0, 0, 0); PG8_LDB(B1, 0, 1); PG8_SCHED; PG8_LDA(At, 0, 0); PG8_STAGE_A(PG8_SA(1, 1), 1, a1);
            if constexpr (GATHER) { if (last && has_next) { _Pragma("unroll") for (int _i = 0; _i < 2; ++_i) { cOff0[_i] = nOff0[_i] + voffA[_i]; cOff1[_i] = nOff1[_i] + voffA[_i]; } } }
            PG8_WAIT_V(8); PG8_WAIT_L(0); PG8_BAR; PG8_MMA(0, 0, At, B0); PG8_MMA(0, 1, At, B1); PG8_BAR; PG8_SCHED;
            PG8_LDA(At, 0, 1); PG8_STAGE(PG8_SB(0, 0), b2, voffB); PG8_STAGE(PG8_SB(0, 1), b2 + hstep, voffB); PG8_STAGE_A(PG8_SA(0, 0), 0, a2);
            PG8_WAIT_V(8); PG8_WAIT_L(0); PG8_BAR; PG8_MMA(1, 0, At, B0); PG8_MMA(1, 1, At, B1); PG8_BAR; PG8_SCHED;
            PG8_LDB(B0, 1, 0); PG8_LDB(B1, 1, 1); PG8_SCHED; PG8_LDA(At, 1, 0); PG8_STAGE_A(PG8_SA(0, 1), 1, a2);
            PG8_WAIT_V(8); PG8_WAIT_L(0); PG8_BAR; PG8_MMA(0, 0, At, B0); PG8_MMA(0, 1, At, B1); PG8_BAR; PG8_SCHED;
            PG8_LDA(At, 1, 1); PG8_STAGE(PG8_SB(1, 0), b3, voffB); PG8_STAGE(PG8_SB(1, 1), b3 + hstep, voffB); PG8_STAGE_A(PG8_SA(1, 0), 0, a3);
            PG8_WAIT_V(8); PG8_WAIT_L(0); PG8_BAR; PG8_MMA(1, 0, At, B0); PG8_MMA(1, 1, At, B1); PG8_BAR; PG8_SCHED;
            } else { static_assert(SP2, "only the two-super-phase loop is kept"); }
        }
        if constexpr (ALIGN_EPI) { if (wr == 0) PG8_BAR; }
        E(acc, cur, wr, wc, fr, fq); S.done(cur);
        if (!has_next) break;
        { float z0 = 0.f; asm volatile("" : "+v"(z0));
#pragma unroll
        for (int a = 0; a < 2; ++a)
#pragma unroll
            for (int b = 0; b < 2; ++b)
#pragma unroll
                for (int m = 0; m < 4; ++m)
#pragma unroll
                    for (int n = 0; n < 2; ++n) acc[a][b][m][n] = (f32x4){z0, z0, z0, z0}; }
        cur = nxt; cA = nA; cB = nB; ++ui;
        if constexpr (ALIGN_EPI) { if (wr == 1) PG8_BAR; }
    }
    PG8_WAIT_V(0);
    if constexpr (!ALIGN_EPI) { if (wr == 0) PG8_BAR; }
    PG8_BAR;
#undef PG8_SA
#undef PG8_SB
#undef PG8_STAGE
#undef PG8_STAGE_A
#undef PG8_ROWS
#undef PG8_LDA
#undef PG8_LDB
#undef PG8_MMA
#undef PG8_WAIT_V
#undef PG8_WAIT_L
#undef PG8_BAR
#undef PG8_SCHED
}
}

namespace pg8 {
__device__ __forceinline__ u32x4 pack8(const f32x4 v0, const f32x4 v1) { u32x4 w; w.x = cvt_pk_bf16(v0[0], v0[1]); w.y = cvt_pk_bf16(v0[2], v0[3]); w.z = cvt_pk_bf16(v1[0], v1[1]); w.w = cvt_pk_bf16(v1[2], v1[3]); return w; }

__device__ __forceinline__ unsigned pk4_fp8(float a, float b, float c, float d) {
    a = __builtin_amdgcn_fmed3f(a, -448.f, 448.f); b = __builtin_amdgcn_fmed3f(b, -448.f, 448.f); c = __builtin_amdgcn_fmed3f(c, -448.f, 448.f); d = __builtin_amdgcn_fmed3f(d, -448.f, 448.f);
    unsigned r = 0u; r = (unsigned)__builtin_amdgcn_cvt_pk_fp8_f32(a, b, (int)r, false); r = (unsigned)__builtin_amdgcn_cvt_pk_fp8_f32(c, d, (int)r, true); return r; }
__device__ __forceinline__ u32x2 pack8_fp8(const f32x4 v0, const f32x4 v1) { u32x2 w; w.x = pk4_fp8(v0[0], v0[1], v0[2], v0[3]); w.y = pk4_fp8(v1[0], v1[1], v1[2], v1[3]); return w; }
constexpr float F8_ASC = 16.f, F8_WGU = 64.f, F8_HSC = 8.f, F8_WDN = 256.f;
struct EpiIn {
    static constexpr bool PERM = true;
    bf16 *Q, *Kb, *V, *QI, *KI, *U; float* WI; int pn_off; float dsc; int glu_from;
    __device__ __forceinline__ void operator()(const f32x4 (&acc)[2][2][4][2], const Unit& u, int wr, int wc, int fr, int fq) const {
        const int row0 = u.pm * BM + wr * 64 + fr; const int pn = (u.pn >= glu_from) ? u.pn - glu_from + 9 : u.pn + pn_off;
        if (pn < 2 || (pn >= 6 && pn < 8)) {
            bf16* base = (pn < 2) ? Q : QI;
            const float sc = ((pn < 2) ? QSCALE : 1.0f) * dsc;
            const int col0 = (pn & 1) * 256 + wc * 32 + 8 * fq;
#pragma unroll
            for (int ai = 0; ai < 2; ++ai)
#pragma unroll
                for (int m = 0; m < 4; ++m) { bf16* rowp = base + (size_t)(row0 + ai * HALF + m * 16) * AW + col0;
#pragma unroll
                    for (int bj = 0; bj < 2; ++bj) *(u32x4*)(rowp + bj * HALF) = pack8(acc[ai][bj][m][0] * sc, acc[ai][bj][m][1] * sc); }
        } else if (pn < 6) {
            const bool isK = pn < 4; bf16* base = isK ? Kb : V;
#pragma unroll
            for (int ai = 0; ai < 2; ++ai)
#pragma unroll
                for (int m = 0; m < 4; ++m) { const int row = row0 + ai * HALF + m * 16, bb = row >> 12, t = row & 4095, tile = t >> 6, r = t & 63;
#pragma unroll
                    for (int bj = 0; bj < 2; ++bj) { const int col = (pn & 1) * 256 + bj * HALF + wc * 32 + 8 * fq, h = col >> 6, d = col & 63;
                        const size_t tb = ((size_t)((bb * NH + h) * 64 + tile)) * 4096;
                        const size_t off = isK ? tb + (d >> 3) * 512 + r * 8 : tb + (d >> 5) * 2048 + r * 32 + (d & 31);
                        *(u32x4*)(base + off) = pack8(acc[ai][bj][m][0] * dsc, acc[ai][bj][m][1] * dsc); } }
        } else if (pn == 8) {
#pragma unroll
            for (int ai = 0; ai < 2; ++ai)
#pragma unroll
                for (int m = 0; m < 4; ++m) { const size_t row = (size_t)(row0 + ai * HALF + m * 16);
                    if (wc < 2) { const int c8 = wc * 4 + fq;
                        *(u32x4*)(KI + (row >> 5) * 2048 + (c8 >> 1) * 512 + (c8 & 1) * 256 + (row & 31) * 8) = pack8(acc[ai][0][m][0] * dsc, acc[ai][0][m][1] * dsc); }
                    else if (wc == 2 && fq == 0) { *(f32x4*)(WI + row * 8) = acc[ai][0][m][0] * dsc; *(f32x4*)(WI + row * 8 + 4) = acc[ai][0][m][1] * dsc; } }
        } else {
            const int col0 = (pn - 9) * 128 + wc * 32 + 8 * fq;
#pragma unroll
            for (int ai = 0; ai < 2; ++ai)
#pragma unroll
                for (int m = 0; m < 4; ++m) { f32x4 o[2];
#pragma unroll
                    for (int n = 0; n < 2; ++n) { const f32x4 a = acc[ai][0][m][n], g = acc[ai][1][m][n];
#pragma unroll
                        for (int e = 0; e < 4; ++e) o[n][e] = a[e] * dsc * fsigmoid(g[e] * dsc); }
                    *(u32x4*)(U + (size_t)(row0 + ai * HALF + m * 16) * CCH + col0) = pack8(o[0], o[1]); }
        }
    }
};
struct EpiRes {
    static constexpr bool PERM = true;
    const bf16* base; bf16* out; float asc;
    __device__ __forceinline__ void operator()(const f32x4 (&acc)[2][2][4][2], const Unit& u, int wr, int wc, int fr, int fq) const {
        const int row0 = u.pm * BM + wr * 64 + fr, col0 = u.pn * BM + wc * 32 + 8 * fq;
#pragma unroll
        for (int ai = 0; ai < 2; ++ai) {
            u32x4 bsv[4][2];
#pragma unroll
            for (int m = 0; m < 4; ++m)
#pragma unroll
                for (int bj = 0; bj < 2; ++bj) bsv[m][bj] = __builtin_nontemporal_load((const u32x4*)(base + (size_t)(row0 + ai * HALF + m * 16) * DM + col0 + bj * HALF));
#pragma unroll
            for (int m = 0; m < 4; ++m) { const size_t off = (size_t)(row0 + ai * HALF + m * 16) * DM + col0;
#pragma unroll
                for (int bj = 0; bj < 2; ++bj) { const u32x4 bs = bsv[m][bj];
                    f32x4 b0, b1; b0[0] = __uint_as_float(bs.x << 16); b0[1] = __uint_as_float(bs.x & 0xffff0000u); b0[2] = __uint_as_float(bs.y << 16); b0[3] = __uint_as_float(bs.y & 0xffff0000u);
                    b1[0] = __uint_as_float(bs.z << 16); b1[1] = __uint_as_float(bs.z & 0xffff0000u); b1[2] = __uint_as_float(bs.w << 16); b1[3] = __uint_as_float(bs.w & 0xffff0000u);
                    *(u32x4*)(out + off + bj * HALF) = pack8(b0 * DN_ALPHA + acc[ai][bj][m][0] * asc, b1 * DN_ALPHA + acc[ai][bj][m][1] * asc); } }
        }
    }
};
struct EpiSwi {
    static constexpr bool PERM = true;
    unsigned char* H; int ldh;
    __device__ __forceinline__ void operator()(const f32x4 (&acc)[2][2][4][2], const Unit& u, int wr, int wc, int fr, int fq) const {
        const int row0 = u.pm * BM + wr * 64 + fr, col0 = u.pn * 128 + wc * 32 + 8 * fq;
        constexpr float ds = 1.0f / (F8_ASC * F8_WGU);
#pragma unroll
        for (int ai = 0; ai < 2; ++ai)
#pragma unroll
            for (int m = 0; m < 4; ++m) { f32x4 o[2];
#pragma unroll
                for (int n = 0; n < 2; ++n) { const f32x4 ga = acc[ai][0][m][n], ua = acc[ai][1][m][n];
#pragma unroll
                    for (int e = 0; e < 4; ++e) o[n][e] = (ga[e] * ua[e]) * ((ds * ds * F8_HSC) * __builtin_amdgcn_rcpf(1.0f + __builtin_amdgcn_exp2f(ga[e] * (-ds * LOG2E)))); }
                *(u32x2*)(H + (size_t)(row0 + ai * HALF + m * 16) * ldh + col0) = pack8_fp8(o[0], o[1]); }
    }
};
struct EpiMoeDown {
    static constexpr bool PERM = true;
    bf16* Yd; const float* rowgate; int tlo;
    __device__ __forceinline__ void operator()(const f32x4 (&acc)[2][2][4][2], const Unit& u, int wr, int wc, int fr, int fq) const {
        const int row0 = (tlo + u.pm) * BM + wr * 64 + fr, col0 = u.pn * BM + wc * 32 + 8 * fq;
#pragma unroll
        for (int ai = 0; ai < 2; ++ai)
#pragma unroll
            for (int m = 0; m < 4; ++m) { const int row = row0 + ai * HALF + m * 16; const float gt = rowgate[row] * (1.0f / (F8_HSC * F8_WDN)); bf16* rowp = Yd + (size_t)row * DM + col0;
#pragma unroll
                for (int bj = 0; bj < 2; ++bj) *(u32x4*)(rowp + bj * HALF) = pack8(acc[ai][bj][m][0] * gt, acc[ai][bj][m][1] * gt); }
    }
};
struct MoeGuOrder : OrderBase {
    static constexpr bool GATHER = true;
    const int* rowlist; const LAS int* texp; int tlo; const char* W; size_t estride;
    __device__ __forceinline__ size_t a_base(const Unit&) const { return 0; }
    __device__ __forceinline__ unsigned a_off(const Unit& u, int r) const { return (unsigned)rowlist[(tlo + u.pm) * BM + r] * (unsigned)DM; }
    __device__ __forceinline__ const char* b_base(const Unit& u) const { return W + (size_t)texp[tlo + u.pm] * estride + (size_t)u.pn * ((size_t)BM * DM); }
};
struct MoeDnOrder : OrderBase {
    static constexpr bool GATHER = true;
    const LAS int* texp; int tlo; const char* W; size_t estride;
    __device__ __forceinline__ size_t a_base(const Unit&) const { return 0; }
    __device__ __forceinline__ unsigned a_off(const Unit& u, int r) const { return (unsigned)(u.pm * BM + r) * (unsigned)DFE; }
    __device__ __forceinline__ const char* b_base(const Unit& u) const { return W + (size_t)texp[tlo + u.pm] * estride + (size_t)u.pn * ((size_t)BM * DFE); }
};
}

typedef GAS unsigned gu32;
#define RLX_AGENT __ATOMIC_RELAXED, __HIP_MEMORY_SCOPE_AGENT
#define XB_TMO      128
#define XB_XCNT(j)  (256  + 64 * (j))
#define XB_XSUB(j)  (1280 + 64 * (j))
#define XB_XGEN(j)  (2304 + 64 * (j))
#define XB_TOP      3328
#define XB_TOPGEN   3392
#define XCD_BAR_WORDS 3456
#define XB_SPIN_CAP (1u << 18)

__device__ __forceinline__ unsigned xb_ld(unsigned* p)              { return __hip_atomic_load(p, __ATOMIC_RELAXED, __HIP_MEMORY_SCOPE_AGENT); }
__device__ __forceinline__ unsigned xb_add(unsigned* p, unsigned v) { return __hip_atomic_fetch_add(p, v, __ATOMIC_RELAXED, __HIP_MEMORY_SCOPE_AGENT); }
__device__ __forceinline__ unsigned xb_xcc_id() { return (unsigned)__builtin_amdgcn_s_getreg((3 << 11) | 20) & 0xFu; }
#define XB_SPIN(cond, bar) do { unsigned _sp = 0; while (cond) { __builtin_amdgcn_s_sleep(1); \
    if ((++_sp & 255u) == 0u) { if (xb_ld(&(bar)[XB_TMO])) break; if (_sp > XB_SPIN_CAP) { atomicAdd(&(bar)[XB_TMO], 1u); break; } } } } while (0)

struct XcdBarrier {
    unsigned* bar; unsigned x;
    volatile LAS unsigned* st;
};
__device__ __forceinline__ XcdBarrier xcd_barrier_post(unsigned* bar, volatile LAS unsigned* st) {
    XcdBarrier b; b.bar = bar; b.x = xb_xcc_id(); b.st = st;
    if (threadIdx.x == 0) (void)xb_add(&bar[XB_XCNT(b.x)], 1u);
    return b;
}
__device__ __forceinline__ void xcd_barrier_complete(unsigned* bar, unsigned x, unsigned& nloc, unsigned& nx) {
    const unsigned G = gridDim.x * gridDim.y * gridDim.z;
    unsigned sum, cnt, mine, sp = 0u;
    for (;;) {
        sum = 0u; cnt = 0u; mine = 0u;
#pragma unroll
        for (unsigned j = 0; j < 16; ++j) { const unsigned c = xb_ld(&bar[XB_XCNT(j)]); sum += c; cnt += (c > 0u) ? 1u : 0u; mine = (j == x) ? c : mine; }
        if (sum == G) break;
        __builtin_amdgcn_s_sleep(1);
        if ((++sp & 255u) == 0u) { if (xb_ld(&bar[XB_TMO])) break; if (sp > XB_SPIN_CAP) { atomicAdd(&bar[XB_TMO], 1u); break; } }
    }
    nloc = mine > 0u ? mine : 1u; nx = cnt > 0u ? cnt : 1u;
}
__device__ __forceinline__ void xcd_barrier(const XcdBarrier& b) {
    asm volatile("s_waitcnt vmcnt(0)" ::: "memory");
    __syncthreads();
    if (threadIdx.x == 0) {
        unsigned* bar = b.bar;
        __builtin_amdgcn_s_waitcnt(0);
        unsigned nloc = b.st[0], nx = b.st[1];
        if (nloc == 0u) { xcd_barrier_complete(bar, b.x, nloc, nx); b.st[0] = nloc; b.st[1] = nx; }
        const unsigned old = xb_add(&bar[XB_XSUB(b.x)], 1u);
        const unsigned gen = old / nloc;
        if (old + 1u == (gen + 1u) * nloc) {
            __builtin_amdgcn_fence(__ATOMIC_RELEASE, "agent");
            asm volatile("s_waitcnt vmcnt(0)" ::: "memory");
            const unsigned og = xb_add(&bar[XB_TOP], 1u);
            const unsigned tg = og / nx;
            if (og + 1u == (tg + 1u) * nx) xb_add(&bar[XB_TOPGEN], 1u);
            else XB_SPIN(xb_ld(&bar[XB_TOPGEN]) == tg, bar);
            __builtin_amdgcn_fence(__ATOMIC_ACQUIRE, "agent");
            xb_add(&bar[XB_XGEN(b.x)], 1u);
            asm volatile("s_waitcnt vmcnt(0)" ::: "memory");
        } else {
            XB_SPIN(xb_ld(&bar[XB_XGEN(b.x)]) == gen, bar);
            __builtin_amdgcn_fence(__ATOMIC_ACQUIRE, "agent");
            asm volatile("s_waitcnt vmcnt(0)" ::: "memory");
        }
    }
    __syncthreads();
}

struct Frame {
    LAS unsigned char* lds;
    int tid, lane, wave, vcu, G;
    unsigned char* ws;
};
__device__ __forceinline__ const float* arg_in(int k) { return (const float*)*(const GAS float* const volatile CAS*)((const CAS char*)__builtin_amdgcn_kernarg_segment_ptr() + 8 * k); }
__device__ __forceinline__ float* arg_out() { return (float*)*(GAS float* const volatile CAS*)((const CAS char*)__builtin_amdgcn_kernarg_segment_ptr() + 160); }
#define WSP(T, off) ((T*)(F.ws + (off)))
__device__ __forceinline__ Frame fresh(const Frame& F0) {
    Frame F = F0; int wv = F0.wave, v = F0.vcu, g = F0.G; asm volatile("" : "+s"(wv), "+s"(v), "+s"(g)); F.wave = wv; F.vcu = v; F.G = g;
    int ln; asm volatile("v_mbcnt_lo_u32_b32 %0, -1, 0\n\tv_mbcnt_hi_u32_b32 %0, -1, %0" : "=v"(ln)); F.lane = ln; F.tid = wv * 64 + ln;
    GAS unsigned char* w = (GAS unsigned char*)F0.ws; asm volatile("" : "+s"(w)); F.ws = (unsigned char*)w;
    return F;
}

__device__ __forceinline__ float wave_sum(float v) {
#define WS_DPP(x, ctrl) __int_as_float(__builtin_amdgcn_update_dpp(0, __float_as_int(x), (ctrl), 0xf, 0xf, false))
    v += WS_DPP(v, 0xB1); v += WS_DPP(v, 0x4E); v += WS_DPP(v, 0x141); v += WS_DPP(v, 0x140);
#undef WS_DPP
    const float r0 = __int_as_float(__builtin_amdgcn_readlane(__float_as_int(v), 0)), r1 = __int_as_float(__builtin_amdgcn_readlane(__float_as_int(v), 16)),
                r2 = __int_as_float(__builtin_amdgcn_readlane(__float_as_int(v), 32)), r3 = __int_as_float(__builtin_amdgcn_readlane(__float_as_int(v), 48));
    return (r0 + r1) + (r2 + r3);
}

struct TrItem { const float* W; int ldw, c0, nv, k0; void* WT; int Kd, r0; float scale; bool fp8; };
__device__ __forceinline__ void tr_load(const TrItem& t, f32x4 (&v)[16], int lane) {
    const int n4 = 4 * (lane & 15); const int nc = n4 < t.nv ? n4 : 0;
    const float* src = t.W + (size_t)(t.k0 + (lane >> 4)) * t.ldw + t.c0 + nc;
#pragma unroll
    for (int i = 0; i < 16; ++i) v[i] = *(const f32x4*)(src + (size_t)(4 * i) * t.ldw);
}
__device__ __forceinline__ void tr_to_lds(const TrItem& t, const f32x4 (&v)[16], LAS float* scr, int lane) {
    const int n4 = 4 * (lane & 15); const float ok = n4 < t.nv ? 1.f : 0.f;
#pragma unroll
    for (int i = 0; i < 16; ++i) { LAS float* d = scr + (4 * i + (lane >> 4)) * 65 + n4; d[0] = v[i][0] * ok; d[1] = v[i][1] * ok; d[2] = v[i][2] * ok; d[3] = v[i][3] * ok; }
}
__device__ __forceinline__ void tr_from_lds(const TrItem& t, LAS float* scr, int lane) {
    LDS_WAIT(); asm volatile("" ::: "memory");
    const int c = lane & 7; const float scale = t.scale;
    if (t.fp8) {
#pragma unroll
        for (int j = 0; j < 8; ++j) { const int nn = (lane >> 3) + 8 * j; const LAS float* s = scr + (8 * c) * 65 + nn;
            u32x2 o; o.x = pg8::pk4_fp8(s[0 * 65] * scale, s[1 * 65] * scale, s[2 * 65] * scale, s[3 * 65] * scale); o.y = pg8::pk4_fp8(s[4 * 65] * scale, s[5 * 65] * scale, s[6 * 65] * scale, s[7 * 65] * scale);
            *(u32x2*)((unsigned char*)t.WT + (size_t)(t.r0 + nn) * t.Kd + t.k0 + 8 * c) = o; }
    } else {
#pragma unroll
        for (int j = 0; j < 8; ++j) { const int nn = (lane >> 3) + 8 * j; const LAS float* s = scr + (8 * c) * 65 + nn;
            u32x4 o; o.x = cvt_pk_bf16(s[0 * 65], s[1 * 65]); o.y = cvt_pk_bf16(s[2 * 65], s[3 * 65]); o.z = cvt_pk_bf16(s[4 * 65], s[5 * 65]); o.w = cvt_pk_bf16(s[6 * 65], s[7 * 65]);
            *(u32x4*)((bf16*)t.WT + (size_t)(t.r0 + nn) * t.Kd + t.k0 + 8 * c) = o; }
    }
    LDS_WAIT(); asm volatile("" ::: "memory");
}
template <class Dec> __device__ __forceinline__ void tr_loop(const Dec& dec, int nitems, int gw, int NGW, LAS float* scr, int lane) {
    int i0 = gw; if (i0 >= nitems) return;
    int i1 = i0 + NGW;
    f32x4 va[16], vb[16];
    TrItem c0 = dec(i0); tr_load(c0, va, lane);
    TrItem c1 = dec(i1 < nitems ? i1 : i0); tr_load(c1, vb, lane);
    for (;;) {
        tr_to_lds(c0, va, scr, lane);
        const int j0 = i1 + NGW; const TrItem n0 = dec(j0 < nitems ? j0 : i0); tr_load(n0, va, lane);
        tr_from_lds(c0, scr, lane);
        if (i1 >= nitems) break;
        tr_to_lds(c1, vb, scr, lane);
        const int j1 = j0 + NGW; const TrItem n1 = dec(j1 < nitems ? j1 : i0); tr_load(n1, vb, lane);
        tr_from_lds(c1, scr, lane);
        if (j0 >= nitems) break;
        c0 = n0; c1 = n1; i0 = j0; i1 = j1;
    }
}

__device__ __forceinline__ void convert_weights(Frame& F, int l) {
    LAS float* scr = (LAS float*)(F.lds + RING_OFF + F.wave * 16640);
    const int gw = F.vcu * NWAVES + F.wave, NGW = F.G * NWAVES, lane = F.lane;
    bf16* WinT = WSP(bf16, WS_WIN); bf16* WoutT = WSP(bf16, WS_WOUT); unsigned char* Wff = WSP(unsigned char, WS_WFF);
    const float* w_in = arg_in(1) + (size_t)l * DM * IN_COLS;
    const float* w_out = arg_in(8) + (size_t)l * DM * DM;
    constexpr int I_IN = (NIN / 64) * 16, I_OUT = 16 * 16;
    tr_loop([=](int it) __attribute__((always_inline)) -> TrItem {
        if (it < I_IN) {
            const int nb = it >> 4, kb = it & 15; int c0 = 0, nv = 64;
            if (nb < 33) c0 = 64 * nb;
            else if (nb == 33) { c0 = OFF_WI; nv = 8; }
            else if (nb < 36) { nv = 0; }
            else { const int rr = 64 * (nb - 36), p = rr >> 8, w = rr & 255; c0 = (w < 128) ? (OFF_GLU + 128 * p + w) : (OFF_GLU + CCH + 128 * p + (w - 128)); }
            if (nb < 24) return TrItem{w_in, IN_COLS, c0, nv, 64 * kb, WinT, DM, 64 * nb, pg8::F8_WGU, true};
            if (nb >= 36) return TrItem{w_in, IN_COLS, c0, nv, 64 * kb, WinT, DM, 64 * (nb - 12), pg8::F8_WGU, true};
            return TrItem{w_in, IN_COLS, c0, nv, 64 * kb, WinT, DM, 64 * nb, 1.f, false};
        }
        const int r = it - I_IN, nb = r >> 4, kb = r & 15; return TrItem{w_out, DM, 64 * nb, 64, 64 * kb, WoutT, DM, 64 * nb, 1.f, false};
    }, I_IN + I_OUT, gw, NGW, scr, lane);
    if ((l & 1) == 0) {
        const int d = l >> 1;
        const float* wg = arg_in(13) + (size_t)d * DM * DFF; const float* wu = arg_in(14) + (size_t)d * DM * DFF; const float* wd = arg_in(15) + (size_t)d * DFF * DM;
        unsigned char* Wgu = Wff; unsigned char* Wdn = Wgu + (size_t)2 * DFF * DM;
        constexpr int I_GU = (2 * DFF / 64) * 16, I_DN = 16 * (DFF / 64);
        const ptrdiff_t dgu = wu - wg;
        tr_loop([=](int it) __attribute__((always_inline)) -> TrItem {
            if (it < I_GU) { const int nb = it >> 4, kb = it & 15, rr = 64 * nb, p = rr >> 8, w = rr & 255;
                return TrItem{wg + ((w < 128) ? (ptrdiff_t)0 : dgu), DFF, 128 * p + (w & 127), 64, 64 * kb, Wgu, DM, rr, pg8::F8_WGU, true}; }
            const int r = it - I_GU, nb = r / (DFF / 64), kb = r % (DFF / 64); return TrItem{wd, DM, 64 * nb, 64, 64 * kb, Wdn, DFF, 64 * nb, pg8::F8_WDN, true};
        }, I_GU + I_DN, gw, NGW, scr, lane);
    } else {
        const int d = l >> 1;
        constexpr int I_GU = (2 * DFE / 64) * 16, I_DN = 16 * (DFE / 64), I_E = I_GU + I_DN;
        const float* wg0 = arg_in(17) + (size_t)d * NE * DM * DFE; const float* wu0 = arg_in(18) + (size_t)d * NE * DM * DFE; const float* wd0 = arg_in(19) + (size_t)d * NE * DFE * DM;
        const ptrdiff_t dgu = wu0 - wg0;
        tr_loop([=](int it) __attribute__((always_inline)) -> TrItem {
            const int e = it / I_E, r0 = it % I_E;
            const float* wg = wg0 + (size_t)e * DM * DFE; const float* wd = wd0 + (size_t)e * DFE * DM;
            unsigned char* Wgu = Wff + (size_t)e * (3 * (size_t)DFE * DM); unsigned char* Wdn = Wgu + (size_t)2 * DFE * DM;
            if (r0 < I_GU) { const int nb = r0 >> 4, kb = r0 & 15, rr = 64 * nb, p = rr >> 8, w = rr & 255;
                return TrItem{wg + ((w < 128) ? (ptrdiff_t)0 : dgu), DFE, 128 * p + (w & 127), 64, 64 * kb, Wgu, DM, rr, pg8::F8_WGU, true}; }
            const int r = r0 - I_GU, nb = r / (DFE / 64), kb = r % (DFE / 64); return TrItem{wd, DM, 64 * nb, 64, 64 * kb, Wdn, DFE, 64 * nb, pg8::F8_WDN, true};
        }, NE * I_E, gw, NGW, scr, lane);
    }
}

__device__ __forceinline__ void cvt_x(Frame& F) {
    const float* x = arg_in(0); bf16* XB = WSP(bf16, WS_XB); unsigned char* XQ = WSP(unsigned char, WS_XQ);
    const int gw = F.vcu * NWAVES + F.wave, NGW = F.G * NWAVES;
    f32x4 vn[4];
    { const f32x4* xr = (const f32x4*)(x + (size_t)gw * DM) + F.lane;
#pragma unroll
      for (int j = 0; j < 4; ++j) vn[j] = xr[64 * j]; }
    for (int m = gw; m < M; m += NGW) {
        f32x4 v[4];
#pragma unroll
        for (int j = 0; j < 4; ++j) v[j] = vn[j];
        { const int mn = (m + NGW < M) ? m + NGW : m; const f32x4* xr = (const f32x4*)(x + (size_t)mn * DM) + F.lane;
#pragma unroll
          for (int j = 0; j < 4; ++j) vn[j] = xr[64 * j]; }
        u32x2* o = (u32x2*)(XB + (size_t)m * DM) + F.lane; unsigned* o8 = (unsigned*)(XQ + (size_t)m * DM) + F.lane;
#pragma unroll
        for (int j = 0; j < 4; ++j) { u32x2 w; w.x = cvt_pk_bf16(v[j][0], v[j][1]); w.y = cvt_pk_bf16(v[j][2], v[j][3]); o[64 * j] = w;
            o8[64 * j] = pg8::pk4_fp8(v[j][0] * pg8::F8_ASC, v[j][1] * pg8::F8_ASC, v[j][2] * pg8::F8_ASC, v[j][3] * pg8::F8_ASC); }
    }
}

__device__ __forceinline__ void ln_load(const bf16* row, f32x4 (&v)[4], int lane) {
#pragma unroll
    for (int j = 0; j < 4; ++j) { const u32x2 a = ((const u32x2*)row)[lane + 64 * j]; v[j][0] = __uint_as_float(a.x << 16); v[j][1] = __uint_as_float(a.x & 0xffff0000u); v[j][2] = __uint_as_float(a.y << 16); v[j][3] = __uint_as_float(a.y & 0xffff0000u); }
}
template <bool FP8OUT> __device__ __forceinline__ void ln_finish(f32x4 (&v)[4], const f32x4 (&g)[4], const f32x4 (&bb)[4], bf16* brow, unsigned char* qrow, float* frow, int lane) {
    float s = 0.f;
#pragma unroll
    for (int j = 0; j < 4; ++j) s += (v[j][0] + v[j][1]) + (v[j][2] + v[j][3]);
    const float mean = wave_sum(s) * (1.f / DM); float s2 = 0.f;
#pragma unroll
    for (int j = 0; j < 4; ++j) { v[j] = v[j] - mean; s2 += (v[j][0] * v[j][0] + v[j][1] * v[j][1]) + (v[j][2] * v[j][2] + v[j][3] * v[j][3]); }
    const float rstd = 1.f / sqrtf(wave_sum(s2) * (1.f / DM) + LN_EPS);
#pragma unroll
    for (int j = 0; j < 4; ++j) { v[j] = v[j] * rstd * g[j] + bb[j];
        { u32x2 w; w.x = cvt_pk_bf16(v[j][0], v[j][1]); w.y = cvt_pk_bf16(v[j][2], v[j][3]); ((u32x2*)brow)[lane + 64 * j] = w; }
        if constexpr (FP8OUT) { ((unsigned*)qrow)[lane + 64 * j] = pg8::pk4_fp8(v[j][0] * pg8::F8_ASC, v[j][1] * pg8::F8_ASC, v[j][2] * pg8::F8_ASC, v[j][3] * pg8::F8_ASC); }
        else { if (frow) ((f32x4*)frow)[lane + 64 * j] = v[j];
               if (qrow) ((unsigned*)qrow)[lane + 64 * j] = pg8::pk4_fp8(v[j][0] * pg8::F8_ASC, v[j][1] * pg8::F8_ASC, v[j][2] * pg8::F8_ASC, v[j][3] * pg8::F8_ASC); } }
}

__device__ __forceinline__ void p_ln1(Frame& F, int l) {
    bf16* R1 = WSP(bf16, WS_R1); bf16* XB = WSP(bf16, WS_XB);
    const bool moe = (l & 1) != 0;
    LAS int* cntL = (LAS int*)(F.lds + LDSCTL_OFF + 1152);
    if (F.tid < 8) cntL[F.tid] = 0;
    __syncthreads();
    f32x4 g[4], bb[4];
#pragma unroll
    for (int j = 0; j < 4; ++j) { g[j] = ((const f32x4*)(arg_in(9) + (size_t)l * DM))[F.lane + 64 * j]; bb[j] = ((const f32x4*)(arg_in(10) + (size_t)l * DM))[F.lane + 64 * j]; }
    const float* router = arg_in(16) + (size_t)(l >> 1) * DM * NE;
    u32x4* route = WSP(u32x4, WS_ROUTE);
    f32x4 vn[4]; ln_load(R1 + (size_t)(F.vcu * 128 + F.wave * 16) * DM, vn, F.lane);
    for (int i = 0; i < 16; ++i) {
        const int m = F.vcu * 128 + F.wave * 16 + i;
        f32x4 v[4];
#pragma unroll
        for (int j = 0; j < 4; ++j) v[j] = vn[j];
        if (i + 1 < 16) ln_load(R1 + (size_t)(m + 1) * DM, vn, F.lane);
        ln_finish<true>(v, g, bb, R1 + (size_t)m * DM, (unsigned char*)XB + (size_t)m * DM, nullptr, F.lane);
        if (moe) {
            float lg[8];
#pragma unroll
            for (int e = 0; e < 8; ++e) lg[e] = 0.f;
#pragma unroll
            for (int j = 0; j < 4; ++j)
#pragma unroll
                for (int c = 0; c < 4; ++c) { const float* rp = router + (size_t)(4 * F.lane + 256 * j + c) * NE; const f32x4 r0 = *(const f32x4*)rp, r1 = *(const f32x4*)(rp + 4); const float xv = v[j][c];
                    lg[0] += xv * r0[0]; lg[1] += xv * r0[1]; lg[2] += xv * r0[2]; lg[3] += xv * r0[3]; lg[4] += xv * r1[0]; lg[5] += xv * r1[1]; lg[6] += xv * r1[2]; lg[7] += xv * r1[3]; }
#pragma unroll
            for (int e = 0; e < 8; ++e) lg[e] = wave_sum(lg[e]);
            int e1 = 0; float v1 = lg[0];
#pragma unroll
            for (int e = 1; e < 8; ++e) if (lg[e] > v1) { v1 = lg[e]; e1 = e; }
            int e2 = -1; float v2 = -3.0e38f;
#pragma unroll
            for (int e = 0; e < 8; ++e) if (e != e1 && (e2 < 0 || lg[e] > v2)) { v2 = lg[e]; e2 = e; }
            const float g1 = 1.0f / (1.0f + __expf(v2 - v1)), g2 = 1.0f - g1;
            if (F.lane == 0) { u32x4 r; r.x = (unsigned)e1; r.y = (unsigned)e2; r.z = __float_as_uint(g1); r.w = __float_as_uint(g2); route[m] = r;
                __hip_atomic_fetch_add(cntL + e1, 1, __ATOMIC_RELAXED, __HIP_MEMORY_SCOPE_WORKGROUP); __hip_atomic_fetch_add(cntL + e2, 1, __ATOMIC_RELAXED, __HIP_MEMORY_SCOPE_WORKGROUP); }
        }
    }
    __syncthreads();
    if (moe && F.tid < 8) WSP(int, WS_CNTWG)[F.vcu * 8 + F.tid] = cntL[F.tid];
}

__device__ __forceinline__ void p_ln2(Frame& F, int l) {
    const bf16* R1 = WSP(bf16, WS_R1); bf16* XB = WSP(bf16, WS_XB); float* outp = (l == DEPTH - 1) ? arg_out() : nullptr;
    f32x4 g[4], bb[4];
#pragma unroll
    for (int j = 0; j < 4; ++j) { g[j] = ((const f32x4*)(arg_in(11) + (size_t)l * DM))[F.lane + 64 * j]; bb[j] = ((const f32x4*)(arg_in(12) + (size_t)l * DM))[F.lane + 64 * j]; }
    f32x4 vn[4]; ln_load(R1 + (size_t)(F.vcu * 128 + F.wave * 16) * DM, vn, F.lane);
    for (int i = 0; i < 16; ++i) {
        const int m = F.vcu * 128 + F.wave * 16 + i;
        f32x4 v[4];
#pragma unroll
        for (int j = 0; j < 4; ++j) v[j] = vn[j];
        if (i + 1 < 16) ln_load(R1 + (size_t)(m + 1) * DM, vn, F.lane);
        ln_finish<false>(v, g, bb, XB + (size_t)m * DM, WSP(unsigned char, WS_XQ) + (size_t)m * DM, outp ? outp + (size_t)m * DM : nullptr, F.lane);
    }
}

__device__ __forceinline__ void moe_tables(Frame& F) {
    LAS int* texp = (LAS int*)(F.lds + LDSCTL_OFF);
    LAS int* tot = (LAS int*)(F.lds + LDSCTL_OFF + 1088);
    LAS int* tbase = (LAS int*)(F.lds + LDSCTL_OFF + 1200);
    const int* cnt = WSP(int, WS_CNTWG);
    LAS int* tmp = (LAS int*)(F.lds + AUX_OFF);
    __syncthreads();
    if (F.tid < 256) { typedef int i32x4_ __attribute__((ext_vector_type(4))); const i32x4_ a = ((const i32x4_*)cnt)[2 * F.tid], b = ((const i32x4_*)cnt)[2 * F.tid + 1];
        *(LAS i32x4_*)(tmp + 8 * F.tid) = a; *(LAS i32x4_*)(tmp + 8 * F.tid + 4) = b; }
    __syncthreads();
    if (F.tid < 8) { int t = 0, off = 0; for (int w = 0; w < 256; ++w) { const int c = tmp[w * 8 + F.tid]; if (w < F.vcu) off += c; t += c; } tot[F.tid] = t; tot[8 + F.tid] = off; }
    __syncthreads();
    if (F.tid == 0) { int b = 0; for (int e = 0; e < 8; ++e) { tbase[e] = b; b += (tot[e] + 255) >> 8; } tbase[8] = b; }
    __syncthreads();
    if (F.tid < MAXT) { int e = 0;
#pragma unroll
        for (int j = 1; j < 8; ++j) e += (F.tid >= tbase[j]) ? 1 : 0;
        texp[F.tid] = e; }
    __syncthreads();
}

__device__ __forceinline__ void p_list(Frame& F) {
    moe_tables(F);
    LAS int* tot = (LAS int*)(F.lds + LDSCTL_OFF + 1088); LAS int* tbase = (LAS int*)(F.lds + LDSCTL_OFF + 1200);
    const u32x4* route = WSP(u32x4, WS_ROUTE);
    int* rowlist = WSP(int, WS_ROWLIST); float* rowgate = WSP(float, WS_ROWGATE); int* slotrow = WSP(int, WS_SLOTROW);
    if (F.wave == 0) {
        int run[8];
#pragma unroll
        for (int e = 0; e < 8; ++e) run[e] = tot[8 + e];
        for (int blk = 0; blk < 2; ++blk) {
            const int t = F.vcu * 128 + blk * 64 + F.lane; const u32x4 r = route[t]; const int e1 = (int)r.x, e2 = (int)r.y;
            int p1 = 0, p2 = 0;
            const unsigned long long lt = (1ull << F.lane) - 1ull;
#pragma unroll
            for (int e = 0; e < 8; ++e) { const unsigned long long mk = __ballot(e1 == e || e2 == e); const int rk = run[e] + __popcll(mk & lt); if (e1 == e) p1 = rk; if (e2 == e) p2 = rk; run[e] += __popcll(mk); }
            const int row1 = tbase[e1] * 256 + p1, row2 = tbase[e2] * 256 + p2;
            rowlist[row1] = t; rowgate[row1] = __uint_as_float(r.z); rowlist[row2] = t; rowgate[row2] = __uint_as_float(r.w);
            slotrow[2 * t] = row1; slotrow[2 * t + 1] = row2;
        }
    }
    if (F.vcu < 8) { const int e = F.vcu, mt = (tot[e] + 255) >> 8; for (int p = tot[e] + F.tid; p < mt * 256; p += NTHR) { rowlist[tbase[e] * 256 + p] = 0; rowgate[tbase[e] * 256 + p] = 0.f; } }
}

__device__ __forceinline__ void p_comb(Frame& F, int l) {
    const bf16* R1 = WSP(bf16, WS_R1); bf16* XB = WSP(bf16, WS_XB); const bf16* Yd = WSP(bf16, WS_YD); const int* slotrow = WSP(int, WS_SLOTROW); float* outp = (l == DEPTH - 1) ? arg_out() : nullptr;
    f32x4 g[4], bb[4];
#pragma unroll
    for (int j = 0; j < 4; ++j) { g[j] = ((const f32x4*)(arg_in(11) + (size_t)l * DM))[F.lane + 64 * j]; bb[j] = ((const f32x4*)(arg_in(12) + (size_t)l * DM))[F.lane + 64 * j]; }
    const int m0 = F.vcu * 128 + F.wave * 16;
    const int myslot = (F.lane < 32) ? slotrow[2 * m0 + F.lane] : 0;
    f32x4 xn[4], an[4], bn[4];
#define COMB_LOAD(i_) do { const int ra_ = __builtin_amdgcn_readlane(myslot, 2 * (i_)), rb_ = __builtin_amdgcn_readlane(myslot, 2 * (i_) + 1); \
        ln_load(R1 + (size_t)(m0 + (i_)) * DM, xn, F.lane); ln_load(Yd + (size_t)ra_ * DM, an, F.lane); ln_load(Yd + (size_t)rb_ * DM, bn, F.lane); } while (0)
    COMB_LOAD(0);
    for (int i = 0; i < 16; ++i) {
        const int m = m0 + i;
        f32x4 v[4];
#pragma unroll
        for (int j = 0; j < 4; ++j) v[j] = xn[j] * DN_ALPHA + (an[j] + bn[j]);
        if (i + 1 < 16) COMB_LOAD(i + 1);
        ln_finish<false>(v, g, bb, XB + (size_t)m * DM, WSP(unsigned char, WS_XQ) + (size_t)m * DM, outp ? outp + (size_t)m * DM : nullptr, F.lane);
    }
#undef COMB_LOAD
}

#define DPP_I(v, ctrl) __builtin_amdgcn_update_dpp(0, (v), (ctrl), 0xf, 0xf, false)
__device__ __forceinline__ int wave_isum(int v) {
    v += DPP_I(v, 0xB1); v += DPP_I(v, 0x4E); v += DPP_I(v, 0x141); v += DPP_I(v, 0x140);
    return __builtin_amdgcn_readlane(v, 0) + __builtin_amdgcn_readlane(v, 16) + __builtin_amdgcn_readlane(v, 32) + __builtin_amdgcn_readlane(v, 48);
}
#define DPP_F(v, ctrl) __int_as_float(__builtin_amdgcn_update_dpp(0, __float_as_int(v), (ctrl), 0xf, 0xf, false))
typedef unsigned short u16x2 __attribute__((__vector_size__(4)));
#define IDX_BAR() asm volatile("s_waitcnt lgkmcnt(0)\n\ts_barrier" ::: "memory")
__device__ __forceinline__ void p_idx(Frame& F, int l) {
    constexpr int QP = 16;
    LAS unsigned short* bins = (LAS unsigned short*)(F.lds + RING_OFF);
    LAS unsigned* hq = (LAS unsigned*)(F.lds + AUX_OFF);
    LAS unsigned* hist = (LAS unsigned*)(F.lds + AUX_OFF + 16384) + F.wave * 256;
    LAS int* ci = (LAS int*)(F.lds + AUX_OFF + 24576) + F.wave * 64;
    LAS float* wtab = (LAS float*)(F.lds + LDSCTL_OFF + 1280);
    LAS float* sqp = (LAS float*)(F.lds + LDSCTL_OFF + 1792);
    const bf16* QI = WSP(bf16, WS_QI); const bf16* KI = WSP(bf16, WS_KI); const float* WI = WSP(float, WS_WI);
    unsigned long long* maskQ = WSP(unsigned long long, WS_MASK);
    const int lane = F.lane, wave = F.wave, tid = F.tid, w = F.vcu;
    const int am = lane & 31, ahm = (am >> 2) & 1, arr = (am & 3) + 4 * (am >> 3), atl = 2 * ahm + (arr >> 3), ah = arr & 7, kg = lane >> 5, hi = lane >> 5, n = lane & 31;
    bf16x8 af[4][4]; float wreg = 0.f;
#define IDX_UNIT(s8_, qb32_, b_) do { const int ui_ = (s8_) >> 1; const int up_ = (ui_ == 0) ? w : (ui_ == 1) ? 511 - w : (ui_ == 2) ? 512 + w : 1023 - w; qb32_ = up_ >> 3; b_ = up_ & 7; } while (0)
#define IDX_LOADQ(s8_) do { int qb_, bb_; IDX_UNIT(s8_, qb_, bb_); const size_t r0_ = (size_t)bb_ * SEQ + qb_ * 32 + ((s8_) & 1) * QP; \
        _Pragma("unroll") for (int rt = 0; rt < 4; ++rt) _Pragma("unroll") for (int ks = 0; ks < 4; ++ks) af[rt][ks] = *(const bf16x8*)(QI + (r0_ + 4 * rt + atl) * AW + ah * 64 + ks * 16 + 8 * kg); \
        if (tid < 128) wreg = WI[(r0_ + (tid >> 3)) * 8 + (tid & 7)]; } while (0)
#define IDX_WTAB(par_) do { if (tid < 128) { wtab[tid] = wreg; float sm = wreg, sq2 = wreg * wreg; \
        sm += DPP_F(sm, 0xB1); sq2 += DPP_F(sq2, 0xB1); sm += DPP_F(sm, 0x4E); sq2 += DPP_F(sq2, 0x4E); sm += DPP_F(sm, 0x141); sq2 += DPP_F(sq2, 0x141); \
        if ((tid & 7) == 0) { const float a_ = 1.0f / (28.02f * sqrtf(sq2) + 1.0e-20f); sqp[32 * (par_) + 2 * (tid >> 3)] = a_; sqp[32 * (par_) + 2 * (tid >> 3) + 1] = 0.33333f - 3.19f * sm * a_; } } } while (0)
    IDX_LOADQ(0);
    IDX_WTAB(0);
    for (int i = tid; i < QP * 256; i += NTHR) hq[i] = 0u;
    IDX_BAR();
    for (int s8 = 0; s8 < 8; ++s8) {
        int qb32, b; IDX_UNIT(s8, qb32, b);
        const int sub = s8 & 1, c = qb32 >> 1, N = 64 * (c + 1), NT32 = 2 * (c + 1);
        const size_t rowb = (size_t)b * SEQ;
        const bool dosel = N > TOPK;
        for (int repA_ = 0; repA_ < (((PROBE_MASK) >> 12) & 1) + 1; ++repA_) {
            const int ntw = (NT32 - wave + 7) >> 3;
            constexpr int BT = 2; const int nbat = (ntw + BT - 1) / BT;
            bf16x8 b0[BT][4], b1[BT][4];
            const LAS float* sqc = sqp + 32 * (s8 & 1);
#define IDX_LOADB(dst, bb_) do { _Pragma("unroll") for (int u = 0; u < BT; ++u) { int j_ = wave + 8 * (BT * (bb_) + u); j_ = j_ < NT32 ? j_ : NT32 - 1; \
            _Pragma("unroll") for (int ks = 0; ks < 4; ++ks) dst[u][ks] = *(const bf16x8*)(KI + (rowb + 32 * j_) * 64 + ks * 512 + kg * 256 + n * 8); } } while (0)
#define IDX_RELU(x) __int_as_float(max(__float_as_int(x), 0))
#define IDX_COMP(src, bb_) do { _Pragma("unroll") for (int rp = 0; rp < 2; ++rp) { \
            f32x4 wq_[4][2];   \
            _Pragma("unroll") for (int rq = 0; rq < 4; ++rq) { const int qi_ = 4 * (2 * rp + (rq >> 1)) + 2 * hi + (rq & 1); const LAS f32x4* wp_ = (const LAS f32x4*)(wtab + qi_ * 8); wq_[rq][0] = wp_[0]; wq_[rq][1] = wp_[1]; } \
            _Pragma("unroll") for (int u = 0; u < BT; ++u) { const int j_ = wave + 8 * (BT * (bb_) + u); if (j_ < NT32) { f32x16 acc0 = {}, acc1 = {}; \
                _Pragma("unroll") for (int ks = 0; ks < 4; ++ks) { acc0 = __builtin_amdgcn_mfma_f32_32x32x16_bf16(af[2 * rp][ks], src[u][ks], acc0, 0, 0, 0); acc1 = __builtin_amdgcn_mfma_f32_32x32x16_bf16(af[2 * rp + 1][ks], src[u][ks], acc1, 0, 0, 0); } \
                _Pragma("unroll") for (int r2 = 0; r2 < 2; ++r2) { const int rt = 2 * rp + r2; const f32x16& ac_ = r2 ? acc1 : acc0; float t_[2]; \
                    _Pragma("unroll") for (int q = 0; q < 2; ++q) { const f32x4 w0_ = wq_[2 * r2 + q][0], w1_ = wq_[2 * r2 + q][1]; \
                        f32x2 s2_ = (f32x2){w0_[0], w0_[1]} * (f32x2){IDX_RELU(ac_[8 * q + 0]), IDX_RELU(ac_[8 * q + 1])}; \
                        s2_ = __builtin_elementwise_fma((f32x2){w0_[2], w0_[3]}, (f32x2){IDX_RELU(ac_[8 * q + 2]), IDX_RELU(ac_[8 * q + 3])}, s2_); \
                        s2_ = __builtin_elementwise_fma((f32x2){w1_[0], w1_[1]}, (f32x2){IDX_RELU(ac_[8 * q + 4]), IDX_RELU(ac_[8 * q + 5])}, s2_); \
                        s2_ = __builtin_elementwise_fma((f32x2){w1_[2], w1_[3]}, (f32x2){IDX_RELU(ac_[8 * q + 6]), IDX_RELU(ac_[8 * q + 7])}, s2_); \
                        const f32x2 mc_ = *(const LAS f32x2*)(sqc + 2 * (4 * rt + 2 * hi + q)); t_[q] = __builtin_fmaf(s2_[0] + s2_[1], mc_[0], mc_[1]); } \
                    const u16x2 pk_ = __builtin_amdgcn_cvt_pknorm_u16(t_[0], t_[1]); \
                    _Pragma("unroll") for (int q = 0; q < 2; ++q) { const int qi_ = 4 * rt + 2 * hi + q; const unsigned short ky_ = q ? pk_[1] : pk_[0]; bins[qi_ * 4096 + 32 * j_ + n] = ky_; \
                        if (dosel) __hip_atomic_fetch_add(hq + qi_ * 256 + ((unsigned)ky_ >> 8), 1u, __ATOMIC_RELAXED, __HIP_MEMORY_SCOPE_WORKGROUP); } } } } } } while (0)
            IDX_LOADB(b0, 0);
            for (int bb = 0; bb < nbat; bb += 2) {
                IDX_LOADB(b1, bb + 1);
                IDX_COMP(b0, bb);
                IDX_LOADB(b0, bb + 2);
                IDX_COMP(b1, bb + 1);
            }
#undef IDX_LOADB
#undef IDX_COMP
#undef IDX_RELU
        }
        if (s8 + 1 < 8) IDX_LOADQ(s8 + 1);
        IDX_BAR();
        for (int repB_ = 0; repB_ < (((PROBE_MASK) >> 13) & 1) + 1; ++repB_)
        for (int qq = 0; qq < 2; ++qq) {
            const int q = wave + 8 * qq;
            const int nch = (N + 511) >> 9;
            const LAS unsigned short* brow = bins + q * 4096;
            LAS unsigned char* st8 = (LAS unsigned char*)hist + 512 * qq;
            { unsigned z0 = 0u; asm volatile("" : "+v"(z0)); *(LAS u32x2*)(st8 + 8 * lane) = (u32x2){z0, z0}; }
#define IDX_SCAN(K, HD, TARGET) \
            int tl_ = 0; _Pragma("unroll") for (int i = 0; i < K; ++i) tl_ += HD[i]; \
            int P_ = tl_; P_ += DPP_I(P_, 0x111); P_ += DPP_I(P_, 0x112); P_ += DPP_I(P_, 0x114); P_ += DPP_I(P_, 0x118); \
            { const int R0 = __builtin_amdgcn_readlane(P_, 15), R1 = __builtin_amdgcn_readlane(P_, 31), R2 = __builtin_amdgcn_readlane(P_, 47); P_ += (lane >= 16 ? R0 : 0) + (lane >= 32 ? R1 : 0) + (lane >= 48 ? R2 : 0); } \
            const unsigned long long over_ = __ballot(P_ >= (TARGET)); const int Lc_ = over_ ? (int)__builtin_ctzll(over_) : 63; \
            int cumL_ = P_ - tl_, bsel_ = 0, cbv_ = 0; bool fnd_ = false; \
            _Pragma("unroll") for (int i = K - 1; i >= 0; --i) { if (!fnd_) { if (cumL_ + HD[i] >= (TARGET) || i == 0) { fnd_ = true; bsel_ = i; cbv_ = HD[i]; } else cumL_ += HD[i]; } } \
            Bs = K * (63 - Lc_) + __builtin_amdgcn_readlane(bsel_, Lc_); cb = __builtin_amdgcn_readlane(cbv_, Lc_); cumv = __builtin_amdgcn_readlane(cumL_, Lc_);
#define IDX_CODE(v, j) ((int)(((j) & 1) ? ((v)[(j) >> 1] >> 16) : ((v)[(j) >> 1] & 0xffffu)))
            int Bs = -1, cb = 0, need = 0, sh = 8; bool fast_ok = true;
            LAS unsigned* crow = hq + q * 256;
            if (dosel) {
                { const u32x4 h4 = *(const LAS u32x4*)(crow + 4 * (63 - lane)); const int hd4[4] = {(int)h4[0], (int)h4[1], (int)h4[2], (int)h4[3]};
                  int cumv; IDX_SCAN(4, hd4, TOPK)
                  need = TOPK - cumv; fast_ok = over_ != 0ull && need >= 1 && need <= cb; }
                if (fast_ok && cb > 64) {
                    { unsigned z0 = 0u; asm volatile("" : "+v"(z0)); *(LAS u32x4*)(crow + 4 * lane) = (u32x4){z0, z0, z0, z0}; }
                    for (int ch = 0; ch < nch; ++ch) { const u32x4 v = *(const LAS u32x4*)(brow + 512 * ch + 8 * lane); const bool okl = 512 * ch + 8 * lane < N;
#pragma unroll
                        for (int j = 0; j < 8; ++j) { const int kj = IDX_CODE(v, j); const bool m = okl && (kj >> 8) == Bs;
                            __hip_atomic_fetch_add(m ? crow + (kj & 255) : (LAS unsigned*)ci + lane, 1u, __ATOMIC_RELAXED, __HIP_MEMORY_SCOPE_WORKGROUP); } }
                    asm volatile("s_waitcnt lgkmcnt(0)" ::: "memory");
                    const u32x4 h4 = *(const LAS u32x4*)(crow + 4 * (63 - lane)); const int hd4[4] = {(int)h4[0], (int)h4[1], (int)h4[2], (int)h4[3]};
                    int nB, nC, nV; bool ok2;
                    { int Bs, cb, cumv; IDX_SCAN(4, hd4, need)
                      nB = Bs; nC = cb; nV = cumv; ok2 = over_ != 0ull; }
                    Bs = (Bs << 8) | nB; sh = 0; need -= nV; cb = nC;
                    fast_ok = ok2 && need >= 1 && need <= cb;
                }
                fast_ok = fast_ok && cb <= 64;
            }
#undef IDX_SCAN
            if (fast_ok) {
                int nc = 0;
                u32x4 vn = *(const LAS u32x4*)(brow + 8 * lane);
                for (int ch = 0; ch < nch; ++ch) { const u32x4 v = vn; const int e0 = 512 * ch + 8 * lane; const bool okl = e0 < N; unsigned byte = 0u;
                    if (ch + 1 < nch) vn = *(const LAS u32x4*)(brow + 512 * (ch + 1) + 8 * lane);
                    int bj[8], cl = 0;
#pragma unroll
                    for (int j = 0; j < 8; ++j) { bj[j] = okl ? (IDX_CODE(v, j) >> sh) : -2; cl += (bj[j] == Bs) ? 1 : 0; byte |= (unsigned)(Bs - bj[j]) >> 31 << j; }
                    int ps = cl;
                    ps += DPP_I(ps, 0x111); ps += DPP_I(ps, 0x112); ps += DPP_I(ps, 0x114); ps += DPP_I(ps, 0x118);
                    ps += __builtin_amdgcn_update_dpp(0, ps, 0x142, 0xa, 0xf, false); ps += __builtin_amdgcn_update_dpp(0, ps, 0x143, 0xc, 0xf, false);
                    int off = nc + ps - cl;
#pragma unroll
                    for (int j = 0; j < 8; ++j) { const bool eq = bj[j] == Bs; crow[eq ? off : 64 + lane] = (unsigned)((IDX_CODE(v, j) << 12) | (e0 + j)); off += eq ? 1 : 0; }
                    nc += __builtin_amdgcn_readlane(ps, 63);
                    st8[64 * ch + lane] = (unsigned char)byte; }
                if (dosel) {
                    asm volatile("s_waitcnt lgkmcnt(0)" ::: "memory");
                    const int mc = (lane < cb) ? (int)crow[lane] : 0; const int mord = (mc & ~4095) | (4095 - (mc & 4095)); int rank = 0;
                    for (int j = 0; j < cb; ++j) { const int oj = __builtin_amdgcn_readlane(mord, j); rank += (oj > mord) ? 1 : 0; }
                    if (lane < cb && rank < need) __hip_atomic_fetch_or((LAS unsigned*)st8 + ((mc & 4095) >> 5), 1u << (mc & 31), __ATOMIC_RELAXED, __HIP_MEMORY_SCOPE_WORKGROUP);
                }
            } else {
                int Tk = -1; unsigned Jx = 0xffffffffu;
                for (int bit = 15; bit >= 0; --bit) {
                    const int cand = Tk < 0 ? (1 << bit) : (Tk | (1 << bit)); int cl = 0;
                    for (int ch = 0; ch < nch; ++ch) { const u32x4 v = *(const LAS u32x4*)(brow + 512 * ch + 8 * lane); const int e0 = 512 * ch + 8 * lane;
#pragma unroll
                        for (int j = 0; j < 8; ++j) cl += (e0 < N && IDX_CODE(v, j) >= cand) ? 1 : 0; }
                    if (wave_isum(cl) >= TOPK) Tk = cand;
                }
                if (Tk < 0) Tk = 0;
                int cg = 0, ce = 0;
                for (int ch = 0; ch < nch; ++ch) { const u32x4 v = *(const LAS u32x4*)(brow + 512 * ch + 8 * lane); const int e0 = 512 * ch + 8 * lane;
#pragma unroll
                    for (int j = 0; j < 8; ++j) if (e0 < N) { cg += (IDX_CODE(v, j) > Tk) ? 1 : 0; ce += (IDX_CODE(v, j) == Tk) ? 1 : 0; } }
                const int nd = TOPK - wave_isum(cg), ceq = wave_isum(ce);
                if (ceq > nd) {
                    unsigned Jc = 0u;
                    for (int bit = 11; bit >= 0; --bit) {
                        const unsigned cj = Jc | (1u << bit); int cl = 0;
                        for (int ch = 0; ch < nch; ++ch) { const u32x4 v = *(const LAS u32x4*)(brow + 512 * ch + 8 * lane); const int e0 = 512 * ch + 8 * lane;
#pragma unroll
                            for (int j = 0; j < 8; ++j) cl += (e0 < N && IDX_CODE(v, j) == Tk && (unsigned)(e0 + j) < cj) ? 1 : 0; }
                        if (wave_isum(cl) < nd) Jc = cj;
                    }
                    Jx = Jc;
                }
                for (int ch = 0; ch < nch; ++ch) { const u32x4 v = *(const LAS u32x4*)(brow + 512 * ch + 8 * lane); const int e0 = 512 * ch + 8 * lane; unsigned byte = 0u;
#pragma unroll
                    for (int j = 0; j < 8; ++j) { const int kj = IDX_CODE(v, j); byte |= (unsigned)((kj > Tk || (kj == Tk && (unsigned)(e0 + j) <= Jx)) ? 1 : 0) << j; }
                    st8[64 * ch + lane] = (unsigned char)(e0 < N ? byte : 0u); }
            }
#undef IDX_CODE
            { unsigned z0 = 0u; asm volatile("" : "+v"(z0)); *(LAS u32x4*)(crow + 4 * lane) = (u32x4){z0, z0, z0, z0}; }
        }
        IDX_WTAB((s8 + 1) & 1);
        IDX_BAR();
        {
            const int tile = tid >> 3, w8 = tid & 7, NJw = 4 * ((qb32 >> 3) + 1);
            if (tile < NJw) {
#pragma unroll
                for (int qq = 0; qq < 2; ++qq) { const u32x2 mk = *(const LAS u32x2*)((const LAS unsigned*)(F.lds + AUX_OFF + 16384) + w8 * 256 + 128 * qq + 2 * tile);
                    maskQ[((size_t)(b * 128 + qb32) * 64 + tile) * 32 + QP * sub + 8 * qq + w8] = ((unsigned long long)mk.y << 32) | mk.x; } }
        }
    }
#undef IDX_UNIT
#undef IDX_LOADQ
#undef IDX_WTAB
#undef IDX_BAR
}

__device__ __forceinline__ void p_conv(Frame& F, int l) {
    LAS bf16* Ut = (LAS bf16*)(F.lds + RING_OFF);
    LAS float* Yt = (LAS float*)(F.lds + RING_OFF + 65536);
    const bf16* U = WSP(bf16, WS_U); bf16* MIX = WSP(bf16, WS_MIX);
    const float* cw = arg_in(2) + (size_t)l * CK * CCH; const int c = F.tid, lane = F.lane;
    float wj[CK];
#pragma unroll
    for (int j = 0; j < CK; ++j) wj[j] = cw[j * CCH + c];
    const float cb = arg_in(3)[l * CCH + c];
    f32x4 lg0 = *(const f32x4*)(arg_in(4) + l * CCH + 8 * lane), lg1 = *(const f32x4*)(arg_in(4) + l * CCH + 8 * lane + 4);
    f32x4 lb0 = *(const f32x4*)(arg_in(5) + l * CCH + 8 * lane), lb1 = *(const f32x4*)(arg_in(5) + l * CCH + 8 * lane + 4);
    f32x4 ms0 = *(const f32x4*)(arg_in(6) + l * DM + CCH + 8 * lane), ms1 = *(const f32x4*)(arg_in(6) + l * DM + CCH + 8 * lane + 4);
    u32x4 tp[8];
#define CONV_LOAD(it_) do { const int un_ = F.vcu + 256 * (it_), b_ = un_ >> 7, t0_ = (un_ & 127) * 32; \
        _Pragma("unroll") for (int k = 0; k < 8; ++k) { const int ch = F.tid + NTHR * k, r = ch >> 6, cc = ch & 63, t = t0_ - 30 + r; unsigned z0 = 0u; asm volatile("" : "+v"(z0)); tp[k] = (u32x4){z0, z0, z0, z0}; \
            if (ch < 62 * 64 && t >= 0) tp[k] = *(const u32x4*)(U + ((size_t)b_ * SEQ + t) * CCH + cc * 8); } } while (0)
    CONV_LOAD(0);
    for (int it = 0; it < 4; ++it) {
        const int unit = F.vcu + 256 * it, b = unit >> 7, tt0 = (unit & 127) * 32;
#pragma unroll
        for (int k = 0; k < 8; ++k) { const int ch = F.tid + NTHR * k, r = ch >> 6, cc = ch & 63; if (ch < 62 * 64) *(LAS u32x4*)(Ut + r * CCH + cc * 8) = tp[k]; }
        if (it + 1 < 4) CONV_LOAD(it + 1);
        __syncthreads();
        float acc[32], uu[62];
#pragma unroll
        for (int s = 0; s < 62; ++s) uu[s] = bf2f(Ut[s * CCH + c]);
#pragma unroll
        for (int tt = 0; tt < 32; ++tt) acc[tt] = cb;
#pragma unroll
        for (int j = 0; j < CK; ++j)
#pragma unroll
            for (int tt = 0; tt < 32; ++tt) acc[tt] = __builtin_fmaf(wj[j], uu[tt + j], acc[tt]);
#pragma unroll
        for (int tt = 0; tt < 32; ++tt) Yt[tt * CCH + c] = acc[tt];
        __syncthreads();
#pragma unroll
        for (int k = 0; k < 4; ++k) { const int tt = F.wave * 4 + k;
            f32x4 y0 = *(const LAS f32x4*)(Yt + tt * CCH + 8 * lane), y1 = *(const LAS f32x4*)(Yt + tt * CCH + 8 * lane + 4);
            const float mean = wave_sum((y0[0] + y0[1]) + (y0[2] + y0[3]) + (y1[0] + y1[1]) + (y1[2] + y1[3])) * (1.f / CCH);
            y0 = y0 - mean; y1 = y1 - mean;
            const float var = wave_sum((y0[0] * y0[0] + y0[1] * y0[1]) + (y0[2] * y0[2] + y0[3] * y0[3]) + (y1[0] * y1[0] + y1[1] * y1[1]) + (y1[2] * y1[2] + y1[3] * y1[3])) * (1.f / CCH);
            const float rstd = 1.f / sqrtf(var + LN_EPS);
            y0 = y0 * rstd * lg0 + lb0; y1 = y1 * rstd * lg1 + lb1;
#pragma unroll
            for (int e = 0; e < 4; ++e) { y0[e] = y0[e] * fsigmoid(y0[e]) * ms0[e]; y1[e] = y1[e] * fsigmoid(y1[e]) * ms1[e]; }
            *(u32x4*)(MIX + ((size_t)b * SEQ + tt0 + tt) * DM + CCH + 8 * lane) = pg8::pack8(y0, y1); }
        __syncthreads();
    }
#undef CONV_LOAD
}

namespace at {
constexpr int QBLK = 32, QB = 256, KVBLK = 64, NSLOT = 3, SLOTB = 8192;
constexpr int LDS_K = 0, LDS_V = NSLOT * SLOTB, LDS_WS = 2 * NSLOT * SLOTB, LDS_OST = LDS_WS + 8 * 64 * 4, LDS_BIAS = LDS_OST + 8 * 4096, LDS_END = LDS_BIAS + 1024;
static_assert(LDS_END <= RING_BYTES, "attention LDS");
constexpr float NEGV = -200.0f;
__device__ __forceinline__ int crow(int r, int hi) { return (r & 3) + 8 * (r >> 2) + 4 * hi; }
#define SBAR() __builtin_amdgcn_sched_barrier(0)
__device__ __forceinline__ void glds16(const void* gsrc, unsigned lds_dst) { unsigned keep;
    asm volatile("s_mov_b32 %0, m0\n\ts_mov_b32 m0, %2\n\ts_nop 0\n\tglobal_load_lds_dwordx4 %1, off\n\ts_mov_b32 m0, %0" : "=&s"(keep) : "v"(gsrc), "s"(lds_dst) : "memory"); }
__device__ __forceinline__ float max3f(float a, float b, float c) { float r; asm("v_max3_f32 %0, %1, %2, %3" : "=v"(r) : "v"(a), "v"(b), "v"(c)); return r; }
__device__ __forceinline__ float max2f(float a, float b) { float r; asm("v_max_f32_e32 %0, %1, %2" : "=v"(r) : "v"(a), "v"(b)); return r; }
__device__ __forceinline__ float fadd_s(float a, float b) { float r; asm("v_add_f32_e32 %0, %1, %2" : "=v"(r) : "v"(a), "v"(b)); return r; }
__device__ __forceinline__ float fsub_s(float a, float b) { float r; asm("v_sub_f32_e32 %0, %1, %2" : "=v"(r) : "v"(a), "v"(b)); return r; }
typedef float f32x2_t __attribute__((ext_vector_type(2))); typedef __bf16 bf16x2_t __attribute__((ext_vector_type(2)));
__device__ __forceinline__ unsigned cvtpk_s(float lo, float hi) { f32x2_t v = {lo, hi}; bf16x2_t b = __builtin_convertvector(v, bf16x2_t); return __builtin_bit_cast(unsigned, b); }
typedef LAS const char* lds_cptr;
typedef short v4i16_t __attribute__((ext_vector_type(4)));
__device__ __forceinline__ void kload8(bf16x8* kf, lds_cptr kp) {
    kf[0] = *(const LAS bf16x8*)(kp);        kf[1] = *(const LAS bf16x8*)(kp + 512);  kf[2] = *(const LAS bf16x8*)(kp + 2048); kf[3] = *(const LAS bf16x8*)(kp + 2560);
    kf[4] = *(const LAS bf16x8*)(kp + 4096); kf[5] = *(const LAS bf16x8*)(kp + 4608); kf[6] = *(const LAS bf16x8*)(kp + 6144); kf[7] = *(const LAS bf16x8*)(kp + 6656); }
__device__ __forceinline__ void kload2(bf16x8* kf, lds_cptr kp, int j) { kf[2 * j] = *(const LAS bf16x8*)(kp + j * 2048); kf[2 * j + 1] = *(const LAS bf16x8*)(kp + j * 2048 + 512); }
__device__ __forceinline__ s16x4 vtr(lds_cptr p) { return __builtin_bit_cast(s16x4, __builtin_amdgcn_ds_read_tr16_b64_v4i16((LAS v4i16_t*)p)); }
__device__ __forceinline__ float rowmax(const f32x16& p0, const f32x16& p1) {
    float a = max3f(p0[0], p0[1], p1[0]), b = max3f(p0[2], p0[3], p1[1]); a = max3f(a, p1[2], p1[3]);
#pragma unroll
    for (int r = 4; r < 16; r += 4) { a = max3f(a, p0[r], p0[r + 1]); b = max3f(b, p0[r + 2], p0[r + 3]); a = max3f(a, p1[r], p1[r + 1]); b = max3f(b, p1[r + 2], p1[r + 3]); }
    const float m = max2f(a, b);
    auto rr = __builtin_amdgcn_permlane32_swap(__float_as_uint(m), __float_as_uint(m), false, false);
    return max2f(__uint_as_float(rr[0]), __uint_as_float(rr[1]));
}
__device__ __forceinline__ void pv(f32x16* o, int vb, bf16x8 pa0, bf16x8 pa1, bf16x8 pa2, bf16x8 pa3) {
#pragma unroll
    for (int d0 = 0; d0 < 2; ++d0) { s16x4 lo[4], hi[4];
#pragma unroll
        for (int ks = 0; ks < 4; ++ks) {
            asm volatile("ds_read_b64_tr_b16 %0,%1 offset:%c2" : "=&v"(lo[ks]) : "v"(vb), "i"(d0 * 4096 + ks * 1024) : "memory");
            asm volatile("ds_read_b64_tr_b16 %0,%1 offset:%c2" : "=&v"(hi[ks]) : "v"(vb), "i"(d0 * 4096 + ks * 1024 + 512) : "memory"); }
        asm volatile("s_waitcnt lgkmcnt(0)" ::: "memory"); SBAR();
#define AT_PK(k) (bf16x8){lo[k][0], lo[k][1], lo[k][2], lo[k][3], hi[k][0], hi[k][1], hi[k][2], hi[k][3]}
        o[d0] = __builtin_amdgcn_mfma_f32_32x32x16_bf16(pa0, AT_PK(0), o[d0], 0, 0, 0);
        o[d0] = __builtin_amdgcn_mfma_f32_32x32x16_bf16(pa1, AT_PK(1), o[d0], 0, 0, 0);
        o[d0] = __builtin_amdgcn_mfma_f32_32x32x16_bf16(pa2, AT_PK(2), o[d0], 0, 0, 0);
        o[d0] = __builtin_amdgcn_mfma_f32_32x32x16_bf16(pa3, AT_PK(3), o[d0], 0, 0, 0);
#undef AT_PK
    }
}
template <int THRL> __device__ __forceinline__ void attn_unit(int b, int h, int qb, const bf16* Q, const bf16* __restrict__ Kt, const bf16* __restrict__ Vt, const unsigned long long* maskQ,
                                                              bf16* MIX, float ms0, float ms1, LAS unsigned char* shm, int tid) {
    const int lane = tid & 63, r32 = lane & 31, hi = lane >> 5; const int wid = __builtin_amdgcn_readfirstlane(tid >> 6);
    const size_t rowbase = (size_t)b * SEQ; const int q0 = qb * QB, qw = q0 + wid * QBLK, cwv = qw >> 6;
    const bf16* Qw = Q + (rowbase + qw) * AW + h * HD;
    const unsigned lds0 = (unsigned)(uintptr_t)shm; const lds_cptr shm3 = (lds_cptr)shm;
    LAS float* wsf = (LAS float*)(shm + LDS_WS) + wid * 64;
    const LAS float* biasT = (const LAS float*)(shm + LDS_BIAS);
    const bf16* ksrc = Kt + ((size_t)(b * NH + h) * 64) * 4096 + wid * 512 + lane * 8;
    const bf16* vsrc = Vt + ((size_t)(b * NH + h) * 64) * 4096 + wid * 512 + lane * 8;
    const unsigned kdst = lds0 + LDS_K + wid * 1024, vdst = lds0 + LDS_V + wid * 1024;
#define DMA_K(t, slot) glds16(ksrc + (size_t)(t) * 4096, (unsigned)__builtin_amdgcn_readfirstlane(kdst + (slot)))
#define DMA_V(t, slot) glds16(vsrc + (size_t)(t) * 4096, (unsigned)__builtin_amdgcn_readfirstlane(vdst + (slot)))
    int r32m = r32; asm volatile("" : "+v"(r32m));
    const unsigned long long* mrow = maskQ + ((size_t)(b * 128 + (qw >> 5)) * 64) * 32 + r32m;
#define MLOAD(dst, t) dst = *(const GAS u32x2*)((const GAS unsigned long long*)mrow + (size_t)(t) * 32)
#define MLOAD_UNUSED(dst, t) dst = *(const u32x2*)(mrow + (size_t)(t) * 32)
#define WAIT_BAR(N, M) asm volatile("s_waitcnt vmcnt(" #N ") lgkmcnt(0)\n\ts_barrier" ::: "memory")
    const int vb0 = (int)(lds0 + LDS_V) + ((lane >> 4) & 1) * 32 + (lane & 3) * 8 + (4 * hi + ((lane & 15) >> 2)) * 64;
    bf16x8 kf[8];
    const lds_cptr kp0 = shm3 + LDS_K + hi * 1024 + r32 * 16; const lds_cptr vp0 = shm3 + LDS_V + ((lane >> 4) & 1) * 32 + (lane & 3) * 8 + (4 * hi + ((lane & 15) >> 2)) * 64;
    const int NT = (q0 + QB) / KVBLK;
    u32x2 mA, mB;
    MLOAD(mA, 0);
    DMA_K(0, 0); DMA_V(0, 0); DMA_K(1, SLOTB);
    const lds_cptr qp = shm3 + LDS_OST + wid * 4096 + hi * 512 + r32 * 16;
#pragma unroll
    for (int d0 = 0; d0 < 4; ++d0) { const bf16x8 qv = *(const bf16x8*)(Qw + (size_t)r32 * AW + d0 * 16 + hi * 8); *(LAS bf16x8*)(shm + LDS_OST + wid * 4096 + hi * 512 + r32 * 16 + d0 * 1024) = qv; }
#define QRD(d0) (*(const LAS bf16x8*)(qp + (d0) * 1024))
    float mhat = 0.f, l_reg = 0.f; f32x16 o[2]; o[0] = f32x16{}; o[1] = f32x16{}; f32x16 negm = f32x16{}; asm volatile("" : "+v"(negm));
#define MASKB(P0, P1, t, MW) do { \
        if (64 * (t) + 63 - qw >= -90 && (t) <= cwv) { const int bi_ = 64 * (t) - (qw + r32) + 128 + 4 * hi; \
            _Pragma("unroll") for (int r = 0; r < 16; ++r) { const int k0_ = (r & 3) + 8 * (r >> 2); int i0_ = bi_ + k0_; i0_ = i0_ < 0 ? 0 : i0_; int i1_ = bi_ + k0_ + 32; i1_ = i1_ < 0 ? 0 : i1_; P0[r] += biasT[i0_]; P1[r] += biasT[i1_]; } } \
        { const unsigned ml_ = MW.x >> (4 * hi), mh_ = MW.y >> (4 * hi); const unsigned nv_ = __float_as_uint(NEGV); \
            _Pragma("unroll") for (int r = 0; r < 16; ++r) { const unsigned s0_ = (unsigned)__builtin_amdgcn_sbfe((int)ml_, (r & 3) + 8 * (r >> 2), 1), s1_ = (unsigned)__builtin_amdgcn_sbfe((int)mh_, (r & 3) + 8 * (r >> 2), 1); \
                P0[r] = __uint_as_float((s0_ & __float_as_uint(P0[r])) | (~s0_ & nv_)); P1[r] = __uint_as_float((s1_ & __float_as_uint(P1[r])) | (~s1_ & nv_)); } } } while (0)
    bool resc = false;
#define START(P0, P1) do { const float rm = rowmax(P0, P1); resc = false; \
    { const float dl = rm; mhat = fadd_s(mhat, dl); \
      _Pragma("unroll") for (int r = 0; r < 16; ++r) { P0[r] = fsub_s(P0[r], dl); P1[r] = fsub_s(P1[r], dl); } \
      _Pragma("unroll") for (int r = 0; r < 16; ++r) negm[r] = -mhat; asm volatile("" : "+v"(negm)); } \
    _Pragma("unroll") for (int r = 0; r < 16; ++r) P0[r] = __builtin_amdgcn_exp2f(P0[r]); } while (0)
#define RESC() do { if (resc) { asm volatile("s_waitcnt lgkmcnt(0)" ::: "memory"); \
      _Pragma("unroll") for (int d_ = 0; d_ < 2; ++d_) _Pragma("unroll") for (int r = 0; r < 16; ++r) o[d_][r] *= wsf[crow(r, hi)]; } } while (0)
    f32x16 pA0, pA1, pB0, pB1;
    int sl_prev = 0, sl_cur = 0, sl_next = SLOTB;
#define ROT() do { sl_prev = sl_cur; sl_cur = sl_next; sl_next = (sl_next == (NSLOT - 1) * SLOTB) ? 0 : sl_next + SLOTB; } while (0)
    DMA_K(2, 2 * SLOTB);
    WAIT_BAR(3, mA);
    {
        const lds_cptr kb = kp0;
        pA0 = f32x16{}; pA1 = f32x16{};
#pragma unroll
        for (int d0 = 0; d0 < 4; ++d0) { const bf16x8 b0 = *(const LAS bf16x8*)(kb + d0 * 2048), b1 = *(const LAS bf16x8*)(kb + d0 * 2048 + 512);
            const bf16x8 qv = QRD(d0); pA0 = __builtin_amdgcn_mfma_f32_32x32x16_bf16(b0, qv, pA0, 0, 0, 0); pA1 = __builtin_amdgcn_mfma_f32_32x32x16_bf16(b1, qv, pA1, 0, 0, 0); }
        MASKB(pA0, pA1, 0, mA);
        asm volatile("s_nop 15\n\ts_nop 7" : "+v"(pA0), "+v"(pA1));
        START(pA0, pA1);
#pragma unroll
        for (int r = 0; r < 16; ++r) pA1[r] = __builtin_amdgcn_exp2f(pA1[r]);
    }
    WAIT_BAR(0, mA);
    MLOAD(mB, 1);
    DMA_K(3, 0); DMA_V(1, SLOTB);
    ROT();
    kload8(kf, kp0 + sl_cur);
    WAIT_BAR(2, mB);
    s16x4 vlo[8], vhi[8]; u32x4 pw0, pw1, pw2, pw3;
#define PKW(P, B) cvtpk_s(P[B], P[B + 1])
#define PAF(k) __builtin_bit_cast(bf16x8, pw##k)
#define VFR(i) (bf16x8){vlo[i][0], vlo[i][1], vlo[i][2], vlo[i][3], vhi[i][0], vhi[i][1], vhi[i][2], vhi[i][3]}
#define PIN(x) asm volatile("" : "+v"(x))
#define MX3(a, b, c) __builtin_fmaxf(__builtin_fmaxf((a), (b)), (c))
#define GAPA(MF, A0, A1, A2, A3, W0, W1, PW) do { MF; sacc += A0; sacc += A1; sacc += A2; sacc += A3; PIN(sacc); W0; W1; PIN(PW); SBAR(); } while (0)
#define EX(v) __builtin_amdgcn_exp2f(v)
#define GAPB(MF, X, B) do { MF; X[B] = EX(X[B]); X[B + 1] = EX(X[B + 1]); X[B + 2] = EX(X[B + 2]); X[B + 3] = EX(X[B + 3]); PIN(X); SBAR(); } while (0)
#define VRD(i) do { vlo[i] = vtr(vp_ + (((i) >> 2) * 4096 + ((i) & 3) * 1024)); vhi[i] = vtr(vp_ + (((i) >> 2) * 4096 + ((i) & 3) * 1024 + 512)); } while (0)
#define KRD(G, j) do { if (G) { kload2(kf, kp0 + sl_next, j); SBAR(); } } while (0)
#define STEP(C0, C1, P0, P1, t, MC, MN, GM, GK, GV, GL) do { SBAR(); \
    const lds_cptr vp_ = vp0 + sl_prev; \
    bf16x8 qa_ = QRD(0), qb_; VRD(0); SBAR(); float sacc = (P0[0] + P0[1]); \
    GAPA(C0 = __builtin_amdgcn_mfma_f32_32x32x16_bf16(kf[0], qa_, negm, 0, 0, 0), P0[2], P0[3], P0[4], P0[5],     pw0[0] = PKW(P0, 0), pw0[1] = PKW(P0, 2), pw0); \
    VRD(4); SBAR(); GAPA(C1 = __builtin_amdgcn_mfma_f32_32x32x16_bf16(kf[1], qa_, negm, 0, 0, 0), P0[6], P0[7], P0[8], P0[9],     pw0[2] = PKW(P0, 4), pw0[3] = PKW(P0, 6), pw0); \
    qb_ = QRD(1); VRD(1); SBAR(); GAPA(C0 = __builtin_amdgcn_mfma_f32_32x32x16_bf16(kf[2], qb_, C0, 0, 0, 0),   P0[10], P0[11], P0[12], P0[13], pw1[0] = PKW(P0, 8), pw1[1] = PKW(P0, 10), pw1); \
    VRD(5); SBAR(); GAPA(C1 = __builtin_amdgcn_mfma_f32_32x32x16_bf16(kf[3], qb_, C1, 0, 0, 0),   P0[14], P0[15], P1[0], P1[1],   pw1[2] = PKW(P0, 12), pw1[3] = PKW(P0, 14), pw1); \
    qa_ = QRD(2); VRD(2); SBAR(); GAPA(C0 = __builtin_amdgcn_mfma_f32_32x32x16_bf16(kf[4], qa_, C0, 0, 0, 0),   P1[2], P1[3], P1[4], P1[5],     pw2[0] = PKW(P1, 0), pw2[1] = PKW(P1, 2), pw2); \
    VRD(6); SBAR(); GAPA(C1 = __builtin_amdgcn_mfma_f32_32x32x16_bf16(kf[5], qa_, C1, 0, 0, 0),   P1[6], P1[7], P1[8], P1[9],     pw2[2] = PKW(P1, 4), pw2[3] = PKW(P1, 6), pw2); \
    qb_ = QRD(3); VRD(3); SBAR(); GAPA(C0 = __builtin_amdgcn_mfma_f32_32x32x16_bf16(kf[6], qb_, C0, 0, 0, 0),   P1[10], P1[11], P1[12], P1[13], pw3[0] = PKW(P1, 8), pw3[1] = PKW(P1, 10), pw3); \
    VRD(7); SBAR(); GAPA(C1 = __builtin_amdgcn_mfma_f32_32x32x16_bf16(kf[7], qb_, C1, 0, 0, 0),   P1[14], P1[15], 0.f, 0.f,       pw3[2] = PKW(P1, 12), pw3[3] = PKW(P1, 14), pw3); \
    l_reg += sacc; \
    MASKB(C0, C1, t, MC); \
    if (GM) { MLOAD(MN, (t) + 1); } if (GK) { DMA_K((t) + 3, sl_cur); } if (GV) { DMA_V((t) + 1, sl_next); } \
    { float a = MX3(C0[0], C0[1], C1[0]), b_ = MX3(C0[2], C0[3], C1[1]); a = MX3(a, C1[2], C1[3]); \
      _Pragma("unroll") for (int r = 4; r < 16; r += 4) { a = MX3(a, C0[r], C0[r + 1]); b_ = MX3(b_, C0[r + 2], C0[r + 3]); a = MX3(a, C1[r], C1[r + 1]); b_ = MX3(b_, C1[r + 2], C1[r + 3]); } \
      float rm = __builtin_fmaxf(a, b_); { auto rr = __builtin_amdgcn_permlane32_swap(__float_as_uint(rm), __float_as_uint(rm), false, false); rm = __builtin_fmaxf(__uint_as_float(rr[0]), __uint_as_float(rr[1])); } \
      resc = false; \
      if (__builtin_expect(__any(rm > (float)THRL), 0)) { const float dl = __builtin_fmaxf(rm, 0.f); mhat += dl; \
        _Pragma("unroll") for (int r = 0; r < 16; ++r) { C0[r] -= dl; C1[r] -= dl; } \
        _Pragma("unroll") for (int r = 0; r < 16; ++r) negm[r] = -mhat; asm volatile("" : "+v"(negm)); \
        const float f = __builtin_amdgcn_exp2f(-dl); l_reg *= f; if (hi == 0) wsf[r32] = f; resc = true; } } \
    SBAR(); \
    GAPB(o[0] = __builtin_amdgcn_mfma_f32_32x32x16_bf16(PAF(0), VFR(0), o[0], 0, 0, 0), C0, 0); \
    GAPB(o[1] = __builtin_amdgcn_mfma_f32_32x32x16_bf16(PAF(0), VFR(4), o[1], 0, 0, 0), C0, 4); \
    KRD(GL, 0); GAPB(o[0] = __builtin_amdgcn_mfma_f32_32x32x16_bf16(PAF(1), VFR(1), o[0], 0, 0, 0), C0, 8); \
    KRD(GL, 1); GAPB(o[1] = __builtin_amdgcn_mfma_f32_32x32x16_bf16(PAF(1), VFR(5), o[1], 0, 0, 0), C0, 12); \
    KRD(GL, 2); GAPB(o[0] = __builtin_amdgcn_mfma_f32_32x32x16_bf16(PAF(2), VFR(2), o[0], 0, 0, 0), C1, 0); \
    KRD(GL, 3); GAPB(o[1] = __builtin_amdgcn_mfma_f32_32x32x16_bf16(PAF(2), VFR(6), o[1], 0, 0, 0), C1, 4); \
    GAPB(o[0] = __builtin_amdgcn_mfma_f32_32x32x16_bf16(PAF(3), VFR(3), o[0], 0, 0, 0), C1, 8); \
    GAPB(o[1] = __builtin_amdgcn_mfma_f32_32x32x16_bf16(PAF(3), VFR(7), o[1], 0, 0, 0), C1, 12); \
    } while (0)
    int t = 1;
    for (; t + 5 < NT; t += 2) {
        STEP(pB0, pB1, pA0, pA1, t, mB, mA, true, true, true, true);       WAIT_BAR(2, mA); RESC(); ROT();
        STEP(pA0, pA1, pB0, pB1, t + 1, mA, mB, true, true, true, true);   WAIT_BAR(2, mB); RESC(); ROT();
    }
#define ENDW(tt, M) do { if ((tt) + 3 < NT) { WAIT_BAR(2, M); } else if ((tt) + 2 < NT) { WAIT_BAR(1, M); } else { WAIT_BAR(0, M); } } while (0)
    for (; t + 1 < NT; t += 2) {
        STEP(pB0, pB1, pA0, pA1, t, mB, mA, (t + 1 < NT), (t + 3 < NT), (t + 1 < NT), (t + 1 < NT));         ENDW(t, mA);     RESC(); ROT();
        STEP(pA0, pA1, pB0, pB1, t + 1, mA, mB, (t + 2 < NT), (t + 4 < NT), (t + 2 < NT), (t + 2 < NT));     ENDW(t + 1, mB); RESC(); ROT();
    }
    STEP(pB0, pB1, pA0, pA1, NT - 1, mB, mA, false, false, false, false); RESC();
    { float sacc = pB0[0] + pB0[1];
#pragma unroll
      for (int r = 2; r < 16; ++r) sacc += pB0[r];
#pragma unroll
      for (int r = 0; r < 16; ++r) sacc += pB1[r];
      l_reg += sacc;
      pw0 = (u32x4){PKW(pB0, 0), PKW(pB0, 2), PKW(pB0, 4), PKW(pB0, 6)}; pw1 = (u32x4){PKW(pB0, 8), PKW(pB0, 10), PKW(pB0, 12), PKW(pB0, 14)};
      pw2 = (u32x4){PKW(pB1, 0), PKW(pB1, 2), PKW(pB1, 4), PKW(pB1, 6)}; pw3 = (u32x4){PKW(pB1, 8), PKW(pB1, 10), PKW(pB1, 12), PKW(pB1, 14)};
      SBAR(); pv(o, vb0 + sl_cur, PAF(0), PAF(1), PAF(2), PAF(3)); }
    { auto rr = __builtin_amdgcn_permlane32_swap(__float_as_uint(l_reg), __float_as_uint(l_reg), false, false); l_reg = __uint_as_float(rr[0]) + __uint_as_float(rr[1]); }
    if (hi == 0) wsf[32 + r32] = l_reg; asm volatile("s_waitcnt lgkmcnt(0)" ::: "memory");
    float rli[16];
#pragma unroll
    for (int r = 0; r < 16; ++r) rli[r] = __builtin_amdgcn_rcpf(wsf[32 + crow(r, hi)]);
    { LAS bf16* stg = (LAS bf16*)(shm + LDS_OST) + wid * 2048;
#pragma unroll
      for (int r = 0; r < 16; ++r) { const int orow = crow(r, hi);
          stg[orow * 64 + r32] = (bf16)(cvtpk_s(o[0][r] * rli[r] * ms0, 0.f) & 0xffffu); stg[orow * 64 + 32 + r32] = (bf16)(cvtpk_s(o[1][r] * rli[r] * ms1, 0.f) & 0xffffu); }
      asm volatile("s_waitcnt lgkmcnt(0)" ::: "memory");
      int ln2 = lane; asm volatile("" : "+v"(ln2));
#pragma unroll
      for (int i = 0; i < 4; ++i) { const int row = i * 8 + (ln2 >> 3), ch = ln2 & 7; const u32x4 v = *(const LAS u32x4*)(stg + row * 64 + ch * 8);
          *(u32x4*)(MIX + (rowbase + qw + row) * DM + h * HD + ch * 8) = v; } }
    asm volatile("s_waitcnt lgkmcnt(0)\n\ts_barrier" ::: "memory");
#undef QRD
#undef DMA_K
#undef DMA_V
#undef MLOAD
#undef WAIT_BAR
#undef MASKB
#undef START
#undef RESC
#undef ROT
#undef PKW
#undef PAF
#undef VFR
#undef PIN
#undef MX3
#undef GAPA
#undef GAPB
#undef EX
#undef VRD
#undef KRD
#undef STEP
#undef ENDW
}
#undef SBAR
}

__device__ __forceinline__ void p_attn(Frame& F, int l) {
    const bf16* Q = WSP(bf16, WS_Q); const bf16* Kg = WSP(bf16, WS_K); const bf16* Vg = WSP(bf16, WS_V); bf16* MIX = WSP(bf16, WS_MIX);
    const unsigned long long* maskQ = WSP(unsigned long long, WS_MASK);
    LAS unsigned char* shm = F.lds + RING_OFF;
    const int tid = F.tid, lane = F.lane, r32 = lane & 31;
    const int bh = F.vcu >> 2, sq = F.vcu & 3, b = bh >> 3, h = bh & 7;
    LAS float* biasT = (LAS float*)(shm + at::LDS_BIAS);
    if (tid < 192) { const int rel = tid - 128, nn = rel < 0 ? -rel : rel; int bk = nn;
        if (nn >= 8) bk = 8 + (nn >= 12) + (nn >= 16) + (nn >= 23) + (nn >= 32) + (nn >= 46) + (nn >= 64) + (nn >= 91);
        bk += (rel > 0) ? 16 : 0;
        biasT[tid] = (arg_in(7)[bk * NH + h] - arg_in(7)[15 * NH + h]) * LOG2E; }
    __syncthreads();
    const float ms0 = arg_in(6)[l * DM + h * 64 + r32], ms1 = arg_in(6)[l * DM + h * 64 + 32 + r32];
    for (int ui = 0; ui < 4; ++ui) {
        const int qb = (ui == 0) ? sq : (ui == 1) ? 7 - sq : (ui == 2) ? 8 + sq : 15 - sq;
        at::attn_unit<8>(b, h, qb, Q, Kg, Vg, maskQ, MIX, ms0, ms1, shm, tid);
    }
}


#define REP(bit) for (int rep_ = 0; rep_ < (((PROBE_MASK) >> (bit)) & 1) + 1; ++rep_)
struct Args { const float* in[20]; float* out; unsigned char* ws; int seg_lo, seg_hi; };
constexpr int N_SEG = 1 + 2 * 8 + 2 * 9;

__global__ void __launch_bounds__(NTHR, 2) fwd_kernel(Args a) {
    extern __shared__ __attribute__((aligned(16))) unsigned char lds_raw[];
    Frame F0;
    F0.lds = (LAS unsigned char*)lds_raw;
    F0.tid = threadIdx.x; F0.lane = F0.tid & 63; F0.wave = __builtin_amdgcn_readfirstlane(F0.tid >> 6);
    F0.G = gridDim.x; { const int bx = blockIdx.x; F0.vcu = (F0.G % 8 == 0) ? (bx % 8) * (F0.G / 8) + bx / 8 : bx; }
    F0.ws = a.ws;
    for (int u = F0.tid; u < (LDS_BYTES - LDSCTL_OFF) / 4; u += NTHR) ((LAS unsigned*)(F0.lds + LDSCTL_OFF))[u] = 0u;
    __syncthreads();
    unsigned* ctl = (unsigned*)(F0.ws + WS_CTL);
    XcdBarrier bar = xcd_barrier_post(ctl + CW_BAR, (volatile LAS unsigned*)(F0.lds + MISC_OFF + 32));
    int sg = 0;
    const int lo = a.seg_lo, hi = a.seg_hi;
#define ACTIVE (lo <= sg && sg < hi)
#define SEAM() do { if (lo <= sg && sg + 1 < hi) xcd_barrier(bar); ++sg; } while (0)

    if (ACTIVE) { Frame F = fresh(F0); cvt_x(F); convert_weights(F, 0); }
    SEAM();
    for (int l = 0; l < DEPTH; ++l) {
        if (ACTIVE) REP(3) {
            {
                Frame F = fresh(F0);
                pg8::DenseOrderG S; S.init_tiles(M / 256, 10, F.G, (int)(F.G % 8 == 0 ? (F.vcu % (F.G / 8)) * 8 + F.vcu / (F.G / 8) : F.vcu)); S.Bt = (const char*)WSP(unsigned char, WS_WIN); S.K = DM / 2;
                pg8::EpiIn E{WSP(bf16, WS_Q), WSP(bf16, WS_K), WSP(bf16, WS_V), WSP(bf16, WS_QI), WSP(bf16, WS_KI), WSP(bf16, WS_U), WSP(float, WS_WI), 0, 1.0f / (pg8::F8_ASC * pg8::F8_WGU), 6};
                pg8::gemm_phase<pg8::EpiIn, pg8::DenseOrderG, true, true, true>(F.tid, F.lds + RING_OFF, (const char*)WSP(unsigned char, WS_XQ), DM / 2, S, E);
            }
            {
                Frame F = fresh(F0);
                pg8::DenseOrder S; S.init_tiles(M / 256, 3, F.G, (int)(F.G % 8 == 0 ? (F.vcu % (F.G / 8)) * 8 + F.vcu / (F.G / 8) : F.vcu)); S.Bt = (const char*)(WSP(bf16, WS_WIN) + (size_t)1536 * DM); S.K = DM;
                pg8::EpiIn E{WSP(bf16, WS_Q), WSP(bf16, WS_K), WSP(bf16, WS_V), WSP(bf16, WS_QI), WSP(bf16, WS_KI), WSP(bf16, WS_U), WSP(float, WS_WI), 6, 1.0f, 99};
                pg8::gemm_phase<pg8::EpiIn, pg8::DenseOrder, true, true>(F.tid, F.lds + RING_OFF, (const char*)WSP(bf16, WS_XB), DM, S, E);
            }
        }
        SEAM();
        if (ACTIVE) {
#ifndef NO_IDX
            REP(0) { Frame F = fresh(F0); p_idx(F, l); }
#endif
#ifndef NO_CONV
            REP(1) { Frame F = fresh(F0); p_conv(F, l); }
#endif
        }
        SEAM();
        if (ACTIVE) {
#ifndef NO_ATTN
            REP(2) { Frame F = fresh(F0); p_attn(F, l); }
#endif
        }
        SEAM();
        if (ACTIVE) REP(4) { Frame F = fresh(F0); bf16* R1 = WSP(bf16, WS_R1);
            pg8::DenseOrder S; S.init_tiles(M / 256, DM / 256, F.G, (int)(F.G % 8 == 0 ? (F.vcu % (F.G / 8)) * 8 + F.vcu / (F.G / 8) : F.vcu)); S.Bt = (const char*)WSP(bf16, WS_WOUT); S.K = DM;
            pg8::EpiRes E{WSP(bf16, WS_XB), R1, 1.0f};
            pg8::gemm_phase<pg8::EpiRes, pg8::DenseOrder, true, true>(F.tid, F.lds + RING_OFF, (const char*)WSP(bf16, WS_MIX), DM, S, E);
        }
        SEAM();
        if (ACTIVE) { Frame F = fresh(F0); p_ln1(F, l); }
        SEAM();
        if ((l & 1) == 0) {
            if (ACTIVE) REP(5) { Frame F = fresh(F0); bf16* XB = WSP(bf16, WS_XB);
                pg8::DenseOrderG S; S.init_tiles(M / 256, 2 * DFF / 256, F.G, (int)(F.G % 8 == 0 ? (F.vcu % (F.G / 8)) * 8 + F.vcu / (F.G / 8) : F.vcu)); S.Bt = (const char*)WSP(bf16, WS_WFF); S.K = DM / 2;
                pg8::EpiSwi E{WSP(unsigned char, WS_H), DFF};
                pg8::gemm_phase<pg8::EpiSwi, pg8::DenseOrderG, true, true, true>(F.tid, F.lds + RING_OFF, (const char*)XB, DM / 2, S, E);
            }
            SEAM();
            if (ACTIVE) { Frame F = fresh(F0); bf16* R1 = WSP(bf16, WS_R1);
                pg8::DenseOrderG S; S.init_tiles(M / 256, DM / 256, F.G, (int)(F.G % 8 == 0 ? (F.vcu % (F.G / 8)) * 8 + F.vcu / (F.G / 8) : F.vcu)); S.Bt = (const char*)(WSP(unsigned char, WS_WFF) + (size_t)2 * DFF * DM); S.K = DFF / 2;
                pg8::EpiRes E{R1, R1, 1.0f / (pg8::F8_HSC * pg8::F8_WDN)};
                pg8::gemm_phase<pg8::EpiRes, pg8::DenseOrderG, true, true, true>(F.tid, F.lds + RING_OFF, (const char*)WSP(unsigned char, WS_H), DFF / 2, S, E);
            }
            SEAM();
            if (ACTIVE) { REP(11) { Frame F = fresh(F0); p_ln2(F, l); } if (l + 1 < DEPTH) REP(8) { Frame F = fresh(F0); convert_weights(F, l + 1); } }
            SEAM();
        } else {
            if (ACTIVE) { Frame F = fresh(F0); p_list(F); }
            SEAM();
            for (int r = 0; r < 1; ++r) {
                if (ACTIVE) REP(6) { Frame F = fresh(F0); bf16* XB = WSP(bf16, WS_XB);
                    moe_tables(F);
                    const int Tm = ((LAS int*)(F.lds + LDSCTL_OFF + 1200))[8]; const int tlo = r * RT; int nMr = Tm - tlo; nMr = nMr < 0 ? 0 : (nMr > RT ? RT : nMr);
                    pg8::MoeGuOrder S; S.init_tiles(nMr, 2 * DFE / 256, F.G, (int)(F.G % 8 == 0 ? (F.vcu % (F.G / 8)) * 8 + F.vcu / (F.G / 8) : F.vcu)); S.rowlist = WSP(int, WS_ROWLIST); S.texp = (const LAS int*)(F.lds + LDSCTL_OFF); S.tlo = tlo;
                    S.W = (const char*)WSP(unsigned char, WS_WFF); S.estride = (size_t)3 * DFE * DM;
                    pg8::EpiSwi E{WSP(unsigned char, WS_H), DFE};
                    pg8::gemm_phase<pg8::EpiSwi, pg8::MoeGuOrder, true, true, true>(F.tid, F.lds + RING_OFF, (const char*)XB, DM / 2, S, E);
                }
                SEAM();
                if (ACTIVE) REP(7) { Frame F = fresh(F0);
                    moe_tables(F);
                    const int Tm = ((LAS int*)(F.lds + LDSCTL_OFF + 1200))[8]; const int tlo = r * RT; int nMr = Tm - tlo; nMr = nMr < 0 ? 0 : (nMr > RT ? RT : nMr);
                    pg8::MoeDnOrder S; S.init_tiles(nMr, DM / 256, F.G, (int)(F.G % 8 == 0 ? (F.vcu % (F.G / 8)) * 8 + F.vcu / (F.G / 8) : F.vcu)); S.texp = (const LAS int*)(F.lds + LDSCTL_OFF); S.tlo = tlo;
                    S.W = (const char*)(WSP(unsigned char, WS_WFF) + (size_t)2 * DFE * DM); S.estride = (size_t)3 * DFE * DM;
                    pg8::EpiMoeDown E{WSP(bf16, WS_YD), WSP(float, WS_ROWGATE), tlo};
                    pg8::gemm_phase<pg8::EpiMoeDown, pg8::MoeDnOrder, true, true, true>(F.tid, F.lds + RING_OFF, (const char*)WSP(unsigned char, WS_H), DFE / 2, S, E);
                }
                SEAM();
            }
            if (ACTIVE) { REP(10) { Frame F = fresh(F0); p_comb(F, l); } if (l + 1 < DEPTH) REP(8) { Frame F = fresh(F0); convert_weights(F, l + 1); } }
            SEAM();
        }
    }
#undef ACTIVE
#undef SEAM
}

#ifndef MK_MULTI
#define MK_MULTI 0
#endif
extern "C" void kernel_launch(void* const* d_in, const int* in_sizes, int n_in, void* d_out, int out_size, void* d_ws, size_t ws_size, hipStream_t stream) {
    static int grid = 0;
    if (grid == 0) {
        if (n_in != 20 || in_sizes[0] != M * DM || out_size != M * DM || ws_size < WS_END) { fprintf(stderr, "kernel_launch: unexpected shapes (n_in %d, in0 %d, out %d, ws %zu, need %zu); nothing launched\n", n_in, n_in > 0 ? in_sizes[0] : -1, out_size, ws_size, (size_t)WS_END); grid = -1; return; }
        int dev = 0, cus = 0, per_cu = 0;
        if (hipGetDevice(&dev) != hipSuccess || hipDeviceGetAttribute(&cus, hipDeviceAttributeMultiprocessorCount, dev) != hipSuccess) { grid = -1; return; }
        if (hipFuncSetAttribute((const void*)fwd_kernel, hipFuncAttributeMaxDynamicSharedMemorySize, LDS_BYTES) != hipSuccess) { fprintf(stderr, "kernel_launch: hipFuncSetAttribute failed\n"); grid = -1; return; }
        if (hipOccupancyMaxActiveBlocksPerMultiprocessor(&per_cu, (const void*)fwd_kernel, NTHR, LDS_BYTES) != hipSuccess || per_cu < 1) fprintf(stderr, "kernel_launch: occupancy query reports %d\n", per_cu);
        (void)hipGetLastError();
        grid = cus;
        if (grid != 256) { fprintf(stderr, "kernel_launch: built for 256 CUs, device has %d; nothing launched\n", cus); grid = -1; return; }
    }
    if (grid < 0) return;
    if (hipMemsetAsync((char*)d_ws + WS_CTL, 0, CTL_ZERO_BYTES, stream) != hipSuccess) return;
    Args a{};
    for (int i = 0; i < 20; ++i) a.in[i] = (const float*)d_in[i];
    a.out = (float*)d_out; a.ws = (unsigned char*)d_ws;
#if MK_MULTI
    for (int s = 0; s < N_SEG; ++s) { a.seg_lo = s; a.seg_hi = s + 1; hipLaunchKernelGGL(fwd_kernel, dim3(grid), dim3(NTHR), LDS_BYTES, stream, a); }
#else
    a.seg_lo = 0; a.seg_hi = N_SEG;
    hipLaunchKernelGGL(fwd_kernel, dim3(grid), dim3(NTHR), LDS_BYTES, stream, a);
#endif
    const hipError_t le = hipPeekAtLastError();
    if (le != hipSuccess) fprintf(stderr, "kernel_launch: launch failed: %s\n", hipGetErrorName(le));
}
```

```cpp
#include <hip/hip_runtime.h>
#include <cstdio>
#include <cstdint>

#define GAS __attribute__((address_space(1)))
#define LAS __attribute__((address_space(3)))
#define CAS __attribute__((address_space(4)))
typedef unsigned short bf16;
typedef short bf16x8 __attribute__((ext_vector_type(8)));
typedef short s16x4 __attribute__((ext_vector_type(4)));
typedef float f32x2 __attribute__((ext_vector_type(2)));
typedef float f32x4 __attribute__((ext_vector_type(4)));
typedef float f32x16 __attribute__((ext_vector_type(16)));
typedef unsigned u32x2 __attribute__((ext_vector_type(2)));
typedef unsigned u32x4 __attribute__((ext_vector_type(4)));
typedef int i32x8 __attribute__((ext_vector_type(8)));

#ifndef PROBE_MASK
#define PROBE_MASK 0
#endif
constexpr int BATCH = 8, SEQ = 4096, DM = 1024, M = BATCH * SEQ, DEPTH = 4;
constexpr int AW = 512, NH = 8, HD = 64, CCH = 512, CK = 31;
constexpr int IN_COLS = 3144, NIN = 3328;
constexpr int OFF_KI = 2048, OFF_WI = 2112, OFF_GLU = 2120;
constexpr int DFF = 2816, DFE = 3584, NE = 8;
constexpr int TOPK = 256;
constexpr float DN_ALPHA = 1.6817928305074290f;
constexpr float LN_EPS = 1e-5f;
constexpr float LOG2E = 1.4426950408889634f;
constexpr float QSCALE = 0.125f * LOG2E;
constexpr int NWAVES = 8, NTHR = 512;
constexpr int MAXT = 272, RT = 272;

constexpr size_t MiB = 1u << 20;
constexpr size_t WS_CTL = 0, CTL_ZERO_BYTES = 1 * MiB;
constexpr size_t WS_WIN = 1 * MiB, WS_WOUT = 8 * MiB, WS_WFF = 10 * MiB;
constexpr size_t WS_R1 = 178 * MiB, WS_XB = 306 * MiB, WS_A = 370 * MiB;
constexpr size_t WS_Q = WS_A, WS_K = WS_A + 32 * MiB, WS_V = WS_A + 64 * MiB, WS_QI = WS_A + 96 * MiB, WS_KI = WS_A + 128 * MiB, WS_WI = WS_A + 132 * MiB,
                 WS_U = WS_A + 133 * MiB, WS_MIX = WS_A + 165 * MiB, WS_H = WS_A;
constexpr size_t WS_YD = 616 * MiB, WS_ROUTE = 752 * MiB, WS_ROWLIST = WS_ROUTE + 512 * 1024, WS_ROWGATE = WS_ROWLIST + 320 * 1024, WS_SLOTROW = WS_ROWGATE + 320 * 1024,
                 WS_CNTWG = WS_SLOTROW + 256 * 1024, WS_MASK = 754 * MiB, WS_XQ = 820 * MiB, WS_END = 852 * MiB;
static_assert((size_t)RT * 256 * DFE <= 246 * MiB && (size_t)M * DFF <= 246 * MiB, "H overlay (fp8)");
static_assert((size_t)MAXT * 256 * DM * 2 <= 136 * MiB, "Yd");
static_assert(WS_CNTWG + 8192 <= WS_MASK && WS_MASK + (size_t)DEPTH * BATCH * 128 * 4096 * 4 <= WS_XQ, "route / masks");
constexpr int CW_BAR = 4096;

constexpr int RING_OFF = 0, RING_BYTES = 131072;
constexpr int AUX_OFF = 131072, AUX_BYTES = 26624;
constexpr int LDSCTL_OFF = AUX_OFF + AUX_BYTES, MISC_OFF = LDSCTL_OFF + 2048;
constexpr int LDS_BYTES = 157 * 1024;
static_assert(MISC_OFF + 128 <= LDS_BYTES, "LDS map");

__device__ __forceinline__ unsigned cvt_pk_bf16(float lo, float hi) { unsigned r; asm volatile("v_cvt_pk_bf16_f32 %0, %1, %2" : "=v"(r) : "v"(lo), "v"(hi)); return r; }
__device__ __forceinline__ float bf2f(unsigned short b) { return __uint_as_float((unsigned)b << 16); }
__device__ __forceinline__ float fsigmoid(float x) { return __builtin_amdgcn_rcpf(1.0f + __builtin_amdgcn_exp2f(-x * LOG2E)); }
#define LDS_WAIT() asm volatile("s_waitcnt lgkmcnt(0)" ::: "memory")
#define VM_WAIT() asm volatile("s_waitcnt vmcnt(0)" ::: "memory")

namespace pg8 {
constexpr int BM = 256, BK = 64, HALF = 128, HTB = HALF * BK * 2, STAGE_BYTES = 8 * HTB, NXCD = 8, WGM = 8;
__host__ __device__ __forceinline__ int lds_byte(int r, int c) { const int st = (r >> 4) * 2 + (c >> 5), rr = r & 15, cc = c & 31, ob = rr * 64 + cc * 2; return st * 1024 + (ob ^ (((ob >> 9) & 1) << 5)); }
__host__ __device__ __forceinline__ void stage_rc(int b, int& R, int& C) { const int st = b / 1024, sb = b % 1024, swz = sb ^ (((sb >> 9) & 1) << 5); R = (st >> 1) * 16 + swz / 64; C = (st & 1) * 32 + (swz % 64) / 2; }
__host__ __device__ __forceinline__ int perm32(int rho) { const int n = rho >> 4, i = rho & 15; return 8 * (i >> 2) + 4 * n + (i & 3); }
struct Unit { int pm, pn; };

struct OrderBase {
    int nM, nN, nwg, G, c;
    __device__ __forceinline__ void init_tiles(int nM_, int nN_, int G_, int c_) { nM = nM_; nN = nN_; nwg = nM * nN; G = G_; c = c_; }
    __device__ __forceinline__ bool next(int i, Unit& u) const { const long L = (long)i * G + c; if (L >= nwg) return false; unit_of((int)L, u); return true; }
    __device__ __forceinline__ void unit_of(int L, Unit& u) const {
        int wgid = L; { const int q = nwg / NXCD, r = nwg % NXCD, xcd = wgid % NXCD, off = wgid / NXCD; wgid = (xcd < r ? xcd * (q + 1) : r * (q + 1) + (xcd - r) * q) + off; }
        const int nig = WGM * nN, gid = wgid / nig, fm = gid * WGM, gsz = (nM - fm) < WGM ? (nM - fm) : WGM;
        u.pm = fm + ((wgid % nig) % gsz); u.pn = (wgid % nig) / gsz;
    }
    __device__ __forceinline__ void a_ready(const Unit&) const {}
    __device__ __forceinline__ void done(const Unit&) const {}
};
struct DenseOrder : OrderBase {
    static constexpr bool GATHER = false;
    const char* Bt; int K;
    __device__ __forceinline__ size_t a_base(const Unit& u) const { return (size_t)u.pm * ((size_t)BM * K * 2); }
    __device__ __forceinline__ unsigned a_off(const Unit&, int) const { return 0u; }
    __device__ __forceinline__ const char* b_base(const Unit& u) const { return Bt + (size_t)u.pn * ((size_t)BM * K * 2); }
};

struct DenseOrderG : OrderBase {
    static constexpr bool GATHER = true;
    const char* Bt; int K;
    __device__ __forceinline__ size_t a_base(const Unit&) const { return 0; }
    __device__ __forceinline__ unsigned a_off(const Unit& u, int r) const { return (unsigned)(u.pm * BM + r) * (unsigned)(K * 2); }
    __device__ __forceinline__ const char* b_base(const Unit& u) const { return Bt + (size_t)u.pn * ((size_t)BM * K * 2); }
};

template <class Epi, class Sched, bool ALIGN_EPI, bool SP2, bool F8 = false>
__device__ __forceinline__ void gemm_phase(const int tid, LAS unsigned char* lds, const char* Abase, const int K, const Sched& S, const Epi& E) {
    const int wid = __builtin_amdgcn_readfirstlane(tid >> 6), lane = tid & 63, wr = wid >> 2, wc = wid & 3, fr = lane & 15, fq = lane >> 4;
    const int nt = K / BK;
    constexpr bool GATHER = Sched::GATHER;
    unsigned voffA[2], voffB[2];
#pragma unroll
    for (int i = 0; i < 2; ++i) { int R, C; stage_rc(tid * 16 + i * 8192, R, C); const int Rb = Epi::PERM ? ((R & ~31) + perm32(R & 31)) : R;
        voffA[i] = GATHER ? (unsigned)C * 2u : (unsigned)(R * K + C) * 2u; voffB[i] = (unsigned)(Rb * K + C) * 2u; }
    const size_t kstep = (size_t)(BK * 2);
    const size_t hstep = (size_t)HALF * K * 2;
    const unsigned ldsw = (unsigned)wid * 1024u;
    const int aoff = lds_byte(wr * 64 + fr, fq * 8), boff = lds_byte(wc * 32 + fr, fq * 8);
#define PG8_SA(b, h) (((b) * 2 + (h)) * HTB)
#define PG8_SB(b, h) ((4 + (b) * 2 + (h)) * HTB)
#define PG8_STAGE(bufoff, gbase, voff) do { _Pragma("unroll") for (int _i = 0; _i < 2; ++_i) \
        __builtin_amdgcn_global_load_lds((const unsigned*)((const char*)(gbase) + (voff)[_i]), (LAS unsigned*)(lds + (bufoff) + ldsw + _i * 8192), 16, 0, 0); } while (0)
typedef int i32x4_t __attribute__((ext_vector_type(4)));
#define PG8_LDA(dst, b, h) do { _Pragma("unroll") for (int m = 0; m < 4; ++m) { if constexpr (F8) { dst[m].lo = *(const LAS i32x4_t*)(lds + PG8_SA(b, h) + aoff + m * 2048); dst[m].hi = *(const LAS i32x4_t*)(lds + PG8_SA(b, h) + aoff + m * 2048 + 1024); } \
        else { _Pragma("unroll") for (int k = 0; k < 2; ++k) dst##b16[m][k] = *(const LAS bf16x8*)(lds + PG8_SA(b, h) + aoff + m * 2048 + k * 1024); } } } while (0)
#define PG8_LDB(dst, b, h) do { _Pragma("unroll") for (int n = 0; n < 2; ++n) { if constexpr (F8) { dst[n].lo = *(const LAS i32x4_t*)(lds + PG8_SB(b, h) + boff + n * 2048); dst[n].hi = *(const LAS i32x4_t*)(lds + PG8_SB(b, h) + boff + n * 2048 + 1024); } \
        else { _Pragma("unroll") for (int k = 0; k < 2; ++k) dst##b16[n][k] = *(const LAS bf16x8*)(lds + PG8_SB(b, h) + boff + n * 2048 + k * 1024); } } } while (0)
#define PG8_MMA(ai, bj, At, Bt) do { __builtin_amdgcn_s_setprio(1); _Pragma("unroll") for (int m = 0; m < 4; ++m) _Pragma("unroll") for (int n = 0; n < 2; ++n) { \
        if constexpr (F8) { acc[ai][bj][m][n] = __builtin_amdgcn_mfma_scale_f32_16x16x128_f8f6f4(Bt[n], At[m], acc[ai][bj][m][n], 0, 0, 0, 0x7f7f7f7f, 0, 0x7f7f7f7f); } \
        else { _Pragma("unroll") for (int k = 0; k < 2; ++k) acc[ai][bj][m][n] = __builtin_amdgcn_mfma_f32_16x16x32_bf16(Bt##b16[n][k], At##b16[m][k], acc[ai][bj][m][n], 0, 0, 0); } } __builtin_amdgcn_s_setprio(0); } while (0)
#define PG8_WAIT_V(n) asm volatile("s_waitcnt vmcnt(" #n ")" ::: "memory")
#define PG8_WAIT_L(n) asm volatile("s_waitcnt lgkmcnt(" #n ")" ::: "memory")
#define PG8_BAR __builtin_amdgcn_s_barrier()
#define PG8_SCHED __builtin_amdgcn_sched_barrier(0)
    Unit cur, nxt; int ui = 0;
    if (!S.next(0, cur)) return;
    f32x4 acc[2][2][4][2];
    { float z0 = 0.f; asm volatile("" : "+v"(z0));
#pragma unroll
    for (int a = 0; a < 2; ++a)
#pragma unroll
        for (int b = 0; b < 2; ++b)
#pragma unroll
            for (int m = 0; m < 4; ++m)
#pragma unroll
                for (int n = 0; n < 2; ++n) acc[a][b][m][n] = (f32x4){z0, z0, z0, z0}; }
    bf16x8 Atb16[F8 ? 1 : 4][2], B0b16[F8 ? 1 : 2][2], B1b16[F8 ? 1 : 2][2]; i32x8 At[F8 ? 4 : 1], B0[F8 ? 2 : 1], B1[F8 ? 2 : 1]; (void)Atb16; (void)B0b16; (void)B1b16; (void)At; (void)B0; (void)B1;
    unsigned cOff0[2], cOff1[2];
#define PG8_ROWS(u) do { if constexpr (GATHER) { _Pragma("unroll") for (int _i = 0; _i < 2; ++_i) { int R_, C_; stage_rc(tid * 16 + _i * 8192, R_, C_); cOff0[_i] = S.a_off(u, R_) + voffA[_i]; cOff1[_i] = S.a_off(u, HALF + R_) + voffA[_i]; } } } while (0)
#define PG8_STAGE_A(bufoff, h, ptr) do { if constexpr (GATHER) { if ((h) == 0) PG8_STAGE(bufoff, ptr, cOff0); else PG8_STAGE(bufoff, ptr, cOff1); } else { PG8_STAGE(bufoff, (ptr) + (h) * hstep, voffA); } } while (0)
    const char* cA = Abase; if constexpr (!GATHER) cA = Abase + S.a_base(cur);
    PG8_ROWS(cur);
    const char* cB = S.b_base(cur);
    S.a_ready(cur);
    {
        PG8_STAGE(PG8_SB(0, 0), cB, voffB); PG8_STAGE(PG8_SB(0, 1), cB + hstep, voffB); PG8_STAGE_A(PG8_SA(0, 0), 0, cA); PG8_STAGE_A(PG8_SA(0, 1), 1, cA);
        if (wr == 1) PG8_BAR;
        PG8_WAIT_V(2); PG8_BAR;
        PG8_STAGE(PG8_SB(1, 0), cB + kstep, voffB); PG8_STAGE_A(PG8_SA(1, 0), 0, cA + kstep); PG8_STAGE(PG8_SB(1, 1), cB + hstep + kstep, voffB);
        PG8_WAIT_V(6); PG8_BAR;
    }
    for (;;) {
        const bool has_next = S.next(ui + 1, nxt);
        unsigned nOff0[2] = {0u, 0u}, nOff1[2] = {0u, 0u};
        if constexpr (GATHER) { if (has_next) { _Pragma("unroll") for (int _i = 0; _i < 2; ++_i) { int R_, C_; stage_rc(tid * 16 + _i * 8192, R_, C_); nOff0[_i] = S.a_off(nxt, R_); nOff1[_i] = S.a_off(nxt, HALF + R_); } } }
        const char* nA = cA; if constexpr (!GATHER) { if (has_next) nA = Abase + S.a_base(nxt); }
        const char* nB = has_next ? S.b_base(nxt) : cB;
#pragma nounroll
        for (int t = 0; t < nt; t += 2) {
            const bool last = (t == nt - 2);
            const char* a1 = cA + (size_t)(t + 1) * kstep;
            const char* a2 = last ? nA : cA + (size_t)(t + 2) * kstep; const char* b2 = last ? nB : cB + (size_t)(t + 2) * kstep;
            const char* a3 = a2 + kstep; const char* b3 = b2 + kstep;
            if (last && has_next) S.a_ready(nxt);
            if constexpr (SP2) {
            PG8_LDB(B0, 0, 0); PG8_LDB(B1, 0, 1); PG8_SCHED; PG8_LDA(At, 0, 0); PG8_STAGE_A(PG8_SA(1, 1), 1, a1);
            if constexpr (GATHER) { if (last && has_next) { _Pragma("unroll") for (int _i = 0; _i < 2; ++_i) { cOff0[_i] = nOff0[_i] + voffA[_i]; cOff1[_i] = nOff1[_i] + voffA[_i]; } } }
            PG8_WAIT_V(8); PG8_WAIT_L(0); PG8_BAR; PG8_MMA(0, 0, At, B0); PG8_MMA(0, 1, At, B1); PG8_BAR; PG8_SCHED;
            PG8_LDA(At, 0, 1); PG8_STAGE(PG8_SB(0, 0), b2, voffB); PG8_STAGE(PG8_SB(0, 1), b2 + hstep, voffB); PG8_STAGE_A(PG8_SA(0, 0), 0, a2);
            PG8_WAIT_V(8); PG8_WAIT_L(0); PG8_BAR; PG8_MMA(1, 0, At, B0); PG8_MMA(1, 1, At, B1); PG8_BAR; PG8_SCHED;
            PG8_LDB(B0, 1, 0); PG8_LDB(B1, 1, 1); PG8_SCHED; PG8_LDA(At, 1, 0); PG8_STAGE_A(PG8_SA(0, 1), 1, a2);
            PG8_WAIT_V(8); PG8_WAIT_L(0); PG8_BAR; PG8_MMA(0, 0, At, B0); PG8_MMA(0, 1, At, B1); PG8_BAR; PG8_SCHED;
            PG8_LDA(At, 1, 1); PG8_STAGE(PG8_SB(1, 0), b3, voffB); PG8_STAGE(PG8_SB(1, 1), b3 + hstep, voffB); PG8_STAGE_A(PG8_SA(1, 0), 0, a3);
            PG8_WAIT_V(8); PG8_WAIT_L(0); PG8_BAR; PG8_MMA(1, 0, At, B0); PG8_MMA(1, 1, At, B1); PG8_BAR; PG8_SCHED;
            } else { static_assert(SP2, "only the two-super-phase loop is kept"); }
        }
        if constexpr (ALIGN_EPI) { if (wr == 0) PG8_BAR; }
        E(acc, cur, wr, wc, fr, fq); S.done(cur);
        if (!has_next) break;
        { float z0 = 0.f; asm volatile("" : "+v"(z0));
#pragma unroll
        for (int a = 0; a < 2; ++a)
#pragma unroll
            for (int b = 0; b < 2; ++b)
#pragma unroll
                for (int m = 0; m < 4; ++m)
#pragma unroll
                    for (int n = 0; n < 2; ++n) acc[a][b][m][n] = (f32x4){z0, z0, z0, z0}; }
        cur = nxt; cA = nA; cB = nB; ++ui;
        if constexpr (ALIGN_EPI) { if (wr == 1) PG8_BAR; }
    }
    PG8_WAIT_V(0);
    if constexpr (!ALIGN_EPI) { if (wr == 0) PG8_BAR; }
    PG8_BAR;
#undef PG8_SA
#undef PG8_SB
#undef PG8_STAGE
#undef PG8_STAGE_A
#undef PG8_ROWS
#undef PG8_LDA
#undef PG8_LDB
#undef PG8_MMA
#undef PG8_WAIT_V
#undef PG8_WAIT_L
#undef PG8_BAR
#undef PG8_SCHED
}
}

namespace pg8 {
__device__ __forceinline__ u32x4 pack8(const f32x4 v0, const f32x4 v1) { u32x4 w; w.x = cvt_pk_bf16(v0[0], v0[1]); w.y = cvt_pk_bf16(v0[2], v0[3]); w.z = cvt_pk_bf16(v1[0], v1[1]); w.w = cvt_pk_bf16(v1[2], v1[3]); return w; }

__device__ __forceinline__ unsigned pk4_fp8(float a, float b, float c, float d) {
    a = __builtin_amdgcn_fmed3f(a, -448.f, 448.f); b = __builtin_amdgcn_fmed3f(b, -448.f, 448.f); c = __builtin_amdgcn_fmed3f(c, -448.f, 448.f); d = __builtin_amdgcn_fmed3f(d, -448.f, 448.f);
    unsigned r = 0u; r = (unsigned)__builtin_amdgcn_cvt_pk_fp8_f32(a, b, (int)r, false); r = (unsigned)__builtin_amdgcn_cvt_pk_fp8_f32(c, d, (int)r, true); return r; }
__device__ __forceinline__ u32x2 pack8_fp8(const f32x4 v0, const f32x4 v1) { u32x2 w; w.x = pk4_fp8(v0[0], v0[1], v0[2], v0[3]); w.y = pk4_fp8(v1[0], v1[1], v1[2], v1[3]); return w; }
constexpr float F8_ASC = 16.f, F8_WGU = 64.f, F8_HSC = 8.f, F8_WDN = 256.f;
struct EpiIn {
    static constexpr bool PERM = true;
    bf16 *Q, *Kb, *V, *QI, *KI, *U; float* WI; int pn_off; float dsc; int glu_from;
    __device__ __forceinline__ void operator()(const f32x4 (&acc)[2][2][4][2], const Unit& u, int wr, int wc, int fr, int fq) const {
        const int row0 = u.pm * BM + wr * 64 + fr; const int pn = (u.pn >= glu_from) ? u.pn - glu_from + 9 : u.pn + pn_off;
        if (pn < 2 || (pn >= 6 && pn < 8)) {
            bf16* base = (pn < 2) ? Q : QI;
            const float sc = ((pn < 2) ? QSCALE : 1.0f) * dsc;
            const int col0 = (pn & 1) * 256 + wc * 32 + 8 * fq;
#pragma unroll
            for (int ai = 0; ai < 2; ++ai)
#pragma unroll
                for (int m = 0; m < 4; ++m) { bf16* rowp = base + (size_t)(row0 + ai * HALF + m * 16) * AW + col0;
#pragma unroll
                    for (int bj = 0; bj < 2; ++bj) *(u32x4*)(rowp + bj * HALF) = pack8(acc[ai][bj][m][0] * sc, acc[ai][bj][m][1] * sc); }
        } else if (pn < 6) {
            const bool isK = pn < 4; bf16* base = isK ? Kb : V;
#pragma unroll
            for (int ai = 0; ai < 2; ++ai)
#pragma unroll
                for (int m = 0; m < 4; ++m) { const int row = row0 + ai * HALF + m * 16, bb = row >> 12, t = row & 4095, tile = t >> 6, r = t & 63;
#pragma unroll
                    for (int bj = 0; bj < 2; ++bj) { const int col = (pn & 1) * 256 + bj * HALF + wc * 32 + 8 * fq, h = col >> 6, d = col & 63;
                        const size_t tb = ((size_t)((bb * NH + h) * 64 + tile)) * 4096;
                        const size_t off = isK ? tb + (d >> 3) * 512 + r * 8 : tb + (d >> 5) * 2048 + r * 32 + (d & 31);
                        *(u32x4*)(base + off) = pack8(acc[ai][bj][m][0] * dsc, acc[ai][bj][m][1] * dsc); } }
        } else if (pn == 8) {
#pragma unroll
            for (int ai = 0; ai < 2; ++ai)
#pragma unroll
                for (int m = 0; m < 4; ++m) { const size_t row = (size_t)(row0 + ai * HALF + m * 16);
                    if (wc < 2) { const int c8 = wc * 4 + fq;
                        *(u32x4*)(KI + (row >> 5) * 2048 + (c8 >> 1) * 512 + (c8 & 1) * 256 + (row & 31) * 8) = pack8(acc[ai][0][m][0] * dsc, acc[ai][0][m][1] * dsc); }
                    else if (wc == 2 && fq == 0) { *(f32x4*)(WI + row * 8) = acc[ai][0][m][0] * dsc; *(f32x4*)(WI + row * 8 + 4) = acc[ai][0][m][1] * dsc; } }
        } else {
            const int col0 = (pn - 9) * 128 + wc * 32 + 8 * fq;
#pragma unroll
            for (int ai = 0; ai < 2; ++ai)
#pragma unroll
                for (int m = 0; m < 4; ++m) { f32x4 o[2];
#pragma unroll
                    for (int n = 0; n < 2; ++n) { const f32x4 a = acc[ai][0][m][n], g = acc[ai][1][m][n];
#pragma unroll
                        for (int e = 0; e < 4; ++e) o[n][e] = a[e] * dsc * fsigmoid(g[e] * dsc); }
                    *(u32x4*)(U + (size_t)(row0 + ai * HALF + m * 16) * CCH + col0) = pack8(o[0], o[1]); }
        }
    }
};
struct EpiRes {
    static constexpr bool PERM = true;
    const bf16* base; bf16* out; float asc;
    __device__ __forceinline__ void operator()(const f32x4 (&acc)[2][2][4][2], const Unit& u, int wr, int wc, int fr, int fq) const {
        const int row0 = u.pm * BM + wr * 64 + fr, col0 = u.pn * BM + wc * 32 + 8 * fq;
#pragma unroll
        for (int ai = 0; ai < 2; ++ai) {
            u32x4 bsv[4][2];
#pragma unroll
            for (int m = 0; m < 4; ++m)
#pragma unroll
                for (int bj = 0; bj < 2; ++bj) bsv[m][bj] = __builtin_nontemporal_load((const u32x4*)(base + (size_t)(row0 + ai * HALF + m * 16) * DM + col0 + bj * HALF));
#pragma unroll
            for (int m = 0; m < 4; ++m) { const size_t off = (size_t)(row0 + ai * HALF + m * 16) * DM + col0;
#pragma unroll
                for (int bj = 0; bj < 2; ++bj) { const u32x4 bs = bsv[m][bj];
                    f32x4 b0, b1; b0[0] = __uint_as_float(bs.x << 16); b0[1] = __uint_as_float(bs.x & 0xffff0000u); b0[2] = __uint_as_float(bs.y << 16); b0[3] = __uint_as_float(bs.y & 0xffff0000u);
                    b1[0] = __uint_as_float(bs.z << 16); b1[1] = __uint_as_float(bs.z & 0xffff0000u); b1[2] = __uint_as_float(bs.w << 16); b1[3] = __uint_as_float(bs.w & 0xffff0000u);
                    *(u32x4*)(out + off + bj * HALF) = pack8(b0 * DN_ALPHA + acc[ai][bj][m][0] * asc, b1 * DN_ALPHA + acc[ai][bj][m][1] * asc); } }
        }
    }
};
struct EpiSwi {
    static constexpr bool PERM = true;
    unsigned char* H; int ldh;
    __device__ __forceinline__ void operator()(const f32x4 (&acc)[2][2][4][2], const Unit& u, int wr, int wc, int fr, int fq) const {
        const int row0 = u.pm * BM + wr * 64 + fr, col0 = u.pn * 128 + wc * 32 + 8 * fq;
        constexpr float ds = 1.0f / (F8_ASC * F8_WGU);
#pragma unroll
        for (int ai = 0; ai < 2; ++ai)
#pragma unroll
            for (int m = 0; m < 4; ++m) { f32x4 o[2];
#pragma unroll
                for (int n = 0; n < 2; ++n) { const f32x4 ga = acc[ai][0][m][n], ua = acc[ai][1][m][n];
#pragma unroll
                    for (int e = 0; e < 4; ++e) o[n][e] = (ga[e] * ua[e]) * ((ds * ds * F8_HSC) * __builtin_amdgcn_rcpf(1.0f + __builtin_amdgcn_exp2f(ga[e] * (-ds * LOG2E)))); }
                *(u32x2*)(H + (size_t)(row0 + ai * HALF + m * 16) * ldh + col0) = pack8_fp8(o[0], o[1]); }
    }
};
struct EpiMoeDown {
    static constexpr bool PERM = true;
    bf16* Yd; const float* rowgate; int tlo;
    __device__ __forceinline__ void operator()(const f32x4 (&acc)[2][2][4][2], const Unit& u, int wr, int wc, int fr, int fq) const {
        const int row0 = (tlo + u.pm) * BM + wr * 64 + fr, col0 = u.pn * BM + wc * 32 + 8 * fq;
#pragma unroll
        for (int ai = 0; ai < 2; ++ai)
#pragma unroll
            for (int m = 0; m < 4; ++m) { const int row = row0 + ai * HALF + m * 16; const float gt = rowgate[row] * (1.0f / (F8_HSC * F8_WDN)); bf16* rowp = Yd + (size_t)row * DM + col0;
#pragma unroll
                for (int bj = 0; bj < 2; ++bj) *(u32x4*)(rowp + bj * HALF) = pack8(acc[ai][bj][m][0] * gt, acc[ai][bj][m][1] * gt); }
    }
};
struct MoeGuOrder : OrderBase {
    static constexpr bool GATHER = true;
    const int* rowlist; const LAS int* texp; int tlo; const char* W; size_t estride;
    __device__ __forceinline__ size_t a_base(const Unit&) const { return 0; }
    __device__ __forceinline__ unsigned a_off(const Unit& u, int r) const { return (unsigned)rowlist[(tlo + u.pm) * BM + r] * (unsigned)DM; }
    __device__ __forceinline__ const char* b_base(const Unit& u) const { return W + (size_t)texp[tlo + u.pm] * estride + (size_t)u.pn * ((size_t)BM * DM); }
};
struct MoeDnOrder : OrderBase {
    static constexpr bool GATHER = true;
    const LAS int* texp; int tlo; const char* W; size_t estride;
    __device__ __forceinline__ size_t a_base(const Unit&) const { return 0; }
    __device__ __forceinline__ unsigned a_off(const Unit& u, int r) const { return (unsigned)(u.pm * BM + r) * (unsigned)DFE; }
    __device__ __forceinline__ const char* b_base(const Unit& u) const { return W + (size_t)texp[tlo + u.pm] * estride + (size_t)u.pn * ((size_t)BM * DFE); }
};
}

typedef GAS unsigned gu32;
#define RLX_AGENT __ATOMIC_RELAXED, __HIP_MEMORY_SCOPE_AGENT
#define XB_TMO      128
#define XB_XCNT(j)  (256  + 64 * (j))
#define XB_XSUB(j)  (1280 + 64 * (j))
#define XB_XGEN(j)  (2304 + 64 * (j))
#define XB_TOP      3328
#define XB_TOPGEN   3392
#define XCD_BAR_WORDS 3456
#define XB_SPIN_CAP (1u << 18)

__device__ __forceinline__ unsigned xb_ld(unsigned* p)              { return __hip_atomic_load(p, __ATOMIC_RELAXED, __HIP_MEMORY_SCOPE_AGENT); }
__device__ __forceinline__ unsigned xb_add(unsigned* p, unsigned v) { return __hip_atomic_fetch_add(p, v, __ATOMIC_RELAXED, __HIP_MEMORY_SCOPE_AGENT); }
__device__ __forceinline__ unsigned xb_xcc_id() { return (unsigned)__builtin_amdgcn_s_getreg((3 << 11) | 20) & 0xFu; }
#define XB_SPIN(cond, bar) do { unsigned _sp = 0; while (cond) { __builtin_amdgcn_s_sleep(1); \
    if ((++_sp & 255u) == 0u) { if (xb_ld(&(bar)[XB_TMO])) break; if (_sp > XB_SPIN_CAP) { atomicAdd(&(bar)[XB_TMO], 1u); break; } } } } while (0)

struct XcdBarrier {
    unsigned* bar; unsigned x;
    volatile LAS unsigned* st;
};
__device__ __forceinline__ XcdBarrier xcd_barrier_post(unsigned* bar, volatile LAS unsigned* st) {
    XcdBarrier b; b.bar = bar; b.x = xb_xcc_id(); b.st = st;
    if (threadIdx.x == 0) (void)xb_add(&bar[XB_XCNT(b.x)], 1u);
    return b;
}
__device__ __forceinline__ void xcd_barrier_complete(unsigned* bar, unsigned x, unsigned& nloc, unsigned& nx) {
    const unsigned G = gridDim.x * gridDim.y * gridDim.z;
    unsigned sum, cnt, mine, sp = 0u;
    for (;;) {
        sum = 0u; cnt = 0u; mine = 0u;
#pragma unroll
        for (unsigned j = 0; j < 16; ++j) { const unsigned c = xb_ld(&bar[XB_XCNT(j)]); sum += c; cnt += (c > 0u) ? 1u : 0u; mine = (j == x) ? c : mine; }
        if (sum == G) break;
        __builtin_amdgcn_s_sleep(1);
        if ((++sp & 255u) == 0u) { if (xb_ld(&bar[XB_TMO])) break; if (sp > XB_SPIN_CAP) { atomicAdd(&bar[XB_TMO], 1u); break; } }
    }
    nloc = mine > 0u ? mine : 1u; nx = cnt > 0u ? cnt : 1u;
}
__device__ __forceinline__ void xcd_barrier(const XcdBarrier& b) {
    asm volatile("s_waitcnt vmcnt(0)" ::: "memory");
    __syncthreads();
    if (threadIdx.x == 0) {
        unsigned* bar = b.bar;
        __builtin_amdgcn_s_waitcnt(0);
        unsigned nloc = b.st[0], nx = b.st[1];
        if (nloc == 0u) { xcd_barrier_complete(bar, b.x, nloc, nx); b.st[0] = nloc; b.st[1] = nx; }
        const unsigned old = xb_add(&bar[XB_XSUB(b.x)], 1u);
        const unsigned gen = old / nloc;
        if (old + 1u == (gen + 1u) * nloc) {
            __builtin_amdgcn_fence(__ATOMIC_RELEASE, "agent");
            asm volatile("s_waitcnt vmcnt(0)" ::: "memory");
            const unsigned og = xb_add(&bar[XB_TOP], 1u);
            const unsigned tg = og / nx;
            if (og + 1u == (tg + 1u) * nx) xb_add(&bar[XB_TOPGEN], 1u);
            else XB_SPIN(xb_ld(&bar[XB_TOPGEN]) == tg, bar);
            __builtin_amdgcn_fence(__ATOMIC_ACQUIRE, "agent");
            xb_add(&bar[XB_XGEN(b.x)], 1u);
            asm volatile("s_waitcnt vmcnt(0)" ::: "memory");
        } else {
            XB_SPIN(xb_ld(&bar[XB_XGEN(b.x)]) == gen, bar);
            __builtin_amdgcn_fence(__ATOMIC_ACQUIRE, "agent");
            asm volatile("s_waitcnt vmcnt(0)" ::: "memory");
        }
    }
    __syncthreads();
}

struct Frame {
    LAS unsigned char* lds;
    int tid, lane, wave, vcu, G;
    unsigned char* ws;
};
__device__ __forceinline__ const float* arg_in(int k) { return (const float*)*(const GAS float* const volatile CAS*)((const CAS char*)__builtin_amdgcn_kernarg_segment_ptr() + 8 * k); }
__device__ __forceinline__ float* arg_out() { return (float*)*(GAS float* const volatile CAS*)((const CAS char*)__builtin_amdgcn_kernarg_segment_ptr() + 160); }
#define WSP(T, off) ((T*)(F.ws + (off)))
__device__ __forceinline__ Frame fresh(const Frame& F0) {
    Frame F = F0; int wv = F0.wave, v = F0.vcu, g = F0.G; asm volatile("" : "+s"(wv), "+s"(v), "+s"(g)); F.wave = wv; F.vcu = v; F.G = g;
    int ln; asm volatile("v_mbcnt_lo_u32_b32 %0, -1, 0\n\tv_mbcnt_hi_u32_b32 %0, -1, %0" : "=v"(ln)); F.lane = ln; F.tid = wv * 64 + ln;
    GAS unsigned char* w = (GAS unsigned char*)F0.ws; asm volatile("" : "+s"(w)); F.ws = (unsigned char*)w;
    return F;
}

__device__ __forceinline__ float wave_sum(float v) {
#define WS_DPP(x, ctrl) __int_as_float(__builtin_amdgcn_update_dpp(0, __float_as_int(x), (ctrl), 0xf, 0xf, false))
    v += WS_DPP(v, 0xB1); v += WS_DPP(v, 0x4E); v += WS_DPP(v, 0x141); v += WS_DPP(v, 0x140);
#undef WS_DPP
    const float r0 = __int_as_float(__builtin_amdgcn_readlane(__float_as_int(v), 0)), r1 = __int_as_float(__builtin_amdgcn_readlane(__float_as_int(v), 16)),
                r2 = __int_as_float(__builtin_amdgcn_readlane(__float_as_int(v), 32)), r3 = __int_as_float(__builtin_amdgcn_readlane(__float_as_int(v), 48));
    return (r0 + r1) + (r2 + r3);
}

struct TrItem { const float* W; int ldw, c0, nv, k0; void* WT; int Kd, r0; float scale; bool fp8; };
__device__ __forceinline__ void tr_load(const TrItem& t, f32x4 (&v)[16], int lane) {
    const int n4 = 4 * (lane & 15); const int nc = n4 < t.nv ? n4 : 0;
    const float* src = t.W + (size_t)(t.k0 + (lane >> 4)) * t.ldw + t.c0 + nc;
#pragma unroll
    for (int i = 0; i < 16; ++i) v[i] = *(const f32x4*)(src + (size_t)(4 * i) * t.ldw);
}
__device__ __forceinline__ void tr_to_lds(const TrItem& t, const f32x4 (&v)[16], LAS float* scr, int lane) {
    const int n4 = 4 * (lane & 15); const float ok = n4 < t.nv ? 1.f : 0.f;
#pragma unroll
    for (int i = 0; i < 16; ++i) { LAS float* d = scr + (4 * i + (lane >> 4)) * 65 + n4; d[0] = v[i][0] * ok; d[1] = v[i][1] * ok; d[2] = v[i][2] * ok; d[3] = v[i][3] * ok; }
}
__device__ __forceinline__ void tr_from_lds(const TrItem& t, LAS float* scr, int lane) {
    LDS_WAIT(); asm volatile("" ::: "memory");
    const int c = lane & 7; const float scale = t.scale;
    if (t.fp8) {
#pragma unroll
        for (int j = 0; j < 8; ++j) { const int nn = (lane >> 3) + 8 * j; const LAS float* s = scr + (8 * c) * 65 + nn;
            u32x2 o; o.x = pg8::pk4_fp8(s[0 * 65] * scale, s[1 * 65] * scale, s[2 * 65] * scale, s[3 * 65] * scale); o.y = pg8::pk4_fp8(s[4 * 65] * scale, s[5 * 65] * scale, s[6 * 65] * scale, s[7 * 65] * scale);
            *(u32x2*)((unsigned char*)t.WT + (size_t)(t.r0 + nn) * t.Kd + t.k0 + 8 * c) = o; }
    } else {
#pragma unroll
        for (int j = 0; j < 8; ++j) { const int nn = (lane >> 3) + 8 * j; const LAS float* s = scr + (8 * c) * 65 + nn;
            u32x4 o; o.x = cvt_pk_bf16(s[0 * 65], s[1 * 65]); o.y = cvt_pk_bf16(s[2 * 65], s[3 * 65]); o.z = cvt_pk_bf16(s[4 * 65], s[5 * 65]); o.w = cvt_pk_bf16(s[6 * 65], s[7 * 65]);
            *(u32x4*)((bf16*)t.WT + (size_t)(t.r0 + nn) * t.Kd + t.k0 + 8 * c) = o; }
    }
    LDS_WAIT(); asm volatile("" ::: "memory");
}
template <class Dec> __device__ __forceinline__ void tr_loop(const Dec& dec, int nitems, int gw, int NGW, LAS float* scr, int lane) {
    int i0 = gw; if (i0 >= nitems) return;
    int i1 = i0 + NGW;
    f32x4 va[16], vb[16];
    TrItem c0 = dec(i0); tr_load(c0, va, lane);
    TrItem c1 = dec(i1 < nitems ? i1 : i0); tr_load(c1, vb, lane);
    for (;;) {
        tr_to_lds(c0, va, scr, lane);
        const int j0 = i1 + NGW; const TrItem n0 = dec(j0 < nitems ? j0 : i0); tr_load(n0, va, lane);
        tr_from_lds(c0, scr, lane);
        if (i1 >= nitems) break;
        tr_to_lds(c1, vb, scr, lane);
        const int j1 = j0 + NGW; const TrItem n1 = dec(j1 < nitems ? j1 : i0); tr_load(n1, vb, lane);
        tr_from_lds(c1, scr, lane);
        if (j0 >= nitems) break;
        c0 = n0; c1 = n1; i0 = j0; i1 = j1;
    }
}

__device__ __forceinline__ void convert_weights(Frame& F, int l) {
    LAS float* scr = (LAS float*)(F.lds + RING_OFF + F.wave * 16640);
    const int gw = F.vcu * NWAVES + F.wave, NGW = F.G * NWAVES, lane = F.lane;
    bf16* WinT = WSP(bf16, WS_WIN); bf16* WoutT = WSP(bf16, WS_WOUT);
    const float* w_in = arg_in(1) + (size_t)l * DM * IN_COLS;
    const float* w_out = arg_in(8) + (size_t)l * DM * DM;
    constexpr int I_IN = (NIN / 64) * 16, I_OUT = 16 * 16;
    tr_loop([=](int it) __attribute__((always_inline)) -> TrItem {
        if (it < I_IN) {
            const int nb = it >> 4, kb = it & 15; int c0 = 0, nv = 64;
            if (nb < 33) c0 = 64 * nb;
            else if (nb == 33) { c0 = OFF_WI; nv = 8; }
            else if (nb < 36) { nv = 0; }
            else { const int rr = 64 * (nb - 36), p = rr >> 8, w = rr & 255; c0 = (w < 128) ? (OFF_GLU + 128 * p + w) : (OFF_GLU + CCH + 128 * p + (w - 128)); }
            if (nb < 24) return TrItem{w_in, IN_COLS, c0, nv, 64 * kb, WinT, DM, 64 * nb, pg8::F8_WGU, true};
            if (nb >= 36) return TrItem{w_in, IN_COLS, c0, nv, 64 * kb, WinT, DM, 64 * (nb - 12), pg8::F8_WGU, true};
            return TrItem{w_in, IN_COLS, c0, nv, 64 * kb, WinT, DM, 64 * nb, 1.f, false};
        }
        const int r = it - I_IN, nb = r >> 4, kb = r & 15; return TrItem{w_out, DM, 64 * nb, 64, 64 * kb, WoutT, DM, 64 * nb, 1.f, false};
    }, I_IN + I_OUT, gw, NGW, scr, lane);
}

constexpr int CONV_ATTN_SCR = 84992, CONV_ATTN_WAVE = 32 * 65 * 4;
static_assert(CONV_ATTN_SCR + NWAVES * CONV_ATTN_WAVE <= LDSCTL_OFF, "conversion tiles of the attention phase");
__device__ __forceinline__ void tr32_load(const TrItem& t, f32x4 (&v)[8], int lane) {
    const int n4 = 4 * (lane & 15); const int nc = n4 < t.nv ? n4 : 0;
    const float* src = t.W + (size_t)(t.k0 + (lane >> 4)) * t.ldw + t.c0 + nc;
#pragma unroll
    for (int i = 0; i < 8; ++i) v[i] = *(const f32x4*)(src + (size_t)(4 * i) * t.ldw);
}
__device__ __forceinline__ void tr32_to_lds(const TrItem& t, const f32x4 (&v)[8], LAS float* scr, int lane) {
    const int n4 = 4 * (lane & 15); const float ok = n4 < t.nv ? 1.f : 0.f;
#pragma unroll
    for (int i = 0; i < 8; ++i) { LAS float* d = scr + (4 * i + (lane >> 4)) * 65 + n4; d[0] = v[i][0] * ok; d[1] = v[i][1] * ok; d[2] = v[i][2] * ok; d[3] = v[i][3] * ok; }
}
__device__ __forceinline__ void tr32_from_lds(const TrItem& t, LAS float* scr, int lane) {
    LDS_WAIT(); asm volatile("" ::: "memory");
    const int c = lane & 3; const float scale = t.scale;
#pragma unroll
    for (int j = 0; j < 4; ++j) { const int nn = (lane >> 2) + 16 * j; const LAS float* s = scr + (8 * c) * 65 + nn;
        u32x2 o; o.x = pg8::pk4_fp8(s[0 * 65] * scale, s[1 * 65] * scale, s[2 * 65] * scale, s[3 * 65] * scale); o.y = pg8::pk4_fp8(s[4 * 65] * scale, s[5 * 65] * scale, s[6 * 65] * scale, s[7 * 65] * scale);
        *(u32x2*)((unsigned char*)t.WT + (size_t)(t.r0 + nn) * t.Kd + t.k0 + 8 * c) = o; }
    LDS_WAIT(); asm volatile("" ::: "memory");
}
template <class Dec> __device__ __forceinline__ void tr32_loop(const Dec& dec, int nitems, int gw, int NGW, LAS float* scr, int lane) {
    int i0 = gw; if (i0 >= nitems) return;
    int i1 = i0 + NGW;
    f32x4 va[8], vb[8];
    TrItem c0 = dec(i0); tr32_load(c0, va, lane);
    TrItem c1 = dec(i1 < nitems ? i1 : i0); tr32_load(c1, vb, lane);
    for (;;) {
        tr32_to_lds(c0, va, scr, lane);
        const int j0 = i1 + NGW; const TrItem n0 = dec(j0 < nitems ? j0 : i0); tr32_load(n0, va, lane);
        tr32_from_lds(c0, scr, lane);
        if (i1 >= nitems) break;
        tr32_to_lds(c1, vb, scr, lane);
        const int j1 = j0 + NGW; const TrItem n1 = dec(j1 < nitems ? j1 : i0); tr32_load(n1, vb, lane);
        tr32_from_lds(c1, scr, lane);
        if (j0 >= nitems) break;
        c0 = n0; c1 = n1; i0 = j0; i1 = j1;
    }
}
__device__ __forceinline__ void convert_ffn(Frame& F, int l) {
    LAS float* scr = (LAS float*)(F.lds + CONV_ATTN_SCR + F.wave * CONV_ATTN_WAVE);
    const int gw = F.vcu * NWAVES + F.wave, NGW = F.G * NWAVES, lane = F.lane;
    unsigned char* Wff = WSP(unsigned char, WS_WFF);
    const int d = l >> 1;
    if ((l & 1) == 0) {
        const float* wg = arg_in(13) + (size_t)d * DM * DFF; const float* wu = arg_in(14) + (size_t)d * DM * DFF; const float* wd = arg_in(15) + (size_t)d * DFF * DM;
        unsigned char* Wgu = Wff; unsigned char* Wdn = Wgu + (size_t)2 * DFF * DM;
        constexpr int I_GU = (2 * DFF / 64) * 32, KB_DN = DFF / 32, I_DN = 16 * KB_DN;
        const ptrdiff_t dgu = wu - wg;
        tr32_loop([=](int it) __attribute__((always_inline)) -> TrItem {
            if (it < I_GU) { const int nb = it >> 5, kb = it & 31, rr = 64 * nb, p = rr >> 8, w = rr & 255;
                return TrItem{wg + ((w < 128) ? (ptrdiff_t)0 : dgu), DFF, 128 * p + (w & 127), 64, 32 * kb, Wgu, DM, rr, pg8::F8_WGU, true}; }
            const int r = it - I_GU, nb = r / KB_DN, kb = r % KB_DN; return TrItem{wd, DM, 64 * nb, 64, 32 * kb, Wdn, DFF, 64 * nb, pg8::F8_WDN, true};
        }, I_GU + I_DN, gw, NGW, scr, lane);
    } else {
        constexpr int I_GU = (2 * DFE / 64) * 32, KB_DN = DFE / 32, I_DN = 16 * KB_DN, I_E = I_GU + I_DN;
        const float* wg0 = arg_in(17) + (size_t)d * NE * DM * DFE; const float* wu0 = arg_in(18) + (size_t)d * NE * DM * DFE; const float* wd0 = arg_in(19) + (size_t)d * NE * DFE * DM;
        const ptrdiff_t dgu = wu0 - wg0;
        tr32_loop([=](int it) __attribute__((always_inline)) -> TrItem {
            const int e = it / I_E, r0 = it % I_E;
            const float* wg = wg0 + (size_t)e * DM * DFE; const float* wd = wd0 + (size_t)e * DFE * DM;
            unsigned char* Wgu = Wff + (size_t)e * (3 * (size_t)DFE * DM); unsigned char* Wdn = Wgu + (size_t)2 * DFE * DM;
            if (r0 < I_GU) { const int nb = r0 >> 5, kb = r0 & 31, rr = 64 * nb, p = rr >> 8, w = rr & 255;
                return TrItem{wg + ((w < 128) ? (ptrdiff_t)0 : dgu), DFE, 128 * p + (w & 127), 64, 32 * kb, Wgu, DM, rr, pg8::F8_WGU, true}; }
            const int r = r0 - I_GU, nb = r / KB_DN, kb = r % KB_DN; return TrItem{wd, DM, 64 * nb, 64, 32 * kb, Wdn, DFE, 64 * nb, pg8::F8_WDN, true};
        }, NE * I_E, gw, NGW, scr, lane);
    }
    asm volatile("s_waitcnt vmcnt(0)" ::: "memory");
}

__device__ __forceinline__ void cvt_x(Frame& F) {
    const float* x = arg_in(0); bf16* XB = WSP(bf16, WS_XB); unsigned char* XQ = WSP(unsigned char, WS_XQ);
    const int gw = F.vcu * NWAVES + F.wave, NGW = F.G * NWAVES;
    f32x4 vn[4];
    { const f32x4* xr = (const f32x4*)(x + (size_t)gw * DM) + F.lane;
#pragma unroll
      for (int j = 0; j < 4; ++j) vn[j] = xr[64 * j]; }
    for (int m = gw; m < M; m += NGW) {
        f32x4 v[4];
#pragma unroll
        for (int j = 0; j < 4; ++j) v[j] = vn[j];
        { const int mn = (m + NGW < M) ? m + NGW : m; const f32x4* xr = (const f32x4*)(x + (size_t)mn * DM) + F.lane;
#pragma unroll
          for (int j = 0; j < 4; ++j) vn[j] = xr[64 * j]; }
        u32x2* o = (u32x2*)(XB + (size_t)m * DM) + F.lane; unsigned* o8 = (unsigned*)(XQ + (size_t)m * DM) + F.lane;
#pragma unroll
        for (int j = 0; j < 4; ++j) { u32x2 w; w.x = cvt_pk_bf16(v[j][0], v[j][1]); w.y = cvt_pk_bf16(v[j][2], v[j][3]); o[64 * j] = w;
            o8[64 * j] = pg8::pk4_fp8(v[j][0] * pg8::F8_ASC, v[j][1] * pg8::F8_ASC, v[j][2] * pg8::F8_ASC, v[j][3] * pg8::F8_ASC); }
    }
}

__device__ __forceinline__ void ln_load(const bf16* row, f32x4 (&v)[4], int lane) {
#pragma unroll
    for (int j = 0; j < 4; ++j) { const u32x2 a = ((const u32x2*)row)[lane + 64 * j]; v[j][0] = __uint_as_float(a.x << 16); v[j][1] = __uint_as_float(a.x & 0xffff0000u); v[j][2] = __uint_as_float(a.y << 16); v[j][3] = __uint_as_float(a.y & 0xffff0000u); }
}
template <bool FP8OUT> __device__ __forceinline__ void ln_finish(f32x4 (&v)[4], const f32x4 (&g)[4], const f32x4 (&bb)[4], bf16* brow, unsigned char* qrow, float* frow, int lane) {
    float s = 0.f;
#pragma unroll
    for (int j = 0; j < 4; ++j) s += (v[j][0] + v[j][1]) + (v[j][2] + v[j][3]);
    const float mean = wave_sum(s) * (1.f / DM); float s2 = 0.f;
#pragma unroll
    for (int j = 0; j < 4; ++j) { v[j] = v[j] - mean; s2 += (v[j][0] * v[j][0] + v[j][1] * v[j][1]) + (v[j][2] * v[j][2] + v[j][3] * v[j][3]); }
    const float rstd = 1.f / sqrtf(wave_sum(s2) * (1.f / DM) + LN_EPS);
#pragma unroll
    for (int j = 0; j < 4; ++j) { v[j] = v[j] * rstd * g[j] + bb[j];
        { u32x2 w; w.x = cvt_pk_bf16(v[j][0], v[j][1]); w.y = cvt_pk_bf16(v[j][2], v[j][3]); ((u32x2*)brow)[lane + 64 * j] = w; }
        if constexpr (FP8OUT) { ((unsigned*)qrow)[lane + 64 * j] = pg8::pk4_fp8(v[j][0] * pg8::F8_ASC, v[j][1] * pg8::F8_ASC, v[j][2] * pg8::F8_ASC, v[j][3] * pg8::F8_ASC); }
        else { if (frow) ((f32x4*)frow)[lane + 64 * j] = v[j];
               if (qrow) ((unsigned*)qrow)[lane + 64 * j] = pg8::pk4_fp8(v[j][0] * pg8::F8_ASC, v[j][1] * pg8::F8_ASC, v[j][2] * pg8::F8_ASC, v[j][3] * pg8::F8_ASC); } }
}

__device__ __forceinline__ void p_ln1(Frame& F, int l) {
    bf16* R1 = WSP(bf16, WS_R1); bf16* XB = WSP(bf16, WS_XB);
    const bool moe = (l & 1) != 0;
    LAS int* cntL = (LAS int*)(F.lds + LDSCTL_OFF + 1152);
    if (F.tid < 8) cntL[F.tid] = 0;
    __syncthreads();
    f32x4 g[4], bb[4];
#pragma unroll
    for (int j = 0; j < 4; ++j) { g[j] = ((const f32x4*)(arg_in(9) + (size_t)l * DM))[F.lane + 64 * j]; bb[j] = ((const f32x4*)(arg_in(10) + (size_t)l * DM))[F.lane + 64 * j]; }
    const float* router = arg_in(16) + (size_t)(l >> 1) * DM * NE;
    u32x4* route = WSP(u32x4, WS_ROUTE);
    f32x4 vn[4]; ln_load(R1 + (size_t)(F.vcu * 128 + F.wave * 16) * DM, vn, F.lane);
    for (int i = 0; i < 16; ++i) {
        const int m = F.vcu * 128 + F.wave * 16 + i;
        f32x4 v[4];
#pragma unroll
        for (int j = 0; j < 4; ++j) v[j] = vn[j];
        if (i + 1 < 16) ln_load(R1 + (size_t)(m + 1) * DM, vn, F.lane);
        ln_finish<true>(v, g, bb, R1 + (size_t)m * DM, (unsigned char*)XB + (size_t)m * DM, nullptr, F.lane);
        if (moe) {
            float lg[8];
#pragma unroll
            for (int e = 0; e < 8; ++e) lg[e] = 0.f;
#pragma unroll
            for (int j = 0; j < 4; ++j)
#pragma unroll
                for (int c = 0; c < 4; ++c) { const float* rp = router + (size_t)(4 * F.lane + 256 * j + c) * NE; const f32x4 r0 = *(const f32x4*)rp, r1 = *(const f32x4*)(rp + 4); const float xv = v[j][c];
                    lg[0] += xv * r0[0]; lg[1] += xv * r0[1]; lg[2] += xv * r0[2]; lg[3] += xv * r0[3]; lg[4] += xv * r1[0]; lg[5] += xv * r1[1]; lg[6] += xv * r1[2]; lg[7] += xv * r1[3]; }
#pragma unroll
            for (int e = 0; e < 8; ++e) lg[e] = wave_sum(lg[e]);
            int e1 = 0; float v1 = lg[0];
#pragma unroll
            for (int e = 1; e < 8; ++e) if (lg[e] > v1) { v1 = lg[e]; e1 = e; }
            int e2 = -1; float v2 = -3.0e38f;
#pragma unroll
            for (int e = 0; e < 8; ++e) if (e != e1 && (e2 < 0 || lg[e] > v2)) { v2 = lg[e]; e2 = e; }
            const float g1 = 1.0f / (1.0f + __expf(v2 - v1)), g2 = 1.0f - g1;
            if (F.lane == 0) { u32x4 r; r.x = (unsigned)e1; r.y = (unsigned)e2; r.z = __float_as_uint(g1); r.w = __float_as_uint(g2); route[m] = r;
                __hip_atomic_fetch_add(cntL + e1, 1, __ATOMIC_RELAXED, __HIP_MEMORY_SCOPE_WORKGROUP); __hip_atomic_fetch_add(cntL + e2, 1, __ATOMIC_RELAXED, __HIP_MEMORY_SCOPE_WORKGROUP); }
        }
    }
    __syncthreads();
    if (moe && F.tid < 8) WSP(int, WS_CNTWG)[F.vcu * 8 + F.tid] = cntL[F.tid];
}

__device__ __forceinline__ void p_ln2(Frame& F, int l) {
    const bf16* R1 = WSP(bf16, WS_R1); bf16* XB = WSP(bf16, WS_XB); float* outp = (l == DEPTH - 1) ? arg_out() : nullptr;
    f32x4 g[4], bb[4];
#pragma unroll
    for (int j = 0; j < 4; ++j) { g[j] = ((const f32x4*)(arg_in(11) + (size_t)l * DM))[F.lane + 64 * j]; bb[j] = ((const f32x4*)(arg_in(12) + (size_t)l * DM))[F.lane + 64 * j]; }
    f32x4 vn[4]; ln_load(R1 + (size_t)(F.vcu * 128 + F.wave * 16) * DM, vn, F.lane);
    for (int i = 0; i < 16; ++i) {
        const int m = F.vcu * 128 + F.wave * 16 + i;
        f32x4 v[4];
#pragma unroll
        for (int j = 0; j < 4; ++j) v[j] = vn[j];
        if (i + 1 < 16) ln_load(R1 + (size_t)(m + 1) * DM, vn, F.lane);
        ln_finish<false>(v, g, bb, XB + (size_t)m * DM, WSP(unsigned char, WS_XQ) + (size_t)m * DM, outp ? outp + (size_t)m * DM : nullptr, F.lane);
    }
}

__device__ __forceinline__ void moe_tables(Frame& F) {
    LAS int* texp = (LAS int*)(F.lds + LDSCTL_OFF);
    LAS int* tot = (LAS int*)(F.lds + LDSCTL_OFF + 1088);
    LAS int* tbase = (LAS int*)(F.lds + LDSCTL_OFF + 1200);
    const int* cnt = WSP(int, WS_CNTWG);
    LAS int* tmp = (LAS int*)(F.lds + AUX_OFF);
    __syncthreads();
    if (F.tid < 256) { typedef int i32x4_ __attribute__((ext_vector_type(4))); const i32x4_ a = ((const i32x4_*)cnt)[2 * F.tid], b = ((const i32x4_*)cnt)[2 * F.tid + 1];
        *(LAS i32x4_*)(tmp + 8 * F.tid) = a; *(LAS i32x4_*)(tmp + 8 * F.tid + 4) = b; }
    __syncthreads();
    if (F.tid < 8) { int t = 0, off = 0; for (int w = 0; w < 256; ++w) { const int c = tmp[w * 8 + F.tid]; if (w < F.vcu) off += c; t += c; } tot[F.tid] = t; tot[8 + F.tid] = off; }
    __syncthreads();
    if (F.tid == 0) { int b = 0; for (int e = 0; e < 8; ++e) { tbase[e] = b; b += (tot[e] + 255) >> 8; } tbase[8] = b; }
    __syncthreads();
    if (F.tid < MAXT) { int e = 0;
#pragma unroll
        for (int j = 1; j < 8; ++j) e += (F.tid >= tbase[j]) ? 1 : 0;
        texp[F.tid] = e; }
    __syncthreads();
}

__device__ __forceinline__ void p_list(Frame& F) {
    moe_tables(F);
    LAS int* tot = (LAS int*)(F.lds + LDSCTL_OFF + 1088); LAS int* tbase = (LAS int*)(F.lds + LDSCTL_OFF + 1200);
    const u32x4* route = WSP(u32x4, WS_ROUTE);
    int* rowlist = WSP(int, WS_ROWLIST); float* rowgate = WSP(float, WS_ROWGATE); int* slotrow = WSP(int, WS_SLOTROW);
    if (F.wave == 0) {
        int run[8];
#pragma unroll
        for (int e = 0; e < 8; ++e) run[e] = tot[8 + e];
        for (int blk = 0; blk < 2; ++blk) {
            const int t = F.vcu * 128 + blk * 64 + F.lane; const u32x4 r = route[t]; const int e1 = (int)r.x, e2 = (int)r.y;
            int p1 = 0, p2 = 0;
            const unsigned long long lt = (1ull << F.lane) - 1ull;
#pragma unroll
            for (int e = 0; e < 8; ++e) { const unsigned long long mk = __ballot(e1 == e || e2 == e); const int rk = run[e] + __popcll(mk & lt); if (e1 == e) p1 = rk; if (e2 == e) p2 = rk; run[e] += __popcll(mk); }
            const int row1 = tbase[e1] * 256 + p1, row2 = tbase[e2] * 256 + p2;
            rowlist[row1] = t; rowgate[row1] = __uint_as_float(r.z); rowlist[row2] = t; rowgate[row2] = __uint_as_float(r.w);
            slotrow[2 * t] = row1; slotrow[2 * t + 1] = row2;
        }
    }
    if (F.vcu < 8) { const int e = F.vcu, mt = (tot[e] + 255) >> 8; for (int p = tot[e] + F.tid; p < mt * 256; p += NTHR) { rowlist[tbase[e] * 256 + p] = 0; rowgate[tbase[e] * 256 + p] = 0.f; } }
}

__device__ __forceinline__ void p_comb(Frame& F, int l) {
    const bf16* R1 = WSP(bf16, WS_R1); bf16* XB = WSP(bf16, WS_XB); const bf16* Yd = WSP(bf16, WS_YD); const int* slotrow = WSP(int, WS_SLOTROW); float* outp = (l == DEPTH - 1) ? arg_out() : nullptr;
    f32x4 g[4], bb[4];
#pragma unroll
    for (int j = 0; j < 4; ++j) { g[j] = ((const f32x4*)(arg_in(11) + (size_t)l * DM))[F.lane + 64 * j]; bb[j] = ((const f32x4*)(arg_in(12) + (size_t)l * DM))[F.lane + 64 * j]; }
    const int m0 = F.vcu * 128 + F.wave * 16;
    const int myslot = (F.lane < 32) ? slotrow[2 * m0 + F.lane] : 0;
    f32x4 xn[4], an[4], bn[4];
#define COMB_LOAD(i_) do { const int ra_ = __builtin_amdgcn_readlane(myslot, 2 * (i_)), rb_ = __builtin_amdgcn_readlane(myslot, 2 * (i_) + 1); \
        ln_load(R1 + (size_t)(m0 + (i_)) * DM, xn, F.lane); ln_load(Yd + (size_t)ra_ * DM, an, F.lane); ln_load(Yd + (size_t)rb_ * DM, bn, F.lane); } while (0)
    COMB_LOAD(0);
    for (int i = 0; i < 16; ++i) {
        const int m = m0 + i;
        f32x4 v[4];
#pragma unroll
        for (int j = 0; j < 4; ++j) v[j] = xn[j] * DN_ALPHA + (an[j] + bn[j]);
        if (i + 1 < 16) COMB_LOAD(i + 1);
        ln_finish<false>(v, g, bb, XB + (size_t)m * DM, WSP(unsigned char, WS_XQ) + (size_t)m * DM, outp ? outp + (size_t)m * DM : nullptr, F.lane);
    }
#undef COMB_LOAD
}

#define DPP_I(v, ctrl) __builtin_amdgcn_update_dpp(0, (v), (ctrl), 0xf, 0xf, false)
__device__ __forceinline__ int wave_isum(int v) {
    v += DPP_I(v, 0xB1); v += DPP_I(v, 0x4E); v += DPP_I(v, 0x141); v += DPP_I(v, 0x140);
    return __builtin_amdgcn_readlane(v, 0) + __builtin_amdgcn_readlane(v, 16) + __builtin_amdgcn_readlane(v, 32) + __builtin_amdgcn_readlane(v, 48);
}
#define DPP_F(v, ctrl) __int_as_float(__builtin_amdgcn_update_dpp(0, __float_as_int(v), (ctrl), 0xf, 0xf, false))
typedef unsigned short u16x2 __attribute__((__vector_size__(4)));
#define IDX_BAR() asm volatile("s_waitcnt lgkmcnt(0)\n\ts_barrier" ::: "memory")
__device__ __forceinline__ void p_idx(Frame& F, int l) {
    constexpr int QP = 16;
    LAS unsigned short* bins = (LAS unsigned short*)(F.lds + RING_OFF);
    LAS unsigned* hq = (LAS unsigned*)(F.lds + AUX_OFF);
    LAS unsigned* hist = (LAS unsigned*)(F.lds + AUX_OFF + 16384) + F.wave * 256;
    LAS int* ci = (LAS int*)(F.lds + AUX_OFF + 24576) + F.wave * 64;
    LAS float* wtab = (LAS float*)(F.lds + LDSCTL_OFF + 1280);
    LAS float* sqp = (LAS float*)(F.lds + LDSCTL_OFF + 1792);
    const bf16* QI = WSP(bf16, WS_QI); const bf16* KI = WSP(bf16, WS_KI); const float* WI = WSP(float, WS_WI);
    unsigned long long* maskQ = WSP(unsigned long long, WS_MASK);
    const int lane = F.lane, wave = F.wave, tid = F.tid, w = F.vcu;
    const int am = lane & 31, ahm = (am >> 2) & 1, arr = (am & 3) + 4 * (am >> 3), atl = 2 * ahm + (arr >> 3), ah = arr & 7, kg = lane >> 5, hi = lane >> 5, n = lane & 31;
    bf16x8 af[4][4]; float wreg = 0.f;
#define IDX_UNIT(s8_, qb32_, b_) do { const int ui_ = (s8_) >> 1; const int up_ = (ui_ == 0) ? w : (ui_ == 1) ? 511 - w : (ui_ == 2) ? 512 + w : 1023 - w; qb32_ = up_ >> 3; b_ = up_ & 7; } while (0)
#define IDX_LOADQ(s8_) do { int qb_, bb_; IDX_UNIT(s8_, qb_, bb_); const size_t r0_ = (size_t)bb_ * SEQ + qb_ * 32 + ((s8_) & 1) * QP; \
        _Pragma("unroll") for (int rt = 0; rt < 4; ++rt) _Pragma("unroll") for (int ks = 0; ks < 4; ++ks) af[rt][ks] = *(const bf16x8*)(QI + (r0_ + 4 * rt + atl) * AW + ah * 64 + ks * 16 + 8 * kg); \
        if (tid < 128) wreg = WI[(r0_ + (tid >> 3)) * 8 + (tid & 7)]; } while (0)
#define IDX_WTAB(par_) do { if (tid < 128) { wtab[tid] = wreg; float sm = wreg, sq2 = wreg * wreg; \
        sm += DPP_F(sm, 0xB1); sq2 += DPP_F(sq2, 0xB1); sm += DPP_F(sm, 0x4E); sq2 += DPP_F(sq2, 0x4E); sm += DPP_F(sm, 0x141); sq2 += DPP_F(sq2, 0x141); \
        if ((tid & 7) == 0) { const float a_ = 1.0f / (28.02f * sqrtf(sq2) + 1.0e-20f); sqp[32 * (par_) + 2 * (tid >> 3)] = a_; sqp[32 * (par_) + 2 * (tid >> 3) + 1] = 0.33333f - 3.19f * sm * a_; } } } while (0)
    IDX_LOADQ(0);
    IDX_WTAB(0);
    for (int i = tid; i < QP * 256; i += NTHR) hq[i] = 0u;
    IDX_BAR();
    for (int s8 = 0; s8 < 8; ++s8) {
        int qb32, b; IDX_UNIT(s8, qb32, b);
        const int sub = s8 & 1, c = qb32 >> 1, N = 64 * (c + 1), NT32 = 2 * (c + 1);
        const size_t rowb = (size_t)b * SEQ;
        const bool dosel = N > TOPK;
        for (int repA_ = 0; repA_ < (((PROBE_MASK) >> 12) & 1) + 1; ++repA_) {
            const int ntw = (NT32 - wave + 7) >> 3;
            constexpr int BT = 2; const int nbat = (ntw + BT - 1) / BT;
            bf16x8 b0[BT][4], b1[BT][4];
            const LAS float* sqc = sqp + 32 * (s8 & 1);
#define IDX_LOADB(dst, bb_) do { _Pragma("unroll") for (int u = 0; u < BT; ++u) { int j_ = wave + 8 * (BT * (bb_) + u); j_ = j_ < NT32 ? j_ : NT32 - 1; \
            _Pragma("unroll") for (int ks = 0; ks < 4; ++ks) dst[u][ks] = *(const bf16x8*)(KI + (rowb + 32 * j_) * 64 + ks * 512 + kg * 256 + n * 8); } } while (0)
#define IDX_RELU(x) __int_as_float(max(__float_as_int(x), 0))
#define IDX_COMP(src, bb_) do { _Pragma("unroll") for (int rp = 0; rp < 2; ++rp) { \
            f32x4 wq_[4][2];   \
            _Pragma("unroll") for (int rq = 0; rq < 4; ++rq) { const int qi_ = 4 * (2 * rp + (rq >> 1)) + 2 * hi + (rq & 1); const LAS f32x4* wp_ = (const LAS f32x4*)(wtab + qi_ * 8); wq_[rq][0] = wp_[0]; wq_[rq][1] = wp_[1]; } \
            _Pragma("unroll") for (int u = 0; u < BT; ++u) { const int j_ = wave + 8 * (BT * (bb_) + u); if (j_ < NT32) { f32x16 acc0 = {}, acc1 = {}; \
                _Pragma("unroll") for (int ks = 0; ks < 4; ++ks) { acc0 = __builtin_amdgcn_mfma_f32_32x32x16_bf16(af[2 * rp][ks], src[u][ks], acc0, 0, 0, 0); acc1 = __builtin_amdgcn_mfma_f32_32x32x16_bf16(af[2 * rp + 1][ks], src[u][ks], acc1, 0, 0, 0); } \
                _Pragma("unroll") for (int r2 = 0; r2 < 2; ++r2) { const int rt = 2 * rp + r2; const f32x16& ac_ = r2 ? acc1 : acc0; float t_[2]; \
                    _Pragma("unroll") for (int q = 0; q < 2; ++q) { const f32x4 w0_ = wq_[2 * r2 + q][0], w1_ = wq_[2 * r2 + q][1]; \
                        f32x2 s2_ = (f32x2){w0_[0], w0_[1]} * (f32x2){IDX_RELU(ac_[8 * q + 0]), IDX_RELU(ac_[8 * q + 1])}; \
                        s2_ = __builtin_elementwise_fma((f32x2){w0_[2], w0_[3]}, (f32x2){IDX_RELU(ac_[8 * q + 2]), IDX_RELU(ac_[8 * q + 3])}, s2_); \
                        s2_ = __builtin_elementwise_fma((f32x2){w1_[0], w1_[1]}, (f32x2){IDX_RELU(ac_[8 * q + 4]), IDX_RELU(ac_[8 * q + 5])}, s2_); \
                        s2_ = __builtin_elementwise_fma((f32x2){w1_[2], w1_[3]}, (f32x2){IDX_RELU(ac_[8 * q + 6]), IDX_RELU(ac_[8 * q + 7])}, s2_); \
                        const f32x2 mc_ = *(const LAS f32x2*)(sqc + 2 * (4 * rt + 2 * hi + q)); t_[q] = __builtin_fmaf(s2_[0] + s2_[1], mc_[0], mc_[1]); } \
                    const u16x2 pk_ = __builtin_amdgcn_cvt_pknorm_u16(t_[0], t_[1]); \
                    _Pragma("unroll") for (int q = 0; q < 2; ++q) { const int qi_ = 4 * rt + 2 * hi + q; const unsigned short ky_ = q ? pk_[1] : pk_[0]; bins[qi_ * 4096 + 32 * j_ + n] = ky_; \
                        if (dosel) __hip_atomic_fetch_add(hq + qi_ * 256 + ((unsigned)ky_ >> 8), 1u, __ATOMIC_RELAXED, __HIP_MEMORY_SCOPE_WORKGROUP); } } } } } } while (0)
            IDX_LOADB(b0, 0);
            for (int bb = 0; bb < nbat; bb += 2) {
                IDX_LOADB(b1, bb + 1);
                IDX_COMP(b0, bb);
                IDX_LOADB(b0, bb + 2);
                IDX_COMP(b1, bb + 1);
            }
#undef IDX_LOADB
#undef IDX_COMP
#undef IDX_RELU
        }
        if (s8 + 1 < 8) IDX_LOADQ(s8 + 1);
        IDX_BAR();
        for (int repB_ = 0; repB_ < (((PROBE_MASK) >> 13) & 1) + 1; ++repB_)
        for (int qq = 0; qq < 2; ++qq) {
            const int q = wave + 8 * qq;
            const int nch = (N + 511) >> 9;
            const LAS unsigned short* brow = bins + q * 4096;
            LAS unsigned char* st8 = (LAS unsigned char*)hist + 512 * qq;
            { unsigned z0 = 0u; asm volatile("" : "+v"(z0)); *(LAS u32x2*)(st8 + 8 * lane) = (u32x2){z0, z0}; }
#define IDX_SCAN(K, HD, TARGET) \
            int tl_ = 0; _Pragma("unroll") for (int i = 0; i < K; ++i) tl_ += HD[i]; \
            int P_ = tl_; P_ += DPP_I(P_, 0x111); P_ += DPP_I(P_, 0x112); P_ += DPP_I(P_, 0x114); P_ += DPP_I(P_, 0x118); \
            { const int R0 = __builtin_amdgcn_readlane(P_, 15), R1 = __builtin_amdgcn_readlane(P_, 31), R2 = __builtin_amdgcn_readlane(P_, 47); P_ += (lane >= 16 ? R0 : 0) + (lane >= 32 ? R1 : 0) + (lane >= 48 ? R2 : 0); } \
            const unsigned long long over_ = __ballot(P_ >= (TARGET)); const int Lc_ = over_ ? (int)__builtin_ctzll(over_) : 63; \
            int cumL_ = P_ - tl_, bsel_ = 0, cbv_ = 0; bool fnd_ = false; \
            _Pragma("unroll") for (int i = K - 1; i >= 0; --i) { if (!fnd_) { if (cumL_ + HD[i] >= (TARGET) || i == 0) { fnd_ = true; bsel_ = i; cbv_ = HD[i]; } else cumL_ += HD[i]; } } \
            Bs = K * (63 - Lc_) + __builtin_amdgcn_readlane(bsel_, Lc_); cb = __builtin_amdgcn_readlane(cbv_, Lc_); cumv = __builtin_amdgcn_readlane(cumL_, Lc_);
#define IDX_CODE(v, j) ((int)(((j) & 1) ? ((v)[(j) >> 1] >> 16) : ((v)[(j) >> 1] & 0xffffu)))
            int Bs = -1, cb = 0, need = 0, sh = 8; bool fast_ok = true;
            LAS unsigned* crow = hq + q * 256;
            if (dosel) {
                { const u32x4 h4 = *(const LAS u32x4*)(crow + 4 * (63 - lane)); const int hd4[4] = {(int)h4[0], (int)h4[1], (int)h4[2], (int)h4[3]};
                  int cumv; IDX_SCAN(4, hd4, TOPK)
                  need = TOPK - cumv; fast_ok = over_ != 0ull && need >= 1 && need <= cb; }
                if (fast_ok && cb > 64) {
                    { unsigned z0 = 0u; asm volatile("" : "+v"(z0)); *(LAS u32x4*)(crow + 4 * lane) = (u32x4){z0, z0, z0, z0}; }
                    for (int ch = 0; ch < nch; ++ch) { const u32x4 v = *(const LAS u32x4*)(brow + 512 * ch + 8 * lane); const bool okl = 512 * ch + 8 * lane < N;
#pragma unroll
                        for (int j = 0; j < 8; ++j) { const int kj = IDX_CODE(v, j); const bool m = okl && (kj >> 8) == Bs;
                            __hip_atomic_fetch_add(m ? crow + (kj & 255) : (LAS unsigned*)ci + lane, 1u, __ATOMIC_RELAXED, __HIP_MEMORY_SCOPE_WORKGROUP); } }
                    asm volatile("s_waitcnt lgkmcnt(0)" ::: "memory");
                    const u32x4 h4 = *(const LAS u32x4*)(crow + 4 * (63 - lane)); const int hd4[4] = {(int)h4[0], (int)h4[1], (int)h4[2], (int)h4[3]};
                    int nB, nC, nV; bool ok2;
                    { int Bs, cb, cumv; IDX_SCAN(4, hd4, need)
                      nB = Bs; nC = cb; nV = cumv; ok2 = over_ != 0ull; }
                    Bs = (Bs << 8) | nB; sh = 0; need -= nV; cb = nC;
                    fast_ok = ok2 && need >= 1 && need <= cb;
                }
                fast_ok = fast_ok && cb <= 64;
            }
#undef IDX_SCAN
            if (fast_ok) {
                int nc = 0;
                u32x4 vn = *(const LAS u32x4*)(brow + 8 * lane);
                for (int ch = 0; ch < nch; ++ch) { const u32x4 v = vn; const int e0 = 512 * ch + 8 * lane; const bool okl = e0 < N; unsigned byte = 0u;
                    if (ch + 1 < nch) vn = *(const LAS u32x4*)(brow + 512 * (ch + 1) + 8 * lane);
                    int bj[8], cl = 0;
#pragma unroll
                    for (int j = 0; j < 8; ++j) { bj[j] = okl ? (IDX_CODE(v, j) >> sh) : -2; cl += (bj[j] == Bs) ? 1 : 0; byte |= (unsigned)(Bs - bj[j]) >> 31 << j; }
                    int ps = cl;
                    ps += DPP_I(ps, 0x111); ps += DPP_I(ps, 0x112); ps += DPP_I(ps, 0x114); ps += DPP_I(ps, 0x118);
                    ps += __builtin_amdgcn_update_dpp(0, ps, 0x142, 0xa, 0xf, false); ps += __builtin_amdgcn_update_dpp(0, ps, 0x143, 0xc, 0xf, false);
                    int off = nc + ps - cl;
#pragma unroll
                    for (int j = 0; j < 8; ++j) { const bool eq = bj[j] == Bs; crow[eq ? off : 64 + lane] = (unsigned)((IDX_CODE(v, j) << 12) | (e0 + j)); off += eq ? 1 : 0; }
                    nc += __builtin_amdgcn_readlane(ps, 63);
                    st8[64 * ch + lane] = (unsigned char)byte; }
                if (dosel) {
                    asm volatile("s_waitcnt lgkmcnt(0)" ::: "memory");
                    const int mc = (lane < cb) ? (int)crow[lane] : 0; const int mord = (mc & ~4095) | (4095 - (mc & 4095)); int rank = 0;
                    for (int j = 0; j < cb; ++j) { const int oj = __builtin_amdgcn_readlane(mord, j); rank += (oj > mord) ? 1 : 0; }
                    if (lane < cb && rank < need) __hip_atomic_fetch_or((LAS unsigned*)st8 + ((mc & 4095) >> 5), 1u << (mc & 31), __ATOMIC_RELAXED, __HIP_MEMORY_SCOPE_WORKGROUP);
                }
            } else {
                int Tk = -1; unsigned Jx = 0xffffffffu;
                for (int bit = 15; bit >= 0; --bit) {
                    const int cand = Tk < 0 ? (1 << bit) : (Tk | (1 << bit)); int cl = 0;
                    for (int ch = 0; ch < nch; ++ch) { const u32x4 v = *(const LAS u32x4*)(brow + 512 * ch + 8 * lane); const int e0 = 512 * ch + 8 * lane;
#pragma unroll
                        for (int j = 0; j < 8; ++j) cl += (e0 < N && IDX_CODE(v, j) >= cand) ? 1 : 0; }
                    if (wave_isum(cl) >= TOPK) Tk = cand;
                }
                if (Tk < 0) Tk = 0;
                int cg = 0, ce = 0;
                for (int ch = 0; ch < nch; ++ch) { const u32x4 v = *(const LAS u32x4*)(brow + 512 * ch + 8 * lane); const int e0 = 512 * ch + 8 * lane;
#pragma unroll
                    for (int j = 0; j < 8; ++j) if (e0 < N) { cg += (IDX_CODE(v, j) > Tk) ? 1 : 0; ce += (IDX_CODE(v, j) == Tk) ? 1 : 0; } }
                const int nd = TOPK - wave_isum(cg), ceq = wave_isum(ce);
                if (ceq > nd) {
                    unsigned Jc = 0u;
                    for (int bit = 11; bit >= 0; --bit) {
                        const unsigned cj = Jc | (1u << bit); int cl = 0;
                        for (int ch = 0; ch < nch; ++ch) { const u32x4 v = *(const LAS u32x4*)(brow + 512 * ch + 8 * lane); const int e0 = 512 * ch + 8 * lane;
#pragma unroll
                            for (int j = 0; j < 8; ++j) cl += (e0 < N && IDX_CODE(v, j) == Tk && (unsigned)(e0 + j) < cj) ? 1 : 0; }
                        if (wave_isum(cl) < nd) Jc = cj;
                    }
                    Jx = Jc;
                }
                for (int ch = 0; ch < nch; ++ch) { const u32x4 v = *(const LAS u32x4*)(brow + 512 * ch + 8 * lane); const int e0 = 512 * ch + 8 * lane; unsigned byte = 0u;
#pragma unroll
                    for (int j = 0; j < 8; ++j) { const int kj = IDX_CODE(v, j); byte |= (unsigned)((kj > Tk || (kj == Tk && (unsigned)(e0 + j) <= Jx)) ? 1 : 0) << j; }
                    st8[64 * ch + lane] = (unsigned char)(e0 < N ? byte : 0u); }
            }
#undef IDX_CODE
            { unsigned z0 = 0u; asm volatile("" : "+v"(z0)); *(LAS u32x4*)(crow + 4 * lane) = (u32x4){z0, z0, z0, z0}; }
        }
        IDX_WTAB((s8 + 1) & 1);
        IDX_BAR();
        {
            const int tile = tid >> 3, w8 = tid & 7, NJw = 4 * ((qb32 >> 3) + 1);
            if (tile < NJw) {
#pragma unroll
                for (int qq = 0; qq < 2; ++qq) { const u32x2 mk = *(const LAS u32x2*)((const LAS unsigned*)(F.lds + AUX_OFF + 16384) + w8 * 256 + 128 * qq + 2 * tile);
                    maskQ[((size_t)(b * 128 + qb32) * 64 + tile) * 32 + QP * sub + 8 * qq + w8] = ((unsigned long long)mk.y << 32) | mk.x; } }
        }
    }
#undef IDX_UNIT
#undef IDX_LOADQ
#undef IDX_WTAB
#undef IDX_BAR
}

__device__ __forceinline__ void p_conv(Frame& F, int l) {
    LAS bf16* Ut = (LAS bf16*)(F.lds + RING_OFF);
    LAS float* Yt = (LAS float*)(F.lds + RING_OFF + 65536);
    const bf16* U = WSP(bf16, WS_U); bf16* MIX = WSP(bf16, WS_MIX);
    const float* cw = arg_in(2) + (size_t)l * CK * CCH; const int c = F.tid, lane = F.lane;
    float wj[CK];
#pragma unroll
    for (int j = 0; j < CK; ++j) wj[j] = cw[j * CCH + c];
    const float cb = arg_in(3)[l * CCH + c];
    f32x4 lg0 = *(const f32x4*)(arg_in(4) + l * CCH + 8 * lane), lg1 = *(const f32x4*)(arg_in(4) + l * CCH + 8 * lane + 4);
    f32x4 lb0 = *(const f32x4*)(arg_in(5) + l * CCH + 8 * lane), lb1 = *(const f32x4*)(arg_in(5) + l * CCH + 8 * lane + 4);
    f32x4 ms0 = *(const f32x4*)(arg_in(6) + l * DM + CCH + 8 * lane), ms1 = *(const f32x4*)(arg_in(6) + l * DM + CCH + 8 * lane + 4);
    u32x4 tp[8];
#define CONV_LOAD(it_) do { const int un_ = F.vcu + 256 * (it_), b_ = un_ >> 7, t0_ = (un_ & 127) * 32; \
        _Pragma("unroll") for (int k = 0; k < 8; ++k) { const int ch = F.tid + NTHR * k, r = ch >> 6, cc = ch & 63, t = t0_ - 30 + r; unsigned z0 = 0u; asm volatile("" : "+v"(z0)); tp[k] = (u32x4){z0, z0, z0, z0}; \
            if (ch < 62 * 64 && t >= 0) tp[k] = *(const u32x4*)(U + ((size_t)b_ * SEQ + t) * CCH + cc * 8); } } while (0)
    CONV_LOAD(0);
    for (int it = 0; it < 4; ++it) {
        const int unit = F.vcu + 256 * it, b = unit >> 7, tt0 = (unit & 127) * 32;
#pragma unroll
        for (int k = 0; k < 8; ++k) { const int ch = F.tid + NTHR * k, r = ch >> 6, cc = ch & 63; if (ch < 62 * 64) *(LAS u32x4*)(Ut + r * CCH + cc * 8) = tp[k]; }
        if (it + 1 < 4) CONV_LOAD(it + 1);
        __syncthreads();
        float acc[32], uu[62];
#pragma unroll
        for (int s = 0; s < 62; ++s) uu[s] = bf2f(Ut[s * CCH + c]);
#pragma unroll
        for (int tt = 0; tt < 32; ++tt) acc[tt] = cb;
#pragma unroll
        for (int j = 0; j < CK; ++j)
#pragma unroll
            for (int tt = 0; tt < 32; ++tt) acc[tt] = __builtin_fmaf(wj[j], uu[tt + j], acc[tt]);
#pragma unroll
        for (int tt = 0; tt < 32; ++tt) Yt[tt * CCH + c] = acc[tt];
        __syncthreads();
#pragma unroll
        for (int k = 0; k < 4; ++k) { const int tt = F.wave * 4 + k;
            f32x4 y0 = *(const LAS f32x4*)(Yt + tt * CCH + 8 * lane), y1 = *(const LAS f32x4*)(Yt + tt * CCH + 8 * lane + 4);
            const float mean = wave_sum((y0[0] + y0[1]) + (y0[2] + y0[3]) + (y1[0] + y1[1]) + (y1[2] + y1[3])) * (1.f / CCH);
            y0 = y0 - mean; y1 = y1 - mean;
            const float var = wave_sum((y0[0] * y0[0] + y0[1] * y0[1]) + (y0[2] * y0[2] + y0[3] * y0[3]) + (y1[0] * y1[0] + y1[1] * y1[1]) + (y1[2] * y1[2] + y1[3] * y1[3])) * (1.f / CCH);
            const float rstd = 1.f / sqrtf(var + LN_EPS);
            y0 = y0 * rstd * lg0 + lb0; y1 = y1 * rstd * lg1 + lb1;
#pragma unroll
            for (int e = 0; e < 4; ++e) { y0[e] = y0[e] * fsigmoid(y0[e]) * ms0[e]; y1[e] = y1[e] * fsigmoid(y1[e]) * ms1[e]; }
            *(u32x4*)(MIX + ((size_t)b * SEQ + tt0 + tt) * DM + CCH + 8 * lane) = pg8::pack8(y0, y1); }
        __syncthreads();
    }
#undef CONV_LOAD
}

namespace at {
constexpr int QBLK = 32, QB = 256, KVBLK = 64, NSLOT = 3, SLOTB = 8192;
constexpr int LDS_K = 0, LDS_V = NSLOT * SLOTB, LDS_WS = 2 * NSLOT * SLOTB, LDS_OST = LDS_WS + 8 * 64 * 4, LDS_BIAS = LDS_OST + 8 * 4096, LDS_END = LDS_BIAS + 1024;
static_assert(LDS_END <= RING_BYTES && LDS_END <= CONV_ATTN_SCR, "attention LDS");
constexpr float NEGV = -200.0f;
__device__ __forceinline__ int crow(int r, int hi) { return (r & 3) + 8 * (r >> 2) + 4 * hi; }
#define SBAR() __builtin_amdgcn_sched_barrier(0)
__device__ __forceinline__ void glds16(const void* gsrc, unsigned lds_dst) { unsigned keep;
    asm volatile("s_mov_b32 %0, m0\n\ts_mov_b32 m0, %2\n\ts_nop 0\n\tglobal_load_lds_dwordx4 %1, off\n\ts_mov_b32 m0, %0" : "=&s"(keep) : "v"(gsrc), "s"(lds_dst) : "memory"); }
__device__ __forceinline__ float max3f(float a, float b, float c) { float r; asm("v_max3_f32 %0, %1, %2, %3" : "=v"(r) : "v"(a), "v"(b), "v"(c)); return r; }
__device__ __forceinline__ float max2f(float a, float b) { float r; asm("v_max_f32_e32 %0, %1, %2" : "=v"(r) : "v"(a), "v"(b)); return r; }
__device__ __forceinline__ float fadd_s(float a, float b) { float r; asm("v_add_f32_e32 %0, %1, %2" : "=v"(r) : "v"(a), "v"(b)); return r; }
__device__ __forceinline__ float fsub_s(float a, float b) { float r; asm("v_sub_f32_e32 %0, %1, %2" : "=v"(r) : "v"(a), "v"(b)); return r; }
typedef float f32x2_t __attribute__((ext_vector_type(2))); typedef __bf16 bf16x2_t __attribute__((ext_vector_type(2)));
__device__ __forceinline__ unsigned cvtpk_s(float lo, float hi) { f32x2_t v = {lo, hi}; bf16x2_t b = __builtin_convertvector(v, bf16x2_t); return __builtin_bit_cast(unsigned, b); }
typedef LAS const char* lds_cptr;
typedef short v4i16_t __attribute__((ext_vector_type(4)));
__device__ __forceinline__ void kload8(bf16x8* kf, lds_cptr kp) {
    kf[0] = *(const LAS bf16x8*)(kp);        kf[1] = *(const LAS bf16x8*)(kp + 512);  kf[2] = *(const LAS bf16x8*)(kp + 2048); kf[3] = *(const LAS bf16x8*)(kp + 2560);
    kf[4] = *(const LAS bf16x8*)(kp + 4096); kf[5] = *(const LAS bf16x8*)(kp + 4608); kf[6] = *(const LAS bf16x8*)(kp + 6144); kf[7] = *(const LAS bf16x8*)(kp + 6656); }
__device__ __forceinline__ void kload2(bf16x8* kf, lds_cptr kp, int j) { kf[2 * j] = *(const LAS bf16x8*)(kp + j * 2048); kf[2 * j + 1] = *(const LAS bf16x8*)(kp + j * 2048 + 512); }
__device__ __forceinline__ s16x4 vtr(lds_cptr p) { return __builtin_bit_cast(s16x4, __builtin_amdgcn_ds_read_tr16_b64_v4i16((LAS v4i16_t*)p)); }
__device__ __forceinline__ float rowmax(const f32x16& p0, const f32x16& p1) {
    float a = max3f(p0[0], p0[1], p1[0]), b = max3f(p0[2], p0[3], p1[1]); a = max3f(a, p1[2], p1[3]);
#pragma unroll
    for (int r = 4; r < 16; r += 4) { a = max3f(a, p0[r], p0[r + 1]); b = max3f(b, p0[r + 2], p0[r + 3]); a = max3f(a, p1[r], p1[r + 1]); b = max3f(b, p1[r + 2], p1[r + 3]); }
    const float m = max2f(a, b);
    auto rr = __builtin_amdgcn_permlane32_swap(__float_as_uint(m), __float_as_uint(m), false, false);
    return max2f(__uint_as_float(rr[0]), __uint_as_float(rr[1]));
}
__device__ __forceinline__ void pv(f32x16* o, int vb, bf16x8 pa0, bf16x8 pa1, bf16x8 pa2, bf16x8 pa3) {
#pragma unroll
    for (int d0 = 0; d0 < 2; ++d0) { s16x4 lo[4], hi[4];
#pragma unroll
        for (int ks = 0; ks < 4; ++ks) {
            asm volatile("ds_read_b64_tr_b16 %0,%1 offset:%c2" : "=&v"(lo[ks]) : "v"(vb), "i"(d0 * 4096 + ks * 1024) : "memory");
            asm volatile("ds_read_b64_tr_b16 %0,%1 offset:%c2" : "=&v"(hi[ks]) : "v"(vb), "i"(d0 * 4096 + ks * 1024 + 512) : "memory"); }
        asm volatile("s_waitcnt lgkmcnt(0)" ::: "memory"); SBAR();
#define AT_PK(k) (bf16x8){lo[k][0], lo[k][1], lo[k][2], lo[k][3], hi[k][0], hi[k][1], hi[k][2], hi[k][3]}
        o[d0] = __builtin_amdgcn_mfma_f32_32x32x16_bf16(pa0, AT_PK(0), o[d0], 0, 0, 0);
        o[d0] = __builtin_amdgcn_mfma_f32_32x32x16_bf16(pa1, AT_PK(1), o[d0], 0, 0, 0);
        o[d0] = __builtin_amdgcn_mfma_f32_32x32x16_bf16(pa2, AT_PK(2), o[d0], 0, 0, 0);
        o[d0] = __builtin_amdgcn_mfma_f32_32x32x16_bf16(pa3, AT_PK(3), o[d0], 0, 0, 0);
#undef AT_PK
    }
}
template <int THRL> __device__ __forceinline__ void attn_unit(int b, int h, int qb, const bf16* Q, const bf16* __restrict__ Kt, const bf16* __restrict__ Vt, const unsigned long long* maskQ,
                                                              bf16* MIX, float ms0, float ms1, LAS unsigned char* shm, int tid) {
    const int lane = tid & 63, r32 = lane & 31, hi = lane >> 5; const int wid = __builtin_amdgcn_readfirstlane(tid >> 6);
    const size_t rowbase = (size_t)b * SEQ; const int q0 = qb * QB, qw = q0 + wid * QBLK, cwv = qw >> 6;
    const bf16* Qw = Q + (rowbase + qw) * AW + h * HD;
    const unsigned lds0 = (unsigned)(uintptr_t)shm; const lds_cptr shm3 = (lds_cptr)shm;
    LAS float* wsf = (LAS float*)(shm + LDS_WS) + wid * 64;
    const LAS float* biasT = (const LAS float*)(shm + LDS_BIAS);
    const bf16* ksrc = Kt + ((size_t)(b * NH + h) * 64) * 4096 + wid * 512 + lane * 8;
    const bf16* vsrc = Vt + ((size_t)(b * NH + h) * 64) * 4096 + wid * 512 + lane * 8;
    const unsigned kdst = lds0 + LDS_K + wid * 1024, vdst = lds0 + LDS_V + wid * 1024;
#define DMA_K(t, slot) glds16(ksrc + (size_t)(t) * 4096, (unsigned)__builtin_amdgcn_readfirstlane(kdst + (slot)))
#define DMA_V(t, slot) glds16(vsrc + (size_t)(t) * 4096, (unsigned)__builtin_amdgcn_readfirstlane(vdst + (slot)))
    int r32m = r32; asm volatile("" : "+v"(r32m));
    const unsigned long long* mrow = maskQ + ((size_t)(b * 128 + (qw >> 5)) * 64) * 32 + r32m;
#define MLOAD(dst, t) dst = *(const GAS u32x2*)((const GAS unsigned long long*)mrow + (size_t)(t) * 32)
#define MLOAD_UNUSED(dst, t) dst = *(const u32x2*)(mrow + (size_t)(t) * 32)
#define WAIT_BAR(N, M) asm volatile("s_waitcnt vmcnt(" #N ") lgkmcnt(0)\n\ts_barrier" ::: "memory")
    const int vb0 = (int)(lds0 + LDS_V) + ((lane >> 4) & 1) * 32 + (lane & 3) * 8 + (4 * hi + ((lane & 15) >> 2)) * 64;
    bf16x8 kf[8];
    const lds_cptr kp0 = shm3 + LDS_K + hi * 1024 + r32 * 16; const lds_cptr vp0 = shm3 + LDS_V + ((lane >> 4) & 1) * 32 + (lane & 3) * 8 + (4 * hi + ((lane & 15) >> 2)) * 64;
    const int NT = (q0 + QB) / KVBLK;
    u32x2 mA, mB;
    MLOAD(mA, 0);
    DMA_K(0, 0); DMA_V(0, 0); DMA_K(1, SLOTB);
    const lds_cptr qp = shm3 + LDS_OST + wid * 4096 + hi * 512 + r32 * 16;
#pragma unroll
    for (int d0 = 0; d0 < 4; ++d0) { const bf16x8 qv = *(const bf16x8*)(Qw + (size_t)r32 * AW + d0 * 16 + hi * 8); *(LAS bf16x8*)(shm + LDS_OST + wid * 4096 + hi * 512 + r32 * 16 + d0 * 1024) = qv; }
#define QRD(d0) (*(const LAS bf16x8*)(qp + (d0) * 1024))
    float mhat = 0.f, l_reg = 0.f; f32x16 o[2]; o[0] = f32x16{}; o[1] = f32x16{}; f32x16 negm = f32x16{}; asm volatile("" : "+v"(negm));
#define MASKB(P0, P1, t, MW) do { \
        if (64 * (t) + 63 - qw >= -90 && (t) <= cwv) { const int bi_ = 64 * (t) - (qw + r32) + 128 + 4 * hi; \
            _Pragma("unroll") for (int r = 0; r < 16; ++r) { const int k0_ = (r & 3) + 8 * (r >> 2); int i0_ = bi_ + k0_; i0_ = i0_ < 0 ? 0 : i0_; int i1_ = bi_ + k0_ + 32; i1_ = i1_ < 0 ? 0 : i1_; P0[r] += biasT[i0_]; P1[r] += biasT[i1_]; } } \
        { const unsigned ml_ = MW.x >> (4 * hi), mh_ = MW.y >> (4 * hi); const unsigned nv_ = __float_as_uint(NEGV); \
            _Pragma("unroll") for (int r = 0; r < 16; ++r) { const unsigned s0_ = (unsigned)__builtin_amdgcn_sbfe((int)ml_, (r & 3) + 8 * (r >> 2), 1), s1_ = (unsigned)__builtin_amdgcn_sbfe((int)mh_, (r & 3) + 8 * (r >> 2), 1); \
                P0[r] = __uint_as_float((s0_ & __float_as_uint(P0[r])) | (~s0_ & nv_)); P1[r] = __uint_as_float((s1_ & __float_as_uint(P1[r])) | (~s1_ & nv_)); } } } while (0)
    bool resc = false;
#define START(P0, P1) do { const float rm = rowmax(P0, P1); resc = false; \
    { const float dl = rm; mhat = fadd_s(mhat, dl); \
      _Pragma("unroll") for (int r = 0; r < 16; ++r) { P0[r] = fsub_s(P0[r], dl); P1[r] = fsub_s(P1[r], dl); } \
      _Pragma("unroll") for (int r = 0; r < 16; ++r) negm[r] = -mhat; asm volatile("" : "+v"(negm)); } \
    _Pragma("unroll") for (int r = 0; r < 16; ++r) P0[r] = __builtin_amdgcn_exp2f(P0[r]); } while (0)
#define RESC() do { if (resc) { asm volatile("s_waitcnt lgkmcnt(0)" ::: "memory"); \
      _Pragma("unroll") for (int d_ = 0; d_ < 2; ++d_) _Pragma("unroll") for (int r = 0; r < 16; ++r) o[d_][r] *= wsf[crow(r, hi)]; } } while (0)
    f32x16 pA0, pA1, pB0, pB1;
    int sl_prev = 0, sl_cur = 0, sl_next = SLOTB;
#define ROT() do { sl_prev = sl_cur; sl_cur = sl_next; sl_next = (sl_next == (NSLOT - 1) * SLOTB) ? 0 : sl_next + SLOTB; } while (0)
    DMA_K(2, 2 * SLOTB);
    WAIT_BAR(3, mA);
    {
        const lds_cptr kb = kp0;
        pA0 = f32x16{}; pA1 = f32x16{};
#pragma unroll
        for (int d0 = 0; d0 < 4; ++d0) { const bf16x8 b0 = *(const LAS bf16x8*)(kb + d0 * 2048), b1 = *(const LAS bf16x8*)(kb + d0 * 2048 + 512);
            const bf16x8 qv = QRD(d0); pA0 = __builtin_amdgcn_mfma_f32_32x32x16_bf16(b0, qv, pA0, 0, 0, 0); pA1 = __builtin_amdgcn_mfma_f32_32x32x16_bf16(b1, qv, pA1, 0, 0, 0); }
        MASKB(pA0, pA1, 0, mA);
        asm volatile("s_nop 15\n\ts_nop 7" : "+v"(pA0), "+v"(pA1));
        START(pA0, pA1);
#pragma unroll
        for (int r = 0; r < 16; ++r) pA1[r] = __builtin_amdgcn_exp2f(pA1[r]);
    }
    WAIT_BAR(0, mA);
    MLOAD(mB, 1);
    DMA_K(3, 0); DMA_V(1, SLOTB);
    ROT();
    kload8(kf, kp0 + sl_cur);
    WAIT_BAR(2, mB);
    s16x4 vlo[8], vhi[8]; u32x4 pw0, pw1, pw2, pw3;
#define PKW(P, B) cvtpk_s(P[B], P[B + 1])
#define PAF(k) __builtin_bit_cast(bf16x8, pw##k)
#define VFR(i) (bf16x8){vlo[i][0], vlo[i][1], vlo[i][2], vlo[i][3], vhi[i][0], vhi[i][1], vhi[i][2], vhi[i][3]}
#define PIN(x) asm volatile("" : "+v"(x))
#define MX3(a, b, c) __builtin_fmaxf(__builtin_fmaxf((a), (b)), (c))
#define GAPA(MF, A0, A1, A2, A3, W0, W1, PW) do { MF; sacc += A0; sacc += A1; sacc += A2; sacc += A3; PIN(sacc); W0; W1; PIN(PW); SBAR(); } while (0)
#define EX(v) __builtin_amdgcn_exp2f(v)
#define GAPB(MF, X, B) do { MF; X[B] = EX(X[B]); X[B + 1] = EX(X[B + 1]); X[B + 2] = EX(X[B + 2]); X[B + 3] = EX(X[B + 3]); PIN(X); SBAR(); } while (0)
#define VRD(i) do { vlo[i] = vtr(vp_ + (((i) >> 2) * 4096 + ((i) & 3) * 1024)); vhi[i] = vtr(vp_ + (((i) >> 2) * 4096 + ((i) & 3) * 1024 + 512)); } while (0)
#define KRD(G, j) do { if (G) { kload2(kf, kp0 + sl_next, j); SBAR(); } } while (0)
#define STEP(C0, C1, P0, P1, t, MC, MN, GM, GK, GV, GL) do { SBAR(); \
    const lds_cptr vp_ = vp0 + sl_prev; \
    bf16x8 qa_ = QRD(0), qb_; VRD(0); SBAR(); float sacc = (P0[0] + P0[1]); \
    GAPA(C0 = __builtin_amdgcn_mfma_f32_32x32x16_bf16(kf[0], qa_, negm, 0, 0, 0), P0[2], P0[3], P0[4], P0[5],     pw0[0] = PKW(P0, 0), pw0[1] = PKW(P0, 2), pw0); \
    VRD(4); SBAR(); GAPA(C1 = __builtin_amdgcn_mfma_f32_32x32x16_bf16(kf[1], qa_, negm, 0, 0, 0), P0[6], P0[7], P0[8], P0[9],     pw0[2] = PKW(P0, 4), pw0[3] = PKW(P0, 6), pw0); \
    qb_ = QRD(1); VRD(1); SBAR(); GAPA(C0 = __builtin_amdgcn_mfma_f32_32x32x16_bf16(kf[2], qb_, C0, 0, 0, 0),   P0[10], P0[11], P0[12], P0[13], pw1[0] = PKW(P0, 8), pw1[1] = PKW(P0, 10), pw1); \
    VRD(5); SBAR(); GAPA(C1 = __builtin_amdgcn_mfma_f32_32x32x16_bf16(kf[3], qb_, C1, 0, 0, 0),   P0[14], P0[15], P1[0], P1[1],   pw1[2] = PKW(P0, 12), pw1[3] = PKW(P0, 14), pw1); \
    qa_ = QRD(2); VRD(2); SBAR(); GAPA(C0 = __builtin_amdgcn_mfma_f32_32x32x16_bf16(kf[4], qa_, C0, 0, 0, 0),   P1[2], P1[3], P1[4], P1[5],     pw2[0] = PKW(P1, 0), pw2[1] = PKW(P1, 2), pw2); \
    VRD(6); SBAR(); GAPA(C1 = __builtin_amdgcn_mfma_f32_32x32x16_bf16(kf[5], qa_, C1, 0, 0, 0),   P1[6], P1[7], P1[8], P1[9],     pw2[2] = PKW(P1, 4), pw2[3] = PKW(P1, 6), pw2); \
    qb_ = QRD(3); VRD(3); SBAR(); GAPA(C0 = __builtin_amdgcn_mfma_f32_32x32x16_bf16(kf[6], qb_, C0, 0, 0, 0),   P1[10], P1[11], P1[12], P1[13], pw3[0] = PKW(P1, 8), pw3[1] = PKW(P1, 10), pw3); \
    VRD(7); SBAR(); GAPA(C1 = __builtin_amdgcn_mfma_f32_32x32x16_bf16(kf[7], qb_, C1, 0, 0, 0),   P1[14], P1[15], 0.f, 0.f,       pw3[2] = PKW(P1, 12), pw3[3] = PKW(P1, 14), pw3); \
    l_reg += sacc; \
    MASKB(C0, C1, t, MC); \
    if (GM) { MLOAD(MN, (t) + 1); } if (GK) { DMA_K((t) + 3, sl_cur); } if (GV) { DMA_V((t) + 1, sl_next); } \
    { float a = MX3(C0[0], C0[1], C1[0]), b_ = MX3(C0[2], C0[3], C1[1]); a = MX3(a, C1[2], C1[3]); \
      _Pragma("unroll") for (int r = 4; r < 16; r += 4) { a = MX3(a, C0[r], C0[r + 1]); b_ = MX3(b_, C0[r + 2], C0[r + 3]); a = MX3(a, C1[r], C1[r + 1]); b_ = MX3(b_, C1[r + 2], C1[r + 3]); } \
      float rm = __builtin_fmaxf(a, b_); { auto rr = __builtin_amdgcn_permlane32_swap(__float_as_uint(rm), __float_as_uint(rm), false, false); rm = __builtin_fmaxf(__uint_as_float(rr[0]), __uint_as_float(rr[1])); } \
      resc = false; \
      if (__builtin_expect(__any(rm > (float)THRL), 0)) { const float dl = __builtin_fmaxf(rm, 0.f); mhat += dl; \
        _Pragma("unroll") for (int r = 0; r < 16; ++r) { C0[r] -= dl; C1[r] -= dl; } \
        _Pragma("unroll") for (int r = 0; r < 16; ++r) negm[r] = -mhat; asm volatile("" : "+v"(negm)); \
        const float f = __builtin_amdgcn_exp2f(-dl); l_reg *= f; if (hi == 0) wsf[r32] = f; resc = true; } } \
    SBAR(); \
    GAPB(o[0] = __builtin_amdgcn_mfma_f32_32x32x16_bf16(PAF(0), VFR(0), o[0], 0, 0, 0), C0, 0); \
    GAPB(o[1] = __builtin_amdgcn_mfma_f32_32x32x16_bf16(PAF(0), VFR(4), o[1], 0, 0, 0), C0, 4); \
    KRD(GL, 0); GAPB(o[0] = __builtin_amdgcn_mfma_f32_32x32x16_bf16(PAF(1), VFR(1), o[0], 0, 0, 0), C0, 8); \
    KRD(GL, 1); GAPB(o[1] = __builtin_amdgcn_mfma_f32_32x32x16_bf16(PAF(1), VFR(5), o[1], 0, 0, 0), C0, 12); \
    KRD(GL, 2); GAPB(o[0] = __builtin_amdgcn_mfma_f32_32x32x16_bf16(PAF(2), VFR(2), o[0], 0, 0, 0), C1, 0); \
    KRD(GL, 3); GAPB(o[1] = __builtin_amdgcn_mfma_f32_32x32x16_bf16(PAF(2), VFR(6), o[1], 0, 0, 0), C1, 4); \
    GAPB(o[0] = __builtin_amdgcn_mfma_f32_32x32x16_bf16(PAF(3), VFR(3), o[0], 0, 0, 0), C1, 8); \
    GAPB(o[1] = __builtin_amdgcn_mfma_f32_32x32x16_bf16(PAF(3), VFR(7), o[1], 0, 0, 0), C1, 12); \
    } while (0)
    int t = 1;
    for (; t + 5 < NT; t += 2) {
        STEP(pB0, pB1, pA0, pA1, t, mB, mA, true, true, true, true);       WAIT_BAR(2, mA); RESC(); ROT();
        STEP(pA0, pA1, pB0, pB1, t + 1, mA, mB, true, true, true, true);   WAIT_BAR(2, mB); RESC(); ROT();
    }
#define ENDW(tt, M) do { if ((tt) + 3 < NT) { WAIT_BAR(2, M); } else if ((tt) + 2 < NT) { WAIT_BAR(1, M); } else { WAIT_BAR(0, M); } } while (0)
    for (; t + 1 < NT; t += 2) {
        STEP(pB0, pB1, pA0, pA1, t, mB, mA, (t + 1 < NT), (t + 3 < NT), (t + 1 < NT), (t + 1 < NT));         ENDW(t, mA);     RESC(); ROT();
        STEP(pA0, pA1, pB0, pB1, t + 1, mA, mB, (t + 2 < NT), (t + 4 < NT), (t + 2 < NT), (t + 2 < NT));     ENDW(t + 1, mB); RESC(); ROT();
    }
    STEP(pB0, pB1, pA0, pA1, NT - 1, mB, mA, false, false, false, false); RESC();
    { float sacc = pB0[0] + pB0[1];
#pragma unroll
      for (int r = 2; r < 16; ++r) sacc += pB0[r];
#pragma unroll
      for (int r = 0; r < 16; ++r) sacc += pB1[r];
      l_reg += sacc;
      pw0 = (u32x4){PKW(pB0, 0), PKW(pB0, 2), PKW(pB0, 4), PKW(pB0, 6)}; pw1 = (u32x4){PKW(pB0, 8), PKW(pB0, 10), PKW(pB0, 12), PKW(pB0, 14)};
      pw2 = (u32x4){PKW(pB1, 0), PKW(pB1, 2), PKW(pB1, 4), PKW(pB1, 6)}; pw3 = (u32x4){PKW(pB1, 8), PKW(pB1, 10), PKW(pB1, 12), PKW(pB1, 14)};
      SBAR(); pv(o, vb0 + sl_cur, PAF(0), PAF(1), PAF(2), PAF(3)); }
    { auto rr = __builtin_amdgcn_permlane32_swap(__float_as_uint(l_reg), __float_as_uint(l_reg), false, false); l_reg = __uint_as_float(rr[0]) + __uint_as_float(rr[1]); }
    if (hi == 0) wsf[32 + r32] = l_reg; asm volatile("s_waitcnt lgkmcnt(0)" ::: "memory");
    float rli[16];
#pragma unroll
    for (int r = 0; r < 16; ++r) rli[r] = __builtin_amdgcn_rcpf(wsf[32 + crow(r, hi)]);
    { LAS bf16* stg = (LAS bf16*)(shm + LDS_OST) + wid * 2048;
#pragma unroll
      for (int r = 0; r < 16; ++r) { const int orow = crow(r, hi);
          stg[orow * 64 + r32] = (bf16)(cvtpk_s(o[0][r] * rli[r] * ms0, 0.f) & 0xffffu); stg[orow * 64 + 32 + r32] = (bf16)(cvtpk_s(o[1][r] * rli[r] * ms1, 0.f) & 0xffffu); }
      asm volatile("s_waitcnt lgkmcnt(0)" ::: "memory");
      int ln2 = lane; asm volatile("" : "+v"(ln2));
#pragma unroll
      for (int i = 0; i < 4; ++i) { const int row = i * 8 + (ln2 >> 3), ch = ln2 & 7; const u32x4 v = *(const LAS u32x4*)(stg + row * 64 + ch * 8);
          *(u32x4*)(MIX + (rowbase + qw + row) * DM + h * HD + ch * 8) = v; } }
    asm volatile("s_waitcnt lgkmcnt(0)\n\ts_barrier" ::: "memory");
#undef QRD
#undef DMA_K
#undef DMA_V
#undef MLOAD
#undef WAIT_BAR
#undef MASKB
#undef START
#undef RESC
#undef ROT
#undef PKW
#undef PAF
#undef VFR
#undef PIN
#undef MX3
#undef GAPA
#undef GAPB
#undef EX
#undef VRD
#undef KRD
#undef STEP
#undef ENDW
}
#undef SBAR
}

__device__ __forceinline__ void p_attn(Frame& F, int l) {
    const bf16* Q = WSP(bf16, WS_Q); const bf16* Kg = WSP(bf16, WS_K); const bf16* Vg = WSP(bf16, WS_V); bf16* MIX = WSP(bf16, WS_MIX);
    const unsigned long long* maskQ = WSP(unsigned long long, WS_MASK);
    LAS unsigned char* shm = F.lds + RING_OFF;
    const int tid = F.tid, lane = F.lane, r32 = lane & 31;
    const int bh = F.vcu >> 2, sq = F.vcu & 3, b = bh >> 3, h = bh & 7;
    LAS float* biasT = (LAS float*)(shm + at::LDS_BIAS);
    if (tid < 192) { const int rel = tid - 128, nn = rel < 0 ? -rel : rel; int bk = nn;
        if (nn >= 8) bk = 8 + (nn >= 12) + (nn >= 16) + (nn >= 23) + (nn >= 32) + (nn >= 46) + (nn >= 64) + (nn >= 91);
        bk += (rel > 0) ? 16 : 0;
        biasT[tid] = (arg_in(7)[bk * NH + h] - arg_in(7)[15 * NH + h]) * LOG2E; }
    __syncthreads();
    const float ms0 = arg_in(6)[l * DM + h * 64 + r32], ms1 = arg_in(6)[l * DM + h * 64 + 32 + r32];
    for (int ui = 0; ui < 4; ++ui) {
        const int qb = (ui == 0) ? sq : (ui == 1) ? 7 - sq : (ui == 2) ? 8 + sq : 15 - sq;
        at::attn_unit<8>(b, h, qb, Q, Kg, Vg, maskQ, MIX, ms0, ms1, shm, tid);
        if (ui == sq) convert_ffn(F, l);
    }
}


#define REP(bit) for (int rep_ = 0; rep_ < (((PROBE_MASK) >> (bit)) & 1) + 1; ++rep_)
struct Args { const float* in[20]; float* out; unsigned char* ws; int seg_lo, seg_hi; };
constexpr int N_SEG = 1 + 2 * 8 + 2 * 9;

__global__ void __launch_bounds__(NTHR, 2) fwd_kernel(Args a) {
    extern __shared__ __attribute__((aligned(16))) unsigned char lds_raw[];
    Frame F0;
    F0.lds = (LAS unsigned char*)lds_raw;
    F0.tid = threadIdx.x; F0.lane = F0.tid & 63; F0.wave = __builtin_amdgcn_readfirstlane(F0.tid >> 6);
    F0.G = gridDim.x; { const int bx = blockIdx.x; F0.vcu = (F0.G % 8 == 0) ? (bx % 8) * (F0.G / 8) + bx / 8 : bx; }
    F0.ws = a.ws;
    for (int u = F0.tid; u < (LDS_BYTES - LDSCTL_OFF) / 4; u += NTHR) ((LAS unsigned*)(F0.lds + LDSCTL_OFF))[u] = 0u;
    __syncthreads();
    unsigned* ctl = (unsigned*)(F0.ws + WS_CTL);
    XcdBarrier bar = xcd_barrier_post(ctl + CW_BAR, (volatile LAS unsigned*)(F0.lds + MISC_OFF + 32));
    int sg = 0;
    const int lo = a.seg_lo, hi = a.seg_hi;
#define ACTIVE (lo <= sg && sg < hi)
#define SEAM() do { if (lo <= sg && sg + 1 < hi) xcd_barrier(bar); ++sg; } while (0)

    if (ACTIVE) { Frame F = fresh(F0); cvt_x(F); convert_weights(F, 0); }
    SEAM();
    for (int l = 0; l < DEPTH; ++l) {
        if (ACTIVE) REP(3) {
            {
                Frame F = fresh(F0);
                pg8::DenseOrderG S; S.init_tiles(M / 256, 10, F.G, (int)(F.G % 8 == 0 ? (F.vcu % (F.G / 8)) * 8 + F.vcu / (F.G / 8) : F.vcu)); S.Bt = (const char*)WSP(unsigned char, WS_WIN); S.K = DM / 2;
                pg8::EpiIn E{WSP(bf16, WS_Q), WSP(bf16, WS_K), WSP(bf16, WS_V), WSP(bf16, WS_QI), WSP(bf16, WS_KI), WSP(bf16, WS_U), WSP(float, WS_WI), 0, 1.0f / (pg8::F8_ASC * pg8::F8_WGU), 6};
                pg8::gemm_phase<pg8::EpiIn, pg8::DenseOrderG, true, true, true>(F.tid, F.lds + RING_OFF, (const char*)WSP(unsigned char, WS_XQ), DM / 2, S, E);
            }
            {
                Frame F = fresh(F0);
                pg8::DenseOrder S; S.init_tiles(M / 256, 3, F.G, (int)(F.G % 8 == 0 ? (F.vcu % (F.G / 8)) * 8 + F.vcu / (F.G / 8) : F.vcu)); S.Bt = (const char*)(WSP(bf16, WS_WIN) + (size_t)1536 * DM); S.K = DM;
                pg8::EpiIn E{WSP(bf16, WS_Q), WSP(bf16, WS_K), WSP(bf16, WS_V), WSP(bf16, WS_QI), WSP(bf16, WS_KI), WSP(bf16, WS_U), WSP(float, WS_WI), 6, 1.0f, 99};
                pg8::gemm_phase<pg8::EpiIn, pg8::DenseOrder, true, true>(F.tid, F.lds + RING_OFF, (const char*)WSP(bf16, WS_XB), DM, S, E);
            }
        }
        SEAM();
        if (ACTIVE) {
#ifndef NO_IDX
            REP(0) { Frame F = fresh(F0); p_idx(F, l); }
#endif
#ifndef NO_CONV
            REP(1) { Frame F = fresh(F0); p_conv(F, l); }
#endif
        }
        SEAM();
        if (ACTIVE) {
#ifndef NO_ATTN
            REP(2) { Frame F = fresh(F0); p_attn(F, l); }
#endif
        }
        SEAM();
        if (ACTIVE) REP(4) { Frame F = fresh(F0); bf16* R1 = WSP(bf16, WS_R1);
            pg8::DenseOrder S; S.init_tiles(M / 256, DM / 256, F.G, (int)(F.G % 8 == 0 ? (F.vcu % (F.G / 8)) * 8 + F.vcu / (F.G / 8) : F.vcu)); S.Bt = (const char*)WSP(bf16, WS_WOUT); S.K = DM;
            pg8::EpiRes E{WSP(bf16, WS_XB), R1, 1.0f};
            pg8::gemm_phase<pg8::EpiRes, pg8::DenseOrder, true, true>(F.tid, F.lds + RING_OFF, (const char*)WSP(bf16, WS_MIX), DM, S, E);
        }
        SEAM();
        if (ACTIVE) { Frame F = fresh(F0); p_ln1(F, l); }
        SEAM();
        if ((l & 1) == 0) {
            if (ACTIVE) REP(5) { Frame F = fresh(F0); bf16* XB = WSP(bf16, WS_XB);
                pg8::DenseOrderG S; S.init_tiles(M / 256, 2 * DFF / 256, F.G, (int)(F.G % 8 == 0 ? (F.vcu % (F.G / 8)) * 8 + F.vcu / (F.G / 8) : F.vcu)); S.Bt = (const char*)WSP(bf16, WS_WFF); S.K = DM / 2;
                pg8::EpiSwi E{WSP(unsigned char, WS_H), DFF};
                pg8::gemm_phase<pg8::EpiSwi, pg8::DenseOrderG, true, true, true>(F.tid, F.lds + RING_OFF, (const char*)XB, DM / 2, S, E);
            }
            SEAM();
            if (ACTIVE) { Frame F = fresh(F0); bf16* R1 = WSP(bf16, WS_R1);
                pg8::DenseOrderG S; S.init_tiles(M / 256, DM / 256, F.G, (int)(F.G % 8 == 0 ? (F.vcu % (F.G / 8)) * 8 + F.vcu / (F.G / 8) : F.vcu)); S.Bt = (const char*)(WSP(unsigned char, WS_WFF) + (size_t)2 * DFF * DM); S.K = DFF / 2;
                pg8::EpiRes E{R1, R1, 1.0f / (pg8::F8_HSC * pg8::F8_WDN)};
                pg8::gemm_phase<pg8::EpiRes, pg8::DenseOrderG, true, true, true>(F.tid, F.lds + RING_OFF, (const char*)WSP(unsigned char, WS_H), DFF / 2, S, E);
            }
            SEAM();
            if (ACTIVE) { REP(11) { Frame F = fresh(F0); p_ln2(F, l); } if (l + 1 < DEPTH) REP(8) { Frame F = fresh(F0); convert_weights(F, l + 1); } }
            SEAM();
        } else {
            if (ACTIVE) { Frame F = fresh(F0); p_list(F); }
            SEAM();
            for (int r = 0; r < 1; ++r) {
                if (ACTIVE) REP(6) { Frame F = fresh(F0); bf16* XB = WSP(bf16, WS_XB);
                    moe_tables(F);
                    const int Tm = ((LAS int*)(F.lds + LDSCTL_OFF + 1200))[8]; const int tlo = r * RT; int nMr = Tm - tlo; nMr = nMr < 0 ? 0 : (nMr > RT ? RT : nMr);
                    pg8::MoeGuOrder S; S.init_tiles(nMr, 2 * DFE / 256, F.G, (int)(F.G % 8 == 0 ? (F.vcu % (F.G / 8)) * 8 + F.vcu / (F.G / 8) : F.vcu)); S.rowlist = WSP(int, WS_ROWLIST); S.texp = (const LAS int*)(F.lds + LDSCTL_OFF); S.tlo = tlo;
                    S.W = (const char*)WSP(unsigned char, WS_WFF); S.estride = (size_t)3 * DFE * DM;
                    pg8::EpiSwi E{WSP(unsigned char, WS_H), DFE};
                    pg8::gemm_phase<pg8::EpiSwi, pg8::MoeGuOrder, true, true, true>(F.tid, F.lds + RING_OFF, (const char*)XB, DM / 2, S, E);
                }
                SEAM();
                if (ACTIVE) REP(7) { Frame F = fresh(F0);
                    moe_tables(F);
                    const int Tm = ((LAS int*)(F.lds + LDSCTL_OFF + 1200))[8]; const int tlo = r * RT; int nMr = Tm - tlo; nMr = nMr < 0 ? 0 : (nMr > RT ? RT : nMr);
                    pg8::MoeDnOrder S; S.init_tiles(nMr, DM / 256, F.G, (int)(F.G % 8 == 0 ? (F.vcu % (F.G / 8)) * 8 + F.vcu / (F.G / 8) : F.vcu)); S.texp = (const LAS int*)(F.lds + LDSCTL_OFF); S.tlo = tlo;
                    S.W = (const char*)(WSP(unsigned char, WS_WFF) + (size_t)2 * DFE * DM); S.estride = (size_t)3 * DFE * DM;
                    pg8::EpiMoeDown E{WSP(bf16, WS_YD), WSP(float, WS_ROWGATE), tlo};
                    pg8::gemm_phase<pg8::EpiMoeDown, pg8::MoeDnOrder, true, true, true>(F.tid, F.lds + RING_OFF, (const char*)WSP(unsigned char, WS_H), DFE / 2, S, E);
                }
                SEAM();
            }
            if (ACTIVE) { REP(10) { Frame F = fresh(F0); p_comb(F, l); } if (l + 1 < DEPTH) REP(8) { Frame F = fresh(F0); convert_weights(F, l + 1); } }
            SEAM();
        }
    }
#undef ACTIVE
#undef SEAM
}

#ifndef MK_MULTI
#define MK_MULTI 0
#endif
extern "C" void kernel_launch(void* const* d_in, const int* in_sizes, int n_in, void* d_out, int out_size, void* d_ws, size_t ws_size, hipStream_t stream) {
    static int grid = 0;
    if (grid == 0) {
        if (n_in != 20 || in_sizes[0] != M * DM || out_size != M * DM || ws_size < WS_END) { fprintf(stderr, "kernel_launch: unexpected shapes (n_in %d, in0 %d, out %d, ws %zu, need %zu); nothing launched\n", n_in, n_in > 0 ? in_sizes[0] : -1, out_size, ws_size, (size_t)WS_END); grid = -1; return; }
        int dev = 0, cus = 0, per_cu = 0;
        if (hipGetDevice(&dev) != hipSuccess || hipDeviceGetAttribute(&cus, hipDeviceAttributeMultiprocessorCount, dev) != hipSuccess) { grid = -1; return; }
        if (hipFuncSetAttribute((const void*)fwd_kernel, hipFuncAttributeMaxDynamicSharedMemorySize, LDS_BYTES) != hipSuccess) { fprintf(stderr, "kernel_launch: hipFuncSetAttribute failed\n"); grid = -1; return; }
        if (hipOccupancyMaxActiveBlocksPerMultiprocessor(&per_cu, (const void*)fwd_kernel, NTHR, LDS_BYTES) != hipSuccess || per_cu < 1) fprintf(stderr, "kernel_launch: occupancy query reports %d\n", per_cu);
        (void)hipGetLastError();
        grid = cus;
        if (grid != 256) { fprintf(stderr, "kernel_launch: built for 256 CUs, device has %d; nothing launched\n", cus); grid = -1; return; }
    }
    if (grid < 0) return;
    if (hipMemsetAsync((char*)d_ws + WS_CTL, 0, CTL_ZERO_BYTES, stream) != hipSuccess) return;
    Args a{};
    for (int i = 0; i < 20; ++i) a.in[i] = (const float*)d_in[i];
    a.out = (float*)d_out; a.ws = (unsigned char*)d_ws;
#if MK_MULTI
    for (int s = 0; s < N_SEG; ++s) { a.seg_lo = s; a.seg_hi = s + 1; hipLaunchKernelGGL(fwd_kernel, dim3(grid), dim3(NTHR), LDS_BYTES, stream, a); }
#else
    a.seg_lo = 0; a.seg_hi = N_SEG;
    hipLaunchKernelGGL(fwd_kernel, dim3(grid), dim3(NTHR), LDS_BYTES, stream, a);
#endif
    const hipError_t le = hipPeekAtLastError();
    if (le != hipSuccess) fprintf(stderr, "kernel_launch: launch failed: %s\n", hipGetErrorName(le));
}
```

```cpp
#include <hip/hip_runtime.h>
#include <cstdio>
#include <cstdint>

#define GAS __attribute__((address_space(1)))
#define LAS __attribute__((address_space(3)))
#define CAS __attribute__((address_space(4)))
typedef unsigned short bf16;
typedef short bf16x8 __attribute__((ext_vector_type(8)));
typedef short s16x4 __attribute__((ext_vector_type(4)));
typedef float f32x2 __attribute__((ext_vector_type(2)));
typedef float f32x4 __attribute__((ext_vector_type(4)));
typedef float f32x16 __attribute__((ext_vector_type(16)));
typedef unsigned u32x2 __attribute__((ext_vector_type(2)));
typedef unsigned u32x4 __attribute__((ext_vector_type(4)));
typedef int i32x8 __attribute__((ext_vector_type(8)));

#ifndef PROBE_MASK
#define PROBE_MASK 0
#endif
constexpr int BATCH = 8, SEQ = 4096, DM = 1024, M = BATCH * SEQ, DEPTH = 4;
constexpr int AW = 512, NH = 8, HD = 64, CCH = 512, CK = 31;
constexpr int IN_COLS = 3144, NIN = 3328;
constexpr int OFF_KI = 2048, OFF_WI = 2112, OFF_GLU = 2120;
constexpr int DFF = 2816, DFE = 3584, NE = 8;
constexpr int TOPK = 256;
constexpr float DN_ALPHA = 1.6817928305074290f;
constexpr float LN_EPS = 1e-5f;
constexpr float LOG2E = 1.4426950408889634f;
constexpr float QSCALE = 0.125f * LOG2E;
constexpr int NWAVES = 8, NTHR = 512;
constexpr int MAXT = 272, RT = 272;

constexpr size_t MiB = 1u << 20;
constexpr size_t WS_CTL = 0, CTL_ZERO_BYTES = 1 * MiB;
constexpr size_t WS_WIN = 1 * MiB, WS_WOUT = 8 * MiB, WS_WFF = 10 * MiB;
constexpr size_t WS_R1 = 178 * MiB, WS_XB = 306 * MiB, WS_A = 370 * MiB;
constexpr size_t WS_Q = WS_A, WS_K = WS_A + 32 * MiB, WS_V = WS_A + 64 * MiB, WS_QI = WS_A + 96 * MiB, WS_KI = WS_A + 128 * MiB, WS_WI = WS_A + 132 * MiB,
                 WS_U = WS_A + 133 * MiB, WS_MIX = WS_A + 165 * MiB, WS_H = WS_A;
constexpr size_t WS_YD = 616 * MiB, WS_ROUTE = 752 * MiB, WS_ROWLIST = WS_ROUTE + 512 * 1024, WS_ROWGATE = WS_ROWLIST + 320 * 1024, WS_SLOTROW = WS_ROWGATE + 320 * 1024,
                 WS_CNTWG = WS_SLOTROW + 256 * 1024, WS_MASK = 754 * MiB, WS_XQ = 820 * MiB, WS_END = 852 * MiB;
static_assert((size_t)RT * 256 * DFE <= 246 * MiB && (size_t)M * DFF <= 246 * MiB, "H overlay (fp8)");
static_assert((size_t)MAXT * 256 * DM * 2 <= 136 * MiB, "Yd");
static_assert(WS_CNTWG + 8192 <= WS_MASK && WS_MASK + (size_t)DEPTH * BATCH * 128 * 4096 * 4 <= WS_XQ, "route / masks");
constexpr int CW_BAR = 4096;

constexpr int RING_OFF = 0, RING_BYTES = 131072;
constexpr int AUX_OFF = 131072, AUX_BYTES = 26624;
constexpr int LDSCTL_OFF = AUX_OFF + AUX_BYTES, MISC_OFF = LDSCTL_OFF + 2048;
constexpr int LDS_BYTES = 157 * 1024;
static_assert(MISC_OFF + 128 <= LDS_BYTES, "LDS map");

__device__ __forceinline__ unsigned cvt_pk_bf16(float lo, float hi) { unsigned r; asm volatile("v_cvt_pk_bf16_f32 %0, %1, %2" : "=v"(r) : "v"(lo), "v"(hi)); return r; }
__device__ __forceinline__ float bf2f(unsigned short b) { return __uint_as_float((unsigned)b << 16); }
__device__ __forceinline__ float fsigmoid(float x) { return __builtin_amdgcn_rcpf(1.0f + __builtin_amdgcn_exp2f(-x * LOG2E)); }
#define LDS_WAIT() asm volatile("s_waitcnt lgkmcnt(0)" ::: "memory")
#define VM_WAIT() asm volatile("s_waitcnt vmcnt(0)" ::: "memory")

namespace pg8 {
constexpr int BM = 256, BK = 64, HALF = 128, HTB = HALF * BK * 2, STAGE_BYTES = 8 * HTB, NXCD = 8, WGM = 8;
__host__ __device__ __forceinline__ int lds_byte(int r, int c) { const int st = (r >> 4) * 2 + (c >> 5), rr = r & 15, cc = c & 31, ob = rr * 64 + cc * 2; return st * 1024 + (ob ^ (((ob >> 9) & 1) << 5)); }
__host__ __device__ __forceinline__ void stage_rc(int b, int& R, int& C) { const int st = b / 1024, sb = b % 1024, swz = sb ^ (((sb >> 9) & 1) << 5); R = (st >> 1) * 16 + swz / 64; C = (st & 1) * 32 + (swz % 64) / 2; }
__host__ __device__ __forceinline__ int perm32(int rho) { const int n = rho >> 4, i = rho & 15; return 8 * (i >> 2) + 4 * n + (i & 3); }
struct Unit { int pm, pn; };

struct OrderBase {
    int nM, nN, nwg, G, c;
    __device__ __forceinline__ void init_tiles(int nM_, int nN_, int G_, int c_) { nM = nM_; nN = nN_; nwg = nM * nN; G = G_; c = c_; }
    __device__ __forceinline__ bool next(int i, Unit& u) const { const long L = (long)i * G + c; if (L >= nwg) return false; unit_of((int)L, u); return true; }
    __device__ __forceinline__ void unit_of(int L, Unit& u) const {
        int wgid = L; { const int q = nwg / NXCD, r = nwg % NXCD, xcd = wgid % NXCD, off = wgid / NXCD; wgid = (xcd < r ? xcd * (q + 1) : r * (q + 1) + (xcd - r) * q) + off; }
        const int nig = WGM * nN, gid = wgid / nig, fm = gid * WGM, gsz = (nM - fm) < WGM ? (nM - fm) : WGM;
        u.pm = fm + ((wgid % nig) % gsz); u.pn = (wgid % nig) / gsz;
    }
    __device__ __forceinline__ void a_ready(const Unit&) const {}
    __device__ __forceinline__ void done(const Unit&) const {}
};
struct DenseOrder : OrderBase {
    static constexpr bool GATHER = false;
    const char* Bt; int K;
    __device__ __forceinline__ size_t a_base(const Unit& u) const { return (size_t)u.pm * ((size_t)BM * K * 2); }
    __device__ __forceinline__ unsigned a_off(const Unit&, int) const { return 0u; }
    __device__ __forceinline__ const char* b_base(const Unit& u) const { return Bt + (size_t)u.pn * ((size_t)BM * K * 2); }
};

struct DenseOrderG : OrderBase {
    static constexpr bool GATHER = true;
    const char* Bt; int K;
    __device__ __forceinline__ size_t a_base(const Unit&) const { return 0; }
    __device__ __forceinline__ unsigned a_off(const Unit& u, int r) const { return (unsigned)(u.pm * BM + r) * (unsigned)(K * 2); }
    __device__ __forceinline__ const char* b_base(const Unit& u) const { return Bt + (size_t)u.pn * ((size_t)BM * K * 2); }
};

template <class Epi, class Sched, bool ALIGN_EPI, bool SP2, bool F8 = false>
__device__ __forceinline__ void gemm_phase(const int tid, LAS unsigned char* lds, const char* Abase, const int K, const Sched& S, const Epi& E) {
    const int wid = __builtin_amdgcn_readfirstlane(tid >> 6), lane = tid & 63, wr = wid >> 2, wc = wid & 3, fr = lane & 15, fq = lane >> 4;
    const int nt = K / BK;
    constexpr bool GATHER = Sched::GATHER;
    unsigned voffA[2], voffB[2];
#pragma unroll
    for (int i = 0; i < 2; ++i) { int R, C; stage_rc(tid * 16 + i * 8192, R, C); const int Rb = Epi::PERM ? ((R & ~31) + perm32(R & 31)) : R;
        voffA[i] = GATHER ? (unsigned)C * 2u : (unsigned)(R * K + C) * 2u; voffB[i] = (unsigned)(Rb * K + C) * 2u; }
    const size_t kstep = (size_t)(BK * 2);
    const size_t hstep = (size_t)HALF * K * 2;
    const unsigned ldsw = (unsigned)wid * 1024u;
    const int aoff = lds_byte(wr * 64 + fr, fq * 8), boff = lds_byte(wc * 32 + fr, fq * 8);
#define PG8_SA(b, h) (((b) * 2 + (h)) * HTB)
#define PG8_SB(b, h) ((4 + (b) * 2 + (h)) * HTB)
#define PG8_STAGE(bufoff, gbase, voff) do { _Pragma("unroll") for (int _i = 0; _i < 2; ++_i) \
        __builtin_amdgcn_global_load_lds((const unsigned*)((const char*)(gbase) + (voff)[_i]), (LAS unsigned*)(lds + (bufoff) + ldsw + _i * 8192), 16, 0, 0); } while (0)
typedef int i32x4_t __attribute__((ext_vector_type(4)));
#define PG8_LDA(dst, b, h) do { _Pragma("unroll") for (int m = 0; m < 4; ++m) { if constexpr (F8) { dst[m].lo = *(const LAS i32x4_t*)(lds + PG8_SA(b, h) + aoff + m * 2048); dst[m].hi = *(const LAS i32x4_t*)(lds + PG8_SA(b, h) + aoff + m * 2048 + 1024); } \
        else { _Pragma("unroll") for (int k = 0; k < 2; ++k) dst##b16[m][k] = *(const LAS bf16x8*)(lds + PG8_SA(b, h) + aoff + m * 2048 + k * 1024); } } } while (0)
#define PG8_LDB(dst, b, h) do { _Pragma("unroll") for (int n = 0; n < 2; ++n) { if constexpr (F8) { dst[n].lo = *(const LAS i32x4_t*)(lds + PG8_SB(b, h) + boff + n * 2048); dst[n].hi = *(const LAS i32x4_t*)(lds + PG8_SB(b, h) + boff + n * 2048 + 1024); } \
        else { _Pragma("unroll") for (int k = 0; k < 2; ++k) dst##b16[n][k] = *(const LAS bf16x8*)(lds + PG8_SB(b, h) + boff + n * 2048 + k * 1024); } } } while (0)
#define PG8_MMA(ai, bj, At, Bt) do { __builtin_amdgcn_s_setprio(1); _Pragma("unroll") for (int m = 0; m < 4; ++m) _Pragma("unroll") for (int n = 0; n < 2; ++n) { \
        if constexpr (F8) { acc[ai][bj][m][n] = __builtin_amdgcn_mfma_scale_f32_16x16x128_f8f6f4(Bt[n], At[m], acc[ai][bj][m][n], 0, 0, 0, 0x7f7f7f7f, 0, 0x7f7f7f7f); } \
        else { _Pragma("unroll") for (int k = 0; k < 2; ++k) acc[ai][bj][m][n] = __builtin_amdgcn_mfma_f32_16x16x32_bf16(Bt##b16[n][k], At##b16[m][k], acc[ai][bj][m][n], 0, 0, 0); } } __builtin_amdgcn_s_setprio(0); } while (0)
#define PG8_WAIT_V(n) asm volatile("s_waitcnt vmcnt(" #n ")" ::: "memory")
#define PG8_WAIT_L(n) asm volatile("s_waitcnt lgkmcnt(" #n ")" ::: "memory")
#define PG8_BAR __builtin_amdgcn_s_barrier()
#define PG8_SCHED __builtin_amdgcn_sched_barrier(0)
    Unit cur, nxt; int ui = 0;
    if (!S.next(0, cur)) return;
    f32x4 acc[2][2][4][2];
    { float z0 = 0.f; asm volatile("" : "+v"(z0));
#pragma unroll
    for (int a = 0; a < 2; ++a)
#pragma unroll
        for (int b = 0; b < 2; ++b)
#pragma unroll
            for (int m = 0; m < 4; ++m)
#pragma unroll
                for (int n = 0; n < 2; ++n) acc[a][b][m][n] = (f32x4){z0, z0, z0, z0}; }
    bf16x8 Atb16[F8 ? 1 : 4][2], B0b16[F8 ? 1 : 2][2], B1b16[F8 ? 1 : 2][2]; i32x8 At[F8 ? 4 : 1], B0[F8 ? 2 : 1], B1[F8 ? 2 : 1]; (void)Atb16; (void)B0b16; (void)B1b16; (void)At; (void)B0; (void)B1;
    unsigned cOff0[2], cOff1[2];
#define PG8_ROWS(u) do { if constexpr (GATHER) { _Pragma("unroll") for (int _i = 0; _i < 2; ++_i) { int R_, C_; stage_rc(tid * 16 + _i * 8192, R_, C_); cOff0[_i] = S.a_off(u, R_) + voffA[_i]; cOff1[_i] = S.a_off(u, HALF + R_) + voffA[_i]; } } } while (0)
#define PG8_STAGE_A(bufoff, h, ptr) do { if constexpr (GATHER) { if ((h) == 0) PG8_STAGE(bufoff, ptr, cOff0); else PG8_STAGE(bufoff, ptr, cOff1); } else { PG8_STAGE(bufoff, (ptr) + (h) * hstep, voffA); } } while (0)
    const char* cA = Abase; if constexpr (!GATHER) cA = Abase + S.a_base(cur);
    PG8_ROWS(cur);
    const char* cB = S.b_base(cur);
    S.a_ready(cur);
    {
        PG8_STAGE(PG8_SB(0, 0), cB, voffB); PG8_STAGE(PG8_SB(0, 1), cB + hstep, voffB); PG8_STAGE_A(PG8_SA(0, 0), 0, cA); PG8_STAGE_A(PG8_SA(0, 1), 1, cA);
        if (wr == 1) PG8_BAR;
        PG8_WAIT_V(2); PG8_BAR;
        PG8_STAGE(PG8_SB(1, 0), cB + kstep, voffB); PG8_STAGE_A(PG8_SA(1, 0), 0, cA + kstep); PG8_STAGE(PG8_SB(1, 1), cB + hstep + kstep, voffB);
        PG8_WAIT_V(6); PG8_BAR;
    }
    for (;;) {
        const bool has_next = S.next(ui + 1, nxt);
        unsigned nOff0[2] = {0u, 0u}, nOff1[2] = {0u, 0u};
        if constexpr (GATHER) { if (has_next) { _Pragma("unroll") for (int _i = 0; _i < 2; ++_i) { int R_, C_; stage_rc(tid * 16 + _i * 8192, R_, C_); nOff0[_i] = S.a_off(nxt, R_); nOff1[_i] = S.a_off(nxt, HALF + R_); } } }
        const char* nA = cA; if constexpr (!GATHER) { if (has_next) nA = Abase + S.a_base(nxt); }
        const char* nB = has_next ? S.b_base(nxt) : cB;
#pragma nounroll
        for (int t = 0; t < nt; t += 2) {
            const bool last = (t == nt - 2);
            const char* a1 = cA + (size_t)(t + 1) * kstep;
            const char* a2 = last ? nA : cA + (size_t)(t + 2) * kstep; const char* b2 = last ? nB : cB + (size_t)(t + 2) * kstep;
            const char* a3 = a2 + kstep; const char* b3 = b2 + kstep;
            if (last && has_next) S.a_ready(nxt);
            if constexpr (SP2) {
            PG8_LDB(B0, 0, 0); PG8_LDB(B1, 0, 1); PG8_SCHED; PG8_LDA(At, 0, 0); PG8_STAGE_A(PG8_SA(1, 1), 1, a1);
            if constexpr (GATHER) { if (last && has_next) { _Pragma("unroll") for (int _i = 0; _i < 2; ++_i) { cOff0[_i] = nOff0[_i] + voffA[_i]; cOff1[_i] = nOff1[_i] + voffA[_i]; } } }
            PG8_WAIT_V(8); PG8_WAIT_L(0); PG8_BAR; PG8_MMA(0, 0, At, B0); PG8_MMA(0, 1, At, B1); PG8_BAR; PG8_SCHED;
            PG8_LDA(At, 0, 1); PG8_STAGE(PG8_SB(0, 0), b2, voffB); PG8_STAGE(PG8_SB(0, 1), b2 + hstep, voffB); PG8_STAGE_A(PG8_SA(0, 0), 0, a2);
            PG8_WAIT_V(8); PG8_WAIT_L(0); PG8_BAR; PG8_MMA(1, 0, At, B0); PG8_MMA(1, 1, At, B1); PG8_BAR; PG8_SCHED;
            PG8_LDB(B0, 1, 0); PG8_LDB(B1, 1, 1); PG8_SCHED; PG8_LDA(At, 1, 0); PG8_STAGE_A(PG8_SA(0, 1), 1, a2);
            PG8_WAIT_V(8); PG8_WAIT_L(0); PG8_BAR; PG8_MMA(0, 0, At, B0); PG8_MMA(0, 1, At, B1); PG8_BAR; PG8_SCHED;
            PG8_LDA(At, 1, 1); PG8_STAGE(PG8_SB(1, 0), b3, voffB); PG8_STAGE(PG8_SB(1, 1), b3 + hstep, voffB); PG8_STAGE_A(PG8_SA(1, 0), 0, a3);
            PG8_WAIT_V(8); PG8_WAIT_L(0); PG8_BAR; PG8_MMA(1, 0, At, B0); PG8_MMA(1, 1, At, B1); PG8_BAR; PG8_SCHED;
            } else { static_assert(SP2, "only the two-super-phase loop is kept"); }
        }
        if constexpr (ALIGN_EPI) { if (wr == 0) PG8_BAR; }
        E(acc, cur, wr, wc, fr, fq); S.done(cur);
        if (!has_next) break;
        { float z0 = 0.f; asm volatile("" : "+v"(z0));
#pragma unroll
        for (int a = 0; a < 2; ++a)
#pragma unroll
            for (int b = 0; b < 2; ++b)
#pragma unroll
                for (int m = 0; m < 4; ++m)
#pragma unroll
                    for (int n = 0; n < 2; ++n) acc[a][b][m][n] = (f32x4){z0, z0, z0, z0}; }
        cur = nxt; cA = nA; cB = nB; ++ui;
        if constexpr (ALIGN_EPI) { if (wr == 1) PG8_BAR; }
    }
    PG8_WAIT_V(0);
    if constexpr (!ALIGN_EPI) { if (wr == 0) PG8_BAR; }
    PG8_BAR;
#undef PG8_SA
#undef PG8_SB
#undef PG8_STAGE
#undef PG8_STAGE_A
#undef PG8_ROWS
#undef PG8_LDA
#undef PG8_LDB
#undef PG8_MMA
#undef PG8_WAIT_V
#undef PG8_WAIT_L
#undef PG8_BAR
#undef PG8_SCHED
}
}

namespace pg8 {
__device__ __forceinline__ u32x4 pack8(const f32x4 v0, const f32x4 v1) { u32x4 w; w.x = cvt_pk_bf16(v0[0], v0[1]); w.y = cvt_pk_bf16(v0[2], v0[3]); w.z = cvt_pk_bf16(v1[0], v1[1]); w.w = cvt_pk_bf16(v1[2], v1[3]); return w; }

__device__ __forceinline__ unsigned pk4_fp8(float a, float b, float c, float d) {
    a = __builtin_amdgcn_fmed3f(a, -448.f, 448.f); b = __builtin_amdgcn_fmed3f(b, -448.f, 448.f); c = __builtin_amdgcn_fmed3f(c, -448.f, 448.f); d = __builtin_amdgcn_fmed3f(d, -448.f, 448.f);
    unsigned r = 0u; r = (unsigned)__builtin_amdgcn_cvt_pk_fp8_f32(a, b, (int)r, false); r = (unsigned)__builtin_amdgcn_cvt_pk_fp8_f32(c, d, (int)r, true); return r; }
__device__ __forceinline__ u32x2 pack8_fp8(const f32x4 v0, const f32x4 v1) { u32x2 w; w.x = pk4_fp8(v0[0], v0[1], v0[2], v0[3]); w.y = pk4_fp8(v1[0], v1[1], v1[2], v1[3]); return w; }
constexpr float F8_ASC = 16.f, F8_WGU = 64.f, F8_HSC = 8.f, F8_WDN = 256.f;
struct EpiIn {
    static constexpr bool PERM = true;
    bf16 *Q, *Kb, *V, *QI, *KI, *U; float* WI; int pn_off; float dsc; int glu_from;
    __device__ __forceinline__ void operator()(const f32x4 (&acc)[2][2][4][2], const Unit& u, int wr, int wc, int fr, int fq) const {
        const int row0 = u.pm * BM + wr * 64 + fr; const int pn = (u.pn >= glu_from) ? u.pn - glu_from + 9 : u.pn + pn_off;
        if (pn < 2 || (pn >= 6 && pn < 8)) {
            bf16* base = (pn < 2) ? Q : QI;
            const float sc = ((pn < 2) ? QSCALE : 1.0f) * dsc;
            const int col0 = (pn & 1) * 256 + wc * 32 + 8 * fq;
#pragma unroll
            for (int ai = 0; ai < 2; ++ai)
#pragma unroll
                for (int m = 0; m < 4; ++m) { bf16* rowp = base + (size_t)(row0 + ai * HALF + m * 16) * AW + col0;
#pragma unroll
                    for (int bj = 0; bj < 2; ++bj) *(u32x4*)(rowp + bj * HALF) = pack8(acc[ai][bj][m][0] * sc, acc[ai][bj][m][1] * sc); }
        } else if (pn < 6) {
            const bool isK = pn < 4; bf16* base = isK ? Kb : V;
#pragma unroll
            for (int ai = 0; ai < 2; ++ai)
#pragma unroll
                for (int m = 0; m < 4; ++m) { const int row = row0 + ai * HALF + m * 16, bb = row >> 12, t = row & 4095, tile = t >> 6, r = t & 63;
#pragma unroll
                    for (int bj = 0; bj < 2; ++bj) { const int col = (pn & 1) * 256 + bj * HALF + wc * 32 + 8 * fq, h = col >> 6, d = col & 63;
                        const size_t tb = ((size_t)((bb * NH + h) * 64 + tile)) * 4096;
                        const size_t off = isK ? tb + (d >> 3) * 512 + r * 8 : tb + (d >> 5) * 2048 + r * 32 + (d & 31);
                        *(u32x4*)(base + off) = pack8(acc[ai][bj][m][0] * dsc, acc[ai][bj][m][1] * dsc); } }
        } else if (pn == 8) {
#pragma unroll
            for (int ai = 0; ai < 2; ++ai)
#pragma unroll
                for (int m = 0; m < 4; ++m) { const size_t row = (size_t)(row0 + ai * HALF + m * 16);
                    if (wc < 2) { const int c8 = wc * 4 + fq;
                        *(u32x4*)(KI + (row >> 5) * 2048 + (c8 >> 1) * 512 + (c8 & 1) * 256 + (row & 31) * 8) = pack8(acc[ai][0][m][0] * dsc, acc[ai][0][m][1] * dsc); }
                    else if (wc == 2 && fq == 0) { *(f32x4*)(WI + row * 8) = acc[ai][0][m][0] * dsc; *(f32x4*)(WI + row * 8 + 4) = acc[ai][0][m][1] * dsc; } }
        } else {
            const int col0 = (pn - 9) * 128 + wc * 32 + 8 * fq;
#pragma unroll
            for (int ai = 0; ai < 2; ++ai)
#pragma unroll
                for (int m = 0; m < 4; ++m) { f32x4 o[2];
#pragma unroll
                    for (int n = 0; n < 2; ++n) { const f32x4 a = acc[ai][0][m][n], g = acc[ai][1][m][n];
#pragma unroll
                        for (int e = 0; e < 4; ++e) o[n][e] = a[e] * dsc * fsigmoid(g[e] * dsc); }
                    *(u32x4*)(U + (size_t)(row0 + ai * HALF + m * 16) * CCH + col0) = pack8(o[0], o[1]); }
        }
    }
};
struct EpiRes {
    static constexpr bool PERM = true;
    const bf16* base; bf16* out; float asc;
    __device__ __forceinline__ void operator()(const f32x4 (&acc)[2][2][4][2], const Unit& u, int wr, int wc, int fr, int fq) const {
        const int row0 = u.pm * BM + wr * 64 + fr, col0 = u.pn * BM + wc * 32 + 8 * fq;
#pragma unroll
        for (int ai = 0; ai < 2; ++ai) {
            u32x4 bsv[4][2];
#pragma unroll
            for (int m = 0; m < 4; ++m)
#pragma unroll
                for (int bj = 0; bj < 2; ++bj) bsv[m][bj] = __builtin_nontemporal_load((const u32x4*)(base + (size_t)(row0 + ai * HALF + m * 16) * DM + col0 + bj * HALF));
#pragma unroll
            for (int m = 0; m < 4; ++m) { const size_t off = (size_t)(row0 + ai * HALF + m * 16) * DM + col0;
#pragma unroll
                for (int bj = 0; bj < 2; ++bj) { const u32x4 bs = bsv[m][bj];
                    f32x4 b0, b1; b0[0] = __uint_as_float(bs.x << 16); b0[1] = __uint_as_float(bs.x & 0xffff0000u); b0[2] = __uint_as_float(bs.y << 16); b0[3] = __uint_as_float(bs.y & 0xffff0000u);
                    b1[0] = __uint_as_float(bs.z << 16); b1[1] = __uint_as_float(bs.z & 0xffff0000u); b1[2] = __uint_as_float(bs.w << 16); b1[3] = __uint_as_float(bs.w & 0xffff0000u);
                    *(u32x4*)(out + off + bj * HALF) = pack8(b0 * DN_ALPHA + acc[ai][bj][m][0] * asc, b1 * DN_ALPHA + acc[ai][bj][m][1] * asc); } }
        }
    }
};
struct EpiSwi {
    static constexpr bool PERM = true;
    unsigned char* H; int ldh;
    __device__ __forceinline__ void operator()(const f32x4 (&acc)[2][2][4][2], const Unit& u, int wr, int wc, int fr, int fq) const {
        const int row0 = u.pm * BM + wr * 64 + fr, col0 = u.pn * 128 + wc * 32 + 8 * fq;
        constexpr float ds = 1.0f / (F8_ASC * F8_WGU);
#pragma unroll
        for (int ai = 0; ai < 2; ++ai)
#pragma unroll
            for (int m = 0; m < 4; ++m) { f32x4 o[2];
#pragma unroll
                for (int n = 0; n < 2; ++n) { const f32x4 ga = acc[ai][0][m][n], ua = acc[ai][1][m][n];
#pragma unroll
                    for (int e = 0; e < 4; ++e) o[n][e] = (ga[e] * ua[e]) * ((ds * ds * F8_HSC) * __builtin_amdgcn_rcpf(1.0f + __builtin_amdgcn_exp2f(ga[e] * (-ds * LOG2E)))); }
                *(u32x2*)(H + (size_t)(row0 + ai * HALF + m * 16) * ldh + col0) = pack8_fp8(o[0], o[1]); }
    }
};
struct EpiMoeDown {
    static constexpr bool PERM = true;
    bf16* Yd; const float* rowgate; int tlo;
    __device__ __forceinline__ void operator()(const f32x4 (&acc)[2][2][4][2], const Unit& u, int wr, int wc, int fr, int fq) const {
        const int row0 = (tlo + u.pm) * BM + wr * 64 + fr, col0 = u.pn * BM + wc * 32 + 8 * fq;
#pragma unroll
        for (int ai = 0; ai < 2; ++ai)
#pragma unroll
            for (int m = 0; m < 4; ++m) { const int row = row0 + ai * HALF + m * 16; const float gt = rowgate[row] * (1.0f / (F8_HSC * F8_WDN)); bf16* rowp = Yd + (size_t)row * DM + col0;
#pragma unroll
                for (int bj = 0; bj < 2; ++bj) *(u32x4*)(rowp + bj * HALF) = pack8(acc[ai][bj][m][0] * gt, acc[ai][bj][m][1] * gt); }
    }
};
struct MoeGuOrder : OrderBase {
    static constexpr bool GATHER = true;
    const int* rowlist; const LAS int* texp; int tlo; const char* W; size_t estride;
    __device__ __forceinline__ size_t a_base(const Unit&) const { return 0; }
    __device__ __forceinline__ unsigned a_off(const Unit& u, int r) const { return (unsigned)rowlist[(tlo + u.pm) * BM + r] * (unsigned)DM; }
    __device__ __forceinline__ const char* b_base(const Unit& u) const { return W + (size_t)texp[tlo + u.pm] * estride + (size_t)u.pn * ((size_t)BM * DM); }
};
struct MoeDnOrder : OrderBase {
    static constexpr bool GATHER = true;
    const LAS int* texp; int tlo; const char* W; size_t estride;
    __device__ __forceinline__ size_t a_base(const Unit&) const { return 0; }
    __device__ __forceinline__ unsigned a_off(const Unit& u, int r) const { return (unsigned)(u.pm * BM + r) * (unsigned)DFE; }
    __device__ __forceinline__ const char* b_base(const Unit& u) const { return W + (size_t)texp[tlo + u.pm] * estride + (size_t)u.pn * ((size_t)BM * DFE); }
};
}

typedef GAS unsigned gu32;
#define RLX_AGENT __ATOMIC_RELAXED, __HIP_MEMORY_SCOPE_AGENT
#define XB_TMO      128
#define XB_XCNT(j)  (256  + 64 * (j))
#define XB_XSUB(j)  (1280 + 64 * (j))
#define XB_XGEN(j)  (2304 + 64 * (j))
#define XB_TOP      3328
#define XB_TOPGEN   3392
#define XCD_BAR_WORDS 3456
#define XB_SPIN_CAP (1u << 18)

__device__ __forceinline__ unsigned xb_ld(unsigned* p)              { return __hip_atomic_load(p, __ATOMIC_RELAXED, __HIP_MEMORY_SCOPE_AGENT); }
__device__ __forceinline__ unsigned xb_add(unsigned* p, unsigned v) { return __hip_atomic_fetch_add(p, v, __ATOMIC_RELAXED, __HIP_MEMORY_SCOPE_AGENT); }
__device__ __forceinline__ unsigned xb_xcc_id() { return (unsigned)__builtin_amdgcn_s_getreg((3 << 11) | 20) & 0xFu; }
#define XB_SPIN(cond, bar) do { unsigned _sp = 0; while (cond) { __builtin_amdgcn_s_sleep(1); \
    if ((++_sp & 255u) == 0u) { if (xb_ld(&(bar)[XB_TMO])) break; if (_sp > XB_SPIN_CAP) { atomicAdd(&(bar)[XB_TMO], 1u); break; } } } } while (0)

struct XcdBarrier {
    unsigned* bar; unsigned x;
    volatile LAS unsigned* st;
};
__device__ __forceinline__ XcdBarrier xcd_barrier_post(unsigned* bar, volatile LAS unsigned* st) {
    XcdBarrier b; b.bar = bar; b.x = xb_xcc_id(); b.st = st;
    if (threadIdx.x == 0) (void)xb_add(&bar[XB_XCNT(b.x)], 1u);
    return b;
}
__device__ __forceinline__ void xcd_barrier_complete(unsigned* bar, unsigned x, unsigned& nloc, unsigned& nx) {
    const unsigned G = gridDim.x * gridDim.y * gridDim.z;
    unsigned sum, cnt, mine, sp = 0u;
    for (;;) {
        sum = 0u; cnt = 0u; mine = 0u;
#pragma unroll
        for (unsigned j = 0; j < 16; ++j) { const unsigned c = xb_ld(&bar[XB_XCNT(j)]); sum += c; cnt += (c > 0u) ? 1u : 0u; mine = (j == x) ? c : mine; }
        if (sum == G) break;
        __builtin_amdgcn_s_sleep(1);
        if ((++sp & 255u) == 0u) { if (xb_ld(&bar[XB_TMO])) break; if (sp > XB_SPIN_CAP) { atomicAdd(&bar[XB_TMO], 1u); break; } }
    }
    nloc = mine > 0u ? mine : 1u; nx = cnt > 0u ? cnt : 1u;
}
__device__ __forceinline__ void xcd_barrier(const XcdBarrier& b) {
    asm volatile("s_waitcnt vmcnt(0)" ::: "memory");
    __syncthreads();
    if (threadIdx.x == 0) {
        unsigned* bar = b.bar;
        __builtin_amdgcn_s_waitcnt(0);
        unsigned nloc = b.st[0], nx = b.st[1];
        if (nloc == 0u) { xcd_barrier_complete(bar, b.x, nloc, nx); b.st[0] = nloc; b.st[1] = nx; }
        const unsigned old = xb_add(&bar[XB_XSUB(b.x)], 1u);
        const unsigned gen = old / nloc;
        if (old + 1u == (gen + 1u) * nloc) {
            __builtin_amdgcn_fence(__ATOMIC_RELEASE, "agent");
            asm volatile("s_waitcnt vmcnt(0)" ::: "memory");
            const unsigned og = xb_add(&bar[XB_TOP], 1u);
            const unsigned tg = og / nx;
            if (og + 1u == (tg + 1u) * nx) xb_add(&bar[XB_TOPGEN], 1u);
            else XB_SPIN(xb_ld(&bar[XB_TOPGEN]) == tg, bar);
            __builtin_amdgcn_fence(__ATOMIC_ACQUIRE, "agent");
            xb_add(&bar[XB_XGEN(b.x)], 1u);
            asm volatile("s_waitcnt vmcnt(0)" ::: "memory");
        } else {
            XB_SPIN(xb_ld(&bar[XB_XGEN(b.x)]) == gen, bar);
            __builtin_amdgcn_fence(__ATOMIC_ACQUIRE, "agent");
            asm volatile("s_waitcnt vmcnt(0)" ::: "memory");
        }
    }
    __syncthreads();
}

struct Frame {
    LAS unsigned char* lds;
    int tid, lane, wave, vcu, G;
    unsigned char* ws;
};
__device__ __forceinline__ const float* arg_in(int k) { return (const float*)*(const GAS float* const volatile CAS*)((const CAS char*)__builtin_amdgcn_kernarg_segment_ptr() + 8 * k); }
__device__ __forceinline__ float* arg_out() { return (float*)*(GAS float* const volatile CAS*)((const CAS char*)__builtin_amdgcn_kernarg_segment_ptr() + 160); }
#define WSP(T, off) ((T*)(F.ws + (off)))
__device__ __forceinline__ Frame fresh(const Frame& F0) {
    Frame F = F0; int wv = F0.wave, v = F0.vcu, g = F0.G; asm volatile("" : "+s"(wv), "+s"(v), "+s"(g)); F.wave = wv; F.vcu = v; F.G = g;
    int ln; asm volatile("v_mbcnt_lo_u32_b32 %0, -1, 0\n\tv_mbcnt_hi_u32_b32 %0, -1, %0" : "=v"(ln)); F.lane = ln; F.tid = wv * 64 + ln;
    GAS unsigned char* w = (GAS unsigned char*)F0.ws; asm volatile("" : "+s"(w)); F.ws = (unsigned char*)w;
    return F;
}

__device__ __forceinline__ float wave_sum(float v) {
#define WS_DPP(x, ctrl) __int_as_float(__builtin_amdgcn_update_dpp(0, __float_as_int(x), (ctrl), 0xf, 0xf, false))
    v += WS_DPP(v, 0xB1); v += WS_DPP(v, 0x4E); v += WS_DPP(v, 0x141); v += WS_DPP(v, 0x140);
#undef WS_DPP
    const float r0 = __int_as_float(__builtin_amdgcn_readlane(__float_as_int(v), 0)), r1 = __int_as_float(__builtin_amdgcn_readlane(__float_as_int(v), 16)),
                r2 = __int_as_float(__builtin_amdgcn_readlane(__float_as_int(v), 32)), r3 = __int_as_float(__builtin_amdgcn_readlane(__float_as_int(v), 48));
    return (r0 + r1) + (r2 + r3);
}

struct TrItem { const float* W; int ldw, c0, nv, k0; void* WT; int Kd, r0; float scale; bool fp8; };
__device__ __forceinline__ void tr_load(const TrItem& t, f32x4 (&v)[16], int lane) {
    const int n4 = 4 * (lane & 15); const int nc = n4 < t.nv ? n4 : 0;
    const float* src = t.W + (size_t)(t.k0 + (lane >> 4)) * t.ldw + t.c0 + nc;
#pragma unroll
    for (int i = 0; i < 16; ++i) v[i] = *(const f32x4*)(src + (size_t)(4 * i) * t.ldw);
}
__device__ __forceinline__ void tr_to_lds(const TrItem& t, const f32x4 (&v)[16], LAS float* scr, int lane) {
    const int n4 = 4 * (lane & 15); const float ok = n4 < t.nv ? 1.f : 0.f;
#pragma unroll
    for (int i = 0; i < 16; ++i) { LAS float* d = scr + (4 * i + (lane >> 4)) * 65 + n4; d[0] = v[i][0] * ok; d[1] = v[i][1] * ok; d[2] = v[i][2] * ok; d[3] = v[i][3] * ok; }
}
__device__ __forceinline__ void tr_from_lds(const TrItem& t, LAS float* scr, int lane) {
    LDS_WAIT(); asm volatile("" ::: "memory");
    const int c = lane & 7; const float scale = t.scale;
    if (t.fp8) {
#pragma unroll
        for (int j = 0; j < 8; ++j) { const int nn = (lane >> 3) + 8 * j; const LAS float* s = scr + (8 * c) * 65 + nn;
            u32x2 o; o.x = pg8::pk4_fp8(s[0 * 65] * scale, s[1 * 65] * scale, s[2 * 65] * scale, s[3 * 65] * scale); o.y = pg8::pk4_fp8(s[4 * 65] * scale, s[5 * 65] * scale, s[6 * 65] * scale, s[7 * 65] * scale);
            *(u32x2*)((unsigned char*)t.WT + (size_t)(t.r0 + nn) * t.Kd + t.k0 + 8 * c) = o; }
    } else {
#pragma unroll
        for (int j = 0; j < 8; ++j) { const int nn = (lane >> 3) + 8 * j; const LAS float* s = scr + (8 * c) * 65 + nn;
            u32x4 o; o.x = cvt_pk_bf16(s[0 * 65], s[1 * 65]); o.y = cvt_pk_bf16(s[2 * 65], s[3 * 65]); o.z = cvt_pk_bf16(s[4 * 65], s[5 * 65]); o.w = cvt_pk_bf16(s[6 * 65], s[7 * 65]);
            *(u32x4*)((bf16*)t.WT + (size_t)(t.r0 + nn) * t.Kd + t.k0 + 8 * c) = o; }
    }
    LDS_WAIT(); asm volatile("" ::: "memory");
}
template <class Dec> __device__ __forceinline__ void tr_loop(const Dec& dec, int nitems, int gw, int NGW, LAS float* scr, int lane) {
    int i0 = gw; if (i0 >= nitems) return;
    int i1 = i0 + NGW;
    f32x4 va[16], vb[16];
    TrItem c0 = dec(i0); tr_load(c0, va, lane);
    TrItem c1 = dec(i1 < nitems ? i1 : i0); tr_load(c1, vb, lane);
    for (;;) {
        tr_to_lds(c0, va, scr, lane);
        const int j0 = i1 + NGW; const TrItem n0 = dec(j0 < nitems ? j0 : i0); tr_load(n0, va, lane);
        tr_from_lds(c0, scr, lane);
        if (i1 >= nitems) break;
        tr_to_lds(c1, vb, scr, lane);
        const int j1 = j0 + NGW; const TrItem n1 = dec(j1 < nitems ? j1 : i0); tr_load(n1, vb, lane);
        tr_from_lds(c1, scr, lane);
        if (j0 >= nitems) break;
        c0 = n0; c1 = n1; i0 = j0; i1 = j1;
    }
}

__device__ __forceinline__ void convert_weights(Frame& F, int l) {
    LAS float* scr = (LAS float*)(F.lds + RING_OFF + F.wave * 16640);
    const int gw = F.vcu * NWAVES + F.wave, NGW = F.G * NWAVES, lane = F.lane;
    bf16* WinT = WSP(bf16, WS_WIN); bf16* WoutT = WSP(bf16, WS_WOUT);
    const float* w_in = arg_in(1) + (size_t)l * DM * IN_COLS;
    const float* w_out = arg_in(8) + (size_t)l * DM * DM;
    constexpr int I_IN = (NIN / 64) * 16, I_OUT = 16 * 16;
    tr_loop([=](int it) __attribute__((always_inline)) -> TrItem {
        if (it < I_IN) {
            const int nb = it >> 4, kb = it & 15; int c0 = 0, nv = 64;
            if (nb < 33) c0 = 64 * nb;
            else if (nb == 33) { c0 = OFF_WI; nv = 8; }
            else if (nb < 36) { nv = 0; }
            else { const int rr = 64 * (nb - 36), p = rr >> 8, w = rr & 255; c0 = (w < 128) ? (OFF_GLU + 128 * p + w) : (OFF_GLU + CCH + 128 * p + (w - 128)); }
            if (nb < 24) return TrItem{w_in, IN_COLS, c0, nv, 64 * kb, WinT, DM, 64 * nb, pg8::F8_WGU, true};
            if (nb >= 36) return TrItem{w_in, IN_COLS, c0, nv, 64 * kb, WinT, DM, 64 * (nb - 12), pg8::F8_WGU, true};
            return TrItem{w_in, IN_COLS, c0, nv, 64 * kb, WinT, DM, 64 * nb, 1.f, false};
        }
        const int r = it - I_IN, nb = r >> 4, kb = r & 15; return TrItem{w_out, DM, 64 * nb, 64, 64 * kb, WoutT, DM, 64 * nb, 1.f, false};
    }, I_IN + I_OUT, gw, NGW, scr, lane);
}

constexpr int CONV_ATTN_SCR = 84992, CONV_ATTN_WAVE = 32 * 65 * 4;
static_assert(CONV_ATTN_SCR + NWAVES * CONV_ATTN_WAVE <= LDSCTL_OFF, "conversion tiles of the attention phase");
__device__ __forceinline__ void tr32_load(const TrItem& t, f32x4 (&v)[8], int lane) {
    const int n4 = 4 * (lane & 15); const int nc = n4 < t.nv ? n4 : 0;
    const float* src = t.W + (size_t)(t.k0 + (lane >> 4)) * t.ldw + t.c0 + nc;
#pragma unroll
    for (int i = 0; i < 8; ++i) v[i] = *(const f32x4*)(src + (size_t)(4 * i) * t.ldw);
}
__device__ __forceinline__ void tr32_to_lds(const TrItem& t, const f32x4 (&v)[8], LAS float* scr, int lane) {
    const int n4 = 4 * (lane & 15); const float ok = n4 < t.nv ? 1.f : 0.f;
#pragma unroll
    for (int i = 0; i < 8; ++i) { LAS float* d = scr + (4 * i + (lane >> 4)) * 65 + n4; d[0] = v[i][0] * ok; d[1] = v[i][1] * ok; d[2] = v[i][2] * ok; d[3] = v[i][3] * ok; }
}
__device__ __forceinline__ void tr32_from_lds(const TrItem& t, LAS float* scr, int lane) {
    LDS_WAIT(); asm volatile("" ::: "memory");
    const int c = lane & 3; const float scale = t.scale;
#pragma unroll
    for (int j = 0; j < 4; ++j) { const int nn = (lane >> 2) + 16 * j; const LAS float* s = scr + (8 * c) * 65 + nn;
        u32x2 o; o.x = pg8::pk4_fp8(s[0 * 65] * scale, s[1 * 65] * scale, s[2 * 65] * scale, s[3 * 65] * scale); o.y = pg8::pk4_fp8(s[4 * 65] * scale, s[5 * 65] * scale, s[6 * 65] * scale, s[7 * 65] * scale);
        *(u32x2*)((unsigned char*)t.WT + (size_t)(t.r0 + nn) * t.Kd + t.k0 + 8 * c) = o; }
    LDS_WAIT(); asm volatile("" ::: "memory");
}
template <class Dec> __device__ __forceinline__ void tr32_loop(const Dec& dec, int nitems, int gw, int NGW, LAS float* scr, int lane) {
    int i0 = gw; if (i0 >= nitems) return;
    int i1 = i0 + NGW;
    f32x4 va[8], vb[8];
    TrItem c0 = dec(i0); tr32_load(c0, va, lane);
    TrItem c1 = dec(i1 < nitems ? i1 : i0); tr32_load(c1, vb, lane);
    for (;;) {
        tr32_to_lds(c0, va, scr, lane);
        const int j0 = i1 + NGW; const TrItem n0 = dec(j0 < nitems ? j0 : i0); tr32_load(n0, va, lane);
        tr32_from_lds(c0, scr, lane);
        if (i1 >= nitems) break;
        tr32_to_lds(c1, vb, scr, lane);
        const int j1 = j0 + NGW; const TrItem n1 = dec(j1 < nitems ? j1 : i0); tr32_load(n1, vb, lane);
        tr32_from_lds(c1, scr, lane);
        if (j0 >= nitems) break;
        c0 = n0; c1 = n1; i0 = j0; i1 = j1;
    }
}
__device__ __forceinline__ void convert_ffn(Frame& F, int l) {
    LAS float* scr = (LAS float*)(F.lds + CONV_ATTN_SCR + F.wave * CONV_ATTN_WAVE);
    const int gw = F.vcu * NWAVES + F.wave, NGW = F.G * NWAVES, lane = F.lane;
    unsigned char* Wff = WSP(unsigned char, WS_WFF);
    const int d = l >> 1;
    if ((l & 1) == 0) {
        const float* wg = arg_in(13) + (size_t)d * DM * DFF; const float* wu = arg_in(14) + (size_t)d * DM * DFF; const float* wd = arg_in(15) + (size_t)d * DFF * DM;
        unsigned char* Wgu = Wff; unsigned char* Wdn = Wgu + (size_t)2 * DFF * DM;
        constexpr int I_GU = (2 * DFF / 64) * 32, KB_DN = DFF / 32, I_DN = 16 * KB_DN;
        const ptrdiff_t dgu = wu - wg;
        tr32_loop([=](int it) __attribute__((always_inline)) -> TrItem {
            if (it < I_GU) { const int nb = it >> 5, kb = it & 31, rr = 64 * nb, p = rr >> 8, w = rr & 255;
                return TrItem{wg + ((w < 128) ? (ptrdiff_t)0 : dgu), DFF, 128 * p + (w & 127), 64, 32 * kb, Wgu, DM, rr, pg8::F8_WGU, true}; }
            const int r = it - I_GU, nb = r / KB_DN, kb = r % KB_DN; return TrItem{wd, DM, 64 * nb, 64, 32 * kb, Wdn, DFF, 64 * nb, pg8::F8_WDN, true};
        }, I_GU + I_DN, gw, NGW, scr, lane);
    } else {
        constexpr int I_GU = (2 * DFE / 64) * 32, KB_DN = DFE / 32, I_DN = 16 * KB_DN, I_E = I_GU + I_DN;
        const float* wg0 = arg_in(17) + (size_t)d * NE * DM * DFE; const float* wu0 = arg_in(18) + (size_t)d * NE * DM * DFE; const float* wd0 = arg_in(19) + (size_t)d * NE * DFE * DM;
        const ptrdiff_t dgu = wu0 - wg0;
        tr32_loop([=](int it) __attribute__((always_inline)) -> TrItem {
            const int e = it / I_E, r0 = it % I_E;
            const float* wg = wg0 + (size_t)e * DM * DFE; const float* wd = wd0 + (size_t)e * DFE * DM;
            unsigned char* Wgu = Wff + (size_t)e * (3 * (size_t)DFE * DM); unsigned char* Wdn = Wgu + (size_t)2 * DFE * DM;
            if (r0 < I_GU) { const int nb = r0 >> 5, kb = r0 & 31, rr = 64 * nb, p = rr >> 8, w = rr & 255;
                return TrItem{wg + ((w < 128) ? (ptrdiff_t)0 : dgu), DFE, 128 * p + (w & 127), 64, 32 * kb, Wgu, DM, rr, pg8::F8_WGU, true}; }
            const int r = r0 - I_GU, nb = r / KB_DN, kb = r % KB_DN; return TrItem{wd, DM, 64 * nb, 64, 32 * kb, Wdn, DFE, 64 * nb, pg8::F8_WDN, true};
        }, NE * I_E, gw, NGW, scr, lane);
    }
    asm volatile("s_waitcnt vmcnt(0)" ::: "memory");
}

__device__ __forceinline__ void cvt_x(Frame& F) {
    const float* x = arg_in(0); bf16* XB = WSP(bf16, WS_XB); unsigned char* XQ = WSP(unsigned char, WS_XQ);
    const int gw = F.vcu * NWAVES + F.wave, NGW = F.G * NWAVES;
    f32x4 vn[4];
    { const f32x4* xr = (const f32x4*)(x + (size_t)gw * DM) + F.lane;
#pragma unroll
      for (int j = 0; j < 4; ++j) vn[j] = xr[64 * j]; }
    for (int m = gw; m < M; m += NGW) {
        f32x4 v[4];
#pragma unroll
        for (int j = 0; j < 4; ++j) v[j] = vn[j];
        { const int mn = (m + NGW < M) ? m + NGW : m; const f32x4* xr = (const f32x4*)(x + (size_t)mn * DM) + F.lane;
#pragma unroll
          for (int j = 0; j < 4; ++j) vn[j] = xr[64 * j]; }
        u32x2* o = (u32x2*)(XB + (size_t)m * DM) + F.lane; unsigned* o8 = (unsigned*)(XQ + (size_t)m * DM) + F.lane;
#pragma unroll
        for (int j = 0; j < 4; ++j) { u32x2 w; w.x = cvt_pk_bf16(v[j][0], v[j][1]); w.y = cvt_pk_bf16(v[j][2], v[j][3]); o[64 * j] = w;
            o8[64 * j] = pg8::pk4_fp8(v[j][0] * pg8::F8_ASC, v[j][1] * pg8::F8_ASC, v[j][2] * pg8::F8_ASC, v[j][3] * pg8::F8_ASC); }
    }
}

__device__ __forceinline__ void ln_load(const bf16* row, f32x4 (&v)[4], int lane) {
#pragma unroll
    for (int j = 0; j < 4; ++j) { const u32x2 a = ((const u32x2*)row)[lane + 64 * j]; v[j][0] = __uint_as_float(a.x << 16); v[j][1] = __uint_as_float(a.x & 0xffff0000u); v[j][2] = __uint_as_float(a.y << 16); v[j][3] = __uint_as_float(a.y & 0xffff0000u); }
}
template <bool FP8OUT> __device__ __forceinline__ void ln_finish(f32x4 (&v)[4], const f32x4 (&g)[4], const f32x4 (&bb)[4], bf16* brow, unsigned char* qrow, float* frow, int lane) {
    float s = 0.f;
#pragma unroll
    for (int j = 0; j < 4; ++j) s += (v[j][0] + v[j][1]) + (v[j][2] + v[j][3]);
    const float mean = wave_sum(s) * (1.f / DM); float s2 = 0.f;
#pragma unroll
    for (int j = 0; j < 4; ++j) { v[j] = v[j] - mean; s2 += (v[j][0] * v[j][0] + v[j][1] * v[j][1]) + (v[j][2] * v[j][2] + v[j][3] * v[j][3]); }
    const float rstd = 1.f / sqrtf(wave_sum(s2) * (1.f / DM) + LN_EPS);
#pragma unroll
    for (int j = 0; j < 4; ++j) { v[j] = v[j] * rstd * g[j] + bb[j];
        if constexpr (FP8OUT) { u32x2 w; w.x = cvt_pk_bf16(v[j][0], v[j][1]); w.y = cvt_pk_bf16(v[j][2], v[j][3]); ((u32x2*)brow)[lane + 64 * j] = w;
            ((unsigned*)qrow)[lane + 64 * j] = pg8::pk4_fp8(v[j][0] * pg8::F8_ASC, v[j][1] * pg8::F8_ASC, v[j][2] * pg8::F8_ASC, v[j][3] * pg8::F8_ASC); }
        else if (frow) ((f32x4*)frow)[lane + 64 * j] = v[j];
        else { u32x2 w; w.x = cvt_pk_bf16(v[j][0], v[j][1]); w.y = cvt_pk_bf16(v[j][2], v[j][3]); ((u32x2*)brow)[lane + 64 * j] = w;
               ((unsigned*)qrow)[lane + 64 * j] = pg8::pk4_fp8(v[j][0] * pg8::F8_ASC, v[j][1] * pg8::F8_ASC, v[j][2] * pg8::F8_ASC, v[j][3] * pg8::F8_ASC); } }
}

__device__ __forceinline__ void p_ln1(Frame& F, int l) {
    bf16* R1 = WSP(bf16, WS_R1); bf16* XB = WSP(bf16, WS_XB);
    const bool moe = (l & 1) != 0;
    LAS int* cntL = (LAS int*)(F.lds + LDSCTL_OFF + 1152);
    if (F.tid < 8) cntL[F.tid] = 0;
    __syncthreads();
    f32x4 g[4], bb[4];
#pragma unroll
    for (int j = 0; j < 4; ++j) { g[j] = ((const f32x4*)(arg_in(9) + (size_t)l * DM))[F.lane + 64 * j]; bb[j] = ((const f32x4*)(arg_in(10) + (size_t)l * DM))[F.lane + 64 * j]; }
    const float* router = arg_in(16) + (size_t)(l >> 1) * DM * NE;
    u32x4* route = WSP(u32x4, WS_ROUTE);
    f32x4 vn[4]; ln_load(R1 + (size_t)(F.vcu * 128 + F.wave * 16) * DM, vn, F.lane);
    for (int i = 0; i < 16; ++i) {
        const int m = F.vcu * 128 + F.wave * 16 + i;
        f32x4 v[4];
#pragma unroll
        for (int j = 0; j < 4; ++j) v[j] = vn[j];
        if (i + 1 < 16) ln_load(R1 + (size_t)(m + 1) * DM, vn, F.lane);
        ln_finish<true>(v, g, bb, R1 + (size_t)m * DM, (unsigned char*)XB + (size_t)m * DM, nullptr, F.lane);
        if (moe) {
            float lg[8];
#pragma unroll
            for (int e = 0; e < 8; ++e) lg[e] = 0.f;
#pragma unroll
            for (int j = 0; j < 4; ++j)
#pragma unroll
                for (int c = 0; c < 4; ++c) { const float* rp = router + (size_t)(4 * F.lane + 256 * j + c) * NE; const f32x4 r0 = *(const f32x4*)rp, r1 = *(const f32x4*)(rp + 4); const float xv = v[j][c];
                    lg[0] += xv * r0[0]; lg[1] += xv * r0[1]; lg[2] += xv * r0[2]; lg[3] += xv * r0[3]; lg[4] += xv * r1[0]; lg[5] += xv * r1[1]; lg[6] += xv * r1[2]; lg[7] += xv * r1[3]; }
#pragma unroll
            for (int e = 0; e < 8; ++e) lg[e] = wave_sum(lg[e]);
            int e1 = 0; float v1 = lg[0];
#pragma unroll
            for (int e = 1; e < 8; ++e) if (lg[e] > v1) { v1 = lg[e]; e1 = e; }
            int e2 = -1; float v2 = -3.0e38f;
#pragma unroll
            for (int e = 0; e < 8; ++e) if (e != e1 && (e2 < 0 || lg[e] > v2)) { v2 = lg[e]; e2 = e; }
            const float g1 = 1.0f / (1.0f + __expf(v2 - v1)), g2 = 1.0f - g1;
            if (F.lane == 0) { u32x4 r; r.x = (unsigned)e1; r.y = (unsigned)e2; r.z = __float_as_uint(g1); r.w = __float_as_uint(g2); route[m] = r;
                __hip_atomic_fetch_add(cntL + e1, 1, __ATOMIC_RELAXED, __HIP_MEMORY_SCOPE_WORKGROUP); __hip_atomic_fetch_add(cntL + e2, 1, __ATOMIC_RELAXED, __HIP_MEMORY_SCOPE_WORKGROUP); }
        }
    }
    __syncthreads();
    if (moe && F.tid < 8) WSP(int, WS_CNTWG)[F.vcu * 8 + F.tid] = cntL[F.tid];
}

__device__ __forceinline__ void p_ln2(Frame& F, int l) {
    const bf16* R1 = WSP(bf16, WS_R1); bf16* XB = WSP(bf16, WS_XB); float* outp = (l == DEPTH - 1) ? arg_out() : nullptr;
    f32x4 g[4], bb[4];
#pragma unroll
    for (int j = 0; j < 4; ++j) { g[j] = ((const f32x4*)(arg_in(11) + (size_t)l * DM))[F.lane + 64 * j]; bb[j] = ((const f32x4*)(arg_in(12) + (size_t)l * DM))[F.lane + 64 * j]; }
    f32x4 vn[4]; ln_load(R1 + (size_t)(F.vcu * 128 + F.wave * 16) * DM, vn, F.lane);
    for (int i = 0; i < 16; ++i) {
        const int m = F.vcu * 128 + F.wave * 16 + i;
        f32x4 v[4];
#pragma unroll
        for (int j = 0; j < 4; ++j) v[j] = vn[j];
        if (i + 1 < 16) ln_load(R1 + (size_t)(m + 1) * DM, vn, F.lane);
        ln_finish<false>(v, g, bb, XB + (size_t)m * DM, WSP(unsigned char, WS_XQ) + (size_t)m * DM, outp ? outp + (size_t)m * DM : nullptr, F.lane);
    }
}

__device__ __forceinline__ void moe_tables(Frame& F) {
    LAS int* texp = (LAS int*)(F.lds + LDSCTL_OFF);
    LAS int* tot = (LAS int*)(F.lds + LDSCTL_OFF + 1088);
    LAS int* tbase = (LAS int*)(F.lds + LDSCTL_OFF + 1200);
    const int* cnt = WSP(int, WS_CNTWG);
    LAS int* tmp = (LAS int*)(F.lds + AUX_OFF);
    __syncthreads();
    if (F.tid < 256) { typedef int i32x4_ __attribute__((ext_vector_type(4))); const i32x4_ a = ((const i32x4_*)cnt)[2 * F.tid], b = ((const i32x4_*)cnt)[2 * F.tid + 1];
        *(LAS i32x4_*)(tmp + 8 * F.tid) = a; *(LAS i32x4_*)(tmp + 8 * F.tid + 4) = b; }
    __syncthreads();
    if (F.tid < 8) { int t = 0, off = 0; for (int w = 0; w < 256; ++w) { const int c = tmp[w * 8 + F.tid]; if (w < F.vcu) off += c; t += c; } tot[F.tid] = t; tot[8 + F.tid] = off; }
    __syncthreads();
    if (F.tid == 0) { int b = 0; for (int e = 0; e < 8; ++e) { tbase[e] = b; b += (tot[e] + 255) >> 8; } tbase[8] = b; }
    __syncthreads();
    if (F.tid < MAXT) { int e = 0;
#pragma unroll
        for (int j = 1; j < 8; ++j) e += (F.tid >= tbase[j]) ? 1 : 0;
        texp[F.tid] = e; }
    __syncthreads();
}

__device__ __forceinline__ void p_list(Frame& F) {
    moe_tables(F);
    LAS int* tot = (LAS int*)(F.lds + LDSCTL_OFF + 1088); LAS int* tbase = (LAS int*)(F.lds + LDSCTL_OFF + 1200);
    const u32x4* route = WSP(u32x4, WS_ROUTE);
    int* rowlist = WSP(int, WS_ROWLIST); float* rowgate = WSP(float, WS_ROWGATE); int* slotrow = WSP(int, WS_SLOTROW);
    if (F.wave == 0) {
        int run[8];
#pragma unroll
        for (int e = 0; e < 8; ++e) run[e] = tot[8 + e];
        for (int blk = 0; blk < 2; ++blk) {
            const int t = F.vcu * 128 + blk * 64 + F.lane; const u32x4 r = route[t]; const int e1 = (int)r.x, e2 = (int)r.y;
            int p1 = 0, p2 = 0;
            const unsigned long long lt = (1ull << F.lane) - 1ull;
#pragma unroll
            for (int e = 0; e < 8; ++e) { const unsigned long long mk = __ballot(e1 == e || e2 == e); const int rk = run[e] + __popcll(mk & lt); if (e1 == e) p1 = rk; if (e2 == e) p2 = rk; run[e] += __popcll(mk); }
            const int row1 = tbase[e1] * 256 + p1, row2 = tbase[e2] * 256 + p2;
            rowlist[row1] = t; rowgate[row1] = __uint_as_float(r.z); rowlist[row2] = t; rowgate[row2] = __uint_as_float(r.w);
            slotrow[2 * t] = row1; slotrow[2 * t + 1] = row2;
        }
    }
    if (F.vcu < 8) { const int e = F.vcu, mt = (tot[e] + 255) >> 8; for (int p = tot[e] + F.tid; p < mt * 256; p += NTHR) { rowlist[tbase[e] * 256 + p] = 0; rowgate[tbase[e] * 256 + p] = 0.f; } }
}

__device__ __forceinline__ void p_comb(Frame& F, int l) {
    const bf16* R1 = WSP(bf16, WS_R1); bf16* XB = WSP(bf16, WS_XB); const bf16* Yd = WSP(bf16, WS_YD); const int* slotrow = WSP(int, WS_SLOTROW); float* outp = (l == DEPTH - 1) ? arg_out() : nullptr;
    f32x4 g[4], bb[4];
#pragma unroll
    for (int j = 0; j < 4; ++j) { g[j] = ((const f32x4*)(arg_in(11) + (size_t)l * DM))[F.lane + 64 * j]; bb[j] = ((const f32x4*)(arg_in(12) + (size_t)l * DM))[F.lane + 64 * j]; }
    const int m0 = F.vcu * 128 + F.wave * 16;
    const int myslot = (F.lane < 32) ? slotrow[2 * m0 + F.lane] : 0;
    f32x4 xn[4], an[4], bn[4];
#define COMB_LOAD(i_) do { const int ra_ = __builtin_amdgcn_readlane(myslot, 2 * (i_)), rb_ = __builtin_amdgcn_readlane(myslot, 2 * (i_) + 1); \
        ln_load(R1 + (size_t)(m0 + (i_)) * DM, xn, F.lane); ln_load(Yd + (size_t)ra_ * DM, an, F.lane); ln_load(Yd + (size_t)rb_ * DM, bn, F.lane); } while (0)
    COMB_LOAD(0);
    for (int i = 0; i < 16; ++i) {
        const int m = m0 + i;
        f32x4 v[4];
#pragma unroll
        for (int j = 0; j < 4; ++j) v[j] = xn[j] * DN_ALPHA + (an[j] + bn[j]);
        if (i + 1 < 16) COMB_LOAD(i + 1);
        ln_finish<false>(v, g, bb, XB + (size_t)m * DM, WSP(unsigned char, WS_XQ) + (size_t)m * DM, outp ? outp + (size_t)m * DM : nullptr, F.lane);
    }
#undef COMB_LOAD
}

#define DPP_I(v, ctrl) __builtin_amdgcn_update_dpp(0, (v), (ctrl), 0xf, 0xf, false)
__device__ __forceinline__ int wave_isum(int v) {
    v += DPP_I(v, 0xB1); v += DPP_I(v, 0x4E); v += DPP_I(v, 0x141); v += DPP_I(v, 0x140);
    return __builtin_amdgcn_readlane(v, 0) + __builtin_amdgcn_readlane(v, 16) + __builtin_amdgcn_readlane(v, 32) + __builtin_amdgcn_readlane(v, 48);
}
#define DPP_F(v, ctrl) __int_as_float(__builtin_amdgcn_update_dpp(0, __float_as_int(v), (ctrl), 0xf, 0xf, false))
typedef unsigned short u16x2 __attribute__((__vector_size__(4)));
#define IDX_BAR() asm volatile("s_waitcnt lgkmcnt(0)\n\ts_barrier" ::: "memory")
__device__ __forceinline__ void p_idx(Frame& F, int l) {
    constexpr int QP = 16;
    LAS unsigned short* bins = (LAS unsigned short*)(F.lds + RING_OFF);
    LAS unsigned* hq = (LAS unsigned*)(F.lds + AUX_OFF);
    LAS unsigned* hist = (LAS unsigned*)(F.lds + AUX_OFF + 16384) + F.wave * 256;
    LAS int* ci = (LAS int*)(F.lds + AUX_OFF + 24576) + F.wave * 64;
    LAS float* wtab = (LAS float*)(F.lds + LDSCTL_OFF + 1280);
    LAS float* sqp = (LAS float*)(F.lds + LDSCTL_OFF + 1792);
    const bf16* QI = WSP(bf16, WS_QI); const bf16* KI = WSP(bf16, WS_KI); const float* WI = WSP(float, WS_WI);
    unsigned long long* maskQ = WSP(unsigned long long, WS_MASK);
    const int lane = F.lane, wave = F.wave, tid = F.tid, w = F.vcu;
    const int am = lane & 31, ahm = (am >> 2) & 1, arr = (am & 3) + 4 * (am >> 3), atl = 2 * ahm + (arr >> 3), ah = arr & 7, kg = lane >> 5, hi = lane >> 5, n = lane & 31;
    bf16x8 af[4][4]; float wreg = 0.f;
#define IDX_UNIT(s8_, qb32_, b_) do { const int ui_ = (s8_) >> 1; const int up_ = (ui_ == 0) ? w : (ui_ == 1) ? 511 - w : (ui_ == 2) ? 512 + w : 1023 - w; qb32_ = up_ >> 3; b_ = up_ & 7; } while (0)
#define IDX_LOADQ(s8_) do { int qb_, bb_; IDX_UNIT(s8_, qb_, bb_); const size_t r0_ = (size_t)bb_ * SEQ + qb_ * 32 + ((s8_) & 1) * QP; \
        _Pragma("unroll") for (int rt = 0; rt < 4; ++rt) _Pragma("unroll") for (int ks = 0; ks < 4; ++ks) af[rt][ks] = *(const bf16x8*)(QI + (r0_ + 4 * rt + atl) * AW + ah * 64 + ks * 16 + 8 * kg); \
        if (tid < 128) wreg = WI[(r0_ + (tid >> 3)) * 8 + (tid & 7)]; } while (0)
#define IDX_WTAB(par_) do { if (tid < 128) { wtab[tid] = wreg; float sm = wreg, sq2 = wreg * wreg; \
        sm += DPP_F(sm, 0xB1); sq2 += DPP_F(sq2, 0xB1); sm += DPP_F(sm, 0x4E); sq2 += DPP_F(sq2, 0x4E); sm += DPP_F(sm, 0x141); sq2 += DPP_F(sq2, 0x141); \
        if ((tid & 7) == 0) { const float a_ = 1.0f / (28.02f * sqrtf(sq2) + 1.0e-20f); sqp[32 * (par_) + 2 * (tid >> 3)] = a_; sqp[32 * (par_) + 2 * (tid >> 3) + 1] = 0.33333f - 3.19f * sm * a_; } } } while (0)
    IDX_LOADQ(0);
    IDX_WTAB(0);
    for (int i = tid; i < QP * 256; i += NTHR) hq[i] = 0u;
    IDX_BAR();
    for (int s8 = 0; s8 < 8; ++s8) {
        int qb32, b; IDX_UNIT(s8, qb32, b);
        const int sub = s8 & 1, c = qb32 >> 1, N = 64 * (c + 1), NT32 = 2 * (c + 1);
        const size_t rowb = (size_t)b * SEQ;
        const bool dosel = N > TOPK;
        for (int repA_ = 0; repA_ < (((PROBE_MASK) >> 12) & 1) + 1; ++repA_) {
            const int ntw = (NT32 - wave + 7) >> 3;
            constexpr int BT = 2; const int nbat = (ntw + BT - 1) / BT;
            bf16x8 b0[BT][4], b1[BT][4];
            const LAS float* sqc = sqp + 32 * (s8 & 1);
#define IDX_LOADB(dst, bb_) do { _Pragma("unroll") for (int u = 0; u < BT; ++u) { int j_ = wave + 8 * (BT * (bb_) + u); j_ = j_ < NT32 ? j_ : NT32 - 1; \
            _Pragma("unroll") for (int ks = 0; ks < 4; ++ks) dst[u][ks] = *(const bf16x8*)(KI + (rowb + 32 * j_) * 64 + ks * 512 + kg * 256 + n * 8); } } while (0)
#define IDX_RELU(x) __int_as_float(max(__float_as_int(x), 0))
#define IDX_COMP(src, bb_) do { _Pragma("unroll") for (int rp = 0; rp < 2; ++rp) { \
            f32x4 wq_[4][2];   \
            _Pragma("unroll") for (int rq = 0; rq < 4; ++rq) { const int qi_ = 4 * (2 * rp + (rq >> 1)) + 2 * hi + (rq & 1); const LAS f32x4* wp_ = (const LAS f32x4*)(wtab + qi_ * 8); wq_[rq][0] = wp_[0]; wq_[rq][1] = wp_[1]; } \
            _Pragma("unroll") for (int u = 0; u < BT; ++u) { const int j_ = wave + 8 * (BT * (bb_) + u); if (j_ < NT32) { f32x16 acc0 = {}, acc1 = {}; \
                _Pragma("unroll") for (int ks = 0; ks < 4; ++ks) { acc0 = __builtin_amdgcn_mfma_f32_32x32x16_bf16(af[2 * rp][ks], src[u][ks], acc0, 0, 0, 0); acc1 = __builtin_amdgcn_mfma_f32_32x32x16_bf16(af[2 * rp + 1][ks], src[u][ks], acc1, 0, 0, 0); } \
                _Pragma("unroll") for (int r2 = 0; r2 < 2; ++r2) { const int rt = 2 * rp + r2; const f32x16& ac_ = r2 ? acc1 : acc0; float t_[2]; \
                    _Pragma("unroll") for (int q = 0; q < 2; ++q) { const f32x4 w0_ = wq_[2 * r2 + q][0], w1_ = wq_[2 * r2 + q][1]; \
                        f32x2 s2_ = (f32x2){w0_[0], w0_[1]} * (f32x2){IDX_RELU(ac_[8 * q + 0]), IDX_RELU(ac_[8 * q + 1])}; \
                        s2_ = __builtin_elementwise_fma((f32x2){w0_[2], w0_[3]}, (f32x2){IDX_RELU(ac_[8 * q + 2]), IDX_RELU(ac_[8 * q + 3])}, s2_); \
                        s2_ = __builtin_elementwise_fma((f32x2){w1_[0], w1_[1]}, (f32x2){IDX_RELU(ac_[8 * q + 4]), IDX_RELU(ac_[8 * q + 5])}, s2_); \
                        s2_ = __builtin_elementwise_fma((f32x2){w1_[2], w1_[3]}, (f32x2){IDX_RELU(ac_[8 * q + 6]), IDX_RELU(ac_[8 * q + 7])}, s2_); \
                        const f32x2 mc_ = *(const LAS f32x2*)(sqc + 2 * (4 * rt + 2 * hi + q)); t_[q] = __builtin_fmaf(s2_[0] + s2_[1], mc_[0], mc_[1]); } \
                    const u16x2 pk_ = __builtin_amdgcn_cvt_pknorm_u16(t_[0], t_[1]); \
                    _Pragma("unroll") for (int q = 0; q < 2; ++q) { const int qi_ = 4 * rt + 2 * hi + q; const unsigned short ky_ = q ? pk_[1] : pk_[0]; bins[qi_ * 4096 + 32 * j_ + n] = ky_; \
                        if (dosel) __hip_atomic_fetch_add(hq + qi_ * 256 + ((unsigned)ky_ >> 8), 1u, __ATOMIC_RELAXED, __HIP_MEMORY_SCOPE_WORKGROUP); } } } } } } while (0)
            IDX_LOADB(b0, 0);
            for (int bb = 0; bb < nbat; bb += 2) {
                IDX_LOADB(b1, bb + 1);
                IDX_COMP(b0, bb);
                IDX_LOADB(b0, bb + 2);
                IDX_COMP(b1, bb + 1);
            }
#undef IDX_LOADB
#undef IDX_COMP
#undef IDX_RELU
        }
        if (s8 + 1 < 8) IDX_LOADQ(s8 + 1);
        IDX_BAR();
        for (int repB_ = 0; repB_ < (((PROBE_MASK) >> 13) & 1) + 1; ++repB_)
        for (int qq = 0; qq < 2; ++qq) {
            const int q = wave + 8 * qq;
            const int nch = (N + 511) >> 9;
            const LAS unsigned short* brow = bins + q * 4096;
            LAS unsigned char* st8 = (LAS unsigned char*)hist + 512 * qq;
            { unsigned z0 = 0u; asm volatile("" : "+v"(z0)); *(LAS u32x2*)(st8 + 8 * lane) = (u32x2){z0, z0}; }
#define IDX_SCAN(K, HD, TARGET) \
            int tl_ = 0; _Pragma("unroll") for (int i = 0; i < K; ++i) tl_ += HD[i]; \
            int P_ = tl_; P_ += DPP_I(P_, 0x111); P_ += DPP_I(P_, 0x112); P_ += DPP_I(P_, 0x114); P_ += DPP_I(P_, 0x118); \
            { const int R0 = __builtin_amdgcn_readlane(P_, 15), R1 = __builtin_amdgcn_readlane(P_, 31), R2 = __builtin_amdgcn_readlane(P_, 47); P_ += (lane >= 16 ? R0 : 0) + (lane >= 32 ? R1 : 0) + (lane >= 48 ? R2 : 0); } \
            const unsigned long long over_ = __ballot(P_ >= (TARGET)); const int Lc_ = over_ ? (int)__builtin_ctzll(over_) : 63; \
            int cumL_ = P_ - tl_, bsel_ = 0, cbv_ = 0; bool fnd_ = false; \
            _Pragma("unroll") for (int i = K - 1; i >= 0; --i) { if (!fnd_) { if (cumL_ + HD[i] >= (TARGET) || i == 0) { fnd_ = true; bsel_ = i; cbv_ = HD[i]; } else cumL_ += HD[i]; } } \
            Bs = K * (63 - Lc_) + __builtin_amdgcn_readlane(bsel_, Lc_); cb = __builtin_amdgcn_readlane(cbv_, Lc_); cumv = __builtin_amdgcn_readlane(cumL_, Lc_);
#define IDX_CODE(v, j) ((int)(((j) & 1) ? ((v)[(j) >> 1] >> 16) : ((v)[(j) >> 1] & 0xffffu)))
            int Bs = -1, cb = 0, need = 0, sh = 8; bool fast_ok = true;
            LAS unsigned* crow = hq + q * 256;
            if (dosel) {
                { const u32x4 h4 = *(const LAS u32x4*)(crow + 4 * (63 - lane)); const int hd4[4] = {(int)h4[0], (int)h4[1], (int)h4[2], (int)h4[3]};
                  int cumv; IDX_SCAN(4, hd4, TOPK)
                  need = TOPK - cumv; fast_ok = over_ != 0ull && need >= 1 && need <= cb; }
                if (fast_ok && cb > 64) {
                    { unsigned z0 = 0u; asm volatile("" : "+v"(z0)); *(LAS u32x4*)(crow + 4 * lane) = (u32x4){z0, z0, z0, z0}; }
                    for (int ch = 0; ch < nch; ++ch) { const u32x4 v = *(const LAS u32x4*)(brow + 512 * ch + 8 * lane); const bool okl = 512 * ch + 8 * lane < N;
#pragma unroll
                        for (int j = 0; j < 8; ++j) { const int kj = IDX_CODE(v, j); const bool m = okl && (kj >> 8) == Bs;
                            __hip_atomic_fetch_add(m ? crow + (kj & 255) : (LAS unsigned*)ci + lane, 1u, __ATOMIC_RELAXED, __HIP_MEMORY_SCOPE_WORKGROUP); } }
                    asm volatile("s_waitcnt lgkmcnt(0)" ::: "memory");
                    const u32x4 h4 = *(const LAS u32x4*)(crow + 4 * (63 - lane)); const int hd4[4] = {(int)h4[0], (int)h4[1], (int)h4[2], (int)h4[3]};
                    int nB, nC, nV; bool ok2;
                    { int Bs, cb, cumv; IDX_SCAN(4, hd4, need)
                      nB = Bs; nC = cb; nV = cumv; ok2 = over_ != 0ull; }
                    Bs = (Bs << 8) | nB; sh = 0; need -= nV; cb = nC;
                    fast_ok = ok2 && need >= 1 && need <= cb;
                }
                fast_ok = fast_ok && cb <= 64;
            }
#undef IDX_SCAN
            if (fast_ok) {
                int nc = 0;
                u32x4 vn = *(const LAS u32x4*)(brow + 8 * lane);
                for (int ch = 0; ch < nch; ++ch) { const u32x4 v = vn; const int e0 = 512 * ch + 8 * lane; const bool okl = e0 < N; unsigned byte = 0u;
                    if (ch + 1 < nch) vn = *(const LAS u32x4*)(brow + 512 * (ch + 1) + 8 * lane);
                    int bj[8], cl = 0;
#pragma unroll
                    for (int j = 0; j < 8; ++j) { bj[j] = okl ? (IDX_CODE(v, j) >> sh) : -2; cl += (bj[j] == Bs) ? 1 : 0; byte |= (unsigned)(Bs - bj[j]) >> 31 << j; }
                    int ps = cl;
                    ps += DPP_I(ps, 0x111); ps += DPP_I(ps, 0x112); ps += DPP_I(ps, 0x114); ps += DPP_I(ps, 0x118);
                    ps += __builtin_amdgcn_update_dpp(0, ps, 0x142, 0xa, 0xf, false); ps += __builtin_amdgcn_update_dpp(0, ps, 0x143, 0xc, 0xf, false);
                    int off = nc + ps - cl;
#pragma unroll
                    for (int j = 0; j < 8; ++j) { const bool eq = bj[j] == Bs; crow[eq ? off : 64 + lane] = (unsigned)((IDX_CODE(v, j) << 12) | (e0 + j)); off += eq ? 1 : 0; }
                    nc += __builtin_amdgcn_readlane(ps, 63);
                    st8[64 * ch + lane] = (unsigned char)byte; }
                if (dosel) {
                    asm volatile("s_waitcnt lgkmcnt(0)" ::: "memory");
                    const int mc = (lane < cb) ? (int)crow[lane] : 0; const int mord = (mc & ~4095) | (4095 - (mc & 4095)); int rank = 0;
                    for (int j = 0; j < cb; ++j) { const int oj = __builtin_amdgcn_readlane(mord, j); rank += (oj > mord) ? 1 : 0; }
                    if (lane < cb && rank < need) __hip_atomic_fetch_or((LAS unsigned*)st8 + ((mc & 4095) >> 5), 1u << (mc & 31), __ATOMIC_RELAXED, __HIP_MEMORY_SCOPE_WORKGROUP);
                }
            } else {
                int Tk = -1; unsigned Jx = 0xffffffffu;
                for (int bit = 15; bit >= 0; --bit) {
                    const int cand = Tk < 0 ? (1 << bit) : (Tk | (1 << bit)); int cl = 0;
                    for (int ch = 0; ch < nch; ++ch) { const u32x4 v = *(const LAS u32x4*)(brow + 512 * ch + 8 * lane); const int e0 = 512 * ch + 8 * lane;
#pragma unroll
                        for (int j = 0; j < 8; ++j) cl += (e0 < N && IDX_CODE(v, j) >= cand) ? 1 : 0; }
                    if (wave_isum(cl) >= TOPK) Tk = cand;
                }
                if (Tk < 0) Tk = 0;
                int cg = 0, ce = 0;
                for (int ch = 0; ch < nch; ++ch) { const u32x4 v = *(const LAS u32x4*)(brow + 512 * ch + 8 * lane); const int e0 = 512 * ch + 8 * lane;
#pragma unroll
                    for (int j = 0; j < 8; ++j) if (e0 < N) { cg += (IDX_CODE(v, j) > Tk) ? 1 : 0; ce += (IDX_CODE(v, j) == Tk) ? 1 : 0; } }
                const int nd = TOPK - wave_isum(cg), ceq = wave_isum(ce);
                if (ceq > nd) {
                    unsigned Jc = 0u;
                    for (int bit = 11; bit >= 0; --bit) {
                        const unsigned cj = Jc | (1u << bit); int cl = 0;
                        for (int ch = 0; ch < nch; ++ch) { const u32x4 v = *(const LAS u32x4*)(brow + 512 * ch + 8 * lane); const int e0 = 512 * ch + 8 * lane;
#pragma unroll
                            for (int j = 0; j < 8; ++j) cl += (e0 < N && IDX_CODE(v, j) == Tk && (unsigned)(e0 + j) < cj) ? 1 : 0; }
                        if (wave_isum(cl) < nd) Jc = cj;
                    }
                    Jx = Jc;
                }
                for (int ch = 0; ch < nch; ++ch) { const u32x4 v = *(const LAS u32x4*)(brow + 512 * ch + 8 * lane); const int e0 = 512 * ch + 8 * lane; unsigned byte = 0u;
#pragma unroll
                    for (int j = 0; j < 8; ++j) { const int kj = IDX_CODE(v, j); byte |= (unsigned)((kj > Tk || (kj == Tk && (unsigned)(e0 + j) <= Jx)) ? 1 : 0) << j; }
                    st8[64 * ch + lane] = (unsigned char)(e0 < N ? byte : 0u); }
            }
#undef IDX_CODE
            { unsigned z0 = 0u; asm volatile("" : "+v"(z0)); *(LAS u32x4*)(crow + 4 * lane) = (u32x4){z0, z0, z0, z0}; }
        }
        IDX_WTAB((s8 + 1) & 1);
        IDX_BAR();
        {
            const int tile = tid >> 3, w8 = tid & 7, NJw = 4 * ((qb32 >> 3) + 1);
            if (tile < NJw) {
#pragma unroll
                for (int qq = 0; qq < 2; ++qq) { const u32x2 mk = *(const LAS u32x2*)((const LAS unsigned*)(F.lds + AUX_OFF + 16384) + w8 * 256 + 128 * qq + 2 * tile);
                    maskQ[((size_t)(b * 128 + qb32) * 64 + tile) * 32 + QP * sub + 8 * qq + w8] = ((unsigned long long)mk.y << 32) | mk.x; } }
        }
    }
#undef IDX_UNIT
#undef IDX_LOADQ
#undef IDX_WTAB
#undef IDX_BAR
}

__device__ __forceinline__ void p_conv(Frame& F, int l) {
    LAS bf16* Ut = (LAS bf16*)(F.lds + RING_OFF);
    LAS float* Yt = (LAS float*)(F.lds + RING_OFF + 65536);
    const bf16* U = WSP(bf16, WS_U); bf16* MIX = WSP(bf16, WS_MIX);
    const float* cw = arg_in(2) + (size_t)l * CK * CCH; const int c = F.tid, lane = F.lane;
    float wj[CK];
#pragma unroll
    for (int j = 0; j < CK; ++j) wj[j] = cw[j * CCH + c];
    const float cb = arg_in(3)[l * CCH + c];
    f32x4 lg0 = *(const f32x4*)(arg_in(4) + l * CCH + 8 * lane), lg1 = *(const f32x4*)(arg_in(4) + l * CCH + 8 * lane + 4);
    f32x4 lb0 = *(const f32x4*)(arg_in(5) + l * CCH + 8 * lane), lb1 = *(const f32x4*)(arg_in(5) + l * CCH + 8 * lane + 4);
    f32x4 ms0 = *(const f32x4*)(arg_in(6) + l * DM + CCH + 8 * lane), ms1 = *(const f32x4*)(arg_in(6) + l * DM + CCH + 8 * lane + 4);
    u32x4 tp[8];
#define CONV_LOAD(it_) do { const int un_ = F.vcu + 256 * (it_), b_ = un_ >> 7, t0_ = (un_ & 127) * 32; \
        _Pragma("unroll") for (int k = 0; k < 8; ++k) { const int ch = F.tid + NTHR * k, r = ch >> 6, cc = ch & 63, t = t0_ - 30 + r; unsigned z0 = 0u; asm volatile("" : "+v"(z0)); tp[k] = (u32x4){z0, z0, z0, z0}; \
            if (ch < 62 * 64 && t >= 0) tp[k] = *(const u32x4*)(U + ((size_t)b_ * SEQ + t) * CCH + cc * 8); } } while (0)
    CONV_LOAD(0);
    for (int it = 0; it < 4; ++it) {
        const int unit = F.vcu + 256 * it, b = unit >> 7, tt0 = (unit & 127) * 32;
#pragma unroll
        for (int k = 0; k < 8; ++k) { const int ch = F.tid + NTHR * k, r = ch >> 6, cc = ch & 63; if (ch < 62 * 64) *(LAS u32x4*)(Ut + r * CCH + cc * 8) = tp[k]; }
        if (it + 1 < 4) CONV_LOAD(it + 1);
        __syncthreads();
        float acc[32], uu[62];
#pragma unroll
        for (int s = 0; s < 62; ++s) uu[s] = bf2f(Ut[s * CCH + c]);
#pragma unroll
        for (int tt = 0; tt < 32; ++tt) acc[tt] = cb;
#pragma unroll
        for (int j = 0; j < CK; ++j)
#pragma unroll
            for (int tt = 0; tt < 32; ++tt) acc[tt] = __builtin_fmaf(wj[j], uu[tt + j], acc[tt]);
#pragma unroll
        for (int tt = 0; tt < 32; ++tt) Yt[tt * CCH + c] = acc[tt];
        __syncthreads();
#pragma unroll
        for (int k = 0; k < 4; ++k) { const int tt = F.wave * 4 + k;
            f32x4 y0 = *(const LAS f32x4*)(Yt + tt * CCH + 8 * lane), y1 = *(const LAS f32x4*)(Yt + tt * CCH + 8 * lane + 4);
            const float mean = wave_sum((y0[0] + y0[1]) + (y0[2] + y0[3]) + (y1[0] + y1[1]) + (y1[2] + y1[3])) * (1.f / CCH);
            y0 = y0 - mean; y1 = y1 - mean;
            const float var = wave_sum((y0[0] * y0[0] + y0[1] * y0[1]) + (y0[2] * y0[2] + y0[3] * y0[3]) + (y1[0] * y1[0] + y1[1] * y1[1]) + (y1[2] * y1[2] + y1[3] * y1[3])) * (1.f / CCH);
            const float rstd = 1.f / sqrtf(var + LN_EPS);
            y0 = y0 * rstd * lg0 + lb0; y1 = y1 * rstd * lg1 + lb1;
#pragma unroll
            for (int e = 0; e < 4; ++e) { y0[e] = y0[e] * fsigmoid(y0[e]) * ms0[e]; y1[e] = y1[e] * fsigmoid(y1[e]) * ms1[e]; }
            *(u32x4*)(MIX + ((size_t)b * SEQ + tt0 + tt) * DM + CCH + 8 * lane) = pg8::pack8(y0, y1); }
        __syncthreads();
    }
#undef CONV_LOAD
}

namespace at {
constexpr int QBLK = 32, QB = 256, KVBLK = 64, NSLOT = 3, SLOTB = 8192;
constexpr int LDS_K = 0, LDS_V = NSLOT * SLOTB, LDS_WS = 2 * NSLOT * SLOTB, LDS_OST = LDS_WS + 8 * 64 * 4, LDS_BIAS = LDS_OST + 8 * 4096, LDS_END = LDS_BIAS + 1024;
static_assert(LDS_END <= RING_BYTES && LDS_END <= CONV_ATTN_SCR, "attention LDS");
constexpr float NEGV = -200.0f;
__device__ __forceinline__ int crow(int r, int hi) { return (r & 3) + 8 * (r >> 2) + 4 * hi; }
#define SBAR() __builtin_amdgcn_sched_barrier(0)
__device__ __forceinline__ void glds16(const void* gsrc, unsigned lds_dst) { unsigned keep;
    asm volatile("s_mov_b32 %0, m0\n\ts_mov_b32 m0, %2\n\ts_nop 0\n\tglobal_load_lds_dwordx4 %1, off\n\ts_mov_b32 m0, %0" : "=&s"(keep) : "v"(gsrc), "s"(lds_dst) : "memory"); }
__device__ __forceinline__ float max3f(float a, float b, float c) { float r; asm("v_max3_f32 %0, %1, %2, %3" : "=v"(r) : "v"(a), "v"(b), "v"(c)); return r; }
__device__ __forceinline__ float max2f(float a, float b) { float r; asm("v_max_f32_e32 %0, %1, %2" : "=v"(r) : "v"(a), "v"(b)); return r; }
__device__ __forceinline__ float fadd_s(float a, float b) { float r; asm("v_add_f32_e32 %0, %1, %2" : "=v"(r) : "v"(a), "v"(b)); return r; }
__device__ __forceinline__ float fsub_s(float a, float b) { float r; asm("v_sub_f32_e32 %0, %1, %2" : "=v"(r) : "v"(a), "v"(b)); return r; }
typedef float f32x2_t __attribute__((ext_vector_type(2))); typedef __bf16 bf16x2_t __attribute__((ext_vector_type(2)));
__device__ __forceinline__ unsigned cvtpk_s(float lo, float hi) { f32x2_t v = {lo, hi}; bf16x2_t b = __builtin_convertvector(v, bf16x2_t); return __builtin_bit_cast(unsigned, b); }
typedef LAS const char* lds_cptr;
typedef short v4i16_t __attribute__((ext_vector_type(4)));
__device__ __forceinline__ void kload8(bf16x8* kf, lds_cptr kp) {
    kf[0] = *(const LAS bf16x8*)(kp);        kf[1] = *(const LAS bf16x8*)(kp + 512);  kf[2] = *(const LAS bf16x8*)(kp + 2048); kf[3] = *(const LAS bf16x8*)(kp + 2560);
    kf[4] = *(const LAS bf16x8*)(kp + 4096); kf[5] = *(const LAS bf16x8*)(kp + 4608); kf[6] = *(const LAS bf16x8*)(kp + 6144); kf[7] = *(const LAS bf16x8*)(kp + 6656); }
__device__ __forceinline__ void kload2(bf16x8* kf, lds_cptr kp, int j) { kf[2 * j] = *(const LAS bf16x8*)(kp + j * 2048); kf[2 * j + 1] = *(const LAS bf16x8*)(kp + j * 2048 + 512); }
__device__ __forceinline__ s16x4 vtr(lds_cptr p) { return __builtin_bit_cast(s16x4, __builtin_amdgcn_ds_read_tr16_b64_v4i16((LAS v4i16_t*)p)); }
__device__ __forceinline__ float rowmax(const f32x16& p0, const f32x16& p1) {
    float a = max3f(p0[0], p0[1], p1[0]), b = max3f(p0[2], p0[3], p1[1]); a = max3f(a, p1[2], p1[3]);
#pragma unroll
    for (int r = 4; r < 16; r += 4) { a = max3f(a, p0[r], p0[r + 1]); b = max3f(b, p0[r + 2], p0[r + 3]); a = max3f(a, p1[r], p1[r + 1]); b = max3f(b, p1[r + 2], p1[r + 3]); }
    const float m = max2f(a, b);
    auto rr = __builtin_amdgcn_permlane32_swap(__float_as_uint(m), __float_as_uint(m), false, false);
    return max2f(__uint_as_float(rr[0]), __uint_as_float(rr[1]));
}
__device__ __forceinline__ void pv(f32x16* o, int vb, bf16x8 pa0, bf16x8 pa1, bf16x8 pa2, bf16x8 pa3) {
#pragma unroll
    for (int d0 = 0; d0 < 2; ++d0) { s16x4 lo[4], hi[4];
#pragma unroll
        for (int ks = 0; ks < 4; ++ks) {
            asm volatile("ds_read_b64_tr_b16 %0,%1 offset:%c2" : "=&v"(lo[ks]) : "v"(vb), "i"(d0 * 4096 + ks * 1024) : "memory");
            asm volatile("ds_read_b64_tr_b16 %0,%1 offset:%c2" : "=&v"(hi[ks]) : "v"(vb), "i"(d0 * 4096 + ks * 1024 + 512) : "memory"); }
        asm volatile("s_waitcnt lgkmcnt(0)" ::: "memory"); SBAR();
#define AT_PK(k) (bf16x8){lo[k][0], lo[k][1], lo[k][2], lo[k][3], hi[k][0], hi[k][1], hi[k][2], hi[k][3]}
        o[d0] = __builtin_amdgcn_mfma_f32_32x32x16_bf16(pa0, AT_PK(0), o[d0], 0, 0, 0);
        o[d0] = __builtin_amdgcn_mfma_f32_32x32x16_bf16(pa1, AT_PK(1), o[d0], 0, 0, 0);
        o[d0] = __builtin_amdgcn_mfma_f32_32x32x16_bf16(pa2, AT_PK(2), o[d0], 0, 0, 0);
        o[d0] = __builtin_amdgcn_mfma_f32_32x32x16_bf16(pa3, AT_PK(3), o[d0], 0, 0, 0);
#undef AT_PK
    }
}
template <int THRL> __device__ __forceinline__ void attn_unit(int b, int h, int qb, const bf16* Q, const bf16* __restrict__ Kt, const bf16* __restrict__ Vt, const unsigned long long* maskQ,
                                                              bf16* MIX, float ms0, float ms1, LAS unsigned char* shm, int tid) {
    const int lane = tid & 63, r32 = lane & 31, hi = lane >> 5; const int wid = __builtin_amdgcn_readfirstlane(tid >> 6);
    const size_t rowbase = (size_t)b * SEQ; const int q0 = qb * QB, qw = q0 + wid * QBLK, cwv = qw >> 6;
    const bf16* Qw = Q + (rowbase + qw) * AW + h * HD;
    const unsigned lds0 = (unsigned)(uintptr_t)shm; const lds_cptr shm3 = (lds_cptr)shm;
    LAS float* wsf = (LAS float*)(shm + LDS_WS) + wid * 64;
    const LAS float* biasT = (const LAS float*)(shm + LDS_BIAS);
    const bf16* ksrc = Kt + ((size_t)(b * NH + h) * 64) * 4096 + wid * 512 + lane * 8;
    const bf16* vsrc = Vt + ((size_t)(b * NH + h) * 64) * 4096 + wid * 512 + lane * 8;
    const unsigned kdst = lds0 + LDS_K + wid * 1024, vdst = lds0 + LDS_V + wid * 1024;
#define DMA_K(t, slot) glds16(ksrc + (size_t)(t) * 4096, (unsigned)__builtin_amdgcn_readfirstlane(kdst + (slot)))
#define DMA_V(t, slot) glds16(vsrc + (size_t)(t) * 4096, (unsigned)__builtin_amdgcn_readfirstlane(vdst + (slot)))
    int r32m = r32; asm volatile("" : "+v"(r32m));
    const unsigned long long* mrow = maskQ + ((size_t)(b * 128 + (qw >> 5)) * 64) * 32 + r32m;
#define MLOAD(dst, t) dst = *(const GAS u32x2*)((const GAS unsigned long long*)mrow + (size_t)(t) * 32)
#define MLOAD_UNUSED(dst, t) dst = *(const u32x2*)(mrow + (size_t)(t) * 32)
#define WAIT_BAR(N, M) asm volatile("s_waitcnt vmcnt(" #N ") lgkmcnt(0)\n\ts_barrier" ::: "memory")
    const int vb0 = (int)(lds0 + LDS_V) + ((lane >> 4) & 1) * 32 + (lane & 3) * 8 + (4 * hi + ((lane & 15) >> 2)) * 64;
    bf16x8 kf[8];
    const lds_cptr kp0 = shm3 + LDS_K + hi * 1024 + r32 * 16; const lds_cptr vp0 = shm3 + LDS_V + ((lane >> 4) & 1) * 32 + (lane & 3) * 8 + (4 * hi + ((lane & 15) >> 2)) * 64;
    const int NT = (q0 + QB) / KVBLK;
    u32x2 mA, mB;
    MLOAD(mA, 0);
    DMA_K(0, 0); DMA_V(0, 0); DMA_K(1, SLOTB);
    const lds_cptr qp = shm3 + LDS_OST + wid * 4096 + hi * 512 + r32 * 16;
#pragma unroll
    for (int d0 = 0; d0 < 4; ++d0) { const bf16x8 qv = *(const bf16x8*)(Qw + (size_t)r32 * AW + d0 * 16 + hi * 8); *(LAS bf16x8*)(shm + LDS_OST + wid * 4096 + hi * 512 + r32 * 16 + d0 * 1024) = qv; }
#define QRD(d0) (*(const LAS bf16x8*)(qp + (d0) * 1024))
    float mhat = 0.f, l_reg = 0.f; f32x16 o[2]; o[0] = f32x16{}; o[1] = f32x16{}; f32x16 negm = f32x16{}; asm volatile("" : "+v"(negm));
#define MASKB(P0, P1, t, MW) do { \
        if (64 * (t) + 63 - qw >= -90 && (t) <= cwv) { const int bi_ = 64 * (t) - (qw + r32) + 128 + 4 * hi; \
            _Pragma("unroll") for (int r = 0; r < 16; ++r) { const int k0_ = (r & 3) + 8 * (r >> 2); int i0_ = bi_ + k0_; i0_ = i0_ < 0 ? 0 : i0_; int i1_ = bi_ + k0_ + 32; i1_ = i1_ < 0 ? 0 : i1_; P0[r] += biasT[i0_]; P1[r] += biasT[i1_]; } } \
        { const unsigned ml_ = MW.x >> (4 * hi), mh_ = MW.y >> (4 * hi); const unsigned nv_ = __float_as_uint(NEGV); \
            _Pragma("unroll") for (int r = 0; r < 16; ++r) { const unsigned s0_ = (unsigned)__builtin_amdgcn_sbfe((int)ml_, (r & 3) + 8 * (r >> 2), 1), s1_ = (unsigned)__builtin_amdgcn_sbfe((int)mh_, (r & 3) + 8 * (r >> 2), 1); \
                P0[r] = __uint_as_float((s0_ & __float_as_uint(P0[r])) | (~s0_ & nv_)); P1[r] = __uint_as_float((s1_ & __float_as_uint(P1[r])) | (~s1_ & nv_)); } } } while (0)
    bool resc = false;
#define START(P0, P1) do { const float rm = rowmax(P0, P1); resc = false; \
    { const float dl = rm; mhat = fadd_s(mhat, dl); \
      _Pragma("unroll") for (int r = 0; r < 16; ++r) { P0[r] = fsub_s(P0[r], dl); P1[r] = fsub_s(P1[r], dl); } \
      _Pragma("unroll") for (int r = 0; r < 16; ++r) negm[r] = -mhat; asm volatile("" : "+v"(negm)); } \
    _Pragma("unroll") for (int r = 0; r < 16; ++r) P0[r] = __builtin_amdgcn_exp2f(P0[r]); } while (0)
#define RESC() do { if (resc) { asm volatile("s_waitcnt lgkmcnt(0)" ::: "memory"); \
      _Pragma("unroll") for (int d_ = 0; d_ < 2; ++d_) _Pragma("unroll") for (int r = 0; r < 16; ++r) o[d_][r] *= wsf[crow(r, hi)]; } } while (0)
    f32x16 pA0, pA1, pB0, pB1;
    int sl_prev = 0, sl_cur = 0, sl_next = SLOTB;
#define ROT() do { sl_prev = sl_cur; sl_cur = sl_next; sl_next = (sl_next == (NSLOT - 1) * SLOTB) ? 0 : sl_next + SLOTB; } while (0)
    DMA_K(2, 2 * SLOTB);
    WAIT_BAR(3, mA);
    {
        const lds_cptr kb = kp0;
        pA0 = f32x16{}; pA1 = f32x16{};
#pragma unroll
        for (int d0 = 0; d0 < 4; ++d0) { const bf16x8 b0 = *(const LAS bf16x8*)(kb + d0 * 2048), b1 = *(const LAS bf16x8*)(kb + d0 * 2048 + 512);
            const bf16x8 qv = QRD(d0); pA0 = __builtin_amdgcn_mfma_f32_32x32x16_bf16(b0, qv, pA0, 0, 0, 0); pA1 = __builtin_amdgcn_mfma_f32_32x32x16_bf16(b1, qv, pA1, 0, 0, 0); }
        MASKB(pA0, pA1, 0, mA);
        asm volatile("s_nop 15\n\ts_nop 7" : "+v"(pA0), "+v"(pA1));
        START(pA0, pA1);
#pragma unroll
        for (int r = 0; r < 16; ++r) pA1[r] = __builtin_amdgcn_exp2f(pA1[r]);
    }
    WAIT_BAR(0, mA);
    MLOAD(mB, 1);
    DMA_K(3, 0); DMA_V(1, SLOTB);
    ROT();
    kload8(kf, kp0 + sl_cur);
    WAIT_BAR(2, mB);
    s16x4 vlo[8], vhi[8]; u32x4 pw0, pw1, pw2, pw3;
#define PKW(P, B) cvtpk_s(P[B], P[B + 1])
#define PAF(k) __builtin_bit_cast(bf16x8, pw##k)
#define VFR(i) (bf16x8){vlo[i][0], vlo[i][1], vlo[i][2], vlo[i][3], vhi[i][0], vhi[i][1], vhi[i][2], vhi[i][3]}
#define PIN(x) asm volatile("" : "+v"(x))
#define MX3(a, b, c) __builtin_fmaxf(__builtin_fmaxf((a), (b)), (c))
#define GAPA(MF, A0, A1, A2, A3, W0, W1, PW) do { MF; sacc += A0; sacc += A1; sacc += A2; sacc += A3; PIN(sacc); W0; W1; PIN(PW); SBAR(); } while (0)
#define EX(v) __builtin_amdgcn_exp2f(v)
#define GAPB(MF, X, B) do { MF; X[B] = EX(X[B]); X[B + 1] = EX(X[B + 1]); X[B + 2] = EX(X[B + 2]); X[B + 3] = EX(X[B + 3]); PIN(X); SBAR(); } while (0)
#define VRD(i) do { vlo[i] = vtr(vp_ + (((i) >> 2) * 4096 + ((i) & 3) * 1024)); vhi[i] = vtr(vp_ + (((i) >> 2) * 4096 + ((i) & 3) * 1024 + 512)); } while (0)
#define KRD(G, j) do { if (G) { kload2(kf, kp0 + sl_next, j); SBAR(); } } while (0)
#define STEP(C0, C1, P0, P1, t, MC, MN, GM, GK, GV, GL) do { SBAR(); \
    const lds_cptr vp_ = vp0 + sl_prev; \
    bf16x8 qa_ = QRD(0), qb_; VRD(0); SBAR(); float sacc = (P0[0] + P0[1]); \
    GAPA(C0 = __builtin_amdgcn_mfma_f32_32x32x16_bf16(kf[0], qa_, negm, 0, 0, 0), P0[2], P0[3], P0[4], P0[5],     pw0[0] = PKW(P0, 0), pw0[1] = PKW(P0, 2), pw0); \
    VRD(4); SBAR(); GAPA(C1 = __builtin_amdgcn_mfma_f32_32x32x16_bf16(kf[1], qa_, negm, 0, 0, 0), P0[6], P0[7], P0[8], P0[9],     pw0[2] = PKW(P0, 4), pw0[3] = PKW(P0, 6), pw0); \
    qb_ = QRD(1); VRD(1); SBAR(); GAPA(C0 = __builtin_amdgcn_mfma_f32_32x32x16_bf16(kf[2], qb_, C0, 0, 0, 0),   P0[10], P0[11], P0[12], P0[13], pw1[0] = PKW(P0, 8), pw1[1] = PKW(P0, 10), pw1); \
    VRD(5); SBAR(); GAPA(C1 = __builtin_amdgcn_mfma_f32_32x32x16_bf16(kf[3], qb_, C1, 0, 0, 0),   P0[14], P0[15], P1[0], P1[1],   pw1[2] = PKW(P0, 12), pw1[3] = PKW(P0, 14), pw1); \
    qa_ = QRD(2); VRD(2); SBAR(); GAPA(C0 = __builtin_amdgcn_mfma_f32_32x32x16_bf16(kf[4], qa_, C0, 0, 0, 0),   P1[2], P1[3], P1[4], P1[5],     pw2[0] = PKW(P1, 0), pw2[1] = PKW(P1, 2), pw2); \
    VRD(6); SBAR(); GAPA(C1 = __builtin_amdgcn_mfma_f32_32x32x16_bf16(kf[5], qa_, C1, 0, 0, 0),   P1[6], P1[7], P1[8], P1[9],     pw2[2] = PKW(P1, 4), pw2[3] = PKW(P1, 6), pw2); \
    qb_ = QRD(3); VRD(3); SBAR(); GAPA(C0 = __builtin_amdgcn_mfma_f32_32x32x16_bf16(kf[6], qb_, C0, 0, 0, 0),   P1[10], P1[11], P1[12], P1[13], pw3[0] = PKW(P1, 8), pw3[1] = PKW(P1, 10), pw3); \
    VRD(7); SBAR(); GAPA(C1 = __builtin_amdgcn_mfma_f32_32x32x16_bf16(kf[7], qb_, C1, 0, 0, 0),   P1[14], P1[15], 0.f, 0.f,       pw3[2] = PKW(P1, 12), pw3[3] = PKW(P1, 14), pw3); \
    l_reg += sacc; \
    MASKB(C0, C1, t, MC); \
    if (GM) { MLOAD(MN, (t) + 1); } if (GK) { DMA_K((t) + 3, sl_cur); } if (GV) { DMA_V((t) + 1, sl_next); } \
    { float a = MX3(C0[0], C0[1], C1[0]), b_ = MX3(C0[2], C0[3], C1[1]); a = MX3(a, C1[2], C1[3]); \
      _Pragma("unroll") for (int r = 4; r < 16; r += 4) { a = MX3(a, C0[r], C0[r + 1]); b_ = MX3(b_, C0[r + 2], C0[r + 3]); a = MX3(a, C1[r], C1[r + 1]); b_ = MX3(b_, C1[r + 2], C1[r + 3]); } \
      float rm = __builtin_fmaxf(a, b_); { auto rr = __builtin_amdgcn_permlane32_swap(__float_as_uint(rm), __float_as_uint(rm), false, false); rm = __builtin_fmaxf(__uint_as_float(rr[0]), __uint_as_float(rr[1])); } \
      resc = false; \
      if (__builtin_expect(__any(rm > (float)THRL), 0)) { const float dl = __builtin_fmaxf(rm, 0.f); mhat += dl; \
        _Pragma("unroll") for (int r = 0; r < 16; ++r) { C0[r] -= dl; C1[r] -= dl; } \
        _Pragma("unroll") for (int r = 0; r < 16; ++r) negm[r] = -mhat; asm volatile("" : "+v"(negm)); \
        const float f = __builtin_amdgcn_exp2f(-dl); l_reg *= f; if (hi == 0) wsf[r32] = f; resc = true; } } \
    SBAR(); \
    GAPB(o[0] = __builtin_amdgcn_mfma_f32_32x32x16_bf16(PAF(0), VFR(0), o[0], 0, 0, 0), C0, 0); \
    GAPB(o[1] = __builtin_amdgcn_mfma_f32_32x32x16_bf16(PAF(0), VFR(4), o[1], 0, 0, 0), C0, 4); \
    KRD(GL, 0); GAPB(o[0] = __builtin_amdgcn_mfma_f32_32x32x16_bf16(PAF(1), VFR(1), o[0], 0, 0, 0), C0, 8); \
    KRD(GL, 1); GAPB(o[1] = __builtin_amdgcn_mfma_f32_32x32x16_bf16(PAF(1), VFR(5), o[1], 0, 0, 0), C0, 12); \
    KRD(GL, 2); GAPB(o[0] = __builtin_amdgcn_mfma_f32_32x32x16_bf16(PAF(2), VFR(2), o[0], 0, 0, 0), C1, 0); \
    KRD(GL, 3); GAPB(o[1] = __builtin_amdgcn_mfma_f32_32x32x16_bf16(PAF(2), VFR(6), o[1], 0, 0, 0), C1, 4); \
    GAPB(o[0] = __builtin_amdgcn_mfma_f32_32x32x16_bf16(PAF(3), VFR(3), o[0], 0, 0, 0), C1, 8); \
    GAPB(o[1] = __builtin_amdgcn_mfma_f32_32x32x16_bf16(PAF(3), VFR(7), o[1], 0, 0, 0), C1, 12); \
    } while (0)
    int t = 1;
    for (; t + 5 < NT; t += 2) {
        STEP(pB0, pB1, pA0, pA1, t, mB, mA, true, true, true, true);       WAIT_BAR(2, mA); RESC(); ROT();
        STEP(pA0, pA1, pB0, pB1, t + 1, mA, mB, true, true, true, true);   WAIT_BAR(2, mB); RESC(); ROT();
    }
#define ENDW(tt, M) do { if ((tt) + 3 < NT) { WAIT_BAR(2, M); } else if ((tt) + 2 < NT) { WAIT_BAR(1, M); } else { WAIT_BAR(0, M); } } while (0)
    for (; t + 1 < NT; t += 2) {
        STEP(pB0, pB1, pA0, pA1, t, mB, mA, (t + 1 < NT), (t + 3 < NT), (t + 1 < NT), (t + 1 < NT));         ENDW(t, mA);     RESC(); ROT();
        STEP(pA0, pA1, pB0, pB1, t + 1, mA, mB, (t + 2 < NT), (t + 4 < NT), (t + 2 < NT), (t + 2 < NT));     ENDW(t + 1, mB); RESC(); ROT();
    }
    STEP(pB0, pB1, pA0, pA1, NT - 1, mB, mA, false, false, false, false); RESC();
    { float sacc = pB0[0] + pB0[1];
#pragma unroll
      for (int r = 2; r < 16; ++r) sacc += pB0[r];
#pragma unroll
      for (int r = 0; r < 16; ++r) sacc += pB1[r];
      l_reg += sacc;
      pw0 = (u32x4){PKW(pB0, 0), PKW(pB0, 2), PKW(pB0, 4), PKW(pB0, 6)}; pw1 = (u32x4){PKW(pB0, 8), PKW(pB0, 10), PKW(pB0, 12), PKW(pB0, 14)};
      pw2 = (u32x4){PKW(pB1, 0), PKW(pB1, 2), PKW(pB1, 4), PKW(pB1, 6)}; pw3 = (u32x4){PKW(pB1, 8), PKW(pB1, 10), PKW(pB1, 12), PKW(pB1, 14)};
      SBAR(); pv(o, vb0 + sl_cur, PAF(0), PAF(1), PAF(2), PAF(3)); }
    { auto rr = __builtin_amdgcn_permlane32_swap(__float_as_uint(l_reg), __float_as_uint(l_reg), false, false); l_reg = __uint_as_float(rr[0]) + __uint_as_float(rr[1]); }
    if (hi == 0) wsf[32 + r32] = l_reg; asm volatile("s_waitcnt lgkmcnt(0)" ::: "memory");
    float rli[16];
#pragma unroll
    for (int r = 0; r < 16; ++r) rli[r] = __builtin_amdgcn_rcpf(wsf[32 + crow(r, hi)]);
    { LAS bf16* stg = (LAS bf16*)(shm + LDS_OST) + wid * 2048;
#pragma unroll
      for (int r = 0; r < 16; ++r) { const int orow = crow(r, hi);
          stg[orow * 64 + r32] = (bf16)(cvtpk_s(o[0][r] * rli[r] * ms0, 0.f) & 0xffffu); stg[orow * 64 + 32 + r32] = (bf16)(cvtpk_s(o[1][r] * rli[r] * ms1, 0.f) & 0xffffu); }
      asm volatile("s_waitcnt lgkmcnt(0)" ::: "memory");
      int ln2 = lane; asm volatile("" : "+v"(ln2));
#pragma unroll
      for (int i = 0; i < 4; ++i) { const int row = i * 8 + (ln2 >> 3), ch = ln2 & 7; const u32x4 v = *(const LAS u32x4*)(stg + row * 64 + ch * 8);
          *(u32x4*)(MIX + (rowbase + qw + row) * DM + h * HD + ch * 8) = v; } }
    asm volatile("s_waitcnt lgkmcnt(0)\n\ts_barrier" ::: "memory");
#undef QRD
#undef DMA_K
#undef DMA_V
#undef MLOAD
#undef WAIT_BAR
#undef MASKB
#undef START
#undef RESC
#undef ROT
#undef PKW
#undef PAF
#undef VFR
#undef PIN
#undef MX3
#undef GAPA
#undef GAPB
#undef EX
#undef VRD
#undef KRD
#undef STEP
#undef ENDW
}
#undef SBAR
}

__device__ __forceinline__ void p_attn(Frame& F, int l) {
    const bf16* Q = WSP(bf16, WS_Q); const bf16* Kg = WSP(bf16, WS_K); const bf16* Vg = WSP(bf16, WS_V); bf16* MIX = WSP(bf16, WS_MIX);
    const unsigned long long* maskQ = WSP(unsigned long long, WS_MASK);
    LAS unsigned char* shm = F.lds + RING_OFF;
    const int tid = F.tid, lane = F.lane, r32 = lane & 31;
    const int bh = F.vcu >> 2, sq = F.vcu & 3, b = bh >> 3, h = bh & 7;
    LAS float* biasT = (LAS float*)(shm + at::LDS_BIAS);
    if (tid < 192) { const int rel = tid - 128, nn = rel < 0 ? -rel : rel; int bk = nn;
        if (nn >= 8) bk = 8 + (nn >= 12) + (nn >= 16) + (nn >= 23) + (nn >= 32) + (nn >= 46) + (nn >= 64) + (nn >= 91);
        bk += (rel > 0) ? 16 : 0;
        biasT[tid] = (arg_in(7)[bk * NH + h] - arg_in(7)[15 * NH + h]) * LOG2E; }
    __syncthreads();
    const float ms0 = arg_in(6)[l * DM + h * 64 + r32], ms1 = arg_in(6)[l * DM + h * 64 + 32 + r32];
    for (int ui = 0; ui < 4; ++ui) {
        const int qb = (ui == 0) ? sq : (ui == 1) ? 7 - sq : (ui == 2) ? 8 + sq : 15 - sq;
        at::attn_unit<8>(b, h, qb, Q, Kg, Vg, maskQ, MIX, ms0, ms1, shm, tid);
        if (ui == sq) convert_ffn(F, l);
    }
}


#define REP(bit) for (int rep_ = 0; rep_ < (((PROBE_MASK) >> (bit)) & 1) + 1; ++rep_)
struct Args { const float* in[20]; float* out; unsigned char* ws; int seg_lo, seg_hi; };
constexpr int N_SEG = 1 + 2 * 8 + 2 * 9;

__global__ void __launch_bounds__(NTHR, 2) fwd_kernel(Args a) {
    extern __shared__ __attribute__((aligned(16))) unsigned char lds_raw[];
    Frame F0;
    F0.lds = (LAS unsigned char*)lds_raw;
    F0.tid = threadIdx.x; F0.lane = F0.tid & 63; F0.wave = __builtin_amdgcn_readfirstlane(F0.tid >> 6);
    F0.G = gridDim.x; { const int bx = blockIdx.x; F0.vcu = (F0.G % 8 == 0) ? (bx % 8) * (F0.G / 8) + bx / 8 : bx; }
    F0.ws = a.ws;
    for (int u = F0.tid; u < (LDS_BYTES - LDSCTL_OFF) / 4; u += NTHR) ((LAS unsigned*)(F0.lds + LDSCTL_OFF))[u] = 0u;
    __syncthreads();
    unsigned* ctl = (unsigned*)(F0.ws + WS_CTL);
    XcdBarrier bar = xcd_barrier_post(ctl + CW_BAR, (volatile LAS unsigned*)(F0.lds + MISC_OFF + 32));
    int sg = 0;
    const int lo = a.seg_lo, hi = a.seg_hi;
#define ACTIVE (lo <= sg && sg < hi)
#define SEAM() do { if (lo <= sg && sg + 1 < hi) xcd_barrier(bar); ++sg; } while (0)

    if (ACTIVE) { Frame F = fresh(F0); cvt_x(F); convert_weights(F, 0); }
    SEAM();
    for (int l = 0; l < DEPTH; ++l) {
        if (ACTIVE) REP(3) {
            {
                Frame F = fresh(F0);
                pg8::DenseOrderG S; S.init_tiles(M / 256, 10, F.G, (int)(F.G % 8 == 0 ? (F.vcu % (F.G / 8)) * 8 + F.vcu / (F.G / 8) : F.vcu)); S.Bt = (const char*)WSP(unsigned char, WS_WIN); S.K = DM / 2;
                pg8::EpiIn E{WSP(bf16, WS_Q), WSP(bf16, WS_K), WSP(bf16, WS_V), WSP(bf16, WS_QI), WSP(bf16, WS_KI), WSP(bf16, WS_U), WSP(float, WS_WI), 0, 1.0f / (pg8::F8_ASC * pg8::F8_WGU), 6};
                pg8::gemm_phase<pg8::EpiIn, pg8::DenseOrderG, true, true, true>(F.tid, F.lds + RING_OFF, (const char*)WSP(unsigned char, WS_XQ), DM / 2, S, E);
            }
            {
                Frame F = fresh(F0);
                pg8::DenseOrder S; S.init_tiles(M / 256, 3, F.G, (int)(F.G % 8 == 0 ? (F.vcu % (F.G / 8)) * 8 + F.vcu / (F.G / 8) : F.vcu)); S.Bt = (const char*)(WSP(bf16, WS_WIN) + (size_t)1536 * DM); S.K = DM;
                pg8::EpiIn E{WSP(bf16, WS_Q), WSP(bf16, WS_K), WSP(bf16, WS_V), WSP(bf16, WS_QI), WSP(bf16, WS_KI), WSP(bf16, WS_U), WSP(float, WS_WI), 6, 1.0f, 99};
                pg8::gemm_phase<pg8::EpiIn, pg8::DenseOrder, true, true>(F.tid, F.lds + RING_OFF, (const char*)WSP(bf16, WS_XB), DM, S, E);
            }
        }
        SEAM();
        if (ACTIVE) {
#ifndef NO_IDX
            REP(0) { Frame F = fresh(F0); p_idx(F, l); }
#endif
#ifndef NO_CONV
            REP(1) { Frame F = fresh(F0); p_conv(F, l); }
#endif
        }
        SEAM();
        if (ACTIVE) {
#ifndef NO_ATTN
            REP(2) { Frame F = fresh(F0); p_attn(F, l); }
#endif
        }
        SEAM();
        if (ACTIVE) REP(4) { Frame F = fresh(F0); bf16* R1 = WSP(bf16, WS_R1);
            pg8::DenseOrder S; S.init_tiles(M / 256, DM / 256, F.G, (int)(F.G % 8 == 0 ? (F.vcu % (F.G / 8)) * 8 + F.vcu / (F.G / 8) : F.vcu)); S.Bt = (const char*)WSP(bf16, WS_WOUT); S.K = DM;
            pg8::EpiRes E{WSP(bf16, WS_XB), R1, 1.0f};
            pg8::gemm_phase<pg8::EpiRes, pg8::DenseOrder, true, true>(F.tid, F.lds + RING_OFF, (const char*)WSP(bf16, WS_MIX), DM, S, E);
        }
        SEAM();
        if (ACTIVE) { Frame F = fresh(F0); p_ln1(F, l); }
        SEAM();
        if ((l & 1) == 0) {
            if (ACTIVE) REP(5) { Frame F = fresh(F0); bf16* XB = WSP(bf16, WS_XB);
                pg8::DenseOrderG S; S.init_tiles(M / 256, 2 * DFF / 256, F.G, (int)(F.G % 8 == 0 ? (F.vcu % (F.G / 8)) * 8 + F.vcu / (F.G / 8) : F.vcu)); S.Bt = (const char*)WSP(bf16, WS_WFF); S.K = DM / 2;
                pg8::EpiSwi E{WSP(unsigned char, WS_H), DFF};
                pg8::gemm_phase<pg8::EpiSwi, pg8::DenseOrderG, true, true, true>(F.tid, F.lds + RING_OFF, (const char*)XB, DM / 2, S, E);
            }
            SEAM();
            if (ACTIVE) { Frame F = fresh(F0); bf16* R1 = WSP(bf16, WS_R1);
                pg8::DenseOrderG S; S.init_tiles(M / 256, DM / 256, F.G, (int)(F.G % 8 == 0 ? (F.vcu % (F.G / 8)) * 8 + F.vcu / (F.G / 8) : F.vcu)); S.Bt = (const char*)(WSP(unsigned char, WS_WFF) + (size_t)2 * DFF * DM); S.K = DFF / 2;
                pg8::EpiRes E{R1, R1, 1.0f / (pg8::F8_HSC * pg8::F8_WDN)};
                pg8::gemm_phase<pg8::EpiRes, pg8::DenseOrderG, true, true, true>(F.tid, F.lds + RING_OFF, (const char*)WSP(unsigned char, WS_H), DFF / 2, S, E);
            }
            SEAM();
            if (ACTIVE) { REP(11) { Frame F = fresh(F0); p_ln2(F, l); } if (l + 1 < DEPTH) REP(8) { Frame F = fresh(F0); convert_weights(F, l + 1); } }
            SEAM();
        } else {
            if (ACTIVE) { Frame F = fresh(F0); p_list(F); }
            SEAM();
            for (int r = 0; r < 1; ++r) {
                if (ACTIVE) REP(6) { Frame F = fresh(F0); bf16* XB = WSP(bf16, WS_XB);
                    moe_tables(F);
                    const int Tm = ((LAS int*)(F.lds + LDSCTL_OFF + 1200))[8]; const int tlo = r * RT; int nMr = Tm - tlo; nMr = nMr < 0 ? 0 : (nMr > RT ? RT : nMr);
                    pg8::MoeGuOrder S; S.init_tiles(nMr, 2 * DFE / 256, F.G, (int)(F.G % 8 == 0 ? (F.vcu % (F.G / 8)) * 8 + F.vcu / (F.G / 8) : F.vcu)); S.rowlist = WSP(int, WS_ROWLIST); S.texp = (const LAS int*)(F.lds + LDSCTL_OFF); S.tlo = tlo;
                    S.W = (const char*)WSP(unsigned char, WS_WFF); S.estride = (size_t)3 * DFE * DM;
                    pg8::EpiSwi E{WSP(unsigned char, WS_H), DFE};
                    pg8::gemm_phase<pg8::EpiSwi, pg8::MoeGuOrder, true, true, true>(F.tid, F.lds + RING_OFF, (const char*)XB, DM / 2, S, E);
                }
                SEAM();
                if (ACTIVE) REP(7) { Frame F = fresh(F0);
                    moe_tables(F);
                    const int Tm = ((LAS int*)(F.lds + LDSCTL_OFF + 1200))[8]; const int tlo = r * RT; int nMr = Tm - tlo; nMr = nMr < 0 ? 0 : (nMr > RT ? RT : nMr);
                    pg8::MoeDnOrder S; S.init_tiles(nMr, DM / 256, F.G, (int)(F.G % 8 == 0 ? (F.vcu % (F.G / 8)) * 8 + F.vcu / (F.G / 8) : F.vcu)); S.texp = (const LAS int*)(F.lds + LDSCTL_OFF); S.tlo = tlo;
                    S.W = (const char*)(WSP(unsigned char, WS_WFF) + (size_t)2 * DFE * DM); S.estride = (size_t)3 * DFE * DM;
                    pg8::EpiMoeDown E{WSP(bf16, WS_YD), WSP(float, WS_ROWGATE), tlo};
                    pg8::gemm_phase<pg8::EpiMoeDown, pg8::MoeDnOrder, true, true, true>(F.tid, F.lds + RING_OFF, (const char*)WSP(unsigned char, WS_H), DFE / 2, S, E);
                }
                SEAM();
            }
            if (ACTIVE) { REP(10) { Frame F = fresh(F0); p_comb(F, l); } if (l + 1 < DEPTH) REP(8) { Frame F = fresh(F0); convert_weights(F, l + 1); } }
            SEAM();
        }
    }
#undef ACTIVE
#undef SEAM
}

#ifndef MK_MULTI
#define MK_MULTI 0
#endif
extern "C" void kernel_launch(void* const* d_in, const int* in_sizes, int n_in, void* d_out, int out_size, void* d_ws, size_t ws_size, hipStream_t stream) {
    static int grid = 0;
    if (grid == 0) {
        if (n_in != 20 || in_sizes[0] != M * DM || out_size != M * DM || ws_size < WS_END) { fprintf(stderr, "kernel_launch: unexpected shapes (n_in %d, in0 %d, out %d, ws %zu, need %zu); nothing launched\n", n_in, n_in > 0 ? in_sizes[0] : -1, out_size, ws_size, (size_t)WS_END); grid = -1; return; }
        int dev = 0, cus = 0, per_cu = 0;
        if (hipGetDevice(&dev) != hipSuccess || hipDeviceGetAttribute(&cus, hipDeviceAttributeMultiprocessorCount, dev) != hipSuccess) { grid = -1; return; }
        if (hipFuncSetAttribute((const void*)fwd_kernel, hipFuncAttributeMaxDynamicSharedMemorySize, LDS_BYTES) != hipSuccess) { fprintf(stderr, "kernel_launch: hipFuncSetAttribute failed\n"); grid = -1; return; }
        if (hipOccupancyMaxActiveBlocksPerMultiprocessor(&per_cu, (const void*)fwd_kernel, NTHR, LDS_BYTES) != hipSuccess || per_cu < 1) fprintf(stderr, "kernel_launch: occupancy query reports %d\n", per_cu);
        (void)hipGetLastError();
        grid = cus;
        if (grid != 256) { fprintf(stderr, "kernel_launch: built for 256 CUs, device has %d; nothing launched\n", cus); grid = -1; return; }
    }
    if (grid < 0) return;
    if (hipMemsetAsync((char*)d_ws + WS_CTL, 0, CTL_ZERO_BYTES, stream) != hipSuccess) return;
    Args a{};
    for (int i = 0; i < 20; ++i) a.in[i] = (const float*)d_in[i];
    a.out = (float*)d_out; a.ws = (unsigned char*)d_ws;
#if MK_MULTI
    for (int s = 0; s < N_SEG; ++s) { a.seg_lo = s; a.seg_hi = s + 1; hipLaunchKernelGGL(fwd_kernel, dim3(grid), dim3(NTHR), LDS_BYTES, stream, a); }
#else
    a.seg_lo = 0; a.seg_hi = N_SEG;
    hipLaunchKernelGGL(fwd_kernel, dim3(grid), dim3(NTHR), LDS_BYTES, stream, a);
#endif
    const hipError_t le = hipPeekAtLastError();
    if (le != hipSuccess) fprintf(stderr, "kernel_launch: launch failed: %s\n", hipGetErrorName(le));
}
```

```cpp
#include <hip/hip_runtime.h>
#include <cstdio>
#include <cstdint>

#define GAS __attribute__((address_space(1)))
#define LAS __attribute__((address_space(3)))
#define CAS __attribute__((address_space(4)))
typedef unsigned short bf16;
typedef short bf16x8 __attribute__((ext_vector_type(8)));
typedef short s16x4 __attribute__((ext_vector_type(4)));
typedef float f32x2 __attribute__((ext_vector_type(2)));
typedef float f32x4 __attribute__((ext_vector_type(4)));
typedef float f32x16 __attribute__((ext_vector_type(16)));
typedef unsigned u32x2 __attribute__((ext_vector_type(2)));
typedef unsigned u32x4 __attribute__((ext_vector_type(4)));
typedef int i32x8 __attribute__((ext_vector_type(8)));

#ifndef PROBE_MASK
#define PROBE_MASK 0
#endif
constexpr int BATCH = 8, SEQ = 4096, DM = 1024, M = BATCH * SEQ, DEPTH = 4;
constexpr int AW = 512, NH = 8, HD = 64, CCH = 512, CK = 31;
constexpr int IN_COLS = 3144, NIN = 3328;
constexpr int OFF_KI = 2048, OFF_WI = 2112, OFF_GLU = 2120;
constexpr int DFF = 2816, DFE = 3584, NE = 8;
constexpr int TOPK = 256;
constexpr float DN_ALPHA = 1.6817928305074290f;
constexpr float LN_EPS = 1e-5f;
constexpr float LOG2E = 1.4426950408889634f;
constexpr float QSCALE = 0.125f * LOG2E;
constexpr int NWAVES = 8, NTHR = 512;
constexpr int MAXT = 272, RT = 272;

constexpr size_t MiB = 1u << 20;
constexpr size_t WS_CTL = 0, CTL_ZERO_BYTES = 1 * MiB;
constexpr size_t WS_WIN = 1 * MiB, WS_WOUT = 8 * MiB, WS_WFF = 10 * MiB;
constexpr size_t WS_R1 = 178 * MiB, WS_XB = 306 * MiB, WS_A = 370 * MiB;
constexpr size_t WS_Q = WS_A, WS_K = WS_A + 32 * MiB, WS_V = WS_A + 64 * MiB, WS_QI = WS_A + 96 * MiB, WS_KI = WS_A + 128 * MiB, WS_WI = WS_A + 132 * MiB,
                 WS_U = WS_A + 133 * MiB, WS_MIX = WS_A + 165 * MiB, WS_H = WS_A;
constexpr size_t WS_YD = 616 * MiB, WS_ROUTE = 752 * MiB, WS_ROWLIST = WS_ROUTE + 512 * 1024, WS_ROWGATE = WS_ROWLIST + 320 * 1024, WS_SLOTROW = WS_ROWGATE + 320 * 1024,
                 WS_CNTWG = WS_SLOTROW + 256 * 1024, WS_MASK = 754 * MiB, WS_XQ = 820 * MiB, WS_END = 852 * MiB;
static_assert((size_t)RT * 256 * DFE <= 246 * MiB && (size_t)M * DFF <= 246 * MiB, "H overlay (fp8)");
static_assert((size_t)MAXT * 256 * DM * 2 <= 136 * MiB, "Yd");
static_assert(WS_CNTWG + 8192 <= WS_MASK && WS_MASK + (size_t)DEPTH * BATCH * 128 * 4096 * 4 <= WS_XQ, "route / masks");
constexpr int CW_BAR = 4096;

constexpr int RING_OFF = 0, RING_BYTES = 131072;
constexpr int AUX_OFF = 131072, AUX_BYTES = 26624;
constexpr int LDSCTL_OFF = AUX_OFF + AUX_BYTES, MISC_OFF = LDSCTL_OFF + 2048;
constexpr int LDS_BYTES = 157 * 1024;
static_assert(MISC_OFF + 128 <= LDS_BYTES, "LDS map");

__device__ __forceinline__ unsigned cvt_pk_bf16(float lo, float hi) { unsigned r; asm volatile("v_cvt_pk_bf16_f32 %0, %1, %2" : "=v"(r) : "v"(lo), "v"(hi)); return r; }
__device__ __forceinline__ float bf2f(unsigned short b) { return __uint_as_float((unsigned)b << 16); }
__device__ __forceinline__ float fsigmoid(float x) { return __builtin_amdgcn_rcpf(1.0f + __builtin_amdgcn_exp2f(-x * LOG2E)); }
#define LDS_WAIT() asm volatile("s_waitcnt lgkmcnt(0)" ::: "memory")
#define VM_WAIT() asm volatile("s_waitcnt vmcnt(0)" ::: "memory")

namespace pg8 {
constexpr int BM = 256, BK = 64, HALF = 128, HTB = HALF * BK * 2, STAGE_BYTES = 8 * HTB, NXCD = 8, WGM = 8;
__host__ __device__ __forceinline__ int lds_byte(int r, int c) { const int st = (r >> 4) * 2 + (c >> 5), rr = r & 15, cc = c & 31, ob = rr * 64 + cc * 2; return st * 1024 + (ob ^ (((ob >> 9) & 1) << 5)); }
__host__ __device__ __forceinline__ void stage_rc(int b, int& R, int& C) { const int st = b / 1024, sb = b % 1024, swz = sb ^ (((sb >> 9) & 1) << 5); R = (st >> 1) * 16 + swz / 64; C = (st & 1) * 32 + (swz % 64) / 2; }
__host__ __device__ __forceinline__ int perm32(int rho) { const int n = rho >> 4, i = rho & 15; return 8 * (i >> 2) + 4 * n + (i & 3); }
struct Unit { int pm, pn; };

struct OrderBase {
    int nM, nN, nwg, G, c;
    __device__ __forceinline__ void init_tiles(int nM_, int nN_, int G_, int c_) { nM = nM_; nN = nN_; nwg = nM * nN; G = G_; c = c_; }
    __device__ __forceinline__ bool next(int i, Unit& u) const { const long L = (long)i * G + c; if (L >= nwg) return false; unit_of((int)L, u); return true; }
    __device__ __forceinline__ void unit_of(int L, Unit& u) const {
        int wgid = L; { const int q = nwg / NXCD, r = nwg % NXCD, xcd = wgid % NXCD, off = wgid / NXCD; wgid = (xcd < r ? xcd * (q + 1) : r * (q + 1) + (xcd - r) * q) + off; }
        const int nig = WGM * nN, gid = wgid / nig, fm = gid * WGM, gsz = (nM - fm) < WGM ? (nM - fm) : WGM;
        u.pm = fm + ((wgid % nig) % gsz); u.pn = (wgid % nig) / gsz;
    }
    __device__ __forceinline__ void a_ready(const Unit&) const {}
    __device__ __forceinline__ void done(const Unit&) const {}
};
struct DenseOrder : OrderBase {
    static constexpr bool GATHER = false;
    const char* Bt; int K;
    __device__ __forceinline__ size_t a_base(const Unit& u) const { return (size_t)u.pm * ((size_t)BM * K * 2); }
    __device__ __forceinline__ unsigned a_off(const Unit&, int) const { return 0u; }
    __device__ __forceinline__ const char* b_base(const Unit& u) const { return Bt + (size_t)u.pn * ((size_t)BM * K * 2); }
};

struct DenseOrderG : OrderBase {
    static constexpr bool GATHER = true;
    const char* Bt; int K;
    __device__ __forceinline__ size_t a_base(const Unit&) const { return 0; }
    __device__ __forceinline__ unsigned a_off(const Unit& u, int r) const { return (unsigned)(u.pm * BM + r) * (unsigned)(K * 2); }
    __device__ __forceinline__ const char* b_base(const Unit& u) const { return Bt + (size_t)u.pn * ((size_t)BM * K * 2); }
};

template <class Epi, class Sched, bool ALIGN_EPI, bool SP2, bool F8 = false>
__device__ __forceinline__ void gemm_phase(const int tid, LAS unsigned char* lds, const char* Abase, const int K, const Sched& S, const Epi& E, const int KS_ = 0) {
    const int KS = KS_ ? KS_ : K;
    const int wid = __builtin_amdgcn_readfirstlane(tid >> 6), lane = tid & 63, wr = wid >> 2, wc = wid & 3, fr = lane & 15, fq = lane >> 4;
    const int nt = K / BK;
    constexpr bool GATHER = Sched::GATHER;
    unsigned voffA[2], voffB[2];
#pragma unroll
    for (int i = 0; i < 2; ++i) { int R, C; stage_rc(tid * 16 + i * 8192, R, C); const int Rb = Epi::PERM ? ((R & ~31) + perm32(R & 31)) : R;
        voffA[i] = GATHER ? (unsigned)C * 2u : (unsigned)(R * KS + C) * 2u; voffB[i] = (unsigned)(Rb * KS + C) * 2u; }
    const size_t kstep = (size_t)(BK * 2);
    const size_t hstep = (size_t)HALF * KS * 2;
    const unsigned ldsw = (unsigned)wid * 1024u;
    const int aoff = lds_byte(wr * 64 + fr, fq * 8), boff = lds_byte(wc * 32 + fr, fq * 8);
#define PG8_SA(b, h) (((b) * 2 + (h)) * HTB)
#define PG8_SB(b, h) ((4 + (b) * 2 + (h)) * HTB)
#define PG8_STAGE(bufoff, gbase, voff) do { _Pragma("unroll") for (int _i = 0; _i < 2; ++_i) \
        __builtin_amdgcn_global_load_lds((const unsigned*)((const char*)(gbase) + (voff)[_i]), (LAS unsigned*)(lds + (bufoff) + ldsw + _i * 8192), 16, 0, 0); } while (0)
typedef int i32x4_t __attribute__((ext_vector_type(4)));
#define PG8_LDA(dst, b, h) do { _Pragma("unroll") for (int m = 0; m < 4; ++m) { if constexpr (F8) { dst[m].lo = *(const LAS i32x4_t*)(lds + PG8_SA(b, h) + aoff + m * 2048); dst[m].hi = *(const LAS i32x4_t*)(lds + PG8_SA(b, h) + aoff + m * 2048 + 1024); } \
        else { _Pragma("unroll") for (int k = 0; k < 2; ++k) dst##b16[m][k] = *(const LAS bf16x8*)(lds + PG8_SA(b, h) + aoff + m * 2048 + k * 1024); } } } while (0)
#define PG8_LDB(dst, b, h) do { _Pragma("unroll") for (int n = 0; n < 2; ++n) { if constexpr (F8) { dst[n].lo = *(const LAS i32x4_t*)(lds + PG8_SB(b, h) + boff + n * 2048); dst[n].hi = *(const LAS i32x4_t*)(lds + PG8_SB(b, h) + boff + n * 2048 + 1024); } \
        else { _Pragma("unroll") for (int k = 0; k < 2; ++k) dst##b16[n][k] = *(const LAS bf16x8*)(lds + PG8_SB(b, h) + boff + n * 2048 + k * 1024); } } } while (0)
#define PG8_MMA(ai, bj, At, Bt) do { __builtin_amdgcn_s_setprio(1); _Pragma("unroll") for (int m = 0; m < 4; ++m) _Pragma("unroll") for (int n = 0; n < 2; ++n) { \
        if constexpr (F8) { acc[ai][bj][m][n] = __builtin_amdgcn_mfma_scale_f32_16x16x128_f8f6f4(Bt[n], At[m], acc[ai][bj][m][n], 0, 0, 0, 0x7f7f7f7f, 0, 0x7f7f7f7f); } \
        else { _Pragma("unroll") for (int k = 0; k < 2; ++k) acc[ai][bj][m][n] = __builtin_amdgcn_mfma_f32_16x16x32_bf16(Bt##b16[n][k], At##b16[m][k], acc[ai][bj][m][n], 0, 0, 0); } } __builtin_amdgcn_s_setprio(0); } while (0)
#define PG8_WAIT_V(n) asm volatile("s_waitcnt vmcnt(" #n ")" ::: "memory")
#define PG8_WAIT_L(n) asm volatile("s_waitcnt lgkmcnt(" #n ")" ::: "memory")
#define PG8_BAR __builtin_amdgcn_s_barrier()
#define PG8_SCHED __builtin_amdgcn_sched_barrier(0)
    Unit cur, nxt; int ui = 0;
    if (!S.next(0, cur)) return;
    f32x4 acc[2][2][4][2];
    { float z0 = 0.f; asm volatile("" : "+v"(z0));
#pragma unroll
    for (int a = 0; a < 2; ++a)
#pragma unroll
        for (int b = 0; b < 2; ++b)
#pragma unroll
            for (int m = 0; m < 4; ++m)
#pragma unroll
                for (int n = 0; n < 2; ++n) acc[a][b][m][n] = (f32x4){z0, z0, z0, z0}; }
    bf16x8 Atb16[F8 ? 1 : 4][2], B0b16[F8 ? 1 : 2][2], B1b16[F8 ? 1 : 2][2]; i32x8 At[F8 ? 4 : 1], B0[F8 ? 2 : 1], B1[F8 ? 2 : 1]; (void)Atb16; (void)B0b16; (void)B1b16; (void)At; (void)B0; (void)B1;
    unsigned cOff0[2], cOff1[2];
#define PG8_ROWS(u) do { if constexpr (GATHER) { _Pragma("unroll") for (int _i = 0; _i < 2; ++_i) { int R_, C_; stage_rc(tid * 16 + _i * 8192, R_, C_); cOff0[_i] = S.a_off(u, R_) + voffA[_i]; cOff1[_i] = S.a_off(u, HALF + R_) + voffA[_i]; } } } while (0)
#define PG8_STAGE_A(bufoff, h, ptr) do { if constexpr (GATHER) { if ((h) == 0) PG8_STAGE(bufoff, ptr, cOff0); else PG8_STAGE(bufoff, ptr, cOff1); } else { PG8_STAGE(bufoff, (ptr) + (h) * hstep, voffA); } } while (0)
    const char* cA = Abase; if constexpr (!GATHER) cA = Abase + S.a_base(cur);
    PG8_ROWS(cur);
    const char* cB = S.b_base(cur);
    S.a_ready(cur);
    {
        PG8_STAGE(PG8_SB(0, 0), cB, voffB); PG8_STAGE(PG8_SB(0, 1), cB + hstep, voffB); PG8_STAGE_A(PG8_SA(0, 0), 0, cA); PG8_STAGE_A(PG8_SA(0, 1), 1, cA);
        if (wr == 1) PG8_BAR;
        PG8_WAIT_V(2); PG8_BAR;
        PG8_STAGE(PG8_SB(1, 0), cB + kstep, voffB); PG8_STAGE_A(PG8_SA(1, 0), 0, cA + kstep); PG8_STAGE(PG8_SB(1, 1), cB + hstep + kstep, voffB);
        PG8_WAIT_V(6); PG8_BAR;
    }
    for (;;) {
        const bool has_next = S.next(ui + 1, nxt);
        unsigned nOff0[2] = {0u, 0u}, nOff1[2] = {0u, 0u};
        if constexpr (GATHER) { if (has_next) { _Pragma("unroll") for (int _i = 0; _i < 2; ++_i) { int R_, C_; stage_rc(tid * 16 + _i * 8192, R_, C_); nOff0[_i] = S.a_off(nxt, R_); nOff1[_i] = S.a_off(nxt, HALF + R_); } } }
        const char* nA = cA; if constexpr (!GATHER) { if (has_next) nA = Abase + S.a_base(nxt); }
        const char* nB = has_next ? S.b_base(nxt) : cB;
#pragma nounroll
        for (int t = 0; t < nt; t += 2) {
            const bool last = (t == nt - 2);
            const char* a1 = cA + (size_t)(t + 1) * kstep;
            const char* a2 = last ? nA : cA + (size_t)(t + 2) * kstep; const char* b2 = last ? nB : cB + (size_t)(t + 2) * kstep;
            const char* a3 = a2 + kstep; const char* b3 = b2 + kstep;
            if (last && has_next) S.a_ready(nxt);
            if constexpr (SP2) {
            PG8_LDB(B0, 0, 0); PG8_LDB(B1, 0, 1); PG8_SCHED; PG8_LDA(At, 0, 0); PG8_STAGE_A(PG8_SA(1, 1), 1, a1);
            if constexpr (GATHER) { if (last && has_next) { _Pragma("unroll") for (int _i = 0; _i < 2; ++_i) { cOff0[_i] = nOff0[_i] + voffA[_i]; cOff1[_i] = nOff1[_i] + voffA[_i]; } } }
            PG8_WAIT_V(8); PG8_WAIT_L(0); PG8_BAR; PG8_MMA(0, 0, At, B0); PG8_MMA(0, 1, At, B1); PG8_BAR; PG8_SCHED;
            PG8_LDA(At, 0, 1); PG8_STAGE(PG8_SB(0, 0), b2, voffB); PG8_STAGE(PG8_SB(0, 1), b2 + hstep, voffB); PG8_STAGE_A(PG8_SA(0, 0), 0, a2);
            PG8_WAIT_V(8); PG8_WAIT_L(0); PG8_BAR; PG8_MMA(1, 0, At, B0); PG8_MMA(1, 1, At, B1); PG8_BAR; PG8_SCHED;
            PG8_LDB(B0, 1, 0); PG8_LDB(B1, 1, 1); PG8_SCHED; PG8_LDA(At, 1, 0); PG8_STAGE_A(PG8_SA(0, 1), 1, a2);
            PG8_WAIT_V(8); PG8_WAIT_L(0); PG8_BAR; PG8_MMA(0, 0, At, B0); PG8_MMA(0, 1, At, B1); PG8_BAR; PG8_SCHED;
            PG8_LDA(At, 1, 1); PG8_STAGE(PG8_SB(1, 0), b3, voffB); PG8_STAGE(PG8_SB(1, 1), b3 + hstep, voffB); PG8_STAGE_A(PG8_SA(1, 0), 0, a3);
            PG8_WAIT_V(8); PG8_WAIT_L(0); PG8_BAR; PG8_MMA(1, 0, At, B0); PG8_MMA(1, 1, At, B1); PG8_BAR; PG8_SCHED;
            } else { static_assert(SP2, "only the two-super-phase loop is kept"); }
        }
        if constexpr (ALIGN_EPI) { if (wr == 0) PG8_BAR; }
        E(acc, cur, wr, wc, fr, fq); S.done(cur);
        if (!has_next) break;
        { float z0 = 0.f; asm volatile("" : "+v"(z0));
#pragma unroll
        for (int a = 0; a < 2; ++a)
#pragma unroll
            for (int b = 0; b < 2; ++b)
#pragma unroll
                for (int m = 0; m < 4; ++m)
#pragma unroll
                    for (int n = 0; n < 2; ++n) acc[a][b][m][n] = (f32x4){z0, z0, z0, z0}; }
        cur = nxt; cA = nA; cB = nB; ++ui;
        if constexpr (ALIGN_EPI) { if (wr == 1) PG8_BAR; }
    }
    PG8_WAIT_V(0);
    if constexpr (!ALIGN_EPI) { if (wr == 0) PG8_BAR; }
    PG8_BAR;
#undef PG8_SA
#undef PG8_SB
#undef PG8_STAGE
#undef PG8_STAGE_A
#undef PG8_ROWS
#undef PG8_LDA
#undef PG8_LDB
#undef PG8_MMA
#undef PG8_WAIT_V
#undef PG8_WAIT_L
#undef PG8_BAR
#undef PG8_SCHED
}
}

namespace pg8 {
__device__ __forceinline__ u32x4 pack8(const f32x4 v0, const f32x4 v1) { u32x4 w; w.x = cvt_pk_bf16(v0[0], v0[1]); w.y = cvt_pk_bf16(v0[2], v0[3]); w.z = cvt_pk_bf16(v1[0], v1[1]); w.w = cvt_pk_bf16(v1[2], v1[3]); return w; }

__device__ __forceinline__ unsigned pk4_fp8(float a, float b, float c, float d) {
    a = __builtin_amdgcn_fmed3f(a, -448.f, 448.f); b = __builtin_amdgcn_fmed3f(b, -448.f, 448.f); c = __builtin_amdgcn_fmed3f(c, -448.f, 448.f); d = __builtin_amdgcn_fmed3f(d, -448.f, 448.f);
    unsigned r = 0u; r = (unsigned)__builtin_amdgcn_cvt_pk_fp8_f32(a, b, (int)r, false); r = (unsigned)__builtin_amdgcn_cvt_pk_fp8_f32(c, d, (int)r, true); return r; }
__device__ __forceinline__ u32x2 pack8_fp8(const f32x4 v0, const f32x4 v1) { u32x2 w; w.x = pk4_fp8(v0[0], v0[1], v0[2], v0[3]); w.y = pk4_fp8(v1[0], v1[1], v1[2], v1[3]); return w; }
constexpr float F8_ASC = 16.f, F8_WGU = 64.f, F8_HSC = 8.f, F8_WDN = 256.f;
struct EpiIn {
    static constexpr bool PERM = true;
    bf16 *Q, *Kb, *V, *QI, *KI, *U; float* WI; int pn_off; float dsc; int glu_from;
    __device__ __forceinline__ void operator()(const f32x4 (&acc)[2][2][4][2], const Unit& u, int wr, int wc, int fr, int fq) const {
        const int row0 = u.pm * BM + wr * 64 + fr; const int pn = (u.pn >= glu_from) ? u.pn - glu_from + 9 : u.pn + pn_off;
        if (pn < 2) {
            const float sc = QSCALE * dsc;
            const int col0 = (pn & 1) * 256 + wc * 32 + 8 * fq;
#pragma unroll
            for (int ai = 0; ai < 2; ++ai)
#pragma unroll
                for (int m = 0; m < 4; ++m) { bf16* rowp = Q + (size_t)(row0 + ai * HALF + m * 16) * AW + col0;
#pragma unroll
                    for (int bj = 0; bj < 2; ++bj) *(u32x4*)(rowp + bj * HALF) = pack8(acc[ai][bj][m][0] * sc, acc[ai][bj][m][1] * sc); }
        } else if (pn >= 6 && pn < 8) {
#pragma unroll
            for (int ai = 0; ai < 2; ++ai)
#pragma unroll
                for (int m = 0; m < 4; ++m) { const int t = row0 + ai * HALF + m * 16, u4 = t >> 2, q = t & 3;
#pragma unroll
                    for (int bj = 0; bj < 2; ++bj) { const int col = (pn & 1) * 256 + bj * HALF + wc * 32 + 8 * fq, h = col >> 6, d0 = col & 63, ks = d0 >> 4, kg = (d0 >> 3) & 1;
                        const int arr = (q & 1) * 8 + h, am = (arr & 3) | ((q >> 1) << 2) | ((arr >> 2) << 3);
                        *(u32x4*)(QI + ((size_t)(u4 * 4 + ks) * 2 + kg) * 256 + am * 8) = pack8(acc[ai][bj][m][0] * dsc, acc[ai][bj][m][1] * dsc); } }
        } else if (pn < 6) {
            const bool isK = pn < 4; bf16* base = isK ? Kb : V;
#pragma unroll
            for (int ai = 0; ai < 2; ++ai)
#pragma unroll
                for (int m = 0; m < 4; ++m) { const int row = row0 + ai * HALF + m * 16, bb = row >> 12, t = row & 4095, tile = t >> 6, r = t & 63;
#pragma unroll
                    for (int bj = 0; bj < 2; ++bj) { const int col = (pn & 1) * 256 + bj * HALF + wc * 32 + 8 * fq, h = col >> 6, d = col & 63;
                        const size_t tb = ((size_t)((bb * NH + h) * 64 + tile)) * 4096;
                        const size_t off = isK ? tb + (d >> 3) * 512 + r * 8 : tb + (d >> 5) * 2048 + r * 32 + (d & 31);
                        *(u32x4*)(base + off) = pack8(acc[ai][bj][m][0] * dsc, acc[ai][bj][m][1] * dsc); } }
        } else if (pn == 8) {
#pragma unroll
            for (int ai = 0; ai < 2; ++ai)
#pragma unroll
                for (int m = 0; m < 4; ++m) { const size_t row = (size_t)(row0 + ai * HALF + m * 16);
                    if (wc < 2) { const int c8 = wc * 4 + fq;
                        *(u32x4*)(KI + (row >> 5) * 2048 + (c8 >> 1) * 512 + (c8 & 1) * 256 + (row & 31) * 8) = pack8(acc[ai][0][m][0] * dsc, acc[ai][0][m][1] * dsc); }
                    else if (wc == 2 && fq == 0) { *(f32x4*)(WI + row * 8) = acc[ai][0][m][0] * dsc; *(f32x4*)(WI + row * 8 + 4) = acc[ai][0][m][1] * dsc; } }
        } else {
            const int col0 = (pn - 9) * 128 + wc * 32 + 8 * fq;
#pragma unroll
            for (int ai = 0; ai < 2; ++ai)
#pragma unroll
                for (int m = 0; m < 4; ++m) { f32x4 o[2];
#pragma unroll
                    for (int n = 0; n < 2; ++n) { const f32x4 a = acc[ai][0][m][n], g = acc[ai][1][m][n];
#pragma unroll
                        for (int e = 0; e < 4; ++e) o[n][e] = a[e] * dsc * fsigmoid(g[e] * dsc); }
                    *(u32x4*)(U + (size_t)(row0 + ai * HALF + m * 16) * CCH + col0) = pack8(o[0], o[1]); }
        }
    }
};
struct EpiBranch {
    static constexpr bool PERM = true;
    bf16* out; float asc;
    __device__ __forceinline__ void operator()(const f32x4 (&acc)[2][2][4][2], const Unit& u, int wr, int wc, int fr, int fq) const {
        const int row0 = u.pm * BM + wr * 64 + fr, col0 = u.pn * BM + wc * 32 + 8 * fq;
#pragma unroll
        for (int ai = 0; ai < 2; ++ai)
#pragma unroll
            for (int m = 0; m < 4; ++m) { bf16* rowp = out + (size_t)(row0 + ai * HALF + m * 16) * DM + col0;
#pragma unroll
                for (int bj = 0; bj < 2; ++bj) *(u32x4*)(rowp + bj * HALF) = pack8(acc[ai][bj][m][0] * asc, acc[ai][bj][m][1] * asc); }
    }
};
struct EpiSwi {
    static constexpr bool PERM = true;
    unsigned char* H; int ldh;
    __device__ __forceinline__ void operator()(const f32x4 (&acc)[2][2][4][2], const Unit& u, int wr, int wc, int fr, int fq) const {
        const int row0 = u.pm * BM + wr * 64 + fr, col0 = u.pn * 128 + wc * 32 + 8 * fq;
        constexpr float ds = 1.0f / (F8_ASC * F8_WGU);
#pragma unroll
        for (int ai = 0; ai < 2; ++ai)
#pragma unroll
            for (int m = 0; m < 4; ++m) { f32x4 o[2];
#pragma unroll
                for (int n = 0; n < 2; ++n) { const f32x4 ga = acc[ai][0][m][n], ua = acc[ai][1][m][n];
#pragma unroll
                    for (int e = 0; e < 4; ++e) o[n][e] = (ga[e] * ua[e]) * ((ds * ds * F8_HSC) * __builtin_amdgcn_rcpf(1.0f + __builtin_amdgcn_exp2f(ga[e] * (-ds * LOG2E)))); }
                *(u32x2*)(H + (size_t)(row0 + ai * HALF + m * 16) * ldh + col0) = pack8_fp8(o[0], o[1]); }
    }
};
struct EpiMoeDown {
    static constexpr bool PERM = true;
    bf16* Yd; int tlo;
    __device__ __forceinline__ void operator()(const f32x4 (&acc)[2][2][4][2], const Unit& u, int wr, int wc, int fr, int fq) const {
        const int row0 = (tlo + u.pm) * BM + wr * 64 + fr, col0 = u.pn * BM + wc * 32 + 8 * fq;
#pragma unroll
        for (int ai = 0; ai < 2; ++ai)
#pragma unroll
            for (int m = 0; m < 4; ++m) { const int row = row0 + ai * HALF + m * 16; const float gt = 1.0f / (F8_HSC * F8_WDN); bf16* rowp = Yd + (size_t)row * DM + col0;
#pragma unroll
                for (int bj = 0; bj < 2; ++bj) *(u32x4*)(rowp + bj * HALF) = pack8(acc[ai][bj][m][0] * gt, acc[ai][bj][m][1] * gt); }
    }
};
struct MoeGuOrder : OrderBase {
    static constexpr bool GATHER = true;
    const int* rowlist; const LAS int* texp; int tlo; const char* W; size_t estride;
    __device__ __forceinline__ size_t a_base(const Unit&) const { return 0; }
    __device__ __forceinline__ unsigned a_off(const Unit& u, int r) const { return (unsigned)rowlist[(tlo + u.pm) * BM + r] * (unsigned)DM; }
    __device__ __forceinline__ const char* b_base(const Unit& u) const { return W + (size_t)texp[tlo + u.pm] * estride + (size_t)u.pn * ((size_t)BM * DM); }
};
struct MoeDnOrder : OrderBase {
    static constexpr bool GATHER = true;
    const LAS int* texp; int tlo; const char* W; size_t estride;
    __device__ __forceinline__ size_t a_base(const Unit&) const { return 0; }
    __device__ __forceinline__ unsigned a_off(const Unit& u, int r) const { return (unsigned)(u.pm * BM + r) * (unsigned)DFE; }
    __device__ __forceinline__ const char* b_base(const Unit& u) const { return W + (size_t)texp[tlo + u.pm] * estride + (size_t)u.pn * ((size_t)BM * DFE); }
};
constexpr int MOE_T0 = 256, MOE_KSL = 512, MOE_NSL = DFE / MOE_KSL, MOE_TAILROWS = (MAXT - MOE_T0) * BM;
static_assert(MOE_NSL * MOE_KSL == DFE, "K slices of the tail tiles");
struct MoeDnTailOrder : OrderBase {
    static constexpr bool GATHER = true;
    const LAS int* texp; const char* W; size_t estride;
    __device__ __forceinline__ size_t a_base(const Unit&) const { return 0; }
    __device__ __forceinline__ unsigned a_off(const Unit& u, int r) const { return (unsigned)((MOE_T0 + u.pm) * BM + r) * (unsigned)DFE + (unsigned)(u.pn >> 2) * (unsigned)MOE_KSL; }
    __device__ __forceinline__ const char* b_base(const Unit& u) const { return W + (size_t)texp[MOE_T0 + u.pm] * estride + (size_t)(u.pn & 3) * ((size_t)BM * DFE) + (size_t)(u.pn >> 2) * MOE_KSL; }
};
struct EpiMoeDownPart {
    static constexpr bool PERM = true;
    bf16* P;
    __device__ __forceinline__ void operator()(const f32x4 (&acc)[2][2][4][2], const Unit& u, int wr, int wc, int fr, int fq) const {
        const int row0 = u.pm * BM + wr * 64 + fr, col0 = (u.pn & 3) * BM + wc * 32 + 8 * fq, ks = u.pn >> 2;
#pragma unroll
        for (int ai = 0; ai < 2; ++ai)
#pragma unroll
            for (int m = 0; m < 4; ++m) { const int row = row0 + ai * HALF + m * 16; const float gt = 1.0f / (F8_HSC * F8_WDN); bf16* rowp = P + ((size_t)ks * MOE_TAILROWS + row) * DM + col0;
#pragma unroll
                for (int bj = 0; bj < 2; ++bj) *(u32x4*)(rowp + bj * HALF) = pack8(acc[ai][bj][m][0] * gt, acc[ai][bj][m][1] * gt); }
    }
};
}

typedef GAS unsigned gu32;
#define RLX_AGENT __ATOMIC_RELAXED, __HIP_MEMORY_SCOPE_AGENT
#define XB_TMO      128
#define XB_XCNT(j)  (256  + 64 * (j))
#define XB_XSUB(j)  (1280 + 64 * (j))
#define XB_XGEN(j)  (2304 + 64 * (j))
#define XB_TOP      3328
#define XB_TOPGEN   3392
#define XCD_BAR_WORDS 3456
#define XB_SPIN_CAP (1u << 18)

__device__ __forceinline__ unsigned xb_ld(unsigned* p)              { return __hip_atomic_load(p, __ATOMIC_RELAXED, __HIP_MEMORY_SCOPE_AGENT); }
__device__ __forceinline__ unsigned xb_add(unsigned* p, unsigned v) { return __hip_atomic_fetch_add(p, v, __ATOMIC_RELAXED, __HIP_MEMORY_SCOPE_AGENT); }
__device__ __forceinline__ unsigned xb_xcc_id() { return (unsigned)__builtin_amdgcn_s_getreg((3 << 11) | 20) & 0xFu; }
#define XB_SPIN(cond, bar) do { unsigned _sp = 0; while (cond) { __builtin_amdgcn_s_sleep(1); \
    if ((++_sp & 255u) == 0u) { if (xb_ld(&(bar)[XB_TMO])) break; if (_sp > XB_SPIN_CAP) { atomicAdd(&(bar)[XB_TMO], 1u); break; } } } } while (0)

struct XcdBarrier {
    unsigned* bar; unsigned x;
    volatile LAS unsigned* st;
};
__device__ __forceinline__ XcdBarrier xcd_barrier_post(unsigned* bar, volatile LAS unsigned* st) {
    XcdBarrier b; b.bar = bar; b.x = xb_xcc_id(); b.st = st;
    if (threadIdx.x == 0) (void)xb_add(&bar[XB_XCNT(b.x)], 1u);
    return b;
}
__device__ __forceinline__ void xcd_barrier_complete(unsigned* bar, unsigned x, unsigned& nloc, unsigned& nx) {
    const unsigned G = gridDim.x * gridDim.y * gridDim.z;
    unsigned sum, cnt, mine, sp = 0u;
    for (;;) {
        sum = 0u; cnt = 0u; mine = 0u;
#pragma unroll
        for (unsigned j = 0; j < 16; ++j) { const unsigned c = xb_ld(&bar[XB_XCNT(j)]); sum += c; cnt += (c > 0u) ? 1u : 0u; mine = (j == x) ? c : mine; }
        if (sum == G) break;
        __builtin_amdgcn_s_sleep(1);
        if ((++sp & 255u) == 0u) { if (xb_ld(&bar[XB_TMO])) break; if (sp > XB_SPIN_CAP) { atomicAdd(&bar[XB_TMO], 1u); break; } }
    }
    nloc = mine > 0u ? mine : 1u; nx = cnt > 0u ? cnt : 1u;
}
__device__ __forceinline__ void xcd_barrier(const XcdBarrier& b) {
    asm volatile("s_waitcnt vmcnt(0)" ::: "memory");
    __syncthreads();
    if (threadIdx.x == 0) {
        unsigned* bar = b.bar;
        __builtin_amdgcn_s_waitcnt(0);
        unsigned nloc = b.st[0], nx = b.st[1];
        if (nloc == 0u) { xcd_barrier_complete(bar, b.x, nloc, nx); b.st[0] = nloc; b.st[1] = nx; }
        const unsigned old = xb_add(&bar[XB_XSUB(b.x)], 1u);
        const unsigned gen = old / nloc;
        if (old + 1u == (gen + 1u) * nloc) {
            __builtin_amdgcn_fence(__ATOMIC_RELEASE, "agent");
            asm volatile("s_waitcnt vmcnt(0)" ::: "memory");
            const unsigned og = xb_add(&bar[XB_TOP], 1u);
            const unsigned tg = og / nx;
            if (og + 1u == (tg + 1u) * nx) xb_add(&bar[XB_TOPGEN], 1u);
            else XB_SPIN(xb_ld(&bar[XB_TOPGEN]) == tg, bar);
            __builtin_amdgcn_fence(__ATOMIC_ACQUIRE, "agent");
            xb_add(&bar[XB_XGEN(b.x)], 1u);
            asm volatile("s_waitcnt vmcnt(0)" ::: "memory");
        } else {
            XB_SPIN(xb_ld(&bar[XB_XGEN(b.x)]) == gen, bar);
            __builtin_amdgcn_fence(__ATOMIC_ACQUIRE, "agent");
            asm volatile("s_waitcnt vmcnt(0)" ::: "memory");
        }
    }
    __syncthreads();
}

struct Frame {
    LAS unsigned char* lds;
    int tid, lane, wave, vcu, G;
    unsigned char* ws;
};
__device__ __forceinline__ const float* arg_in(int k) { return (const float*)*(const GAS float* const volatile CAS*)((const CAS char*)__builtin_amdgcn_kernarg_segment_ptr() + 8 * k); }
__device__ __forceinline__ float* arg_out() { return (float*)*(GAS float* const volatile CAS*)((const CAS char*)__builtin_amdgcn_kernarg_segment_ptr() + 160); }
#define WSP(T, off) ((T*)(F.ws + (off)))
__device__ __forceinline__ Frame fresh(const Frame& F0) {
    Frame F = F0; int wv = F0.wave, v = F0.vcu, g = F0.G; asm volatile("" : "+s"(wv), "+s"(v), "+s"(g)); F.wave = wv; F.vcu = v; F.G = g;
    int ln; asm volatile("v_mbcnt_lo_u32_b32 %0, -1, 0\n\tv_mbcnt_hi_u32_b32 %0, -1, %0" : "=v"(ln)); F.lane = ln; F.tid = wv * 64 + ln;
    GAS unsigned char* w = (GAS unsigned char*)F0.ws; asm volatile("" : "+s"(w)); F.ws = (unsigned char*)w;
    return F;
}

__device__ __forceinline__ float wave_sum(float v) {
#define WS_DPP(x, ctrl) __int_as_float(__builtin_amdgcn_update_dpp(0, __float_as_int(x), (ctrl), 0xf, 0xf, false))
    v += WS_DPP(v, 0xB1); v += WS_DPP(v, 0x4E); v += WS_DPP(v, 0x141); v += WS_DPP(v, 0x140);
#undef WS_DPP
    const float r0 = __int_as_float(__builtin_amdgcn_readlane(__float_as_int(v), 0)), r1 = __int_as_float(__builtin_amdgcn_readlane(__float_as_int(v), 16)),
                r2 = __int_as_float(__builtin_amdgcn_readlane(__float_as_int(v), 32)), r3 = __int_as_float(__builtin_amdgcn_readlane(__float_as_int(v), 48));
    return (r0 + r1) + (r2 + r3);
}

struct TrItem { const float* W; int ldw, c0, nv, k0; void* WT; int Kd, r0; float scale; bool fp8; };
__device__ __forceinline__ void tr_load(const TrItem& t, f32x4 (&v)[16], int lane) {
    const int n4 = 4 * (lane & 15); const int nc = n4 < t.nv ? n4 : 0;
    const float* src = t.W + (size_t)(t.k0 + (lane >> 4)) * t.ldw + t.c0 + nc;
#pragma unroll
    for (int i = 0; i < 16; ++i) v[i] = *(const f32x4*)(src + (size_t)(4 * i) * t.ldw);
}
__device__ __forceinline__ void tr_to_lds(const TrItem& t, const f32x4 (&v)[16], LAS float* scr, int lane) {
    const int n4 = 4 * (lane & 15); const float ok = n4 < t.nv ? 1.f : 0.f;
#pragma unroll
    for (int i = 0; i < 16; ++i) { LAS float* d = scr + (4 * i + (lane >> 4)) * 65 + n4; d[0] = v[i][0] * ok; d[1] = v[i][1] * ok; d[2] = v[i][2] * ok; d[3] = v[i][3] * ok; }
}
__device__ __forceinline__ void tr_from_lds(const TrItem& t, LAS float* scr, int lane) {
    LDS_WAIT(); asm volatile("" ::: "memory");
    const int c = lane & 7; const float scale = t.scale;
    if (t.fp8) {
#pragma unroll
        for (int j = 0; j < 8; ++j) { const int nn = (lane >> 3) + 8 * j; const LAS float* s = scr + (8 * c) * 65 + nn;
            u32x2 o; o.x = pg8::pk4_fp8(s[0 * 65] * scale, s[1 * 65] * scale, s[2 * 65] * scale, s[3 * 65] * scale); o.y = pg8::pk4_fp8(s[4 * 65] * scale, s[5 * 65] * scale, s[6 * 65] * scale, s[7 * 65] * scale);
            *(u32x2*)((unsigned char*)t.WT + (size_t)(t.r0 + nn) * t.Kd + t.k0 + 8 * c) = o; }
    } else {
#pragma unroll
        for (int j = 0; j < 8; ++j) { const int nn = (lane >> 3) + 8 * j; const LAS float* s = scr + (8 * c) * 65 + nn;
            u32x4 o; o.x = cvt_pk_bf16(s[0 * 65], s[1 * 65]); o.y = cvt_pk_bf16(s[2 * 65], s[3 * 65]); o.z = cvt_pk_bf16(s[4 * 65], s[5 * 65]); o.w = cvt_pk_bf16(s[6 * 65], s[7 * 65]);
            *(u32x4*)((bf16*)t.WT + (size_t)(t.r0 + nn) * t.Kd + t.k0 + 8 * c) = o; }
    }
    LDS_WAIT(); asm volatile("" ::: "memory");
}
template <class Dec> __device__ __forceinline__ void tr_loop(const Dec& dec, int nitems, int gw, int NGW, LAS float* scr, int lane) {
    int i0 = gw; if (i0 >= nitems) return;
    int i1 = i0 + NGW;
    f32x4 va[16], vb[16];
    TrItem c0 = dec(i0); tr_load(c0, va, lane);
    TrItem c1 = dec(i1 < nitems ? i1 : i0); tr_load(c1, vb, lane);
    for (;;) {
        tr_to_lds(c0, va, scr, lane);
        const int j0 = i1 + NGW; const TrItem n0 = dec(j0 < nitems ? j0 : i0); tr_load(n0, va, lane);
        tr_from_lds(c0, scr, lane);
        if (i1 >= nitems) break;
        tr_to_lds(c1, vb, scr, lane);
        const int j1 = j0 + NGW; const TrItem n1 = dec(j1 < nitems ? j1 : i0); tr_load(n1, vb, lane);
        tr_from_lds(c1, scr, lane);
        if (j0 >= nitems) break;
        c0 = n0; c1 = n1; i0 = j0; i1 = j1;
    }
}

__device__ __forceinline__ void convert_weights(Frame& F, int l) {
    LAS float* scr = (LAS float*)(F.lds + RING_OFF + F.wave * 16640);
    const int gw = F.vcu * NWAVES + F.wave, NGW = F.G * NWAVES, lane = F.lane;
    bf16* WinT = WSP(bf16, WS_WIN); bf16* WoutT = WSP(bf16, WS_WOUT);
    const float* w_in = arg_in(1) + (size_t)l * DM * IN_COLS;
    const float* w_out = arg_in(8) + (size_t)l * DM * DM;
    constexpr int I_IN = (NIN / 64) * 16, I_OUT = 16 * 16;
    tr_loop([=](int it) __attribute__((always_inline)) -> TrItem {
        if (it < I_IN) {
            const int nb = it >> 4, kb = it & 15; int c0 = 0, nv = 64;
            if (nb < 33) c0 = 64 * nb;
            else if (nb == 33) { c0 = OFF_WI; nv = 8; }
            else if (nb < 36) { nv = 0; }
            else { const int rr = 64 * (nb - 36), p = rr >> 8, w = rr & 255; c0 = (w < 128) ? (OFF_GLU + 128 * p + w) : (OFF_GLU + CCH + 128 * p + (w - 128)); }
            if (nb < 24) return TrItem{w_in, IN_COLS, c0, nv, 64 * kb, WinT, DM, 64 * nb, pg8::F8_WGU, true};
            if (nb >= 36) return TrItem{w_in, IN_COLS, c0, nv, 64 * kb, WinT, DM, 64 * (nb - 12), pg8::F8_WGU, true};
            return TrItem{w_in, IN_COLS, c0, nv, 64 * kb, WinT, DM, 64 * nb, 1.f, false};
        }
        const int r = it - I_IN, nb = r >> 4, kb = r & 15; return TrItem{w_out, DM, 64 * nb, 64, 64 * kb, WoutT, DM, 64 * nb, 1.f, false};
    }, I_IN + I_OUT, gw, NGW, scr, lane);
}

constexpr int CONV_ATTN_SCR = 84992, CONV_ATTN_WAVE = 32 * 65 * 4;
static_assert(CONV_ATTN_SCR + NWAVES * CONV_ATTN_WAVE <= LDSCTL_OFF, "conversion tiles of the attention phase");
__device__ __forceinline__ void tr32_load(const TrItem& t, f32x4 (&v)[8], int lane) {
    const int n4 = 4 * (lane & 15); const int nc = n4 < t.nv ? n4 : 0;
    const float* src = t.W + (size_t)(t.k0 + (lane >> 4)) * t.ldw + t.c0 + nc;
#pragma unroll
    for (int i = 0; i < 8; ++i) v[i] = *(const f32x4*)(src + (size_t)(4 * i) * t.ldw);
}
__device__ __forceinline__ void tr32_to_lds(const TrItem& t, const f32x4 (&v)[8], LAS float* scr, int lane) {
    const int n4 = 4 * (lane & 15); const float ok = n4 < t.nv ? 1.f : 0.f;
#pragma unroll
    for (int i = 0; i < 8; ++i) { LAS float* d = scr + (4 * i + (lane >> 4)) * 65 + n4; d[0] = v[i][0] * ok; d[1] = v[i][1] * ok; d[2] = v[i][2] * ok; d[3] = v[i][3] * ok; }
}
__device__ __forceinline__ void tr32_from_lds(const TrItem& t, LAS float* scr, int lane) {
    LDS_WAIT(); asm volatile("" ::: "memory");
    const int c = lane & 3; const float scale = t.scale;
#pragma unroll
    for (int j = 0; j < 4; ++j) { const int nn = (lane >> 2) + 16 * j; const LAS float* s = scr + (8 * c) * 65 + nn;
        u32x2 o; o.x = pg8::pk4_fp8(s[0 * 65] * scale, s[1 * 65] * scale, s[2 * 65] * scale, s[3 * 65] * scale); o.y = pg8::pk4_fp8(s[4 * 65] * scale, s[5 * 65] * scale, s[6 * 65] * scale, s[7 * 65] * scale);
        *(u32x2*)((unsigned char*)t.WT + (size_t)(t.r0 + nn) * t.Kd + t.k0 + 8 * c) = o; }
    LDS_WAIT(); asm volatile("" ::: "memory");
}
template <class Dec> __device__ __forceinline__ void tr32_loop(const Dec& dec, int nitems, int gw, int NGW, LAS float* scr, int lane) {
    int i0 = gw; if (i0 >= nitems) return;
    int i1 = i0 + NGW;
    f32x4 va[8], vb[8];
    TrItem c0 = dec(i0); tr32_load(c0, va, lane);
    TrItem c1 = dec(i1 < nitems ? i1 : i0); tr32_load(c1, vb, lane);
    for (;;) {
        tr32_to_lds(c0, va, scr, lane);
        const int j0 = i1 + NGW; const TrItem n0 = dec(j0 < nitems ? j0 : i0); tr32_load(n0, va, lane);
        tr32_from_lds(c0, scr, lane);
        if (i1 >= nitems) break;
        tr32_to_lds(c1, vb, scr, lane);
        const int j1 = j0 + NGW; const TrItem n1 = dec(j1 < nitems ? j1 : i0); tr32_load(n1, vb, lane);
        tr32_from_lds(c1, scr, lane);
        if (j0 >= nitems) break;
        c0 = n0; c1 = n1; i0 = j0; i1 = j1;
    }
}
__device__ __forceinline__ void convert_ffn(Frame& F, int l) {
    LAS float* scr = (LAS float*)(F.lds + CONV_ATTN_SCR + F.wave * CONV_ATTN_WAVE);
    const int gw = F.vcu * NWAVES + F.wave, NGW = F.G * NWAVES, lane = F.lane;
    unsigned char* Wff = WSP(unsigned char, WS_WFF);
    const int d = l >> 1;
    if ((l & 1) == 0) {
        const float* wg = arg_in(13) + (size_t)d * DM * DFF; const float* wu = arg_in(14) + (size_t)d * DM * DFF; const float* wd = arg_in(15) + (size_t)d * DFF * DM;
        unsigned char* Wgu = Wff; unsigned char* Wdn = Wgu + (size_t)2 * DFF * DM;
        constexpr int I_GU = (2 * DFF / 64) * 32, KB_DN = DFF / 32, I_DN = 16 * KB_DN;
        const ptrdiff_t dgu = wu - wg;
        tr32_loop([=](int it) __attribute__((always_inline)) -> TrItem {
            if (it < I_GU) { const int nb = it >> 5, kb = it & 31, rr = 64 * nb, p = rr >> 8, w = rr & 255;
                return TrItem{wg + ((w < 128) ? (ptrdiff_t)0 : dgu), DFF, 128 * p + (w & 127), 64, 32 * kb, Wgu, DM, rr, pg8::F8_WGU, true}; }
            const int r = it - I_GU, nb = r / KB_DN, kb = r % KB_DN; return TrItem{wd, DM, 64 * nb, 64, 32 * kb, Wdn, DFF, 64 * nb, pg8::F8_WDN, true};
        }, I_GU + I_DN, gw, NGW, scr, lane);
    } else {
        constexpr int I_GU = (2 * DFE / 64) * 32, KB_DN = DFE / 32, I_DN = 16 * KB_DN, I_E = I_GU + I_DN;
        const float* wg0 = arg_in(17) + (size_t)d * NE * DM * DFE; const float* wu0 = arg_in(18) + (size_t)d * NE * DM * DFE; const float* wd0 = arg_in(19) + (size_t)d * NE * DFE * DM;
        const ptrdiff_t dgu = wu0 - wg0;
        tr32_loop([=](int it) __attribute__((always_inline)) -> TrItem {
            const int e = it / I_E, r0 = it % I_E;
            const float* wg = wg0 + (size_t)e * DM * DFE; const float* wd = wd0 + (size_t)e * DFE * DM;
            unsigned char* Wgu = Wff + (size_t)e * (3 * (size_t)DFE * DM); unsigned char* Wdn = Wgu + (size_t)2 * DFE * DM;
            if (r0 < I_GU) { const int nb = r0 >> 5, kb = r0 & 31, rr = 64 * nb, p = rr >> 8, w = rr & 255;
                return TrItem{wg + ((w < 128) ? (ptrdiff_t)0 : dgu), DFE, 128 * p + (w & 127), 64, 32 * kb, Wgu, DM, rr, pg8::F8_WGU, true}; }
            const int r = r0 - I_GU, nb = r / KB_DN, kb = r % KB_DN; return TrItem{wd, DM, 64 * nb, 64, 32 * kb, Wdn, DFE, 64 * nb, pg8::F8_WDN, true};
        }, NE * I_E, gw, NGW, scr, lane);
    }
    asm volatile("s_waitcnt vmcnt(0)" ::: "memory");
}

__device__ __forceinline__ void cvt_x(Frame& F) {
    const float* x = arg_in(0); bf16* XB = WSP(bf16, WS_XB); unsigned char* XQ = WSP(unsigned char, WS_XQ);
    const int gw = F.vcu * NWAVES + F.wave, NGW = F.G * NWAVES;
    f32x4 vn[4];
    { const f32x4* xr = (const f32x4*)(x + (size_t)gw * DM) + F.lane;
#pragma unroll
      for (int j = 0; j < 4; ++j) vn[j] = xr[64 * j]; }
    for (int m = gw; m < M; m += NGW) {
        f32x4 v[4];
#pragma unroll
        for (int j = 0; j < 4; ++j) v[j] = vn[j];
        { const int mn = (m + NGW < M) ? m + NGW : m; const f32x4* xr = (const f32x4*)(x + (size_t)mn * DM) + F.lane;
#pragma unroll
          for (int j = 0; j < 4; ++j) vn[j] = xr[64 * j]; }
        u32x2* o = (u32x2*)(XB + (size_t)m * DM) + F.lane; unsigned* o8 = (unsigned*)(XQ + (size_t)m * DM) + F.lane;
#pragma unroll
        for (int j = 0; j < 4; ++j) { u32x2 w; w.x = cvt_pk_bf16(v[j][0], v[j][1]); w.y = cvt_pk_bf16(v[j][2], v[j][3]); o[64 * j] = w;
            o8[64 * j] = pg8::pk4_fp8(v[j][0] * pg8::F8_ASC, v[j][1] * pg8::F8_ASC, v[j][2] * pg8::F8_ASC, v[j][3] * pg8::F8_ASC); }
    }
}

__device__ __forceinline__ void ln_load(const bf16* row, f32x4 (&v)[4], int lane) {
#pragma unroll
    for (int j = 0; j < 4; ++j) { const u32x2 a = ((const u32x2*)row)[lane + 64 * j]; v[j][0] = __uint_as_float(a.x << 16); v[j][1] = __uint_as_float(a.x & 0xffff0000u); v[j][2] = __uint_as_float(a.y << 16); v[j][3] = __uint_as_float(a.y & 0xffff0000u); }
}
template <bool FP8OUT> __device__ __forceinline__ void ln_finish(f32x4 (&v)[4], const f32x4 (&g)[4], const f32x4 (&bb)[4], bf16* brow, unsigned char* qrow, float* frow, int lane) {
    float s = 0.f;
#pragma unroll
    for (int j = 0; j < 4; ++j) s += (v[j][0] + v[j][1]) + (v[j][2] + v[j][3]);
    const float mean = wave_sum(s) * (1.f / DM); float s2 = 0.f;
#pragma unroll
    for (int j = 0; j < 4; ++j) { v[j] = v[j] - mean; s2 += (v[j][0] * v[j][0] + v[j][1] * v[j][1]) + (v[j][2] * v[j][2] + v[j][3] * v[j][3]); }
    const float rstd = 1.f / sqrtf(wave_sum(s2) * (1.f / DM) + LN_EPS);
#pragma unroll
    for (int j = 0; j < 4; ++j) { v[j] = v[j] * rstd * g[j] + bb[j];
        if constexpr (FP8OUT) { u32x2 w; w.x = cvt_pk_bf16(v[j][0], v[j][1]); w.y = cvt_pk_bf16(v[j][2], v[j][3]); ((u32x2*)brow)[lane + 64 * j] = w;
            ((unsigned*)qrow)[lane + 64 * j] = pg8::pk4_fp8(v[j][0] * pg8::F8_ASC, v[j][1] * pg8::F8_ASC, v[j][2] * pg8::F8_ASC, v[j][3] * pg8::F8_ASC); }
        else if (frow) ((f32x4*)frow)[lane + 64 * j] = v[j];
        else { u32x2 w; w.x = cvt_pk_bf16(v[j][0], v[j][1]); w.y = cvt_pk_bf16(v[j][2], v[j][3]); ((u32x2*)brow)[lane + 64 * j] = w;
               ((unsigned*)qrow)[lane + 64 * j] = pg8::pk4_fp8(v[j][0] * pg8::F8_ASC, v[j][1] * pg8::F8_ASC, v[j][2] * pg8::F8_ASC, v[j][3] * pg8::F8_ASC); } }
}

__device__ __forceinline__ void p_ln1(Frame& F, int l) {
    bf16* R1 = WSP(bf16, WS_R1); const bf16* XB = WSP(bf16, WS_XB);
    const bool moe = (l & 1) != 0;
    LAS int* cntL = (LAS int*)(F.lds + LDSCTL_OFF + 1152);
    if (F.tid < 8) cntL[F.tid] = 0;
    __syncthreads();
    f32x4 g[4], bb[4];
#pragma unroll
    for (int j = 0; j < 4; ++j) { g[j] = ((const f32x4*)(arg_in(9) + (size_t)l * DM))[F.lane + 64 * j]; bb[j] = ((const f32x4*)(arg_in(10) + (size_t)l * DM))[F.lane + 64 * j]; }
    const float* router = arg_in(16) + (size_t)(l >> 1) * DM * NE;
    u32x4* route = WSP(u32x4, WS_ROUTE);
    f32x4 rw[16][2];
    if (moe) {
        LAS unsigned char* rl = F.lds + RING_OFF;
#pragma unroll
        for (int i = 0; i < 4; ++i) { const int p = F.tid + NTHR * i, ch = p >> 3; *(LAS f32x4*)(rl + (ch >> 6) * 9216 + (ch & 63) * 144 + (p & 7) * 16) = ((const f32x4*)router)[p]; }
        __syncthreads();
#pragma unroll
        for (int j = 0; j < 4; ++j)
#pragma unroll
            for (int c = 0; c < 4; ++c) { const LAS f32x4* rp = (const LAS f32x4*)(rl + j * 9216 + F.lane * 144 + c * 32); rw[4 * j + c][0] = rp[0]; rw[4 * j + c][1] = rp[1]; }
    }
    unsigned char* X8 = WSP(unsigned char, WS_YD);
    f32x4 vn[4], xn[4]; ln_load(R1 + (size_t)(F.vcu * 128 + F.wave * 16) * DM, vn, F.lane); ln_load(XB + (size_t)(F.vcu * 128 + F.wave * 16) * DM, xn, F.lane);
    for (int i = 0; i < 16; ++i) {
        const int m = F.vcu * 128 + F.wave * 16 + i;
        f32x4 v[4];
#pragma unroll
        for (int j = 0; j < 4; ++j) v[j] = xn[j] * DN_ALPHA + vn[j];
        if (i + 1 < 16) { ln_load(R1 + (size_t)(m + 1) * DM, vn, F.lane); ln_load(XB + (size_t)(m + 1) * DM, xn, F.lane); }
        ln_finish<true>(v, g, bb, R1 + (size_t)m * DM, X8 + (size_t)m * DM, nullptr, F.lane);
        if (moe) {
            float lg[8];
#pragma unroll
            for (int e = 0; e < 8; ++e) lg[e] = 0.f;
#pragma unroll
            for (int j = 0; j < 4; ++j)
#pragma unroll
                for (int c = 0; c < 4; ++c) { const f32x4 r0 = rw[4 * j + c][0], r1 = rw[4 * j + c][1]; const float xv = v[j][c];
                    lg[0] += xv * r0[0]; lg[1] += xv * r0[1]; lg[2] += xv * r0[2]; lg[3] += xv * r0[3]; lg[4] += xv * r1[0]; lg[5] += xv * r1[1]; lg[6] += xv * r1[2]; lg[7] += xv * r1[3]; }
#pragma unroll
            for (int e = 0; e < 8; ++e) lg[e] = wave_sum(lg[e]);
            int e1 = 0; float v1 = lg[0];
#pragma unroll
            for (int e = 1; e < 8; ++e) if (lg[e] > v1) { v1 = lg[e]; e1 = e; }
            int e2 = -1; float v2 = -3.0e38f;
#pragma unroll
            for (int e = 0; e < 8; ++e) if (e != e1 && (e2 < 0 || lg[e] > v2)) { v2 = lg[e]; e2 = e; }
            const float g1 = 1.0f / (1.0f + __expf(v2 - v1)), g2 = 1.0f - g1;
            if (F.lane == 0) { u32x4 r; r.x = (unsigned)e1; r.y = (unsigned)e2; r.z = __float_as_uint(g1); r.w = __float_as_uint(g2); route[m] = r;
                __hip_atomic_fetch_add(cntL + e1, 1, __ATOMIC_RELAXED, __HIP_MEMORY_SCOPE_WORKGROUP); __hip_atomic_fetch_add(cntL + e2, 1, __ATOMIC_RELAXED, __HIP_MEMORY_SCOPE_WORKGROUP); }
        }
    }
    __syncthreads();
    if (moe && F.tid < 8) WSP(int, WS_CNTWG)[F.vcu * 8 + F.tid] = cntL[F.tid];
}

__device__ __forceinline__ void p_ln2(Frame& F, int l) {
    const bf16* R1 = WSP(bf16, WS_R1); bf16* XB = WSP(bf16, WS_XB); float* outp = (l == DEPTH - 1) ? arg_out() : nullptr;
    f32x4 g[4], bb[4];
#pragma unroll
    for (int j = 0; j < 4; ++j) { g[j] = ((const f32x4*)(arg_in(11) + (size_t)l * DM))[F.lane + 64 * j]; bb[j] = ((const f32x4*)(arg_in(12) + (size_t)l * DM))[F.lane + 64 * j]; }
    const bf16* Y = WSP(bf16, WS_YD);
    f32x4 vn[4], yn[4]; ln_load(R1 + (size_t)(F.vcu * 128 + F.wave * 16) * DM, vn, F.lane); ln_load(Y + (size_t)(F.vcu * 128 + F.wave * 16) * DM, yn, F.lane);
    for (int i = 0; i < 16; ++i) {
        const int m = F.vcu * 128 + F.wave * 16 + i;
        f32x4 v[4];
#pragma unroll
        for (int j = 0; j < 4; ++j) v[j] = vn[j] * DN_ALPHA + yn[j];
        if (i + 1 < 16) { ln_load(R1 + (size_t)(m + 1) * DM, vn, F.lane); ln_load(Y + (size_t)(m + 1) * DM, yn, F.lane); }
        ln_finish<false>(v, g, bb, XB + (size_t)m * DM, WSP(unsigned char, WS_XQ) + (size_t)m * DM, outp ? outp + (size_t)m * DM : nullptr, F.lane);
    }
}

__device__ __forceinline__ void moe_tables(Frame& F) {
    LAS int* texp = (LAS int*)(F.lds + LDSCTL_OFF);
    LAS int* tot = (LAS int*)(F.lds + LDSCTL_OFF + 1088);
    LAS int* tbase = (LAS int*)(F.lds + LDSCTL_OFF + 1200);
    const int* cnt = WSP(int, WS_CNTWG);
    LAS int* tmp = (LAS int*)(F.lds + AUX_OFF);
    __syncthreads();
    if (F.tid < 256) { typedef int i32x4_ __attribute__((ext_vector_type(4))); const i32x4_ a = ((const i32x4_*)cnt)[2 * F.tid], b = ((const i32x4_*)cnt)[2 * F.tid + 1];
        *(LAS i32x4_*)(tmp + 8 * F.tid) = a; *(LAS i32x4_*)(tmp + 8 * F.tid + 4) = b; }
    __syncthreads();
    if (F.tid < 8) { int t = 0, off = 0; for (int w = 0; w < 256; ++w) { const int c = tmp[w * 8 + F.tid]; if (w < F.vcu) off += c; t += c; } tot[F.tid] = t; tot[8 + F.tid] = off; }
    __syncthreads();
    if (F.tid == 0) { int b = 0; for (int e = 0; e < 8; ++e) { tbase[e] = b; b += (tot[e] + 255) >> 8; } tbase[8] = b; }
    __syncthreads();
    if (F.tid < MAXT) { int e = 0;
#pragma unroll
        for (int j = 1; j < 8; ++j) e += (F.tid >= tbase[j]) ? 1 : 0;
        texp[F.tid] = e; }
    __syncthreads();
}

__device__ __forceinline__ void p_list(Frame& F) {
    moe_tables(F);
    LAS int* tot = (LAS int*)(F.lds + LDSCTL_OFF + 1088); LAS int* tbase = (LAS int*)(F.lds + LDSCTL_OFF + 1200);
    const u32x4* route = WSP(u32x4, WS_ROUTE);
    int* rowlist = WSP(int, WS_ROWLIST); int* slotrow = WSP(int, WS_SLOTROW);
    if (F.wave == 0) {
        int run[8];
#pragma unroll
        for (int e = 0; e < 8; ++e) run[e] = tot[8 + e];
        for (int blk = 0; blk < 2; ++blk) {
            const int t = F.vcu * 128 + blk * 64 + F.lane; const u32x4 r = route[t]; const int e1 = (int)r.x, e2 = (int)r.y;
            int p1 = 0, p2 = 0;
            const unsigned long long lt = (1ull << F.lane) - 1ull;
#pragma unroll
            for (int e = 0; e < 8; ++e) { const unsigned long long mk = __ballot(e1 == e || e2 == e); const int rk = run[e] + __popcll(mk & lt); if (e1 == e) p1 = rk; if (e2 == e) p2 = rk; run[e] += __popcll(mk); }
            const int row1 = tbase[e1] * 256 + p1, row2 = tbase[e2] * 256 + p2;
            rowlist[row1] = t; rowlist[row2] = t;
            slotrow[2 * t] = row1; slotrow[2 * t + 1] = row2;
        }
    }
    if (F.vcu < 8) { const int e = F.vcu, mt = (tot[e] + 255) >> 8; for (int p = tot[e] + F.tid; p < mt * 256; p += NTHR) { rowlist[tbase[e] * 256 + p] = 0; } }
}

__device__ __forceinline__ void p_comb(Frame& F, int l) {
    const bf16* R1 = WSP(bf16, WS_R1); bf16* XB = WSP(bf16, WS_XB); const bf16* Yd = WSP(bf16, WS_YD); const int* slotrow = WSP(int, WS_SLOTROW); float* outp = (l == DEPTH - 1) ? arg_out() : nullptr;
    f32x4 g[4], bb[4];
#pragma unroll
    for (int j = 0; j < 4; ++j) { g[j] = ((const f32x4*)(arg_in(11) + (size_t)l * DM))[F.lane + 64 * j]; bb[j] = ((const f32x4*)(arg_in(12) + (size_t)l * DM))[F.lane + 64 * j]; }
    const int m0 = F.vcu * 128 + F.wave * 16;
    const int myslot = (F.lane < 32) ? slotrow[2 * m0 + F.lane] : 0;
    const u32x4 myroute = WSP(u32x4, WS_ROUTE)[m0 + (F.lane & 15)];
    f32x4 xn[4], an[4], bn[4];
    const bf16* Pt = WSP(bf16, WS_MASK);
#define COMB_ROW(r_, dst) do { if ((r_) < pg8::MOE_T0 * 256) ln_load(Yd + (size_t)(r_) * DM, dst, F.lane); \
        else { ln_load(Pt + (size_t)((r_) - pg8::MOE_T0 * 256) * DM, dst, F.lane); \
               for (int ks_ = 1; ks_ < pg8::MOE_NSL; ++ks_) { f32x4 t_[4]; ln_load(Pt + ((size_t)ks_ * pg8::MOE_TAILROWS + ((r_) - pg8::MOE_T0 * 256)) * DM, t_, F.lane); _Pragma("unroll") for (int j_ = 0; j_ < 4; ++j_) dst[j_] += t_[j_]; } } } while (0)
#define COMB_LOAD(i_) do { const int ra_ = __builtin_amdgcn_readlane(myslot, 2 * (i_)), rb_ = __builtin_amdgcn_readlane(myslot, 2 * (i_) + 1); \
        ln_load(R1 + (size_t)(m0 + (i_)) * DM, xn, F.lane); COMB_ROW(ra_, an); COMB_ROW(rb_, bn); } while (0)
    COMB_LOAD(0);
    for (int i = 0; i < 16; ++i) {
        const int m = m0 + i;
        f32x4 v[4];
        const float g1 = __uint_as_float((unsigned)__builtin_amdgcn_readlane((int)myroute.z, i)), g2 = __uint_as_float((unsigned)__builtin_amdgcn_readlane((int)myroute.w, i));
#pragma unroll
        for (int j = 0; j < 4; ++j) v[j] = xn[j] * DN_ALPHA + (an[j] * g1 + bn[j] * g2);
        if (i + 1 < 16) COMB_LOAD(i + 1);
        ln_finish<false>(v, g, bb, XB + (size_t)m * DM, WSP(unsigned char, WS_XQ) + (size_t)m * DM, outp ? outp + (size_t)m * DM : nullptr, F.lane);
    }
#undef COMB_LOAD
#undef COMB_ROW
}

#define DPP_I(v, ctrl) __builtin_amdgcn_update_dpp(0, (v), (ctrl), 0xf, 0xf, false)
__device__ __forceinline__ int wave_isum(int v) {
    v += DPP_I(v, 0xB1); v += DPP_I(v, 0x4E); v += DPP_I(v, 0x141); v += DPP_I(v, 0x140);
    return __builtin_amdgcn_readlane(v, 0) + __builtin_amdgcn_readlane(v, 16) + __builtin_amdgcn_readlane(v, 32) + __builtin_amdgcn_readlane(v, 48);
}
#define DPP_F(v, ctrl) __int_as_float(__builtin_amdgcn_update_dpp(0, __float_as_int(v), (ctrl), 0xf, 0xf, false))
typedef unsigned short u16x2 __attribute__((__vector_size__(4)));
#define IDX_BAR() asm volatile("s_waitcnt lgkmcnt(0)\n\ts_barrier" ::: "memory")
__device__ __forceinline__ void p_idx(Frame& F, int l) {
    constexpr int QP = 16;
    LAS unsigned short* bins = (LAS unsigned short*)(F.lds + RING_OFF);
    LAS unsigned* hq = (LAS unsigned*)(F.lds + AUX_OFF);
    LAS unsigned* hist = (LAS unsigned*)(F.lds + AUX_OFF + 16384) + F.wave * 256;
    LAS int* ci = (LAS int*)(F.lds + AUX_OFF + 24576) + F.wave * 64;
    LAS float* wtab = (LAS float*)(F.lds + LDSCTL_OFF + 1280);
    LAS float* sqp = (LAS float*)(F.lds + LDSCTL_OFF + 1792);
    const bf16* QI = WSP(bf16, WS_QI); const bf16* KI = WSP(bf16, WS_KI); const float* WI = WSP(float, WS_WI);
    unsigned long long* maskQ = WSP(unsigned long long, WS_MASK);
    const int lane = F.lane, wave = F.wave, tid = F.tid, w = F.vcu;
    const int am = lane & 31, ahm = (am >> 2) & 1, arr = (am & 3) + 4 * (am >> 3), atl = 2 * ahm + (arr >> 3), ah = arr & 7, kg = lane >> 5, hi = lane >> 5, n = lane & 31;
    bf16x8 af[4][4]; float wreg = 0.f;
#define IDX_UNIT(s8_, qb32_, b_) do { const int ui_ = (s8_) >> 1; const int up_ = (ui_ == 0) ? w : (ui_ == 1) ? 511 - w : (ui_ == 2) ? 512 + w : 1023 - w; qb32_ = up_ >> 3; b_ = up_ & 7; } while (0)
#define IDX_LOADQ(s8_) do { int qb_, bb_; IDX_UNIT(s8_, qb_, bb_); const size_t r0_ = (size_t)bb_ * SEQ + qb_ * 32 + ((s8_) & 1) * QP; \
        _Pragma("unroll") for (int rt = 0; rt < 4; ++rt) _Pragma("unroll") for (int ks = 0; ks < 4; ++ks) af[rt][ks] = *(const bf16x8*)(QI + ((((r0_ >> 2) + rt) * 4 + ks) * 2 + kg) * 256 + (lane & 31) * 8); \
        if (tid < 128) wreg = WI[(r0_ + (tid >> 3)) * 8 + (tid & 7)]; } while (0)
#define IDX_WTAB(par_) do { if (tid < 128) { wtab[tid] = wreg; float sm = wreg, sq2 = wreg * wreg; \
        sm += DPP_F(sm, 0xB1); sq2 += DPP_F(sq2, 0xB1); sm += DPP_F(sm, 0x4E); sq2 += DPP_F(sq2, 0x4E); sm += DPP_F(sm, 0x141); sq2 += DPP_F(sq2, 0x141); \
        if ((tid & 7) == 0) { const float a_ = 1.0f / (28.02f * sqrtf(sq2) + 1.0e-20f); sqp[32 * (par_) + 2 * (tid >> 3)] = a_; sqp[32 * (par_) + 2 * (tid >> 3) + 1] = 0.33333f - 3.19f * sm * a_; } } } while (0)
    IDX_LOADQ(0);
    IDX_WTAB(0);
    for (int i = tid; i < QP * 256; i += NTHR) hq[i] = 0u;
    IDX_BAR();
    for (int s8 = 0; s8 < 8; ++s8) {
        int qb32, b; IDX_UNIT(s8, qb32, b);
        const int sub = s8 & 1, c = qb32 >> 1, N = 64 * (c + 1), NT32 = 2 * (c + 1);
        const size_t rowb = (size_t)b * SEQ;
        const bool dosel = N > TOPK;
        for (int repA_ = 0; repA_ < (((PROBE_MASK) >> 12) & 1) + 1; ++repA_) {
            const int ntw = (NT32 - wave + 7) >> 3;
            constexpr int BT = 2; const int nbat = (ntw + BT - 1) / BT;
            bf16x8 b0[BT][4], b1[BT][4];
            const LAS float* sqc = sqp + 32 * (s8 & 1);
#define IDX_LOADB(dst, bb_) do { _Pragma("unroll") for (int u = 0; u < BT; ++u) { int j_ = wave + 8 * (BT * (bb_) + u); j_ = j_ < NT32 ? j_ : NT32 - 1; \
            _Pragma("unroll") for (int ks = 0; ks < 4; ++ks) dst[u][ks] = *(const bf16x8*)(KI + (rowb + 32 * j_) * 64 + ks * 512 + kg * 256 + n * 8); } } while (0)
#define IDX_RELU(x) __int_as_float(max(__float_as_int(x), 0))
#define IDX_COMP(src, bb_) do { _Pragma("unroll") for (int rp = 0; rp < 2; ++rp) { \
            f32x4 wq_[4][2];   \
            _Pragma("unroll") for (int rq = 0; rq < 4; ++rq) { const int qi_ = 4 * (2 * rp + (rq >> 1)) + 2 * hi + (rq & 1); const LAS f32x4* wp_ = (const LAS f32x4*)(wtab + qi_ * 8); wq_[rq][0] = wp_[0]; wq_[rq][1] = wp_[1]; } \
            _Pragma("unroll") for (int u = 0; u < BT; ++u) { const int j_ = wave + 8 * (BT * (bb_) + u); if (j_ < NT32) { f32x16 acc0 = {}, acc1 = {}; \
                _Pragma("unroll") for (int ks = 0; ks < 4; ++ks) { acc0 = __builtin_amdgcn_mfma_f32_32x32x16_bf16(af[2 * rp][ks], src[u][ks], acc0, 0, 0, 0); acc1 = __builtin_amdgcn_mfma_f32_32x32x16_bf16(af[2 * rp + 1][ks], src[u][ks], acc1, 0, 0, 0); } \
                _Pragma("unroll") for (int r2 = 0; r2 < 2; ++r2) { const int rt = 2 * rp + r2; const f32x16& ac_ = r2 ? acc1 : acc0; float t_[2]; \
                    _Pragma("unroll") for (int q = 0; q < 2; ++q) { const f32x4 w0_ = wq_[2 * r2 + q][0], w1_ = wq_[2 * r2 + q][1]; \
                        f32x2 s2_ = (f32x2){w0_[0], w0_[1]} * (f32x2){IDX_RELU(ac_[8 * q + 0]), IDX_RELU(ac_[8 * q + 1])}; \
                        s2_ = __builtin_elementwise_fma((f32x2){w0_[2], w0_[3]}, (f32x2){IDX_RELU(ac_[8 * q + 2]), IDX_RELU(ac_[8 * q + 3])}, s2_); \
                        s2_ = __builtin_elementwise_fma((f32x2){w1_[0], w1_[1]}, (f32x2){IDX_RELU(ac_[8 * q + 4]), IDX_RELU(ac_[8 * q + 5])}, s2_); \
                        s2_ = __builtin_elementwise_fma((f32x2){w1_[2], w1_[3]}, (f32x2){IDX_RELU(ac_[8 * q + 6]), IDX_RELU(ac_[8 * q + 7])}, s2_); \
                        const f32x2 mc_ = *(const LAS f32x2*)(sqc + 2 * (4 * rt + 2 * hi + q)); t_[q] = __builtin_fmaf(s2_[0] + s2_[1], mc_[0], mc_[1]); } \
                    const u16x2 pk_ = __builtin_amdgcn_cvt_pknorm_u16(t_[0], t_[1]); \
                    _Pragma("unroll") for (int q = 0; q < 2; ++q) { const int qi_ = 4 * rt + 2 * hi + q; const unsigned short ky_ = q ? pk_[1] : pk_[0]; bins[qi_ * 4096 + 32 * j_ + n] = ky_; \
                        if (dosel) __hip_atomic_fetch_add(hq + qi_ * 256 + ((unsigned)ky_ >> 8), 1u, __ATOMIC_RELAXED, __HIP_MEMORY_SCOPE_WORKGROUP); } } } } } } while (0)
            IDX_LOADB(b0, 0);
            for (int bb = 0; bb < nbat; bb += 2) {
                IDX_LOADB(b1, bb + 1);
                IDX_COMP(b0, bb);
                IDX_LOADB(b0, bb + 2);
                IDX_COMP(b1, bb + 1);
            }
#undef IDX_LOADB
#undef IDX_COMP
#undef IDX_RELU
        }
        if (s8 + 1 < 8) IDX_LOADQ(s8 + 1);
        IDX_BAR();
        for (int repB_ = 0; repB_ < (((PROBE_MASK) >> 13) & 1) + 1; ++repB_)
        for (int qq = 0; qq < 2; ++qq) {
            const int q = wave + 8 * qq;
            const int nch = (N + 511) >> 9;
            const LAS unsigned short* brow = bins + q * 4096;
            LAS unsigned char* st8 = (LAS unsigned char*)hist + 512 * qq;
            { unsigned z0 = 0u; asm volatile("" : "+v"(z0)); *(LAS u32x2*)(st8 + 8 * lane) = (u32x2){z0, z0}; }
#define IDX_SCAN(K, HD, TARGET) \
            int tl_ = 0; _Pragma("unroll") for (int i = 0; i < K; ++i) tl_ += HD[i]; \
            int P_ = tl_; P_ += DPP_I(P_, 0x111); P_ += DPP_I(P_, 0x112); P_ += DPP_I(P_, 0x114); P_ += DPP_I(P_, 0x118); \
            { const int R0 = __builtin_amdgcn_readlane(P_, 15), R1 = __builtin_amdgcn_readlane(P_, 31), R2 = __builtin_amdgcn_readlane(P_, 47); P_ += (lane >= 16 ? R0 : 0) + (lane >= 32 ? R1 : 0) + (lane >= 48 ? R2 : 0); } \
            const unsigned long long over_ = __ballot(P_ >= (TARGET)); const int Lc_ = over_ ? (int)__builtin_ctzll(over_) : 63; \
            int cumL_ = P_ - tl_, bsel_ = 0, cbv_ = 0; bool fnd_ = false; \
            _Pragma("unroll") for (int i = K - 1; i >= 0; --i) { if (!fnd_) { if (cumL_ + HD[i] >= (TARGET) || i == 0) { fnd_ = true; bsel_ = i; cbv_ = HD[i]; } else cumL_ += HD[i]; } } \
            Bs = K * (63 - Lc_) + __builtin_amdgcn_readlane(bsel_, Lc_); cb = __builtin_amdgcn_readlane(cbv_, Lc_); cumv = __builtin_amdgcn_readlane(cumL_, Lc_);
#define IDX_CODE(v, j) ((int)(((j) & 1) ? ((v)[(j) >> 1] >> 16) : ((v)[(j) >> 1] & 0xffffu)))
            int Bs = -1, cb = 0, need = 0, sh = 8; bool fast_ok = true;
            LAS unsigned* crow = hq + q * 256;
            if (dosel) {
                { const u32x4 h4 = *(const LAS u32x4*)(crow + 4 * (63 - lane)); const int hd4[4] = {(int)h4[0], (int)h4[1], (int)h4[2], (int)h4[3]};
                  int cumv; IDX_SCAN(4, hd4, TOPK)
                  need = TOPK - cumv; fast_ok = over_ != 0ull && need >= 1 && need <= cb; }
                if (fast_ok && cb > 64) {
                    { unsigned z0 = 0u; asm volatile("" : "+v"(z0)); *(LAS u32x4*)(crow + 4 * lane) = (u32x4){z0, z0, z0, z0}; }
                    for (int ch = 0; ch < nch; ++ch) { const u32x4 v = *(const LAS u32x4*)(brow + 512 * ch + 8 * lane); const bool okl = 512 * ch + 8 * lane < N;
#pragma unroll
                        for (int j = 0; j < 8; ++j) { const int kj = IDX_CODE(v, j); const bool m = okl && (kj >> 8) == Bs;
                            __hip_atomic_fetch_add(m ? crow + (kj & 255) : (LAS unsigned*)ci + lane, 1u, __ATOMIC_RELAXED, __HIP_MEMORY_SCOPE_WORKGROUP); } }
                    asm volatile("s_waitcnt lgkmcnt(0)" ::: "memory");
                    const u32x4 h4 = *(const LAS u32x4*)(crow + 4 * (63 - lane)); const int hd4[4] = {(int)h4[0], (int)h4[1], (int)h4[2], (int)h4[3]};
                    int nB, nC, nV; bool ok2;
                    { int Bs, cb, cumv; IDX_SCAN(4, hd4, need)
                      nB = Bs; nC = cb; nV = cumv; ok2 = over_ != 0ull; }
                    Bs = (Bs << 8) | nB; sh = 0; need -= nV; cb = nC;
                    fast_ok = ok2 && need >= 1 && need <= cb;
                }
                fast_ok = fast_ok && cb <= 64;
            }
#undef IDX_SCAN
            if (fast_ok) {
                int nc = 0;
                u32x4 vn = *(const LAS u32x4*)(brow + 8 * lane);
                for (int ch = 0; ch < nch; ++ch) { const u32x4 v = vn; const int e0 = 512 * ch + 8 * lane; const bool okl = e0 < N; unsigned byte = 0u;
                    if (ch + 1 < nch) vn = *(const LAS u32x4*)(brow + 512 * (ch + 1) + 8 * lane);
                    int bj[8], cl = 0;
#pragma unroll
                    for (int j = 0; j < 8; ++j) { bj[j] = okl ? (IDX_CODE(v, j) >> sh) : -2; cl += (bj[j] == Bs) ? 1 : 0; byte |= (unsigned)(Bs - bj[j]) >> 31 << j; }
                    int ps = cl;
                    ps += DPP_I(ps, 0x111); ps += DPP_I(ps, 0x112); ps += DPP_I(ps, 0x114); ps += DPP_I(ps, 0x118);
                    ps += __builtin_amdgcn_update_dpp(0, ps, 0x142, 0xa, 0xf, false); ps += __builtin_amdgcn_update_dpp(0, ps, 0x143, 0xc, 0xf, false);
                    int off = nc + ps - cl;
#pragma unroll
                    for (int j = 0; j < 8; ++j) { const bool eq = bj[j] == Bs; crow[eq ? off : 64 + lane] = (unsigned)((IDX_CODE(v, j) << 12) | (e0 + j)); off += eq ? 1 : 0; }
                    nc += __builtin_amdgcn_readlane(ps, 63);
                    st8[64 * ch + lane] = (unsigned char)byte; }
                if (dosel) {
                    asm volatile("s_waitcnt lgkmcnt(0)" ::: "memory");
                    const int mc = (lane < cb) ? (int)crow[lane] : 0; const int mord = (mc & ~4095) | (4095 - (mc & 4095)); int rank = 0;
                    for (int j = 0; j < cb; ++j) { const int oj = __builtin_amdgcn_readlane(mord, j); rank += (oj > mord) ? 1 : 0; }
                    if (lane < cb && rank < need) __hip_atomic_fetch_or((LAS unsigned*)st8 + ((mc & 4095) >> 5), 1u << (mc & 31), __ATOMIC_RELAXED, __HIP_MEMORY_SCOPE_WORKGROUP);
                }
            } else {
                int Tk = -1; unsigned Jx = 0xffffffffu;
                for (int bit = 15; bit >= 0; --bit) {
                    const int cand = Tk < 0 ? (1 << bit) : (Tk | (1 << bit)); int cl = 0;
                    for (int ch = 0; ch < nch; ++ch) { const u32x4 v = *(const LAS u32x4*)(brow + 512 * ch + 8 * lane); const int e0 = 512 * ch + 8 * lane;
#pragma unroll
                        for (int j = 0; j < 8; ++j) cl += (e0 < N && IDX_CODE(v, j) >= cand) ? 1 : 0; }
                    if (wave_isum(cl) >= TOPK) Tk = cand;
                }
                if (Tk < 0) Tk = 0;
                int cg = 0, ce = 0;
                for (int ch = 0; ch < nch; ++ch) { const u32x4 v = *(const LAS u32x4*)(brow + 512 * ch + 8 * lane); const int e0 = 512 * ch + 8 * lane;
#pragma unroll
                    for (int j = 0; j < 8; ++j) if (e0 < N) { cg += (IDX_CODE(v, j) > Tk) ? 1 : 0; ce += (IDX_CODE(v, j) == Tk) ? 1 : 0; } }
                const int nd = TOPK - wave_isum(cg), ceq = wave_isum(ce);
                if (ceq > nd) {
                    unsigned Jc = 0u;
                    for (int bit = 11; bit >= 0; --bit) {
                        const unsigned cj = Jc | (1u << bit); int cl = 0;
                        for (int ch = 0; ch < nch; ++ch) { const u32x4 v = *(const LAS u32x4*)(brow + 512 * ch + 8 * lane); const int e0 = 512 * ch + 8 * lane;
#pragma unroll
                            for (int j = 0; j < 8; ++j) cl += (e0 < N && IDX_CODE(v, j) == Tk && (unsigned)(e0 + j) < cj) ? 1 : 0; }
                        if (wave_isum(cl) < nd) Jc = cj;
                    }
                    Jx = Jc;
                }
                for (int ch = 0; ch < nch; ++ch) { const u32x4 v = *(const LAS u32x4*)(brow + 512 * ch + 8 * lane); const int e0 = 512 * ch + 8 * lane; unsigned byte = 0u;
#pragma unroll
                    for (int j = 0; j < 8; ++j) { const int kj = IDX_CODE(v, j); byte |= (unsigned)((kj > Tk || (kj == Tk && (unsigned)(e0 + j) <= Jx)) ? 1 : 0) << j; }
                    st8[64 * ch + lane] = (unsigned char)(e0 < N ? byte : 0u); }
            }
#undef IDX_CODE
            { unsigned z0 = 0u; asm volatile("" : "+v"(z0)); *(LAS u32x4*)(crow + 4 * lane) = (u32x4){z0, z0, z0, z0}; }
        }
        IDX_WTAB((s8 + 1) & 1);
        IDX_BAR();
        {
            const int tile = tid >> 3, w8 = tid & 7, NJw = 4 * ((qb32 >> 3) + 1);
            if (tile < NJw) {
#pragma unroll
                for (int qq = 0; qq < 2; ++qq) { const u32x2 mk = *(const LAS u32x2*)((const LAS unsigned*)(F.lds + AUX_OFF + 16384) + w8 * 256 + 128 * qq + 2 * tile);
                    maskQ[((size_t)(b * 128 + qb32) * 64 + tile) * 32 + QP * sub + 8 * qq + w8] = ((unsigned long long)mk.y << 32) | mk.x; } }
        }
    }
#undef IDX_UNIT
#undef IDX_LOADQ
#undef IDX_WTAB
#undef IDX_BAR
}

__device__ __forceinline__ void p_conv(Frame& F, int l) {
    LAS bf16* Ut = (LAS bf16*)(F.lds + RING_OFF);
    LAS float* Yt = (LAS float*)(F.lds + RING_OFF + 65536);
    const bf16* U = WSP(bf16, WS_U); bf16* MIX = WSP(bf16, WS_MIX);
    const float* cw = arg_in(2) + (size_t)l * CK * CCH; const int c = F.tid, lane = F.lane;
    float wj[CK];
#pragma unroll
    for (int j = 0; j < CK; ++j) wj[j] = cw[j * CCH + c];
    const float cb = arg_in(3)[l * CCH + c];
    f32x4 lg0 = *(const f32x4*)(arg_in(4) + l * CCH + 8 * lane), lg1 = *(const f32x4*)(arg_in(4) + l * CCH + 8 * lane + 4);
    f32x4 lb0 = *(const f32x4*)(arg_in(5) + l * CCH + 8 * lane), lb1 = *(const f32x4*)(arg_in(5) + l * CCH + 8 * lane + 4);
    f32x4 ms0 = *(const f32x4*)(arg_in(6) + l * DM + CCH + 8 * lane), ms1 = *(const f32x4*)(arg_in(6) + l * DM + CCH + 8 * lane + 4);
    u32x4 tp[8];
#define CONV_LOAD(it_) do { const int un_ = F.vcu + 256 * (it_), b_ = un_ >> 7, t0_ = (un_ & 127) * 32; \
        _Pragma("unroll") for (int k = 0; k < 8; ++k) { const int ch = F.tid + NTHR * k, r = ch >> 6, cc = ch & 63, t = t0_ - 30 + r; unsigned z0 = 0u; asm volatile("" : "+v"(z0)); tp[k] = (u32x4){z0, z0, z0, z0}; \
            if (ch < 62 * 64 && t >= 0) tp[k] = *(const u32x4*)(U + ((size_t)b_ * SEQ + t) * CCH + cc * 8); } } while (0)
    CONV_LOAD(0);
    for (int it = 0; it < 4; ++it) {
        const int unit = F.vcu + 256 * it, b = unit >> 7, tt0 = (unit & 127) * 32;
#pragma unroll
        for (int k = 0; k < 8; ++k) { const int ch = F.tid + NTHR * k, r = ch >> 6, cc = ch & 63; if (ch < 62 * 64) *(LAS u32x4*)(Ut + r * CCH + cc * 8) = tp[k]; }
        if (it + 1 < 4) CONV_LOAD(it + 1);
        __syncthreads();
        float acc[32], uu[62];
#pragma unroll
        for (int s = 0; s < 62; ++s) uu[s] = bf2f(Ut[s * CCH + c]);
#pragma unroll
        for (int tt = 0; tt < 32; ++tt) acc[tt] = cb;
#pragma unroll
        for (int j = 0; j < CK; ++j)
#pragma unroll
            for (int tt = 0; tt < 32; ++tt) acc[tt] = __builtin_fmaf(wj[j], uu[tt + j], acc[tt]);
#pragma unroll
        for (int tt = 0; tt < 32; ++tt) Yt[tt * CCH + c] = acc[tt];
        __syncthreads();
#pragma unroll
        for (int k = 0; k < 4; ++k) { const int tt = F.wave * 4 + k;
            f32x4 y0 = *(const LAS f32x4*)(Yt + tt * CCH + 8 * lane), y1 = *(const LAS f32x4*)(Yt + tt * CCH + 8 * lane + 4);
            const float mean = wave_sum((y0[0] + y0[1]) + (y0[2] + y0[3]) + (y1[0] + y1[1]) + (y1[2] + y1[3])) * (1.f / CCH);
            y0 = y0 - mean; y1 = y1 - mean;
            const float var = wave_sum((y0[0] * y0[0] + y0[1] * y0[1]) + (y0[2] * y0[2] + y0[3] * y0[3]) + (y1[0] * y1[0] + y1[1] * y1[1]) + (y1[2] * y1[2] + y1[3] * y1[3])) * (1.f / CCH);
            const float rstd = 1.f / sqrtf(var + LN_EPS);
            y0 = y0 * rstd * lg0 + lb0; y1 = y1 * rstd * lg1 + lb1;
#pragma unroll
            for (int e = 0; e < 4; ++e) { y0[e] = y0[e] * fsigmoid(y0[e]) * ms0[e]; y1[e] = y1[e] * fsigmoid(y1[e]) * ms1[e]; }
            *(u32x4*)(MIX + ((size_t)b * SEQ + tt0 + tt) * DM + CCH + 8 * lane) = pg8::pack8(y0, y1); }
        __syncthreads();
    }
#undef CONV_LOAD
}

namespace at {
constexpr int QBLK = 32, QB = 256, KVBLK = 64, NSLOT = 3, SLOTB = 8192;
constexpr int LDS_K = 0, LDS_V = NSLOT * SLOTB, LDS_WS = 2 * NSLOT * SLOTB, LDS_OST = LDS_WS + 8 * 64 * 4, LDS_BIAS = LDS_OST + 8 * 4096, LDS_END = LDS_BIAS + 1024;
static_assert(LDS_END <= RING_BYTES && LDS_END <= CONV_ATTN_SCR, "attention LDS");
constexpr float NEGV = -200.0f;
__device__ __forceinline__ int crow(int r, int hi) { return (r & 3) + 8 * (r >> 2) + 4 * hi; }
#define SBAR() __builtin_amdgcn_sched_barrier(0)
__device__ __forceinline__ void glds16(const void* gsrc, unsigned lds_dst) { unsigned keep;
    asm volatile("s_mov_b32 %0, m0\n\ts_mov_b32 m0, %2\n\ts_nop 0\n\tglobal_load_lds_dwordx4 %1, off\n\ts_mov_b32 m0, %0" : "=&s"(keep) : "v"(gsrc), "s"(lds_dst) : "memory"); }
__device__ __forceinline__ float max3f(float a, float b, float c) { float r; asm("v_max3_f32 %0, %1, %2, %3" : "=v"(r) : "v"(a), "v"(b), "v"(c)); return r; }
__device__ __forceinline__ float max2f(float a, float b) { float r; asm("v_max_f32_e32 %0, %1, %2" : "=v"(r) : "v"(a), "v"(b)); return r; }
__device__ __forceinline__ float fadd_s(float a, float b) { float r; asm("v_add_f32_e32 %0, %1, %2" : "=v"(r) : "v"(a), "v"(b)); return r; }
__device__ __forceinline__ float fsub_s(float a, float b) { float r; asm("v_sub_f32_e32 %0, %1, %2" : "=v"(r) : "v"(a), "v"(b)); return r; }
typedef float f32x2_t __attribute__((ext_vector_type(2))); typedef __bf16 bf16x2_t __attribute__((ext_vector_type(2)));
__device__ __forceinline__ unsigned cvtpk_s(float lo, float hi) { f32x2_t v = {lo, hi}; bf16x2_t b = __builtin_convertvector(v, bf16x2_t); return __builtin_bit_cast(unsigned, b); }
typedef LAS const char* lds_cptr;
typedef short v4i16_t __attribute__((ext_vector_type(4)));
__device__ __forceinline__ void kload8(bf16x8* kf, lds_cptr kp) {
    kf[0] = *(const LAS bf16x8*)(kp);        kf[1] = *(const LAS bf16x8*)(kp + 512);  kf[2] = *(const LAS bf16x8*)(kp + 2048); kf[3] = *(const LAS bf16x8*)(kp + 2560);
    kf[4] = *(const LAS bf16x8*)(kp + 4096); kf[5] = *(const LAS bf16x8*)(kp + 4608); kf[6] = *(const LAS bf16x8*)(kp + 6144); kf[7] = *(const LAS bf16x8*)(kp + 6656); }
__device__ __forceinline__ void kload2(bf16x8* kf, lds_cptr kp, int j) { kf[2 * j] = *(const LAS bf16x8*)(kp + j * 2048); kf[2 * j + 1] = *(const LAS bf16x8*)(kp + j * 2048 + 512); }
__device__ __forceinline__ s16x4 vtr(lds_cptr p) { return __builtin_bit_cast(s16x4, __builtin_amdgcn_ds_read_tr16_b64_v4i16((LAS v4i16_t*)p)); }
__device__ __forceinline__ float rowmax(const f32x16& p0, const f32x16& p1) {
    float a = max3f(p0[0], p0[1], p1[0]), b = max3f(p0[2], p0[3], p1[1]); a = max3f(a, p1[2], p1[3]);
#pragma unroll
    for (int r = 4; r < 16; r += 4) { a = max3f(a, p0[r], p0[r + 1]); b = max3f(b, p0[r + 2], p0[r + 3]); a = max3f(a, p1[r], p1[r + 1]); b = max3f(b, p1[r + 2], p1[r + 3]); }
    const float m = max2f(a, b);
    auto rr = __builtin_amdgcn_permlane32_swap(__float_as_uint(m), __float_as_uint(m), false, false);
    return max2f(__uint_as_float(rr[0]), __uint_as_float(rr[1]));
}
__device__ __forceinline__ void pv(f32x16* o, int vb, bf16x8 pa0, bf16x8 pa1, bf16x8 pa2, bf16x8 pa3) {
#pragma unroll
    for (int d0 = 0; d0 < 2; ++d0) { s16x4 lo[4], hi[4];
#pragma unroll
        for (int ks = 0; ks < 4; ++ks) {
            asm volatile("ds_read_b64_tr_b16 %0,%1 offset:%c2" : "=&v"(lo[ks]) : "v"(vb), "i"(d0 * 4096 + ks * 1024) : "memory");
            asm volatile("ds_read_b64_tr_b16 %0,%1 offset:%c2" : "=&v"(hi[ks]) : "v"(vb), "i"(d0 * 4096 + ks * 1024 + 512) : "memory"); }
        asm volatile("s_waitcnt lgkmcnt(0)" ::: "memory"); SBAR();
#define AT_PK(k) (bf16x8){lo[k][0], lo[k][1], lo[k][2], lo[k][3], hi[k][0], hi[k][1], hi[k][2], hi[k][3]}
        o[d0] = __builtin_amdgcn_mfma_f32_32x32x16_bf16(pa0, AT_PK(0), o[d0], 0, 0, 0);
        o[d0] = __builtin_amdgcn_mfma_f32_32x32x16_bf16(pa1, AT_PK(1), o[d0], 0, 0, 0);
        o[d0] = __builtin_amdgcn_mfma_f32_32x32x16_bf16(pa2, AT_PK(2), o[d0], 0, 0, 0);
        o[d0] = __builtin_amdgcn_mfma_f32_32x32x16_bf16(pa3, AT_PK(3), o[d0], 0, 0, 0);
#undef AT_PK
    }
}
template <int THRL> __device__ __forceinline__ void attn_unit(int b, int h, int qb, const bf16* Q, const bf16* __restrict__ Kt, const bf16* __restrict__ Vt, const unsigned long long* maskQ,
                                                              bf16* MIX, float ms0, float ms1, LAS unsigned char* shm, int tid, bool first_dma_done, bool prefetch_next) {
    const int lane = tid & 63, r32 = lane & 31, hi = lane >> 5; const int wid = __builtin_amdgcn_readfirstlane(tid >> 6);
    const size_t rowbase = (size_t)b * SEQ; const int q0 = qb * QB, qw = q0 + wid * QBLK, cwv = qw >> 6;
    const bf16* Qw = Q + (rowbase + qw) * AW + h * HD;
    const unsigned lds0 = (unsigned)(uintptr_t)shm; const lds_cptr shm3 = (lds_cptr)shm;
    LAS float* wsf = (LAS float*)(shm + LDS_WS) + wid * 64;
    const LAS float* biasT = (const LAS float*)(shm + LDS_BIAS);
    const bf16* ksrc = Kt + ((size_t)(b * NH + h) * 64) * 4096 + wid * 512 + lane * 8;
    const bf16* vsrc = Vt + ((size_t)(b * NH + h) * 64) * 4096 + wid * 512 + lane * 8;
    const unsigned kdst = lds0 + LDS_K + wid * 1024, vdst = lds0 + LDS_V + wid * 1024;
#define DMA_K(t, slot) glds16(ksrc + (size_t)(t) * 4096, (unsigned)__builtin_amdgcn_readfirstlane(kdst + (slot)))
#define DMA_V(t, slot) glds16(vsrc + (size_t)(t) * 4096, (unsigned)__builtin_amdgcn_readfirstlane(vdst + (slot)))
    int r32m = r32; asm volatile("" : "+v"(r32m));
    const unsigned long long* mrow = maskQ + ((size_t)(b * 128 + (qw >> 5)) * 64) * 32 + r32m;
#define MLOAD(dst, t) dst = *(const GAS u32x2*)((const GAS unsigned long long*)mrow + (size_t)(t) * 32)
#define MLOAD_UNUSED(dst, t) dst = *(const u32x2*)(mrow + (size_t)(t) * 32)
#define WAIT_BAR(N, M) asm volatile("s_waitcnt vmcnt(" #N ") lgkmcnt(0)\n\ts_barrier" ::: "memory")
    const int vb0 = (int)(lds0 + LDS_V) + ((lane >> 4) & 1) * 32 + (lane & 3) * 8 + (4 * hi + ((lane & 15) >> 2)) * 64;
    bf16x8 kf[8];
    const lds_cptr kp0 = shm3 + LDS_K + hi * 1024 + r32 * 16; const lds_cptr vp0 = shm3 + LDS_V + ((lane >> 4) & 1) * 32 + (lane & 3) * 8 + (4 * hi + ((lane & 15) >> 2)) * 64;
    const int NT = (q0 + QB) / KVBLK;
    u32x2 mA, mB;
    MLOAD(mA, 0);
    if (!first_dma_done) { DMA_K(0, 0); DMA_V(0, 0); DMA_K(1, SLOTB); }
    const lds_cptr qp = shm3 + LDS_OST + wid * 4096 + hi * 512 + r32 * 16;
#pragma unroll
    for (int d0 = 0; d0 < 4; ++d0) { const bf16x8 qv = *(const bf16x8*)(Qw + (size_t)r32 * AW + d0 * 16 + hi * 8); *(LAS bf16x8*)(shm + LDS_OST + wid * 4096 + hi * 512 + r32 * 16 + d0 * 1024) = qv; }
#define QRD(d0) (*(const LAS bf16x8*)(qp + (d0) * 1024))
    float mhat = 0.f, l_reg = 0.f; f32x16 o[2]; o[0] = f32x16{}; o[1] = f32x16{}; f32x16 negm = f32x16{}; asm volatile("" : "+v"(negm));
#define MASKB(P0, P1, t, MW) do { \
        if (64 * (t) + 63 - qw >= -90 && (t) <= cwv) { const int bi_ = 64 * (t) - (qw + r32) + 128 + 4 * hi; \
            _Pragma("unroll") for (int r = 0; r < 16; ++r) { const int k0_ = (r & 3) + 8 * (r >> 2); int i0_ = bi_ + k0_; i0_ = i0_ < 0 ? 0 : i0_; int i1_ = bi_ + k0_ + 32; i1_ = i1_ < 0 ? 0 : i1_; P0[r] += biasT[i0_]; P1[r] += biasT[i1_]; } } \
        { const unsigned ml_ = MW.x >> (4 * hi), mh_ = MW.y >> (4 * hi); const unsigned nv_ = __float_as_uint(NEGV); \
            _Pragma("unroll") for (int r = 0; r < 16; ++r) { const unsigned s0_ = (unsigned)__builtin_amdgcn_sbfe((int)ml_, (r & 3) + 8 * (r >> 2), 1), s1_ = (unsigned)__builtin_amdgcn_sbfe((int)mh_, (r & 3) + 8 * (r >> 2), 1); \
                P0[r] = __uint_as_float((s0_ & __float_as_uint(P0[r])) | (~s0_ & nv_)); P1[r] = __uint_as_float((s1_ & __float_as_uint(P1[r])) | (~s1_ & nv_)); } } } while (0)
    bool resc = false;
#define START(P0, P1) do { const float rm = rowmax(P0, P1); resc = false; \
    { const float dl = rm; mhat = fadd_s(mhat, dl); \
      _Pragma("unroll") for (int r = 0; r < 16; ++r) { P0[r] = fsub_s(P0[r], dl); P1[r] = fsub_s(P1[r], dl); } \
      _Pragma("unroll") for (int r = 0; r < 16; ++r) negm[r] = -mhat; asm volatile("" : "+v"(negm)); } \
    _Pragma("unroll") for (int r = 0; r < 16; ++r) P0[r] = __builtin_amdgcn_exp2f(P0[r]); } while (0)
#define RESC() do { if (resc) { asm volatile("s_waitcnt lgkmcnt(0)" ::: "memory"); \
      _Pragma("unroll") for (int d_ = 0; d_ < 2; ++d_) _Pragma("unroll") for (int r = 0; r < 16; ++r) o[d_][r] *= wsf[crow(r, hi)]; } } while (0)
    f32x16 pA0, pA1, pB0, pB1;
    int sl_prev = 0, sl_cur = 0, sl_next = SLOTB;
#define ROT() do { sl_prev = sl_cur; sl_cur = sl_next; sl_next = (sl_next == (NSLOT - 1) * SLOTB) ? 0 : sl_next + SLOTB; } while (0)
    DMA_K(2, 2 * SLOTB);
    WAIT_BAR(3, mA);
    {
        const lds_cptr kb = kp0;
        pA0 = f32x16{}; pA1 = f32x16{};
#pragma unroll
        for (int d0 = 0; d0 < 4; ++d0) { const bf16x8 b0 = *(const LAS bf16x8*)(kb + d0 * 2048), b1 = *(const LAS bf16x8*)(kb + d0 * 2048 + 512);
            const bf16x8 qv = QRD(d0); pA0 = __builtin_amdgcn_mfma_f32_32x32x16_bf16(b0, qv, pA0, 0, 0, 0); pA1 = __builtin_amdgcn_mfma_f32_32x32x16_bf16(b1, qv, pA1, 0, 0, 0); }
        MASKB(pA0, pA1, 0, mA);
        asm volatile("s_nop 15\n\ts_nop 7" : "+v"(pA0), "+v"(pA1));
        START(pA0, pA1);
#pragma unroll
        for (int r = 0; r < 16; ++r) pA1[r] = __builtin_amdgcn_exp2f(pA1[r]);
    }
    WAIT_BAR(0, mA);
    MLOAD(mB, 1);
    DMA_K(3, 0); DMA_V(1, SLOTB);
    ROT();
    kload8(kf, kp0 + sl_cur);
    WAIT_BAR(2, mB);
    s16x4 vlo[8], vhi[8]; u32x4 pw0, pw1, pw2, pw3;
#define PKW(P, B) cvtpk_s(P[B], P[B + 1])
#define PAF(k) __builtin_bit_cast(bf16x8, pw##k)
#define VFR(i) (bf16x8){vlo[i][0], vlo[i][1], vlo[i][2], vlo[i][3], vhi[i][0], vhi[i][1], vhi[i][2], vhi[i][3]}
#define PIN(x) asm volatile("" : "+v"(x))
#define MX3(a, b, c) __builtin_fmaxf(__builtin_fmaxf((a), (b)), (c))
#define GAPA(MF, A0, A1, A2, A3, W0, W1, PW) do { MF; sacc += A0; sacc += A1; sacc += A2; sacc += A3; PIN(sacc); W0; W1; PIN(PW); SBAR(); } while (0)
#define EX(v) __builtin_amdgcn_exp2f(v)
#define GAPB(MF, X, B) do { MF; X[B] = EX(X[B]); X[B + 1] = EX(X[B + 1]); X[B + 2] = EX(X[B + 2]); X[B + 3] = EX(X[B + 3]); PIN(X); SBAR(); } while (0)
#define VRD(i) do { vlo[i] = vtr(vp_ + (((i) >> 2) * 4096 + ((i) & 3) * 1024)); vhi[i] = vtr(vp_ + (((i) >> 2) * 4096 + ((i) & 3) * 1024 + 512)); } while (0)
#define KRD(G, j) do { if (G) { kload2(kf, kp0 + sl_next, j); SBAR(); } } while (0)
#define STEP(C0, C1, P0, P1, t, MC, MN, GM, GK, GV, GL) do { SBAR(); \
    const lds_cptr vp_ = vp0 + sl_prev; \
    bf16x8 qa_ = QRD(0), qb_; VRD(0); SBAR(); float sacc = (P0[0] + P0[1]); \
    GAPA(C0 = __builtin_amdgcn_mfma_f32_32x32x16_bf16(kf[0], qa_, negm, 0, 0, 0), P0[2], P0[3], P0[4], P0[5],     pw0[0] = PKW(P0, 0), pw0[1] = PKW(P0, 2), pw0); \
    VRD(4); SBAR(); GAPA(C1 = __builtin_amdgcn_mfma_f32_32x32x16_bf16(kf[1], qa_, negm, 0, 0, 0), P0[6], P0[7], P0[8], P0[9],     pw0[2] = PKW(P0, 4), pw0[3] = PKW(P0, 6), pw0); \
    qb_ = QRD(1); VRD(1); SBAR(); GAPA(C0 = __builtin_amdgcn_mfma_f32_32x32x16_bf16(kf[2], qb_, C0, 0, 0, 0),   P0[10], P0[11], P0[12], P0[13], pw1[0] = PKW(P0, 8), pw1[1] = PKW(P0, 10), pw1); \
    VRD(5); SBAR(); GAPA(C1 = __builtin_amdgcn_mfma_f32_32x32x16_bf16(kf[3], qb_, C1, 0, 0, 0),   P0[14], P0[15], P1[0], P1[1],   pw1[2] = PKW(P0, 12), pw1[3] = PKW(P0, 14), pw1); \
    qa_ = QRD(2); VRD(2); SBAR(); GAPA(C0 = __builtin_amdgcn_mfma_f32_32x32x16_bf16(kf[4], qa_, C0, 0, 0, 0),   P1[2], P1[3], P1[4], P1[5],     pw2[0] = PKW(P1, 0), pw2[1] = PKW(P1, 2), pw2); \
    VRD(6); SBAR(); GAPA(C1 = __builtin_amdgcn_mfma_f32_32x32x16_bf16(kf[5], qa_, C1, 0, 0, 0),   P1[6], P1[7], P1[8], P1[9],     pw2[2] = PKW(P1, 4), pw2[3] = PKW(P1, 6), pw2); \
    qb_ = QRD(3); VRD(3); SBAR(); GAPA(C0 = __builtin_amdgcn_mfma_f32_32x32x16_bf16(kf[6], qb_, C0, 0, 0, 0),   P1[10], P1[11], P1[12], P1[13], pw3[0] = PKW(P1, 8), pw3[1] = PKW(P1, 10), pw3); \
    VRD(7); SBAR(); GAPA(C1 = __builtin_amdgcn_mfma_f32_32x32x16_bf16(kf[7], qb_, C1, 0, 0, 0),   P1[14], P1[15], 0.f, 0.f,       pw3[2] = PKW(P1, 12), pw3[3] = PKW(P1, 14), pw3); \
    l_reg += sacc; \
    MASKB(C0, C1, t, MC); \
    if (GM) { MLOAD(MN, (t) + 1); } if (GK) { DMA_K((t) + 3, sl_cur); } if (GV) { DMA_V((t) + 1, sl_next); } \
    { float a = MX3(C0[0], C0[1], C1[0]), b_ = MX3(C0[2], C0[3], C1[1]); a = MX3(a, C1[2], C1[3]); \
      _Pragma("unroll") for (int r = 4; r < 16; r += 4) { a = MX3(a, C0[r], C0[r + 1]); b_ = MX3(b_, C0[r + 2], C0[r + 3]); a = MX3(a, C1[r], C1[r + 1]); b_ = MX3(b_, C1[r + 2], C1[r + 3]); } \
      float rm = __builtin_fmaxf(a, b_); { auto rr = __builtin_amdgcn_permlane32_swap(__float_as_uint(rm), __float_as_uint(rm), false, false); rm = __builtin_fmaxf(__uint_as_float(rr[0]), __uint_as_float(rr[1])); } \
      resc = false; \
      if (__builtin_expect(__any(rm > (float)THRL), 0)) { const float dl = __builtin_fmaxf(rm, 0.f); mhat += dl; \
        _Pragma("unroll") for (int r = 0; r < 16; ++r) { C0[r] -= dl; C1[r] -= dl; } \
        _Pragma("unroll") for (int r = 0; r < 16; ++r) negm[r] = -mhat; asm volatile("" : "+v"(negm)); \
        const float f = __builtin_amdgcn_exp2f(-dl); l_reg *= f; if (hi == 0) wsf[r32] = f; resc = true; } } \
    SBAR(); \
    GAPB(o[0] = __builtin_amdgcn_mfma_f32_32x32x16_bf16(PAF(0), VFR(0), o[0], 0, 0, 0), C0, 0); \
    GAPB(o[1] = __builtin_amdgcn_mfma_f32_32x32x16_bf16(PAF(0), VFR(4), o[1], 0, 0, 0), C0, 4); \
    KRD(GL, 0); GAPB(o[0] = __builtin_amdgcn_mfma_f32_32x32x16_bf16(PAF(1), VFR(1), o[0], 0, 0, 0), C0, 8); \
    KRD(GL, 1); GAPB(o[1] = __builtin_amdgcn_mfma_f32_32x32x16_bf16(PAF(1), VFR(5), o[1], 0, 0, 0), C0, 12); \
    KRD(GL, 2); GAPB(o[0] = __builtin_amdgcn_mfma_f32_32x32x16_bf16(PAF(2), VFR(2), o[0], 0, 0, 0), C1, 0); \
    KRD(GL, 3); GAPB(o[1] = __builtin_amdgcn_mfma_f32_32x32x16_bf16(PAF(2), VFR(6), o[1], 0, 0, 0), C1, 4); \
    GAPB(o[0] = __builtin_amdgcn_mfma_f32_32x32x16_bf16(PAF(3), VFR(3), o[0], 0, 0, 0), C1, 8); \
    GAPB(o[1] = __builtin_amdgcn_mfma_f32_32x32x16_bf16(PAF(3), VFR(7), o[1], 0, 0, 0), C1, 12); \
    } while (0)
    int t = 1;
    for (; t + 5 < NT; t += 2) {
        STEP(pB0, pB1, pA0, pA1, t, mB, mA, true, true, true, true);       WAIT_BAR(2, mA); RESC(); ROT();
        STEP(pA0, pA1, pB0, pB1, t + 1, mA, mB, true, true, true, true);   WAIT_BAR(2, mB); RESC(); ROT();
    }
#define ENDW(tt, M) do { if ((tt) + 3 < NT) { WAIT_BAR(2, M); } else if ((tt) + 2 < NT) { WAIT_BAR(1, M); } else { WAIT_BAR(0, M); } } while (0)
#define STEP_NONE(t, MN, GM, GK, GV) do { if (GM) { MLOAD(MN, (t) + 1); } if (GK) { DMA_K((t) + 3, sl_cur); } if (GV) { DMA_V((t) + 1, sl_next); } resc = false; } while (0)
    for (; t + 3 < NT; t += 2) {
        STEP(pB0, pB1, pA0, pA1, t, mB, mA, (t + 1 < NT), (t + 3 < NT), (t + 1 < NT), (t + 1 < NT));         ENDW(t, mA);     RESC(); ROT();
        STEP(pA0, pA1, pB0, pB1, t + 1, mA, mB, (t + 2 < NT), (t + 4 < NT), (t + 2 < NT), (t + 2 < NT));     ENDW(t + 1, mB); RESC(); ROT();
    }
    const int cw = cwv - (NT - 4);
    STEP(pB0, pB1, pA0, pA1, NT - 3, mB, mA, true, false, true, true); WAIT_BAR(1, mA); RESC(); ROT();
    if (cw >= 1) {
        STEP(pA0, pA1, pB0, pB1, NT - 2, mA, mB, true, false, true, true); WAIT_BAR(0, mB); RESC(); ROT();
        if (cw >= 2) { STEP(pB0, pB1, pA0, pA1, NT - 1, mB, mA, false, false, false, false); RESC(); }
        else { STEP_NONE(NT - 1, mA, false, false, false); }
    } else {
        STEP_NONE(NT - 2, mB, true, false, true); WAIT_BAR(0, mB); ROT();
        STEP_NONE(NT - 1, mA, false, false, false);
    }
    if (cw == 3) { float sacc = pB0[0] + pB0[1];
#pragma unroll
      for (int r = 2; r < 16; ++r) sacc += pB0[r];
#pragma unroll
      for (int r = 0; r < 16; ++r) sacc += pB1[r];
      l_reg += sacc;
      pw0 = (u32x4){PKW(pB0, 0), PKW(pB0, 2), PKW(pB0, 4), PKW(pB0, 6)}; pw1 = (u32x4){PKW(pB0, 8), PKW(pB0, 10), PKW(pB0, 12), PKW(pB0, 14)};
      pw2 = (u32x4){PKW(pB1, 0), PKW(pB1, 2), PKW(pB1, 4), PKW(pB1, 6)}; pw3 = (u32x4){PKW(pB1, 8), PKW(pB1, 10), PKW(pB1, 12), PKW(pB1, 14)};
      SBAR(); pv(o, vb0 + sl_cur, PAF(0), PAF(1), PAF(2), PAF(3)); }
    asm volatile("s_waitcnt lgkmcnt(0)\n\ts_barrier" ::: "memory");
    if (prefetch_next) { DMA_K(0, 0); DMA_V(0, 0); DMA_K(1, SLOTB); }
    { auto rr = __builtin_amdgcn_permlane32_swap(__float_as_uint(l_reg), __float_as_uint(l_reg), false, false); l_reg = __uint_as_float(rr[0]) + __uint_as_float(rr[1]); }
    if (hi == 0) wsf[32 + r32] = l_reg; asm volatile("s_waitcnt lgkmcnt(0)" ::: "memory");
    float rli[16];
#pragma unroll
    for (int r = 0; r < 16; ++r) rli[r] = __builtin_amdgcn_rcpf(wsf[32 + crow(r, hi)]);
    { LAS bf16* stg = (LAS bf16*)(shm + LDS_OST) + wid * 2048;
#pragma unroll
      for (int r = 0; r < 16; ++r) { const int orow = crow(r, hi);
          stg[orow * 64 + r32] = (bf16)(cvtpk_s(o[0][r] * rli[r] * ms0, 0.f) & 0xffffu); stg[orow * 64 + 32 + r32] = (bf16)(cvtpk_s(o[1][r] * rli[r] * ms1, 0.f) & 0xffffu); }
      asm volatile("s_waitcnt lgkmcnt(0)" ::: "memory");
      int ln2 = lane; asm volatile("" : "+v"(ln2));
#pragma unroll
      for (int i = 0; i < 4; ++i) { const int row = i * 8 + (ln2 >> 3), ch = ln2 & 7; const u32x4 v = *(const LAS u32x4*)(stg + row * 64 + ch * 8);
          *(u32x4*)(MIX + (rowbase + qw + row) * DM + h * HD + ch * 8) = v; } }
    asm volatile("s_waitcnt lgkmcnt(0)" ::: "memory");
#undef QRD
#undef DMA_K
#undef DMA_V
#undef MLOAD
#undef WAIT_BAR
#undef MASKB
#undef START
#undef RESC
#undef ROT
#undef PKW
#undef PAF
#undef VFR
#undef PIN
#undef MX3
#undef GAPA
#undef GAPB
#undef EX
#undef VRD
#undef KRD
#undef STEP_NONE
#undef STEP
#undef ENDW
}
#undef SBAR
}

__device__ __forceinline__ void p_attn(Frame& F, int l) {
    const bf16* Q = WSP(bf16, WS_Q); const bf16* Kg = WSP(bf16, WS_K); const bf16* Vg = WSP(bf16, WS_V); bf16* MIX = WSP(bf16, WS_MIX);
    const unsigned long long* maskQ = WSP(unsigned long long, WS_MASK);
    LAS unsigned char* shm = F.lds + RING_OFF;
    const int tid = F.tid, lane = F.lane, r32 = lane & 31;
    const int bh = F.vcu >> 2, sq = F.vcu & 3, b = bh >> 3, h = bh & 7;
    LAS float* biasT = (LAS float*)(shm + at::LDS_BIAS);
    if (tid < 192) { const int rel = tid - 128, nn = rel < 0 ? -rel : rel; int bk = nn;
        if (nn >= 8) bk = 8 + (nn >= 12) + (nn >= 16) + (nn >= 23) + (nn >= 32) + (nn >= 46) + (nn >= 64) + (nn >= 91);
        bk += (rel > 0) ? 16 : 0;
        biasT[tid] = (arg_in(7)[bk * NH + h] - arg_in(7)[15 * NH + h]) * LOG2E; }
    __syncthreads();
    const float ms0 = arg_in(6)[l * DM + h * 64 + r32], ms1 = arg_in(6)[l * DM + h * 64 + 32 + r32];
    for (int ui = 0; ui < 4; ++ui) {
        const int qb = (ui == 0) ? sq : (ui == 1) ? 7 - sq : (ui == 2) ? 8 + sq : 15 - sq;
        at::attn_unit<8>(b, h, qb, Q, Kg, Vg, maskQ, MIX, ms0, ms1, shm, tid, ui > 0, ui < 3);
        if (ui == sq) convert_ffn(F, l);
    }
}


#define REP(bit) for (int rep_ = 0; rep_ < (((PROBE_MASK) >> (bit)) & 1) + 1; ++rep_)
struct Args { const float* in[20]; float* out; unsigned char* ws; int seg_lo, seg_hi; };
constexpr int N_SEG = 1 + 2 * 8 + 2 * 9;

__global__ void __launch_bounds__(NTHR, 2) fwd_kernel(Args a) {
    extern __shared__ __attribute__((aligned(16))) unsigned char lds_raw[];
    Frame F0;
    F0.lds = (LAS unsigned char*)lds_raw;
    F0.tid = threadIdx.x; F0.lane = F0.tid & 63; F0.wave = __builtin_amdgcn_readfirstlane(F0.tid >> 6);
    F0.G = gridDim.x; { const int bx = blockIdx.x; F0.vcu = (F0.G % 8 == 0) ? (bx % 8) * (F0.G / 8) + bx / 8 : bx; }
    F0.ws = a.ws;
    for (int u = F0.tid; u < (LDS_BYTES - LDSCTL_OFF) / 4; u += NTHR) ((LAS unsigned*)(F0.lds + LDSCTL_OFF))[u] = 0u;
    __syncthreads();
    unsigned* ctl = (unsigned*)(F0.ws + WS_CTL);
    XcdBarrier bar = xcd_barrier_post(ctl + CW_BAR, (volatile LAS unsigned*)(F0.lds + MISC_OFF + 32));
    int sg = 0;
    const int lo = a.seg_lo, hi = a.seg_hi;
#define ACTIVE (lo <= sg && sg < hi)
#define SEAM() do { if (lo <= sg && sg + 1 < hi) xcd_barrier(bar); ++sg; } while (0)

    if (ACTIVE) { Frame F = fresh(F0); cvt_x(F); convert_weights(F, 0); }
    SEAM();
    for (int l = 0; l < DEPTH; ++l) {
        if (ACTIVE) REP(3) {
            {
                Frame F = fresh(F0);
                pg8::DenseOrderG S; S.init_tiles(M / 256, 10, F.G, (int)(F.G % 8 == 0 ? (F.vcu % (F.G / 8)) * 8 + F.vcu / (F.G / 8) : F.vcu)); S.Bt = (const char*)WSP(unsigned char, WS_WIN); S.K = DM / 2;
                pg8::EpiIn E{WSP(bf16, WS_Q), WSP(bf16, WS_K), WSP(bf16, WS_V), WSP(bf16, WS_QI), WSP(bf16, WS_KI), WSP(bf16, WS_U), WSP(float, WS_WI), 0, 1.0f / (pg8::F8_ASC * pg8::F8_WGU), 6};
                pg8::gemm_phase<pg8::EpiIn, pg8::DenseOrderG, true, true, true>(F.tid, F.lds + RING_OFF, (const char*)WSP(unsigned char, WS_XQ), DM / 2, S, E);
            }
            {
                Frame F = fresh(F0);
                pg8::DenseOrder S; S.init_tiles(M / 256, 3, F.G, (int)(F.G % 8 == 0 ? (F.vcu % (F.G / 8)) * 8 + F.vcu / (F.G / 8) : F.vcu)); S.Bt = (const char*)(WSP(bf16, WS_WIN) + (size_t)1536 * DM); S.K = DM;
                pg8::EpiIn E{WSP(bf16, WS_Q), WSP(bf16, WS_K), WSP(bf16, WS_V), WSP(bf16, WS_QI), WSP(bf16, WS_KI), WSP(bf16, WS_U), WSP(float, WS_WI), 6, 1.0f, 99};
                pg8::gemm_phase<pg8::EpiIn, pg8::DenseOrder, true, true>(F.tid, F.lds + RING_OFF, (const char*)WSP(bf16, WS_XB), DM, S, E);
            }
        }
        SEAM();
        if (ACTIVE) {
            const bool conv_first = (F0.vcu & 1) != 0;
#pragma nounroll
            for (int k2 = 0; k2 < 2; ++k2) {
                if ((k2 == 0) == conv_first) { REP(1) { Frame F = fresh(F0); p_conv(F, l); } }
                else { REP(0) { Frame F = fresh(F0); p_idx(F, l); } }
            }
        }
        SEAM();
        if (ACTIVE) {
#ifndef NO_ATTN
            REP(2) { Frame F = fresh(F0); p_attn(F, l); }
#endif
        }
        SEAM();
        if (ACTIVE) REP(4) { Frame F = fresh(F0); bf16* R1 = WSP(bf16, WS_R1);
            pg8::DenseOrder S; S.init_tiles(M / 256, DM / 256, F.G, (int)(F.G % 8 == 0 ? (F.vcu % (F.G / 8)) * 8 + F.vcu / (F.G / 8) : F.vcu)); S.Bt = (const char*)WSP(bf16, WS_WOUT); S.K = DM;
            pg8::EpiBranch E{R1, 1.0f};
            pg8::gemm_phase<pg8::EpiBranch, pg8::DenseOrder, true, true>(F.tid, F.lds + RING_OFF, (const char*)WSP(bf16, WS_MIX), DM, S, E);
        }
        SEAM();
        if (ACTIVE) { Frame F = fresh(F0); p_ln1(F, l); }
        SEAM();
        if ((l & 1) == 0) {
            if (ACTIVE) REP(5) { Frame F = fresh(F0);
                pg8::DenseOrderG S; S.init_tiles(M / 256, 2 * DFF / 256, F.G, (int)(F.G % 8 == 0 ? (F.vcu % (F.G / 8)) * 8 + F.vcu / (F.G / 8) : F.vcu)); S.Bt = (const char*)WSP(bf16, WS_WFF); S.K = DM / 2;
                pg8::EpiSwi E{WSP(unsigned char, WS_H), DFF};
                pg8::gemm_phase<pg8::EpiSwi, pg8::DenseOrderG, true, true, true>(F.tid, F.lds + RING_OFF, (const char*)WSP(unsigned char, WS_YD), DM / 2, S, E);
            }
            SEAM();
            if (ACTIVE) { Frame F = fresh(F0); bf16* R1 = WSP(bf16, WS_R1);
                pg8::DenseOrderG S; S.init_tiles(M / 256, DM / 256, F.G, (int)(F.G % 8 == 0 ? (F.vcu % (F.G / 8)) * 8 + F.vcu / (F.G / 8) : F.vcu)); S.Bt = (const char*)(WSP(unsigned char, WS_WFF) + (size_t)2 * DFF * DM); S.K = DFF / 2;
                pg8::EpiBranch E{WSP(bf16, WS_YD), 1.0f / (pg8::F8_HSC * pg8::F8_WDN)};
                pg8::gemm_phase<pg8::EpiBranch, pg8::DenseOrderG, true, true, true>(F.tid, F.lds + RING_OFF, (const char*)WSP(unsigned char, WS_H), DFF / 2, S, E);
            }
            SEAM();
            if (ACTIVE) { REP(11) { Frame F = fresh(F0); p_ln2(F, l); } if (l + 1 < DEPTH) REP(8) { Frame F = fresh(F0); convert_weights(F, l + 1); } }
            SEAM();
        } else {
            if (ACTIVE) { Frame F = fresh(F0); p_list(F); }
            SEAM();
            for (int r = 0; r < 1; ++r) {
                if (ACTIVE) REP(6) { Frame F = fresh(F0);
                    moe_tables(F);
                    const int Tm = ((LAS int*)(F.lds + LDSCTL_OFF + 1200))[8]; const int tlo = r * RT; int nMr = Tm - tlo; nMr = nMr < 0 ? 0 : (nMr > RT ? RT : nMr);
                    pg8::MoeGuOrder S; S.init_tiles(nMr, 2 * DFE / 256, F.G, (int)(F.G % 8 == 0 ? (F.vcu % (F.G / 8)) * 8 + F.vcu / (F.G / 8) : F.vcu)); S.rowlist = WSP(int, WS_ROWLIST); S.texp = (const LAS int*)(F.lds + LDSCTL_OFF); S.tlo = tlo;
                    S.W = (const char*)WSP(unsigned char, WS_WFF); S.estride = (size_t)3 * DFE * DM;
                    pg8::EpiSwi E{WSP(unsigned char, WS_H), DFE};
                    pg8::gemm_phase<pg8::EpiSwi, pg8::MoeGuOrder, true, true, true>(F.tid, F.lds + RING_OFF, (const char*)WSP(unsigned char, WS_YD), DM / 2, S, E);
                }
                SEAM();
                if (ACTIVE) REP(7) { Frame F = fresh(F0);
                    moe_tables(F);
                    const int Tm = ((LAS int*)(F.lds + LDSCTL_OFF + 1200))[8]; const int tlo = r * RT; int nMr = Tm - tlo; nMr = nMr < 0 ? 0 : (nMr > pg8::MOE_T0 ? pg8::MOE_T0 : nMr);
                    pg8::MoeDnOrder S; S.init_tiles(nMr, DM / 256, F.G, (int)(F.G % 8 == 0 ? (F.vcu % (F.G / 8)) * 8 + F.vcu / (F.G / 8) : F.vcu)); S.texp = (const LAS int*)(F.lds + LDSCTL_OFF); S.tlo = tlo;
                    S.W = (const char*)(WSP(unsigned char, WS_WFF) + (size_t)2 * DFE * DM); S.estride = (size_t)3 * DFE * DM;
                    pg8::EpiMoeDown E{WSP(bf16, WS_YD), tlo};
                    pg8::gemm_phase<pg8::EpiMoeDown, pg8::MoeDnOrder, true, true, true>(F.tid, F.lds + RING_OFF, (const char*)WSP(unsigned char, WS_H), DFE / 2, S, E);
                    {
                        int nT = Tm - pg8::MOE_T0; nT = nT < 0 ? 0 : nT;
                        pg8::MoeDnTailOrder S2; S2.init_tiles(nT, 4 * pg8::MOE_NSL, F.G, (int)(F.G % 8 == 0 ? (F.vcu % (F.G / 8)) * 8 + F.vcu / (F.G / 8) : F.vcu)); S2.texp = (const LAS int*)(F.lds + LDSCTL_OFF);
                        S2.W = (const char*)(WSP(unsigned char, WS_WFF) + (size_t)2 * DFE * DM); S2.estride = (size_t)3 * DFE * DM;
                        pg8::EpiMoeDownPart E2{WSP(bf16, WS_MASK)};
                        pg8::gemm_phase<pg8::EpiMoeDownPart, pg8::MoeDnTailOrder, true, true, true>(F.tid, F.lds + RING_OFF, (const char*)WSP(unsigned char, WS_H), pg8::MOE_KSL / 2, S2, E2, DFE / 2);
                    }
                }
                SEAM();
            }
            if (ACTIVE) { REP(10) { Frame F = fresh(F0); p_comb(F, l); } if (l + 1 < DEPTH) REP(8) { Frame F = fresh(F0); convert_weights(F, l + 1); } }
            SEAM();
        }
    }
#undef ACTIVE
#undef SEAM
}

#ifndef MK_MULTI
#define MK_MULTI 0
#endif
extern "C" void kernel_launch(void* const* d_in, const int* in_sizes, int n_in, void* d_out, int out_size, void* d_ws, size_t ws_size, hipStream_t stream) {
    static int grid = 0;
    if (grid == 0) {
        if (n_in != 20 || in_sizes[0] != M * DM || out_size != M * DM || ws_size < WS_END) { fprintf(stderr, "kernel_launch: unexpected shapes (n_in %d, in0 %d, out %d, ws %zu, need %zu); nothing launched\n", n_in, n_in > 0 ? in_sizes[0] : -1, out_size, ws_size, (size_t)WS_END); grid = -1; return; }
        int dev = 0, cus = 0, per_cu = 0;
        if (hipGetDevice(&dev) != hipSuccess || hipDeviceGetAttribute(&cus, hipDeviceAttributeMultiprocessorCount, dev) != hipSuccess) { grid = -1; return; }
        if (hipFuncSetAttribute((const void*)fwd_kernel, hipFuncAttributeMaxDynamicSharedMemorySize, LDS_BYTES) != hipSuccess) { fprintf(stderr, "kernel_launch: hipFuncSetAttribute failed\n"); grid = -1; return; }
        if (hipOccupancyMaxActiveBlocksPerMultiprocessor(&per_cu, (const void*)fwd_kernel, NTHR, LDS_BYTES) != hipSuccess || per_cu < 1) fprintf(stderr, "kernel_launch: occupancy query reports %d\n", per_cu);
        (void)hipGetLastError();
        grid = cus;
        if (grid != 256) { fprintf(stderr, "kernel_launch: built for 256 CUs, device has %d; nothing launched\n", cus); grid = -1; return; }
    }
    if (grid < 0) return;
    if (hipMemsetAsync((char*)d_ws + WS_CTL, 0, CTL_ZERO_BYTES, stream) != hipSuccess) return;
    Args a{};
    for (int i = 0; i < 20; ++i) a.in[i] = (const float*)d_in[i];
    a.out = (float*)d_out; a.ws = (unsigned char*)d_ws;
#if MK_MULTI
    for (int s = 0; s < N_SEG; ++s) { a.seg_lo = s; a.seg_hi = s + 1; hipLaunchKernelGGL(fwd_kernel, dim3(grid), dim3(NTHR), LDS_BYTES, stream, a); }
#else
    a.seg_lo = 0; a.seg_hi = N_SEG;
    hipLaunchKernelGGL(fwd_kernel, dim3(grid), dim3(NTHR), LDS_BYTES, stream, a);
#endif
    const hipError_t le = hipPeekAtLastError();
    if (le != hipSuccess) fprintf(stderr, "kernel_launch: launch failed: %s\n", hipGetErrorName(le));
}
```
